# Optimizing an MI355X kernel written in HIP

```python
import math
import jax, jax.numpy as jnp
from jax import lax
import numpy as np

D_MODEL = 2048
BATCH = 32
SEQ = 256
DEPTH = 4
DEC_BATCH = 2
DEC_SEQ = 1024
PAST_LEN = 256

GRID_W = 64
MIX_W = D_MODEL
MLA_HEADS = 8
MLA_NOPE = 128
MLA_ROPE = 64
MLA_QK = MLA_NOPE + MLA_ROPE
MLA_V = 128
MLA_Q_RANK = 768
MLA_KV_RANK = 512
ROPE_F = MLA_ROPE // 4
ROPE_BASE = 10000.0
Q_BLOCK = 128
GDN_HEADS = 4
GDN_DK = 128
GDN_DV = 128
GDN_CHUNK = 64
SSD_HEADS = 8
SSD_P = 64
SSD_GROUPS = 2
SSD_N = 128
SSD_CHUNK = 128
SSD_INNER = SSD_HEADS * SSD_P
CONV_W = 5
FF = -(-8 * D_MODEL // (3 * 256)) * 256
MLA_IN = MLA_Q_RANK + MLA_KV_RANK + MLA_ROPE
GDN_QK = GDN_HEADS * GDN_DK
GDN_VW = GDN_HEADS * GDN_DV
GDN_IN = 2 * GDN_QK + 2 * GDN_VW + 4 * GDN_HEADS
SSD_XBC = SSD_INNER + 2 * SSD_GROUPS * SSD_N
SSD_IN = SSD_INNER + SSD_XBC + 2 * SSD_HEADS
IN_W = MLA_IN + GDN_IN + SSD_IN
EPS = 1e-6

kernel_name = "hybrid_mla_gdn_ssd_diffusion_step"

f32 = jnp.float32


def rmsnorm(x, g):
    xf = x.astype(f32)
    y = xf * lax.rsqrt(jnp.mean(xf * xf, -1, keepdims=True) + EPS)
    return (y * g.astype(f32)).astype(x.dtype)


def l2norm(x):
    xf = x.astype(f32)
    return (xf * lax.rsqrt(jnp.sum(xf * xf, -1, keepdims=True) + EPS)).astype(x.dtype)


def dwconv_centred(x, w):
    pad = (w.shape[0] - 1) // 2
    return lax.conv_general_dilated(x, w[:, None, :].astype(x.dtype), (1,), [(pad, pad)],
                                    dimension_numbers=('NWC', 'WIO', 'NWC'),
                                    feature_group_count=x.shape[-1])


def axial_rope_tables(n_tokens):
    rows = n_tokens // GRID_W
    row = jnp.repeat(jnp.arange(rows, dtype=f32), GRID_W)
    col = jnp.tile(jnp.arange(GRID_W, dtype=f32), rows)
    inv = ROPE_BASE ** (-jnp.arange(ROPE_F, dtype=f32) / ROPE_F)
    ang = jnp.stack([row[:, None] * inv, col[:, None] * inv], axis=1)
    return jnp.cos(ang), jnp.sin(ang)


def rope2d(u, cos, sin):
    sh = u.shape
    uf = u.astype(f32).reshape(sh[:-1] + (2, 2, ROPE_F))
    c, s = cos[:, None], sin[:, None]
    u1, u2 = uf[..., 0, :], uf[..., 1, :]
    out = jnp.stack([u1 * c - u2 * s, u2 * c + u1 * s], axis=-2)
    return out.reshape(sh).astype(u.dtype)


def rope_tail(t, rope):
    cos, sin = rope
    return jnp.concatenate([t[..., :MLA_NOPE], rope2d(t[..., MLA_NOPE:], cos, sin)], -1)


def softmax_attention(q, k, v):
    B, Tq, H, D = q.shape
    nb = Tq // Q_BLOCK
    scale = D ** -0.5
    qb = q.reshape(B, nb, Q_BLOCK, H, D).swapaxes(0, 1)

    def block(qi):
        s = jnp.einsum('bqhd,bkhd->bhqk', qi, k).astype(f32) * scale
        pr = jax.nn.softmax(s, axis=-1).astype(v.dtype)
        return jnp.einsum('bhqk,bkhd->bqhd', pr, v)

    o = lax.map(block, qb)
    return o.swapaxes(0, 1).reshape(B, Tq, H, v.shape[-1])


def mla_keys_values(ckv, krope, p, l):
    B, T, _ = ckv.shape
    kv = (ckv @ p['mla_w_ukv'][l]).reshape(B, T, MLA_HEADS, MLA_NOPE + MLA_V)
    k_nope, v = kv[..., :MLA_NOPE], kv[..., MLA_NOPE:]
    k_pe = jnp.broadcast_to(krope[:, :, None, :], (B, T, MLA_HEADS, MLA_ROPE)).astype(k_nope.dtype)
    k = jnp.concatenate([k_nope, k_pe], -1)
    return rmsnorm(k, p['mla_k_g'][l]), v


def mla(u, p, l, rope, ctx_ckv, ctx_krope):
    B, T, _ = u.shape
    cq, ckv, krope = jnp.split(u, [MLA_Q_RANK, MLA_Q_RANK + MLA_KV_RANK], -1)
    ckv = rmsnorm(ckv, p['mla_kvnorm_g'][l])
    q = (rmsnorm(cq, p['mla_qnorm_g'][l]) @ p['mla_w_uq'][l]).reshape(B, T, MLA_HEADS, MLA_QK)
    q = rmsnorm(q, p['mla_q_g'][l])
    k, v = mla_keys_values(ckv, krope, p, l)
    if rope is not None:
        q = rope_tail(q, rope)
        k = rope_tail(k, rope)
    if ctx_ckv is not None:
        kc, vc = mla_keys_values(ctx_ckv.astype(u.dtype), ctx_krope.astype(u.dtype), p, l)
        k = jnp.concatenate([kc, k], 1)
        v = jnp.concatenate([vc, v], 1)
    o = softmax_attention(q, k, v)
    return o.reshape(B, T, MLA_HEADS * MLA_V), ckv, krope


def delta_rule_chunked(q, k, v, g, beta, s0):
    B, T, H, DK = q.shape
    DV = v.shape[-1]
    C = GDN_CHUNK
    N = T // C
    ch4 = lambda t: t.astype(f32).reshape(B, N, C, H, -1).transpose(1, 0, 3, 2, 4)
    ch3 = lambda t: t.astype(f32).reshape(B, N, C, H).transpose(1, 0, 3, 2)
    q = ch4(q) * (DK ** -0.5)
    k = ch4(k)
    v = ch4(v)
    beta = ch3(beta)
    gc = jnp.cumsum(ch3(g), -1)
    tri = jnp.tril(jnp.ones((C, C), bool))
    strict = jnp.tril(jnp.ones((C, C), bool), -1)
    decay = jnp.exp(jnp.where(tri, gc[..., :, None] - gc[..., None, :], -jnp.inf))
    kb = k * beta[..., None]
    A = jnp.where(strict, jnp.einsum('nbhid,nbhjd->nbhij', kb, k) * decay, 0.0)
    eye = jnp.eye(C, dtype=f32)
    Tm = lax.linalg.triangular_solve(A + eye, jnp.broadcast_to(eye, A.shape), left_side=True,
                                     lower=True, unit_diagonal=True)
    w = Tm @ (kb * jnp.exp(gc)[..., None])
    uu = Tm @ (v * beta[..., None])
    qk = jnp.where(tri, jnp.einsum('nbhid,nbhjd->nbhij', q, k) * decay, 0.0)

    def step(S, inp):
        qi, ki, ui, wi, gi, ai = inp
        v_new = ui - wi @ S
        o = (qi * jnp.exp(gi)[..., None]) @ S + ai @ v_new
        gl = gi[..., -1]
        S = S * jnp.exp(gl)[..., None, None] + jnp.einsum(
            'bhcd,bhce->bhde', ki * jnp.exp(gl[..., None] - gi)[..., None], v_new)
        return S, o

    s_fin, o = lax.scan(step, s0.astype(f32), (q, k, uu, w, gc, qk))
    return o.transpose(1, 0, 3, 2, 4).reshape(B, T, H, DV), s_fin


def gated_deltanet(u, p, l, s0):
    B, T, _ = u.shape
    qkv, z, b, a = jnp.split(u, [2 * GDN_QK + GDN_VW, 2 * GDN_QK + 2 * GDN_VW,
                                 2 * GDN_QK + 2 * GDN_VW + 2 * GDN_HEADS], -1)
    qkv = jax.nn.silu(dwconv_centred(qkv, p['gdn_conv_w'][l]))
    q, k, v = jnp.split(qkv, [GDN_QK, 2 * GDN_QK], -1)
    q = l2norm(q.reshape(B, T, GDN_HEADS, GDN_DK))
    k = l2norm(k.reshape(B, T, GDN_HEADS, GDN_DK))
    v = v.reshape(B, T, GDN_HEADS, GDN_DV)
    beta = jax.nn.sigmoid(b.astype(f32)).reshape(B, T, 2, GDN_HEADS)
    g = -jnp.exp(p['gdn_a_log'][l].astype(f32)) * jax.nn.softplus(
        a.astype(f32).reshape(B, T, 2, GDN_HEADS) + p['gdn_dt_bias'][l].astype(f32))
    if s0 is None:
        s0 = jnp.zeros((B, 2, GDN_HEADS, GDN_DK, GDN_DV), f32)
    flip = lambda t: jnp.flip(t, 1)
    o_f, s_f = delta_rule_chunked(q, k, v, g[:, :, 0], beta[:, :, 0], s0[:, 0])
    o_b, s_b = delta_rule_chunked(flip(q), flip(k), flip(v), flip(g[:, :, 1]), flip(beta[:, :, 1]), s0[:, 1])
    o = o_f + flip(o_b)
    o = rmsnorm(o, p['gdn_norm_g'][l]) * jax.nn.silu(z.astype(f32).reshape(B, T, GDN_HEADS, GDN_DV))
    return o.reshape(B, T, GDN_VW).astype(u.dtype), jnp.stack([s_f, s_b], 1).astype(u.dtype)


def ssd_chunked(x, dt, A, Bm, Cm, s0):
    B, T, H, P = x.shape
    Q = SSD_CHUNK
    nc = T // Q
    rep = H // Bm.shape[2]
    Bh = jnp.repeat(Bm.astype(f32), rep, 2).reshape(B, nc, Q, H, -1)
    Ch = jnp.repeat(Cm.astype(f32), rep, 2).reshape(B, nc, Q, H, -1)
    xdt = (x.astype(f32) * dt[..., None]).reshape(B, nc, Q, H, P)
    acum = jnp.cumsum((dt * A).reshape(B, nc, Q, H).transpose(0, 3, 1, 2), -1)
    tri = jnp.tril(jnp.ones((Q, Q), bool))
    Lmat = jnp.exp(jnp.where(tri, acum[..., :, None] - acum[..., None, :], -jnp.inf))
    scores = jnp.einsum('bclhn,bcshn->bhcls', Ch, Bh) * Lmat
    y = jnp.einsum('bhcls,bcshp->bclhp', scores, xdt)
    decay_to_end = jnp.exp(acum[..., -1:] - acum)
    chunk_states = jnp.einsum('bcshn,bhcs,bcshp->cbhpn', Bh, decay_to_end, xdt)
    chunk_decay = jnp.exp(acum[..., -1]).transpose(2, 0, 1)

    def step(S, inp):
        st, dec = inp
        return S * dec[..., None, None] + st, S

    s_fin, s_start = lax.scan(step, s0.astype(f32), (chunk_states, chunk_decay))
    y = y + jnp.einsum('bclhn,cbhpn,bhcl->bclhp', Ch, s_start, jnp.exp(acum))
    return y.reshape(B, T, H, P), s_fin


def mamba2_ssd(u, p, l, s0):
    B, T, _ = u.shape
    z, xbc, dt2 = jnp.split(u, [SSD_INNER, SSD_INNER + SSD_XBC], -1)
    xbc = jax.nn.silu(dwconv_centred(xbc, p['ssd_conv_w'][l]) + p['ssd_conv_b'][l])
    x, Bm, Cm = jnp.split(xbc, [SSD_INNER, SSD_INNER + SSD_GROUPS * SSD_N], -1)
    x = x.reshape(B, T, SSD_HEADS, SSD_P)
    Bm = Bm.reshape(B, T, SSD_GROUPS, SSD_N)
    Cm = Cm.reshape(B, T, SSD_GROUPS, SSD_N)
    dt = jax.nn.softplus(dt2.astype(f32).reshape(B, T, 2, SSD_HEADS) + p['ssd_dt_bias'][l].astype(f32))
    A = -jnp.exp(p['ssd_a_log'][l].astype(f32))
    if s0 is None:
        s0 = jnp.zeros((B, 2, SSD_HEADS, SSD_P, SSD_N), f32)
    flip = lambda t: jnp.flip(t, 1)
    y_f, s_f = ssd_chunked(x, dt[:, :, 0], A[0], Bm, Cm, s0[:, 0])
    y_b, s_b = ssd_chunked(flip(x), flip(dt[:, :, 1]), A[1], flip(Bm), flip(Cm), s0[:, 1])
    y = y_f + flip(y_b) + x.astype(f32) * p['ssd_d'][l].astype(f32)[:, None]
    y = y.reshape(B, T, SSD_INNER) * jax.nn.silu(z.astype(f32))
    y = rmsnorm(y.reshape(B, T, SSD_GROUPS, SSD_INNER // SSD_GROUPS),
                p['ssd_norm_g'][l].reshape(SSD_GROUPS, SSD_INNER // SSD_GROUPS))
    return y.reshape(B, T, SSD_INNER).astype(u.dtype), jnp.stack([s_f, s_b], 1).astype(u.dtype)


def trunk_layer(x, cvec, p, l, rope, ctx):
    mods = (jax.nn.silu(cvec) @ p['ada_w'][l] + p['ada_b'][l]).reshape(cvec.shape[0], 6, 1, D_MODEL)
    shift1, scale1, gate1, shift2, scale2, gate2 = mods.transpose(1, 0, 2, 3)
    h = rmsnorm(x, p['norm1_g'][l]) * (1 + scale1) + shift1
    u = h @ p['w_in'][l]
    u_mla, u_gdn, u_ssd = jnp.split(u, [MLA_IN, MLA_IN + GDN_IN], -1)
    ctx_ckv, ctx_kr, s_gdn0, s_ssd0 = ctx if ctx is not None else (None, None, None, None)
    o_mla, ckv, kr = mla(u_mla, p, l, rope, ctx_ckv, ctx_kr)
    o_gdn, s_gdn = gated_deltanet(u_gdn, p, l, s_gdn0)
    o_ssd, s_ssd = mamba2_ssd(u_ssd, p, l, s_ssd0)
    mixed = jnp.concatenate([o_mla, o_gdn, o_ssd], -1) @ p['w_out'][l]
    x = x + gate1 * mixed
    h = rmsnorm(x, p['norm2_g'][l]) * (1 + scale2) + shift2
    gt, up = jnp.split(h @ p['ffn_w_gu'][l], 2, -1)
    x = x + gate2 * ((jax.nn.silu(gt) * up) @ p['ffn_w_down'][l])
    return x, (ckv, kr, s_gdn, s_ssd)


def setup_inputs(seed: int = 0) -> dict:
    key = jax.random.key(seed)
    ks = iter(jax.random.split(key, 40))
    nrm = lambda shape, s: jax.random.normal(next(ks), shape, f32) * s
    gain = lambda shape: 1.0 + 0.02 * jax.random.normal(next(ks), shape, f32)

    def dt_bias(shape):
        dt = jnp.exp(jax.random.uniform(next(ks), shape, f32, math.log(1e-3), math.log(1e-1)))
        return dt + jnp.log(-jnp.expm1(-dt))

    a_log = lambda shape: jnp.log(jax.random.uniform(next(ks), shape, f32, 1.0, 16.0))
    L = DEPTH
    return {
        'x_prompt': nrm((BATCH, SEQ, D_MODEL), 1.0),
        'x_sample': nrm((DEC_BATCH, DEC_SEQ, D_MODEL), 1.0),
        'cache_mla_ckv': nrm((DEC_BATCH, L, PAST_LEN, MLA_KV_RANK), 1.0),
        'cache_mla_krope': nrm((DEC_BATCH, L, PAST_LEN, MLA_ROPE), 1.0),
        'state_gdn': nrm((DEC_BATCH, L, 2, GDN_HEADS, GDN_DK, GDN_DV), 0.1),
        'state_ssd': nrm((DEC_BATCH, L, 2, SSD_HEADS, SSD_P, SSD_N), 0.1),
        'c': nrm((DEC_BATCH, D_MODEL), 1.0),
        'c_ctx': nrm((D_MODEL,), 1.0),
        'norm1_g': gain((L, D_MODEL)),
        'norm2_g': gain((L, D_MODEL)),
        'ada_w': nrm((L, D_MODEL, 6 * D_MODEL), 0.5 * D_MODEL ** -0.5),
        'ada_b': nrm((L, 6 * D_MODEL), 0.01),
        'w_in': nrm((L, D_MODEL, IN_W), D_MODEL ** -0.5),
        'w_out': nrm((L, MIX_W, D_MODEL), MIX_W ** -0.5),
        'mla_qnorm_g': gain((L, MLA_Q_RANK)),
        'mla_w_uq': nrm((L, MLA_Q_RANK, MLA_HEADS * MLA_QK), MLA_Q_RANK ** -0.5),
        'mla_kvnorm_g': gain((L, MLA_KV_RANK)),
        'mla_w_ukv': nrm((L, MLA_KV_RANK, MLA_HEADS * (MLA_NOPE + MLA_V)), MLA_KV_RANK ** -0.5),
        'mla_q_g': gain((L, MLA_QK)),
        'mla_k_g': gain((L, MLA_QK)),
        'gdn_conv_w': nrm((L, CONV_W, 2 * GDN_QK + GDN_VW), CONV_W ** -0.5),
        'gdn_a_log': a_log((L, 2, GDN_HEADS)),
        'gdn_dt_bias': dt_bias((L, 2, GDN_HEADS)),
        'gdn_norm_g': gain((L, GDN_DV)),
        'ssd_conv_w': nrm((L, CONV_W, SSD_XBC), CONV_W ** -0.5),
        'ssd_conv_b': nrm((L, SSD_XBC), 0.01),
        'ssd_a_log': a_log((L, 2, SSD_HEADS)),
        'ssd_dt_bias': dt_bias((L, 2, SSD_HEADS)),
        'ssd_d': gain((L, SSD_HEADS)),
        'ssd_norm_g': gain((L, SSD_INNER)),
        'ffn_w_gu': nrm((L, D_MODEL, 2 * FF), D_MODEL ** -0.5),
        'ffn_w_down': nrm((L, FF, D_MODEL), FF ** -0.5),
    }


def reference(x_prompt, x_sample, cache_mla_ckv, cache_mla_krope, state_gdn, state_ssd, c, c_ctx,
              norm1_g, norm2_g, ada_w, ada_b, w_in, w_out, mla_qnorm_g, mla_w_uq, mla_kvnorm_g,
              mla_w_ukv, mla_q_g, mla_k_g, gdn_conv_w, gdn_a_log, gdn_dt_bias, gdn_norm_g,
              ssd_conv_w, ssd_conv_b, ssd_a_log, ssd_dt_bias, ssd_d, ssd_norm_g, ffn_w_gu, ffn_w_down):
    p = dict(norm1_g=norm1_g, norm2_g=norm2_g, ada_w=ada_w, ada_b=ada_b, w_in=w_in, w_out=w_out,
             mla_qnorm_g=mla_qnorm_g, mla_w_uq=mla_w_uq, mla_kvnorm_g=mla_kvnorm_g,
             mla_w_ukv=mla_w_ukv, mla_q_g=mla_q_g, mla_k_g=mla_k_g, gdn_conv_w=gdn_conv_w,
             gdn_a_log=gdn_a_log, gdn_dt_bias=gdn_dt_bias, gdn_norm_g=gdn_norm_g,
             ssd_conv_w=ssd_conv_w, ssd_conv_b=ssd_conv_b, ssd_a_log=ssd_a_log,
             ssd_dt_bias=ssd_dt_bias, ssd_d=ssd_d, ssd_norm_g=ssd_norm_g,
             ffn_w_gu=ffn_w_gu, ffn_w_down=ffn_w_down)
    xp = x_prompt
    cc = c_ctx[None, :]
    ckvs, krs, sgs, sss = [], [], [], []
    for l in range(DEPTH):
        xp, (ckv, kr, sg, ss) = trunk_layer(xp, cc, p, l, None, None)
        ckvs.append(ckv)
        krs.append(kr)
        sgs.append(sg)
        sss.append(ss)
    rope = axial_rope_tables(x_sample.shape[1])
    xs = x_sample
    for l in range(DEPTH):
        xs, _ = trunk_layer(xs, c, p, l, rope,
                            (cache_mla_ckv[:, l], cache_mla_krope[:, l], state_gdn[:, l], state_ssd[:, l]))
    return (xp, xs, jnp.stack(ckvs, 1), jnp.stack(krs, 1), jnp.stack(sgs, 1), jnp.stack(sss, 1))
```

```cpp
#include <hip/hip_runtime.h>
#include <cstdio>
#include <cstdint>
#include <cstddef>
#ifndef MK_ONE_LAUNCH
#define MK_ONE_LAUNCH 1
#endif
namespace pg8 {
#define PG8_LAS __attribute__((address_space(3)))
typedef unsigned short bf16_t;
typedef short bf16x8 __attribute__((ext_vector_type(8)));
typedef float f32x4 __attribute__((ext_vector_type(4)));
typedef unsigned u32x4 __attribute__((ext_vector_type(4)));
constexpr int BM = 256, BK = 64, HALF = 128, HTB = HALF * BK * 2  , STAGE_BYTES = 8 * HTB, NXCD = 8, WGM = 8;

__host__ __device__ __forceinline__ int lds_byte(int r, int c) { const int st = (r >> 4) * 2 + (c >> 5), rr = r & 15, cc = c & 31, ob = rr * 64 + cc * 2; return st * 1024 + (ob ^ (((ob >> 9) & 1) << 5)); }
__host__ __device__ __forceinline__ void stage_rc(int b, int& R, int& C) { const int st = b / 1024, sb = b % 1024, swz = sb ^ (((sb >> 9) & 1) << 5); R = (st >> 1) * 16 + swz / 64; C = (st & 1) * 32 + (swz % 64) / 2; }
__host__ __device__ __forceinline__ int perm32(int rho) { const int n = rho >> 4, i = rho & 15; return 8 * (i >> 2) + 4 * n + (i & 3); }

struct Unit { int pm, pn; };
struct Gemm { const bf16_t* A; const bf16_t* Bt; int M, N, K; };

struct StaticOrder {
    int nM, nN, nwg, G, c;
    __host__ __device__ void init(int M, int N, int G_, int c_) { nM = M / BM; nN = N / BM; nwg = nM * nN; G = G_; c = c_; }
    __host__ __device__ bool next(int i, Unit& u) const {
        const long L = (long)i * G + c; if (L >= nwg) return false;
        int wgid = (int)L; { const int q = nwg / NXCD, r = nwg % NXCD, xcd = wgid % NXCD, off = wgid / NXCD; wgid = (xcd < r ? xcd * (q + 1) : r * (q + 1) + (xcd - r) * q) + off; }
        const int nig = WGM * nN, gid = wgid / nig, fm = gid * WGM, gsz = (nM - fm) < WGM ? (nM - fm) : WGM;
        u.pm = fm + ((wgid % nig) % gsz); u.pn = (wgid % nig) / gsz; return true;
    }
    __device__ __forceinline__ void a_ready(const Unit&) const {}
    __device__ __forceinline__ void done(const Unit&) const {}
};

__device__ __forceinline__ unsigned cvt_pk_bf16(float lo, float hi) { unsigned r; asm volatile("v_cvt_pk_bf16_f32 %0, %1, %2" : "=v"(r) : "v"(lo), "v"(hi)); return r; }
__device__ __forceinline__ float silu_f(float x) { return x * __builtin_amdgcn_rcpf(1.0f + __expf(-x)); }

struct EpiF32 {
    static constexpr bool PERM = false, AFTER_DRAIN = false;
    float* C; int ldc;
    __device__ __forceinline__ void operator()(const f32x4 (&acc)[2][2][4][2], const Unit& u, int wr, int wc, int fr, int fq) const {
        const int row0 = u.pm * BM + wr * 64 + fr, col0 = u.pn * BM + wc * 32 + 4 * fq;
#pragma unroll
        for (int ai = 0; ai < 2; ++ai)
#pragma unroll
            for (int m = 0; m < 4; ++m) { float* rowp = C + (size_t)(row0 + ai * HALF + m * 16) * ldc + col0;
#pragma unroll
                for (int bj = 0; bj < 2; ++bj)
#pragma unroll
                    for (int n = 0; n < 2; ++n) *(f32x4*)(rowp + bj * HALF + n * 16) = acc[ai][bj][m][n]; }
    }
};
struct EpiBf16 {
    static constexpr bool PERM = true, AFTER_DRAIN = false;
    bf16_t* O; int ldc;
    __device__ __forceinline__ void operator()(const f32x4 (&acc)[2][2][4][2], const Unit& u, int wr, int wc, int fr, int fq) const {
        const int row0 = u.pm * BM + wr * 64 + fr; const int col0 = u.pn * BM + wc * 32 + 8 * fq;
#pragma unroll
        for (int ai = 0; ai < 2; ++ai)
#pragma unroll
            for (int m = 0; m < 4; ++m) { bf16_t* rowp = O + (size_t)(row0 + ai * HALF + m * 16) * ldc + col0;
#pragma unroll
                for (int bj = 0; bj < 2; ++bj) { const f32x4 v0 = acc[ai][bj][m][0], v1 = acc[ai][bj][m][1];
                    u32x4 w; w.x = cvt_pk_bf16(v0[0], v0[1]); w.y = cvt_pk_bf16(v0[2], v0[3]); w.z = cvt_pk_bf16(v1[0], v1[1]); w.w = cvt_pk_bf16(v1[2], v1[3]);
                    *(u32x4*)(rowp + bj * HALF) = w; } }
    }
};
struct EpiResid {
    static constexpr bool PERM = false, AFTER_DRAIN = false;
    float* X; int ldc; const float* gate;
    __device__ __forceinline__ void operator()(const f32x4 (&acc)[2][2][4][2], const Unit& u, int wr, int wc, int fr, int fq) const {
        const int row0 = u.pm * BM + wr * 64 + fr, col0 = u.pn * BM + wc * 32 + 4 * fq;
        const int cr = u.pm < 32 ? 0 : 1 + ((u.pm - 32) >> 2);
        const float* gp = gate + (size_t)cr * 12288 + col0;
        f32x4 gv[2][2];
#pragma unroll
        for (int bj = 0; bj < 2; ++bj)
#pragma unroll
            for (int n = 0; n < 2; ++n) gv[bj][n] = *(const f32x4*)(gp + bj * HALF + n * 16);
#pragma unroll
        for (int ai = 0; ai < 2; ++ai)
#pragma unroll
            for (int m = 0; m < 4; ++m) { float* rowp = X + (size_t)(row0 + ai * HALF + m * 16) * ldc + col0;
#pragma unroll
                for (int bj = 0; bj < 2; ++bj)
#pragma unroll
                    for (int n = 0; n < 2; ++n) { f32x4 x = *(const f32x4*)(rowp + bj * HALF + n * 16); x = x + gv[bj][n] * acc[ai][bj][m][n]; *(f32x4*)(rowp + bj * HALF + n * 16) = x; } }
    }
};
struct EpiSwiglu {
    static constexpr bool PERM = true, AFTER_DRAIN = false;
    bf16_t* O; int ldc;
    __device__ __forceinline__ void operator()(const f32x4 (&acc)[2][2][4][2], const Unit& u, int wr, int wc, int fr, int fq) const {
        const int row0 = u.pm * BM + wr * 64 + fr; const int col0 = u.pn * HALF + wc * 32 + 8 * fq;
#pragma unroll
        for (int ai = 0; ai < 2; ++ai)
#pragma unroll
            for (int m = 0; m < 4; ++m) { bf16_t* rowp = O + (size_t)(row0 + ai * HALF + m * 16) * ldc + col0;
                f32x4 v0, v1;
#pragma unroll
                for (int j = 0; j < 4; ++j) { v0[j] = silu_f(acc[ai][0][m][0][j]) * acc[ai][1][m][0][j]; v1[j] = silu_f(acc[ai][0][m][1][j]) * acc[ai][1][m][1][j]; }
                u32x4 w; w.x = cvt_pk_bf16(v0[0], v0[1]); w.y = cvt_pk_bf16(v0[2], v0[3]); w.z = cvt_pk_bf16(v1[0], v1[1]); w.w = cvt_pk_bf16(v1[2], v1[3]);
                *(u32x4*)rowp = w; }
    }
};

template <class Epi, class Sched, bool ALIGN_EPI = false, bool SP2 = false>
__device__ __forceinline__ void gemm_phase(PG8_LAS unsigned char* lds, const Gemm g, const Sched& S, const Epi& E) {
    int tid_l = threadIdx.x; asm volatile("" : "+v"(tid_l)); const int tid = tid_l, wid = __builtin_amdgcn_readfirstlane(tid >> 6), lane = tid & 63, wr = wid >> 2, wc = wid & 3, fr = lane & 15, fq = lane >> 4;
    const int K = g.K, nt = K / BK;
    unsigned voffA[2], voffB[2];
#pragma unroll
    for (int i = 0; i < 2; ++i) { int R, C; stage_rc(tid * 16 + i * 8192, R, C); const int Rb = Epi::PERM ? ((R & ~31) + perm32(R & 31)) : R;
        voffA[i] = (unsigned)(R * K + C) * 2u; voffB[i] = (unsigned)(Rb * K + C) * 2u; }
    const size_t kstep = (size_t)(BK * 2);
    const size_t hstep = (size_t)HALF * K * 2;
    const size_t tstep = 2 * hstep;
    const unsigned ldsw = (unsigned)wid * 1024u;
    const int aoff = lds_byte(wr * 64 + fr, fq * 8), boff = lds_byte(wc * 32 + fr, fq * 8);
#define PG8_SA(b, h) (((b) * 2 + (h)) * HTB)
#define PG8_SB(b, h) ((4 + (b) * 2 + (h)) * HTB)
#define PG8_STAGE(bufoff, gbase, voff) do { _Pragma("unroll") for (int _i = 0; _i < 2; ++_i) \
        __builtin_amdgcn_global_load_lds((const unsigned*)((const char*)(gbase) + (voff)[_i]), (PG8_LAS unsigned*)(lds + (bufoff) + ldsw + _i * 8192), 16, 0, 0); } while (0)
#define PG8_LDA(dst, b, h) do { _Pragma("unroll") for (int m = 0; m < 4; ++m) _Pragma("unroll") for (int k = 0; k < 2; ++k) dst[m][k] = *(const PG8_LAS bf16x8*)(lds + PG8_SA(b, h) + aoff + m * 2048 + k * 1024); } while (0)
#define PG8_LDB(dst, b, h) do { _Pragma("unroll") for (int n = 0; n < 2; ++n) _Pragma("unroll") for (int k = 0; k < 2; ++k) dst[n][k] = *(const PG8_LAS bf16x8*)(lds + PG8_SB(b, h) + boff + n * 2048 + k * 1024); } while (0)
#define PG8_MMA(ai, bj, At, Bt) do { __builtin_amdgcn_s_setprio(1); _Pragma("unroll") for (int m = 0; m < 4; ++m) _Pragma("unroll") for (int n = 0; n < 2; ++n) _Pragma("unroll") for (int k = 0; k < 2; ++k) \
        acc[ai][bj][m][n] = __builtin_amdgcn_mfma_f32_16x16x32_bf16(Bt[n][k], At[m][k], acc[ai][bj][m][n], 0, 0, 0); __builtin_amdgcn_s_setprio(0); } while (0)
#define PG8_WAIT_V(n) asm volatile("s_waitcnt vmcnt(" #n ")" ::: "memory")
#define PG8_WAIT_L(n) asm volatile("s_waitcnt lgkmcnt(" #n ")" ::: "memory")
#define PG8_BAR __builtin_amdgcn_s_barrier()
#define PG8_SCHED __builtin_amdgcn_sched_barrier(0)
    Unit cur, nxt; int ui = 0;
    if (!S.next(0, cur)) return;
    f32x4 acc[2][2][4][2];
#pragma unroll
    for (int a = 0; a < 2; ++a)
#pragma unroll
        for (int b = 0; b < 2; ++b)
#pragma unroll
            for (int m = 0; m < 4; ++m)
#pragma unroll
                for (int n = 0; n < 2; ++n) acc[a][b][m][n] = (f32x4){0.f, 0.f, 0.f, 0.f};
    bf16x8 At[4][2], B0[2][2], B1[2][2];
    const char* cA = (const char*)g.A + (size_t)cur.pm * tstep; const char* cB = (const char*)g.Bt + (size_t)cur.pn * tstep;
    S.a_ready(cur);
    if constexpr (SP2) {
        PG8_STAGE(PG8_SB(0, 0), cB, voffB); PG8_STAGE(PG8_SB(0, 1), cB + hstep, voffB); PG8_STAGE(PG8_SA(0, 0), cA, voffA); PG8_STAGE(PG8_SA(0, 1), cA + hstep, voffA);
        if (wr == 1) PG8_BAR;
        PG8_WAIT_V(2); PG8_BAR;
        PG8_STAGE(PG8_SB(1, 0), cB + kstep, voffB); PG8_STAGE(PG8_SA(1, 0), cA + kstep, voffA); PG8_STAGE(PG8_SB(1, 1), cB + hstep + kstep, voffB);
        PG8_WAIT_V(6); PG8_BAR;
    } else {
        PG8_STAGE(PG8_SB(0, 0), cB, voffB); PG8_STAGE(PG8_SA(0, 0), cA, voffA); PG8_STAGE(PG8_SB(0, 1), cB + hstep, voffB); PG8_STAGE(PG8_SA(0, 1), cA + hstep, voffA);
        if (wr == 1) PG8_BAR;
        PG8_WAIT_V(4); PG8_BAR;
        PG8_STAGE(PG8_SB(1, 0), cB + kstep, voffB); PG8_STAGE(PG8_SA(1, 0), cA + kstep, voffA); PG8_STAGE(PG8_SB(1, 1), cB + hstep + kstep, voffB);
        PG8_WAIT_V(6); PG8_BAR;
    }
    for (;;) {
        const bool has_next = S.next(ui + 1, nxt);
        const char* nA = has_next ? (const char*)g.A + (size_t)nxt.pm * tstep : cA; const char* nB = has_next ? (const char*)g.Bt + (size_t)nxt.pn * tstep : cB;
        for (int t = 0; t < nt; t += 2) {
            const bool last = (t == nt - 2);
            const char* a1 = cA + (size_t)(t + 1) * kstep;
            const char* a2 = last ? nA : cA + (size_t)(t + 2) * kstep; const char* b2 = last ? nB : cB + (size_t)(t + 2) * kstep;
            const char* a3 = a2 + kstep; const char* b3 = b2 + kstep;
            if (last && has_next) S.a_ready(nxt);
            if constexpr (SP2) {
            PG8_LDB(B0, 0, 0); PG8_LDB(B1, 0, 1); PG8_SCHED; PG8_LDA(At, 0, 0); PG8_STAGE(PG8_SA(1, 1), a1 + hstep, voffA);
            PG8_WAIT_V(8); PG8_WAIT_L(0); PG8_BAR; PG8_MMA(0, 0, At, B0); PG8_MMA(0, 1, At, B1); PG8_BAR; PG8_SCHED;
            PG8_LDA(At, 0, 1); PG8_STAGE(PG8_SB(0, 0), b2, voffB); PG8_STAGE(PG8_SB(0, 1), b2 + hstep, voffB); PG8_STAGE(PG8_SA(0, 0), a2, voffA);
            PG8_WAIT_V(8); PG8_WAIT_L(0); PG8_BAR; PG8_MMA(1, 0, At, B0); PG8_MMA(1, 1, At, B1); PG8_BAR; PG8_SCHED;
            PG8_LDB(B0, 1, 0); PG8_LDB(B1, 1, 1); PG8_SCHED; PG8_LDA(At, 1, 0); PG8_STAGE(PG8_SA(0, 1), a2 + hstep, voffA);
            PG8_WAIT_V(8); PG8_WAIT_L(0); PG8_BAR; PG8_MMA(0, 0, At, B0); PG8_MMA(0, 1, At, B1); PG8_BAR; PG8_SCHED;
            PG8_LDA(At, 1, 1); PG8_STAGE(PG8_SB(1, 0), b3, voffB); PG8_STAGE(PG8_SB(1, 1), b3 + hstep, voffB); PG8_STAGE(PG8_SA(1, 0), a3, voffA);
            PG8_WAIT_V(8); PG8_WAIT_L(0); PG8_BAR; PG8_MMA(1, 0, At, B0); PG8_MMA(1, 1, At, B1); PG8_BAR; PG8_SCHED;
            } else {
            PG8_LDB(B0, 0, 0); PG8_SCHED; PG8_LDA(At, 0, 0); PG8_STAGE(PG8_SA(1, 1), a1 + hstep, voffA);
            PG8_WAIT_L(8); PG8_BAR; PG8_WAIT_L(0); PG8_MMA(0, 0, At, B0); PG8_BAR; PG8_SCHED;
            PG8_LDB(B1, 0, 1); PG8_STAGE(PG8_SB(0, 0), b2, voffB);
            PG8_BAR; PG8_WAIT_L(0); PG8_MMA(0, 1, At, B1); PG8_BAR;
            PG8_LDA(At, 0, 1); PG8_STAGE(PG8_SA(0, 0), a2, voffA);
            PG8_BAR; PG8_WAIT_L(0); PG8_MMA(1, 0, At, B0); PG8_BAR; PG8_SCHED;
            PG8_STAGE(PG8_SB(0, 1), b2 + hstep, voffB);
            PG8_WAIT_V(6); PG8_BAR; PG8_MMA(1, 1, At, B1); PG8_BAR;
            PG8_LDB(B0, 1, 0); PG8_SCHED; PG8_LDA(At, 1, 0); PG8_STAGE(PG8_SA(0, 1), a2 + hstep, voffA);
            PG8_WAIT_L(8); PG8_BAR; PG8_WAIT_L(0); PG8_MMA(0, 0, At, B0); PG8_BAR; PG8_SCHED;
            PG8_LDB(B1, 1, 1); PG8_STAGE(PG8_SB(1, 0), b3, voffB);
            PG8_BAR; PG8_WAIT_L(0); PG8_MMA(0, 1, At, B1); PG8_BAR;
            PG8_LDA(At, 1, 1); PG8_STAGE(PG8_SA(1, 0), a3, voffA);
            PG8_BAR; PG8_WAIT_L(0); PG8_MMA(1, 0, At, B0); PG8_BAR; PG8_SCHED;
            PG8_STAGE(PG8_SB(1, 1), b3 + hstep, voffB);
            PG8_WAIT_V(6); PG8_BAR; PG8_MMA(1, 1, At, B1); PG8_BAR;
            }
        }
        if constexpr (ALIGN_EPI) { if (wr == 0) PG8_BAR; }
        if constexpr (!Epi::AFTER_DRAIN) { E(acc, cur, wr, wc, fr, fq); S.done(cur); }
        if (!has_next) break;
#pragma unroll
        for (int a = 0; a < 2; ++a)
#pragma unroll
            for (int b = 0; b < 2; ++b)
#pragma unroll
                for (int m = 0; m < 4; ++m)
#pragma unroll
                    for (int n = 0; n < 2; ++n) acc[a][b][m][n] = (f32x4){0.f, 0.f, 0.f, 0.f};
        cur = nxt; cA = nA; cB = nB; ++ui;
        if constexpr (ALIGN_EPI) { if (wr == 1) PG8_BAR; }
    }
    PG8_WAIT_V(0);
    if constexpr (!ALIGN_EPI) { if (wr == 0) PG8_BAR; }
    PG8_BAR;
    if constexpr (Epi::AFTER_DRAIN) { E.fused(acc, cur, wr, wc, fr, fq, lds, wid, lane); S.done(cur); }
#undef PG8_SA
#undef PG8_SB
#undef PG8_STAGE
#undef PG8_LDA
#undef PG8_LDB
#undef PG8_MMA
#undef PG8_WAIT_V
#undef PG8_WAIT_L
#undef PG8_BAR
#undef PG8_SCHED
}
}
constexpr int D = 2048, NCTX = 8192, M = 10240, MK = 10752, DEPTH = 4, NWAVES = 8;
constexpr int IN_W = 4960, IN_WP = 5120, FF = 5632;
constexpr int U_CQ = 0, U_CKV = 768, U_KR = 1280, U_GQKV = 1344, U_GZ = 1344 + 1536, U_GB = 1344 + 2048, U_GA = 1344 + 2056, U_SZ = 3408, U_SXBC = 3408 + 512, U_SDT = 3408 + 1536;
constexpr float EPS = 1e-6f;
constexpr int NPH_L = 11, NPHASES = 1 + DEPTH * NPH_L;
constexpr size_t O_YP = 0, O_YS = 16777216, O_CKV = 20971520, O_KR = 37748736, O_SG = 39845888, O_SS = 56623104;
constexpr size_t MiB = 1u << 20;
constexpr size_t WS_CTL = 0, CTL_ZERO_BYTES = 1 * MiB;
constexpr size_t WL_IN = 0, WL_UQ = WL_IN + (size_t)IN_WP * D * 2, WL_UKV = WL_UQ + (size_t)1536 * 768 * 2, WL_OUT = WL_UKV + (size_t)2048 * 512 * 2,
                 WL_GU = WL_OUT + (size_t)D * D * 2, WL_DN = WL_GU + (size_t)2 * FF * D * 2, WL_SIZE = WL_DN + (size_t)D * FF * 2;
constexpr size_t WS_W = 2 * MiB;
constexpr size_t WS_MODS = WS_W + 4 * WL_SIZE;
constexpr size_t WS_H = WS_MODS + 1 * MiB;
constexpr size_t WS_U = WS_H + (size_t)M * D * 2;
constexpr size_t WS_CQN = WS_U + (size_t)M * IN_WP * 4;
constexpr size_t WS_CKVN = WS_CQN + (size_t)M * 768 * 2;
constexpr size_t WS_QRAW = WS_CKVN + (size_t)MK * 512 * 2;
constexpr size_t WS_KN = WS_QRAW + (size_t)M * 1536 * 4;
constexpr size_t WS_VT = WS_KN + (size_t)MK * 1024 * 4;
constexpr size_t WS_QB = WS_VT + (size_t)1024 * MK * 2;
constexpr size_t WS_KB = WS_QB + (size_t)M * 1536 * 2;
constexpr size_t WS_GQ = WS_KB + (size_t)MK * 1536 * 2;
constexpr size_t WS_GBG = WS_GQ + (size_t)3 * M * 512 * 4;
constexpr size_t WS_GO = WS_GBG + (size_t)2 * M * 8 * 4;
constexpr size_t WS_XBC = WS_GO + (size_t)2 * M * 512 * 4;
constexpr size_t WS_SDT = WS_XBC + (size_t)M * 1024 * 4;
constexpr size_t WS_SY = WS_SDT + (size_t)2 * M * 16 * 4;
constexpr size_t WS_MIX = WS_SY + (size_t)2 * M * 512 * 4;
constexpr size_t WS_ACT = WS_MIX + (size_t)M * D * 2;
constexpr size_t WS_END = WS_ACT + (size_t)M * FF * 2;
constexpr int CW_BAR = 4096;
constexpr int RING_BYTES = 131072, LDSCTL_OFF = RING_BYTES, MISC_OFF = LDSCTL_OFF + 320, LDS_BYTES = 147456;

#define GAS __attribute__((address_space(1)))
#define LAS __attribute__((address_space(3)))
typedef unsigned short bf16;
typedef unsigned v4u __attribute__((ext_vector_type(4)));
typedef unsigned v2u __attribute__((ext_vector_type(2)));
typedef float f32x4 __attribute__((ext_vector_type(4)));
typedef float f32x2 __attribute__((ext_vector_type(2)));
typedef short bf16x8 __attribute__((ext_vector_type(8)));
typedef GAS unsigned gu32;
#define RLX_AGENT __ATOMIC_RELAXED, __HIP_MEMORY_SCOPE_AGENT
#define LDS_WAIT() asm volatile("s_waitcnt lgkmcnt(0)" ::: "memory")
#define VM_WAIT() asm volatile("s_waitcnt vmcnt(0)" ::: "memory")
__device__ __forceinline__ unsigned f2bf(float f) { unsigned u = __builtin_bit_cast(unsigned, f); return (u + 0x7fffu + ((u >> 16) & 1u)) >> 16; }
__device__ __forceinline__ unsigned pk2(float lo, float hi) { return f2bf(lo) | (f2bf(hi) << 16); }
__device__ __forceinline__ float wave_sum(float v) {
#pragma unroll
    for (int o = 1; o < 64; o <<= 1) v += __shfl_xor(v, o);
    return v;
}
__device__ __forceinline__ float half_sum(float v) {
#pragma unroll
    for (int o = 1; o < 32; o <<= 1) v += __shfl_xor(v, o);
    return v;
}
__device__ __forceinline__ float silu(float x) { return x / (1.0f + expf(-x)); }
__device__ __forceinline__ float softplus(float x) { return x > 20.f ? x : log1pf(expf(x)); }

#define XB_TMO      128
#define XB_XCNT(j)  (256  + 64 * (j))
#define XB_XSUB(j)  (1280 + 64 * (j))
#define XB_XGEN(j)  (2304 + 64 * (j))
#define XB_TOP      3328
#define XB_TOPGEN   3392
#define XCD_BAR_WORDS 3456
#define XB_SPIN_CAP (1u << 18)

__device__ __forceinline__ unsigned xb_ld(unsigned* p)              { return __hip_atomic_load(p, __ATOMIC_RELAXED, __HIP_MEMORY_SCOPE_AGENT); }
__device__ __forceinline__ unsigned xb_add(unsigned* p, unsigned v) { return __hip_atomic_fetch_add(p, v, __ATOMIC_RELAXED, __HIP_MEMORY_SCOPE_AGENT); }
__device__ __forceinline__ unsigned xb_xcc_id() { return (unsigned)__builtin_amdgcn_s_getreg((3 << 11) | 20) & 0xFu; }
#define XB_SPIN(cond, bar) do { unsigned _sp = 0; while (cond) { __builtin_amdgcn_s_sleep(1); \
    if ((++_sp & 255u) == 0u) { if (xb_ld(&(bar)[XB_TMO])) break; if (_sp > XB_SPIN_CAP) { atomicAdd(&(bar)[XB_TMO], 1u); break; } } } } while (0)

struct XcdBarrier {
    unsigned* bar; unsigned x;
    volatile LAS unsigned* st;
};

__device__ __forceinline__ XcdBarrier xcd_barrier_post(unsigned* bar, volatile LAS unsigned* st) {
    XcdBarrier b; b.bar = bar; b.x = xb_xcc_id(); b.st = st;
    if (threadIdx.x == 0) (void)xb_add(&bar[XB_XCNT(b.x)], 1u);
    return b;
}
__device__ __forceinline__ void xcd_barrier_complete(unsigned* bar, unsigned x, unsigned& nloc, unsigned& nx) {
    const unsigned G = gridDim.x * gridDim.y * gridDim.z;
    unsigned sum, cnt, mine, sp = 0u;
    for (;;) {
        sum = 0u; cnt = 0u; mine = 0u;
#pragma unroll
        for (unsigned j = 0; j < 16; ++j) { const unsigned c = xb_ld(&bar[XB_XCNT(j)]); sum += c; cnt += (c > 0u) ? 1u : 0u; mine = (j == x) ? c : mine; }
        if (sum == G) break;
        __builtin_amdgcn_s_sleep(1);
        if ((++sp & 255u) == 0u) { if (xb_ld(&bar[XB_TMO])) break; if (sp > XB_SPIN_CAP) { atomicAdd(&bar[XB_TMO], 1u); break; } }
    }
    nloc = mine > 0u ? mine : 1u; nx = cnt > 0u ? cnt : 1u;
}

__device__ __forceinline__ void xcd_barrier(const XcdBarrier& b) {
    asm volatile("s_waitcnt vmcnt(0)" ::: "memory");
    __syncthreads();
    if (threadIdx.x == 0) {
        unsigned* bar = b.bar;
        __builtin_amdgcn_s_waitcnt(0);
        unsigned nloc = b.st[0], nx = b.st[1];
        if (nloc == 0u) { xcd_barrier_complete(bar, b.x, nloc, nx); b.st[0] = nloc; b.st[1] = nx; }
        const unsigned old = xb_add(&bar[XB_XSUB(b.x)], 1u);
        const unsigned gen = old / nloc;
        if (old + 1u == (gen + 1u) * nloc) {
            __builtin_amdgcn_fence(__ATOMIC_RELEASE, "agent");
            asm volatile("s_waitcnt vmcnt(0)" ::: "memory");
            const unsigned og = xb_add(&bar[XB_TOP], 1u);
            const unsigned tg = og / nx;
            if (og + 1u == (tg + 1u) * nx) xb_add(&bar[XB_TOPGEN], 1u);
            else XB_SPIN(xb_ld(&bar[XB_TOPGEN]) == tg, bar);
            __builtin_amdgcn_fence(__ATOMIC_ACQUIRE, "agent");
            xb_add(&bar[XB_XGEN(b.x)], 1u);
            asm volatile("s_waitcnt vmcnt(0)" ::: "memory");
        } else {
            XB_SPIN(xb_ld(&bar[XB_XGEN(b.x)]) == gen, bar);
            __builtin_amdgcn_fence(__ATOMIC_ACQUIRE, "agent");
            asm volatile("s_waitcnt vmcnt(0)" ::: "memory");
        }
    }
    __syncthreads();
}
struct Args { const float* in[32]; float* out; unsigned char* ws; int ph_lo, ph_hi; };
#define CAS __attribute__((address_space(4)))
typedef const float* const CAS* kin_t;
struct Ctx { kin_t in; float* out; unsigned char* ws; };

__device__ __forceinline__ void transpose_item(const float* __restrict__ W, int K, int N, bf16* WT, int k0, int n0, int drow0, LAS float* scr, int lane) {
#pragma unroll 8
    for (int i = 0; i < 32; ++i) { const int kk = 2 * i + (lane >> 5); scr[kk * 33 + (lane & 31)] = W[(size_t)(k0 + kk) * N + n0 + (lane & 31)]; }
    LDS_WAIT(); asm volatile("" ::: "memory");
    const int c = lane & 7;
#pragma unroll
    for (int j = 0; j < 4; ++j) { const int n = (lane >> 3) + 8 * j; const LAS float* s = scr + (8 * c) * 33 + n;
        v4u o; o.x = pk2(s[0 * 33], s[1 * 33]); o.y = pk2(s[2 * 33], s[3 * 33]); o.z = pk2(s[4 * 33], s[5 * 33]); o.w = pk2(s[6 * 33], s[7 * 33]);
        *(GAS v4u*)(WT + (size_t)(drow0 + n) * K + k0 + 8 * c) = o; }
    LDS_WAIT(); asm volatile("" ::: "memory");
}
constexpr size_t WLE_IN = 0, WLE_UQ = WLE_IN + (size_t)IN_WP * D, WLE_KV = WLE_UQ + (size_t)1536 * 768, WLE_OUT = WLE_KV + (size_t)2048 * 512,
                 WLE_GU = WLE_OUT + (size_t)D * D, WLE_DN = WLE_GU + (size_t)2 * FF * D, WLE_SIZE = WLE_DN + (size_t)D * FF;
static_assert(WLE_SIZE * 2 == WL_SIZE, "weight map");

__device__ __forceinline__ void ph_prologue(const Ctx& A, LAS unsigned char* lds, int tid, int lane, int wave, int vcu, int G) {
    const int gw = vcu * NWAVES + wave, NGW = G * NWAVES;
    LAS float* scr = (LAS float*)(lds + wave * 8704);
    constexpr int I_IN = 32 * 155, I_UQ = 12 * 48, I_KV = 8 * 64, I_OUT = 32 * 64, I_GU = 32 * 352, I_DN = 88 * 64, I_L = I_IN + I_UQ + I_KV + I_OUT + I_GU + I_DN;
    for (int it = gw; it < DEPTH * I_L; it += NGW) {
        const int l = it / I_L; int r = it - l * I_L;
        bf16* wl = (bf16*)(A.ws + WS_W) + (size_t)l * WLE_SIZE;
        if (r < I_IN) { const int kb = r / 155, nb = r - kb * 155; transpose_item(A.in[12] + (size_t)l * D * IN_W, D, IN_W, wl + WLE_IN, 64 * kb, 32 * nb, 32 * nb, scr, lane); continue; } r -= I_IN;
        if (r < I_UQ) { const int kb = r / 48, nb = r - kb * 48; transpose_item(A.in[15] + (size_t)l * 768 * 1536, 768, 1536, wl + WLE_UQ, 64 * kb, 32 * nb, 32 * nb, scr, lane); continue; } r -= I_UQ;
        if (r < I_KV) { const int kb = r / 64, nb = r - kb * 64; const int n0 = 32 * nb, hh = n0 >> 8, c = n0 & 255; const int dr = (c < 128 ? 0 : 1024) + hh * 128 + (c & 127);
                        transpose_item(A.in[17] + (size_t)l * 512 * 2048, 512, 2048, wl + WLE_KV, 64 * kb, n0, dr, scr, lane); continue; } r -= I_KV;
        if (r < I_OUT) { const int kb = r / 64, nb = r - kb * 64; transpose_item(A.in[13] + (size_t)l * D * D, D, D, wl + WLE_OUT, 64 * kb, 32 * nb, 32 * nb, scr, lane); continue; } r -= I_OUT;
        if (r < I_GU) { const int kb = r / 352, nb = r - kb * 352; const int n0 = 32 * nb; int dr; if (n0 < FF) dr = (n0 >> 7) * 256 + (n0 & 127); else { const int n1 = n0 - FF; dr = (n1 >> 7) * 256 + 128 + (n1 & 127); }
                        transpose_item(A.in[30] + (size_t)l * D * 2 * FF, D, 2 * FF, wl + WLE_GU, 64 * kb, n0, dr, scr, lane); continue; } r -= I_GU;
        { const int kb = r / 64, nb = r - kb * 64; transpose_item(A.in[31] + (size_t)l * FF * D, FF, D, wl + WLE_DN, 64 * kb, 32 * nb, 32 * nb, scr, lane); }
    }
    { const int gt = vcu * 512 + tid, NGT = G * 512;
      for (int i = gt; i < DEPTH * 40960; i += NGT) { const int l = i / 40960, r = i - l * 40960; *(GAS v4u*)((bf16*)(A.ws + WS_W) + (size_t)l * WLE_SIZE + WLE_IN + (size_t)IN_W * D + (size_t)r * 8) = (v4u){0u, 0u, 0u, 0u}; }
      const f32x4* xp = (const f32x4*)A.in[0]; const f32x4* xs = (const f32x4*)A.in[1]; f32x4* o = (f32x4*)A.out;
      for (int i = gt; i < 4194304; i += NGT) o[i] = xp[i];
      for (int i = gt; i < 1048576; i += NGT) o[4194304 + i] = xs[i]; }
    LAS float* scond = (LAS float*)(lds + 81920);
    LAS float* red = (LAS float*)(lds + 81920 + 24576);
    for (int i = tid; i < 3 * 2048; i += 512) { const int r = i >> 11, k = i & 2047; const float c = r == 0 ? A.in[7][k] : A.in[6][(r - 1) * 2048 + k]; scond[i] = silu(c); }
    __syncthreads();
    float* mods = (float*)(A.ws + WS_MODS);
    for (int item = vcu; item < 384; item += G) {
        const int l = item / 96, j0 = (item - l * 96) * 128;
        const float* w = A.in[10] + (size_t)l * 2048 * 12288 + j0 + 2 * lane;
        float a0x = 0, a0y = 0, a1x = 0, a1y = 0, a2x = 0, a2y = 0;
        const int kbeg = wave * 256;
#pragma unroll 8
        for (int k = kbeg; k < kbeg + 256; ++k) { const f32x2 v = *(const f32x2*)(w + (size_t)k * 12288); const float c0 = scond[k], c1 = scond[2048 + k], c2 = scond[4096 + k];
            a0x += c0 * v.x; a0y += c0 * v.y; a1x += c1 * v.x; a1y += c1 * v.y; a2x += c2 * v.x; a2y += c2 * v.y; }
        red[(wave * 3 + 0) * 128 + 2 * lane] = a0x; red[(wave * 3 + 0) * 128 + 2 * lane + 1] = a0y;
        red[(wave * 3 + 1) * 128 + 2 * lane] = a1x; red[(wave * 3 + 1) * 128 + 2 * lane + 1] = a1y;
        red[(wave * 3 + 2) * 128 + 2 * lane] = a2x; red[(wave * 3 + 2) * 128 + 2 * lane + 1] = a2y;
        __syncthreads();
        if (tid < 384) { const int r = tid >> 7, j = tid & 127; float s = 0.f;
#pragma unroll
            for (int w8 = 0; w8 < 8; ++w8) s += red[(w8 * 3 + r) * 128 + j];
            mods[(size_t)(l * 3 + r) * 12288 + j0 + j] = s + A.in[11][(size_t)l * 12288 + j0 + j]; }
        __syncthreads();
    }
}

__device__ __forceinline__ void ph_norm(const float* X, const float* g, const float* mods_l, int shift_idx, bf16* H, int lane, int gw, int NGW) {
    for (int m = gw; m < M; m += NGW) {
        const int cr = m < NCTX ? 0 : 1 + ((m - NCTX) >> 10);
        const f32x4* xr = (const f32x4*)(X + (size_t)m * D) + lane;
        f32x4 v[8]; float ss = 0.f;
#pragma unroll
        for (int j = 0; j < 8; ++j) { v[j] = xr[64 * j]; ss += (v[j].x * v[j].x + v[j].y * v[j].y) + (v[j].z * v[j].z + v[j].w * v[j].w); }
        const float rstd = 1.0f / sqrtf(wave_sum(ss) * (1.0f / D) + EPS);
        const float* sh = mods_l + (size_t)cr * 12288 + shift_idx * 2048; const float* sc = sh + 2048;
#pragma unroll
        for (int j = 0; j < 8; ++j) { const int c = 4 * lane + 256 * j; const f32x4 g4 = *(const f32x4*)(g + c), s4 = *(const f32x4*)(sc + c), h4 = *(const f32x4*)(sh + c);
            const f32x4 o = v[j] * rstd * g4 * (s4 + 1.0f) + h4; v2u w; w.x = pk2(o.x, o.y); w.y = pk2(o.z, o.w); *(GAS v2u*)(H + (size_t)m * D + c) = w; }
    }
}

__device__ __forceinline__ void ph_prep(const Ctx& A, int l, int lane, int gw, int NGW) {
    const float* U = (const float*)(A.ws + WS_U);
    bf16* CQN = (bf16*)(A.ws + WS_CQN); bf16* CKVN = (bf16*)(A.ws + WS_CKVN);
    float* GQ = (float*)(A.ws + WS_GQ); float* GK = GQ + (size_t)M * 512; float* GV = GK + (size_t)M * 512;
    float* GBETA = (float*)(A.ws + WS_GBG); float* GG = GBETA + (size_t)M * 8;
    float* XBC = (float*)(A.ws + WS_XBC); float* SDT = (float*)(A.ws + WS_SDT); float* SDA = SDT + (size_t)M * 16;
    const float* qn_g = A.in[14] + l * 768; const float* kvn_g = A.in[16] + l * 512;
    const float* gconv = A.in[20] + (size_t)l * 5 * 1536; const float* sconv = A.in[24] + (size_t)l * 5 * 1024; const float* sconvb = A.in[25] + l * 1024;
    for (int m = gw; m < MK; m += NGW) {
        if (m >= M) {
            const int j = m - M, b = j >> 8, t = j & 255; const float* src = A.in[2] + ((size_t)(b * 4 + l) * 256 + t) * 512;
#pragma unroll
            for (int i = 0; i < 2; ++i) { const int c = 4 * lane + 256 * i; const f32x4 v = *(const f32x4*)(src + c); v2u w; w.x = pk2(v.x, v.y); w.y = pk2(v.z, v.w); *(GAS v2u*)(CKVN + (size_t)m * 512 + c) = w; }
            continue;
        }
        const bool ctx = m < NCTX; const int t = ctx ? (m & 255) : ((m - NCTX) & 1023), T = ctx ? 256 : 1024;
        const float* u = U + (size_t)m * IN_WP;
        { f32x4 v[3]; float ss = 0.f;
#pragma unroll
          for (int i = 0; i < 3; ++i) { v[i] = *(const f32x4*)(u + U_CQ + 4 * lane + 256 * i); ss += (v[i].x * v[i].x + v[i].y * v[i].y) + (v[i].z * v[i].z + v[i].w * v[i].w); }
          const float rstd = 1.0f / sqrtf(wave_sum(ss) * (1.0f / 768.f) + EPS);
#pragma unroll
          for (int i = 0; i < 3; ++i) { const int c = 4 * lane + 256 * i; const f32x4 o = v[i] * rstd * *(const f32x4*)(qn_g + c); v2u w; w.x = pk2(o.x, o.y); w.y = pk2(o.z, o.w); *(GAS v2u*)(CQN + (size_t)m * 768 + c) = w; } }
        { f32x4 v[2]; float ss = 0.f;
#pragma unroll
          for (int i = 0; i < 2; ++i) { v[i] = *(const f32x4*)(u + U_CKV + 4 * lane + 256 * i); ss += (v[i].x * v[i].x + v[i].y * v[i].y) + (v[i].z * v[i].z + v[i].w * v[i].w); }
          const float rstd = 1.0f / sqrtf(wave_sum(ss) * (1.0f / 512.f) + EPS);
          const int b = m >> 8;
#pragma unroll
          for (int i = 0; i < 2; ++i) { const int c = 4 * lane + 256 * i; const f32x4 o = v[i] * rstd * *(const f32x4*)(kvn_g + c); v2u w; w.x = pk2(o.x, o.y); w.y = pk2(o.z, o.w); *(GAS v2u*)(CKVN + (size_t)m * 512 + c) = w;
              if (ctx) *(f32x4*)(A.out + O_CKV + ((size_t)(b * 4 + l) * 256 + t) * 512 + c) = o; }
          if (ctx) A.out[O_KR + ((size_t)(b * 4 + l) * 256 + t) * 64 + lane] = u[U_KR + lane]; }
        {
#pragma unroll
          for (int i = 0; i < 6; ++i) { const int c = 4 * lane + 256 * i; f32x4 acc = (f32x4){0.f, 0.f, 0.f, 0.f};
#pragma unroll
              for (int j = 0; j < 5; ++j) { const int tt = t + j - 2; if (tt >= 0 && tt < T) acc += *(const f32x4*)(gconv + j * 1536 + c) * *(const f32x4*)(u + (ptrdiff_t)(j - 2) * IN_WP + U_GQKV + c); }
              acc.x = silu(acc.x); acc.y = silu(acc.y); acc.z = silu(acc.z); acc.w = silu(acc.w);
              if (i < 4) { const float ss = half_sum((acc.x * acc.x + acc.y * acc.y) + (acc.z * acc.z + acc.w * acc.w)); acc = acc * (1.0f / sqrtf(ss + EPS)); }
              float* dst = i < 2 ? GQ + (size_t)m * 512 + c : (i < 4 ? GK + (size_t)m * 512 + (c - 512) : GV + (size_t)m * 512 + (c - 1024));
              *(f32x4*)dst = acc; }
          if (lane < 8) { const float bi = u[U_GB + lane], ai = u[U_GA + lane]; GBETA[(size_t)m * 8 + lane] = 1.0f / (1.0f + expf(-bi));
              GG[(size_t)m * 8 + lane] = -expf(A.in[21][l * 8 + lane]) * softplus(ai + A.in[22][l * 8 + lane]); } }
        {
#pragma unroll
          for (int i = 0; i < 4; ++i) { const int c = 4 * lane + 256 * i; f32x4 acc = *(const f32x4*)(sconvb + c);
#pragma unroll
              for (int j = 0; j < 5; ++j) { const int tt = t + j - 2; if (tt >= 0 && tt < T) acc += *(const f32x4*)(sconv + j * 1024 + c) * *(const f32x4*)(u + (ptrdiff_t)(j - 2) * IN_WP + U_SXBC + c); }
              acc.x = silu(acc.x); acc.y = silu(acc.y); acc.z = silu(acc.z); acc.w = silu(acc.w);
              *(f32x4*)(XBC + (size_t)m * 1024 + c) = acc; }
          if (lane < 16) { const float dt = softplus(u[U_SDT + lane] + A.in[27][l * 16 + lane]); SDT[(size_t)m * 16 + lane] = dt; SDA[(size_t)m * 16 + lane] = -expf(A.in[26][l * 16 + lane]) * dt; } }
    }
}

__device__ __forceinline__ void ph_finalize(const Ctx& A, int l, int lane, int gw, int NGW) {
    const float* U = (const float*)(A.ws + WS_U); const float* QRAW = (const float*)(A.ws + WS_QRAW); const float* KN = (const float*)(A.ws + WS_KN);
    bf16* QB = (bf16*)(A.ws + WS_QB); bf16* KB = (bf16*)(A.ws + WS_KB);
    const float* q_g = A.in[18] + l * 192; const float* k_g = A.in[19] + l * 192;
    const float QS = 0.07216878364870322f * 1.4426950408889634f;
    const float inv_f = powf(10000.f, -(float)(lane & 15) * (1.0f / 16.f));
    const float qg0 = q_g[lane], qg1 = q_g[64 + lane], qg2 = q_g[128 + lane], kg0 = k_g[lane], kg1 = k_g[64 + lane], kg2 = k_g[128 + lane];
    for (int m = gw; m < MK; m += NGW) {
        const bool fresh = m < M, latent = fresh && m >= NCTX;
        float cs = 1.f, sn = 0.f;
        if (latent) { const int t = (m - NCTX) & 1023; const float pos = (float)((lane >> 5) ? (t & 63) : (t >> 6)); const float ang = pos * inv_f; cs = cosf(ang); sn = sinf(ang); }
        const bool hi = (lane >> 4) & 1;
        const float* krp = fresh ? U + (size_t)m * IN_WP + U_KR : A.in[3] + ((size_t)(((m - M) >> 8) * 4 + l) * 256 + ((m - M) & 255)) * 64;
        const float kr_raw = krp[lane];
        for (int h = 0; h < 8; ++h) {
            if (fresh) { const float* q = QRAW + (size_t)m * 1536 + h * 192; float x0 = q[lane], x1 = q[64 + lane], x2 = q[128 + lane];
                const float rstd = 1.0f / sqrtf(wave_sum(x0 * x0 + x1 * x1 + x2 * x2) * (1.0f / 192.f) + EPS);
                x0 *= rstd * qg0; x1 *= rstd * qg1; x2 *= rstd * qg2;
                if (latent) { const float p = __shfl_xor(x2, 16); x2 = hi ? x2 * cs + p * sn : x2 * cs - p * sn; }
                bf16* dst = QB + ((size_t)m * 8 + h) * 192; dst[lane] = (bf16)f2bf(x0 * QS); dst[64 + lane] = (bf16)f2bf(x1 * QS); dst[128 + lane] = (bf16)f2bf(x2 * QS); }
            { const float* kn = KN + (size_t)m * 1024 + h * 128; float x0 = kn[lane], x1 = kn[64 + lane], x2 = kr_raw;
                const float rstd = 1.0f / sqrtf(wave_sum(x0 * x0 + x1 * x1 + x2 * x2) * (1.0f / 192.f) + EPS);
                x0 *= rstd * kg0; x1 *= rstd * kg1; x2 *= rstd * kg2;
                if (latent) { const float p = __shfl_xor(x2, 16); x2 = hi ? x2 * cs + p * sn : x2 * cs - p * sn; }
                bf16* dst = KB + ((size_t)m * 8 + h) * 192; dst[lane] = (bf16)f2bf(x0); dst[64 + lane] = (bf16)f2bf(x1); dst[128 + lane] = (bf16)f2bf(x2); }
        }
    }
}

__device__ __forceinline__ void attn_item(const bf16* __restrict__ QB, const bf16* __restrict__ KB, const bf16* __restrict__ VT, bf16* MIX, int qrow0, int h, int mkA, int nA, int mkB, int nB, LAS unsigned char* plds, int lane) {
    const int fr = lane & 15, fq = lane >> 4;
    bf16x8 qf[6];
#pragma unroll
    for (int d = 0; d < 6; ++d) qf[d] = *(const bf16x8*)(QB + ((size_t)(qrow0 + fr) * 8 + h) * 192 + d * 32 + fq * 8);
    f32x4 o[8];
#pragma unroll
    for (int i = 0; i < 8; ++i) o[i] = (f32x4){0.f, 0.f, 0.f, 0.f};
    float mrow[4] = {-1e30f, -1e30f, -1e30f, -1e30f}, lrow[4] = {0.f, 0.f, 0.f, 0.f};
    for (int seg = 0; seg < 2; ++seg) {
        const int mk0 = seg ? mkB : mkA, n = seg ? nB : nA;
        for (int kt = 0; kt < n; kt += 32) {
            f32x4 s0 = (f32x4){0.f, 0.f, 0.f, 0.f}, s1 = s0;
            const bf16* kp0 = KB + ((size_t)(mk0 + kt + fr) * 8 + h) * 192 + fq * 8; const bf16* kp1 = kp0 + (size_t)16 * 8 * 192;
#pragma unroll
            for (int d = 0; d < 6; ++d) { const bf16x8 k0 = *(const bf16x8*)(kp0 + d * 32), k1 = *(const bf16x8*)(kp1 + d * 32);
                s0 = __builtin_amdgcn_mfma_f32_16x16x32_bf16(qf[d], k0, s0, 0, 0, 0); s1 = __builtin_amdgcn_mfma_f32_16x16x32_bf16(qf[d], k1, s1, 0, 0, 0); }
            float al[4];
#pragma unroll
            for (int r = 0; r < 4; ++r) { float v = fmaxf(s0[r], s1[r]);
                v = fmaxf(v, __shfl_xor(v, 1)); v = fmaxf(v, __shfl_xor(v, 2)); v = fmaxf(v, __shfl_xor(v, 4)); v = fmaxf(v, __shfl_xor(v, 8));
                const float mnew = fmaxf(mrow[r], v); al[r] = exp2f(mrow[r] - mnew); mrow[r] = mnew;
                s0[r] = exp2f(s0[r] - mnew); s1[r] = exp2f(s1[r] - mnew); lrow[r] = lrow[r] * al[r] + s0[r] + s1[r]; }
#pragma unroll
            for (int i = 0; i < 8; ++i) { o[i][0] *= al[0]; o[i][1] *= al[1]; o[i][2] *= al[2]; o[i][3] *= al[3]; }
#pragma unroll
            for (int r = 0; r < 4; ++r) { *(LAS bf16*)(plds + (4 * fq + r) * 64 + fr * 2) = (bf16)f2bf(s0[r]); *(LAS bf16*)(plds + (4 * fq + r) * 64 + 32 + fr * 2) = (bf16)f2bf(s1[r]); }
            asm volatile("s_waitcnt lgkmcnt(0)" ::: "memory");
            const bf16x8 pf = *(const LAS bf16x8*)(plds + fr * 64 + fq * 16);
            asm volatile("s_waitcnt lgkmcnt(0)" ::: "memory");
#pragma unroll
            for (int i = 0; i < 8; ++i) { const bf16x8 vf = *(const bf16x8*)(VT + (size_t)(h * 128 + i * 16 + fr) * MK + mk0 + kt + fq * 8);
                o[i] = __builtin_amdgcn_mfma_f32_16x16x32_bf16(pf, vf, o[i], 0, 0, 0); }
        }
    }
#pragma unroll
    for (int r = 0; r < 4; ++r) { float lt = lrow[r]; lt += __shfl_xor(lt, 1); lt += __shfl_xor(lt, 2); lt += __shfl_xor(lt, 4); lt += __shfl_xor(lt, 8);
        const float inv = 1.0f / lt; bf16* dst = MIX + (size_t)(qrow0 + 4 * fq + r) * D + h * 128 + fr;
#pragma unroll
        for (int i = 0; i < 8; ++i) dst[i * 16] = (bf16)f2bf(o[i][r] * inv); }
}
__device__ __forceinline__ void ph_attn(const Ctx& A, LAS unsigned char* lds, int lane, int wave, int gw, int NGW) {
    const bf16* QB = (const bf16*)(A.ws + WS_QB); const bf16* KB = (const bf16*)(A.ws + WS_KB); const bf16* VT = (const bf16*)(A.ws + WS_VT); bf16* MIX = (bf16*)(A.ws + WS_MIX);
    LAS unsigned char* plds = lds + wave * 1024;
    for (int slot = gw; slot < 2048; slot += NGW) {
        if (slot < 1024) { const int b = slot >> 9, rem = slot & 511, h = rem >> 6, qt = rem & 63;
            attn_item(QB, KB, VT, MIX, NCTX + b * 1024 + qt * 16, h, M + b * 256, 256, NCTX + b * 1024, 1024, plds, lane); }
        else { const int s2 = slot - 1024;
            for (int i = 0; i < 4; ++i) { const int ci = s2 * 4 + i, b = ci >> 7, rem = ci & 127, h = rem >> 4, qt = rem & 15;
                attn_item(QB, KB, VT, MIX, b * 256 + qt * 16, h, b * 256, 256, 0, 0, plds, lane); } }
    }
}

__device__ __forceinline__ void ph_gdn_scan(const Ctx& A, int l, LAS unsigned char* lds, int tid, int vcu, int G) {
    const float* GQ = (const float*)(A.ws + WS_GQ); const float* GK = GQ + (size_t)M * 512; const float* GV = GK + (size_t)M * 512;
    const float* GBETA = (const float*)(A.ws + WS_GBG); const float* GG = GBETA + (size_t)M * 8; float* GO = (float*)(A.ws + WS_GO);
    const int grp = tid >> 7, j = tid & 127;
    const int item = grp * G + vcu;
    const bool active = item < 272;
    int T = 0, row0 = 0, h = 0, dir = 0, b = 0; bool lat = false;
    if (active) { if (item < 256) { b = item >> 3; h = (item >> 1) & 3; dir = item & 1; T = 256; row0 = b * 256; }
                  else { const int q = item - 256; b = q >> 3; h = (q >> 1) & 3; dir = q & 1; T = 1024; row0 = NCTX + b * 1024; lat = true; } }
    int Tmax = 0;
    for (int p = 0; p < 4; ++p) { const int it = p * G + vcu; if (it < 272) { const int tt = it < 256 ? 256 : 1024; Tmax = tt > Tmax ? tt : Tmax; } }
    float S[128];
    if (lat) { const float* s0 = A.in[4] + ((size_t)(((b * 4 + l) * 2 + dir) * 4 + h) * 128) * 128 + j;
#pragma unroll
        for (int i = 0; i < 128; ++i) S[i] = s0[(size_t)i * 128]; }
    else {
#pragma unroll
        for (int i = 0; i < 128; ++i) S[i] = 0.f; }
    LAS float* sk = (LAS float*)(lds + grp * 24832); LAS float* sq = sk + 2048; LAS float* sv = sk + 4096; LAS float* sg = sk + 6144; LAS float* sb = sk + 6160;
    for (int t0 = 0; t0 < Tmax; t0 += 16) {
        const bool on = active && t0 < T;
        if (on) {
#pragma unroll 4
            for (int s = 0; s < 16; ++s) { const int tok = dir ? T - 1 - (t0 + s) : t0 + s; const size_t mo = (size_t)(row0 + tok) * 512 + h * 128 + j;
                sk[s * 128 + j] = GK[mo]; sq[s * 128 + j] = GQ[mo]; sv[s * 128 + j] = GV[mo]; }
            if (j < 16) { const int tok = dir ? T - 1 - (t0 + j) : t0 + j; const size_t mo = (size_t)(row0 + tok) * 8 + dir * 4 + h; sg[j] = GG[mo]; sb[j] = GBETA[mo]; }
        }
        __syncthreads();
        if (on) {
#pragma unroll 1
            for (int s = 0; s < 16; ++s) {
                const float dec = expf(sg[s]);
                float kS = 0.f;
#pragma unroll
                for (int i = 0; i < 128; i += 4) { const f32x4 k4 = *(const LAS f32x4*)(sk + s * 128 + i); kS += k4.x * S[i] + k4.y * S[i + 1] + k4.z * S[i + 2] + k4.w * S[i + 3];
                    if ((i & 15) == 12) asm volatile("" ::: "memory"); }
                const float vn = sb[s] * (sv[s * 128 + j] - dec * kS);
                float o = 0.f;
#pragma unroll
                for (int i = 0; i < 128; i += 4) { const f32x4 k4 = *(const LAS f32x4*)(sk + s * 128 + i); const f32x4 q4 = *(const LAS f32x4*)(sq + s * 128 + i);
                    S[i] = dec * S[i] + k4.x * vn; S[i + 1] = dec * S[i + 1] + k4.y * vn; S[i + 2] = dec * S[i + 2] + k4.z * vn; S[i + 3] = dec * S[i + 3] + k4.w * vn;
                    o += q4.x * S[i] + q4.y * S[i + 1] + q4.z * S[i + 2] + q4.w * S[i + 3];
                    if ((i & 15) == 12) asm volatile("" ::: "memory"); }
                const int tok = dir ? T - 1 - (t0 + s) : t0 + s;
                GO[((size_t)dir * M + row0 + tok) * 512 + h * 128 + j] = o * 0.08838834764831845f;
            }
        }
        __syncthreads();
    }
    if (active && !lat) { float* dst = A.out + O_SG + ((size_t)(((b * 4 + l) * 2 + dir) * 4 + h) * 128) * 128 + j;
#pragma unroll
        for (int i = 0; i < 128; ++i) dst[(size_t)i * 128] = S[i]; }
}

__device__ __forceinline__ void ph_ssd_scan(const Ctx& A, int l, LAS unsigned char* lds, int lane, int wave, int vcu, int G) {
    const float* XBC = (const float*)(A.ws + WS_XBC); const float* SDT = (const float*)(A.ws + WS_SDT); const float* SDA = SDT + (size_t)M * 16; float* SY = (float*)(A.ws + WS_SY);
    int b, h, dir, T, row0; bool lat = false;
    if (wave < 2) { const int item = wave * G + vcu; if (item >= 512) return; b = item >> 4; h = (item >> 1) & 7; dir = item & 1; T = 256; row0 = b * 256; }
    else if (wave == 2) { const int q = vcu - 16; if (q < 0 || q >= 32) return; b = q >> 4; h = (q >> 1) & 7; dir = q & 1; T = 1024; row0 = NCTX + b * 1024; lat = true; }
    else return;
    float S[128];
    if (lat) { const float* s0 = A.in[5] + ((size_t)(((b * 4 + l) * 2 + dir) * 8 + h) * 64 + lane) * 128;
#pragma unroll
        for (int n = 0; n < 128; n += 4) { const f32x4 v = *(const f32x4*)(s0 + n); S[n] = v.x; S[n + 1] = v.y; S[n + 2] = v.z; S[n + 3] = v.w; } }
    else {
#pragma unroll
        for (int n = 0; n < 128; ++n) S[n] = 0.f; }
    LAS float* sB = (LAS float*)(lds + wave * 10496); LAS float* sC = sB + 1024; LAS float* sx = sB + 2048; LAS float* sdt = sB + 2560; LAS float* sda = sB + 2568;
    const int g = h >> 2;
    for (int t0 = 0; t0 < T; t0 += 8) {
#pragma unroll 4
        for (int s = 0; s < 8; ++s) { const int tok = dir ? T - 1 - (t0 + s) : t0 + s; const float* xr = XBC + (size_t)(row0 + tok) * 1024;
            sB[s * 128 + lane] = xr[512 + g * 128 + lane]; sB[s * 128 + 64 + lane] = xr[512 + g * 128 + 64 + lane];
            sC[s * 128 + lane] = xr[768 + g * 128 + lane]; sC[s * 128 + 64 + lane] = xr[768 + g * 128 + 64 + lane];
            sx[s * 64 + lane] = xr[h * 64 + lane]; }
        if (lane < 8) { const int tok = dir ? T - 1 - (t0 + lane) : t0 + lane; const size_t mo = (size_t)(row0 + tok) * 16 + dir * 8 + h; sdt[lane] = SDT[mo]; sda[lane] = SDA[mo]; }
        asm volatile("s_waitcnt lgkmcnt(0)" ::: "memory");
#pragma unroll 1
        for (int s = 0; s < 8; ++s) {
            const float a = expf(sda[s]); const float xd = sx[s * 64 + lane] * sdt[s];
            float y = 0.f;
#pragma unroll
            for (int n = 0; n < 128; n += 4) { const f32x4 b4 = *(const LAS f32x4*)(sB + s * 128 + n); const f32x4 c4 = *(const LAS f32x4*)(sC + s * 128 + n);
                S[n] = a * S[n] + xd * b4.x; S[n + 1] = a * S[n + 1] + xd * b4.y; S[n + 2] = a * S[n + 2] + xd * b4.z; S[n + 3] = a * S[n + 3] + xd * b4.w;
                y += S[n] * c4.x + S[n + 1] * c4.y + S[n + 2] * c4.z + S[n + 3] * c4.w; }
            const int tok = dir ? T - 1 - (t0 + s) : t0 + s;
            SY[((size_t)dir * M + row0 + tok) * 512 + h * 64 + lane] = y;
        }
        asm volatile("s_waitcnt lgkmcnt(0)" ::: "memory");
    }
    if (!lat) { float* dst = A.out + O_SS + ((size_t)(((b * 4 + l) * 2 + dir) * 8 + h) * 64 + lane) * 128;
#pragma unroll
        for (int n = 0; n < 128; n += 4) *(f32x4*)(dst + n) = (f32x4){S[n], S[n + 1], S[n + 2], S[n + 3]}; }
}

__device__ __forceinline__ void ph_post(const Ctx& A, int l, int lane, int gw, int NGW) {
    const float* U = (const float*)(A.ws + WS_U); const float* GO = (const float*)(A.ws + WS_GO); const float* SY = (const float*)(A.ws + WS_SY); const float* XBC = (const float*)(A.ws + WS_XBC);
    bf16* MIX = (bf16*)(A.ws + WS_MIX);
    const float* gng = A.in[23] + l * 128; const float* sd = A.in[28] + l * 8; const float* sng = A.in[29] + l * 512;
    for (int m = gw; m < M; m += NGW) {
        const float* u = U + (size_t)m * IN_WP;
#pragma unroll
        for (int i = 0; i < 2; ++i) { const int c = 4 * lane + 256 * i;
            f32x4 o = *(const f32x4*)(GO + (size_t)m * 512 + c) + *(const f32x4*)(GO + ((size_t)M + m) * 512 + c);
            const float ss = half_sum((o.x * o.x + o.y * o.y) + (o.z * o.z + o.w * o.w)); const float rstd = 1.0f / sqrtf(ss * (1.0f / 128.f) + EPS);
            const f32x4 g4 = *(const f32x4*)(gng + (c & 127)); const f32x4 z = *(const f32x4*)(u + U_GZ + c);
            o = o * rstd * g4; o.x *= silu(z.x); o.y *= silu(z.y); o.z *= silu(z.z); o.w *= silu(z.w);
            v2u w; w.x = pk2(o.x, o.y); w.y = pk2(o.z, o.w); *(GAS v2u*)(MIX + (size_t)m * D + 1024 + c) = w; }
#pragma unroll
        for (int i = 0; i < 2; ++i) { const int c = 4 * lane + 256 * i;
            f32x4 y = *(const f32x4*)(SY + (size_t)m * 512 + c) + *(const f32x4*)(SY + ((size_t)M + m) * 512 + c) + *(const f32x4*)(XBC + (size_t)m * 1024 + c) * sd[c >> 6];
            const f32x4 z = *(const f32x4*)(u + U_SZ + c);
            y.x *= silu(z.x); y.y *= silu(z.y); y.z *= silu(z.z); y.w *= silu(z.w);
            const float ss = wave_sum((y.x * y.x + y.y * y.y) + (y.z * y.z + y.w * y.w)); const float rstd = 1.0f / sqrtf(ss * (1.0f / 256.f) + EPS);
            y = y * rstd * *(const f32x4*)(sng + c);
            v2u w; w.x = pk2(y.x, y.y); w.y = pk2(y.z, y.w); *(GAS v2u*)(MIX + (size_t)m * D + 1536 + c) = w; }
    }
}

#ifndef MK_ONE_LAUNCH
#define MK_ONE_LAUNCH 0
#endif
__global__ void __launch_bounds__(NWAVES * 64, 2) mk_fwd(Args args) {
    extern __shared__ __attribute__((aligned(16))) unsigned char lds_raw[];
    LAS unsigned char* lds = (LAS unsigned char*)lds_raw;
    const int tid0 = threadIdx.x;
    for (int u = tid0; u < (LDS_BYTES - LDSCTL_OFF) / 4; u += NWAVES * 64) ((LAS unsigned*)(lds + LDSCTL_OFF))[u] = 0u;
    __syncthreads();
    const int lo0 = args.ph_lo, hi0 = args.ph_hi;
    XcdBarrier bar; bar.bar = (unsigned*)(args.ws + WS_CTL) + CW_BAR; bar.x = 0; bar.st = nullptr;
    if ((hi0 - lo0) > 1) bar = xcd_barrier_post((unsigned*)(args.ws + WS_CTL) + CW_BAR, (volatile LAS unsigned*)(lds + MISC_OFF) + 8);
#define IN(k) (lo <= (k) && (k) < hi)
#define SEAM(k) do { if (IN((k) + 1)) xcd_barrier(bar); } while (0)
#define PHASE_ROOTS() Ctx C; int G = (int)gridDim.x, bx = (int)blockIdx.x; int tid = tid0; asm volatile("" : "+v"(tid)); const int lane = tid & 63, wave = __builtin_amdgcn_readfirstlane(tid >> 6); (void)lane; (void)wave; \
    { unsigned long long kp_ = (unsigned long long)__builtin_amdgcn_kernarg_segment_ptr(); float* o_ = args.out; unsigned char* w_ = args.ws; \
      asm volatile("" : "+s"(kp_), "+s"(o_), "+s"(w_), "+s"(G), "+s"(bx)); C.in = (kin_t)kp_; C.out = o_; C.ws = w_; } \
    const int vcu = (G % 8 == 0) ? (bx % 8) * (G / 8) + bx / 8 : bx; const int gw = vcu * NWAVES + wave, NGW = G * NWAVES; (void)gw; (void)NGW; (void)vcu

    { int lo = lo0, hi = hi0;
    if (IN(0)) { PHASE_ROOTS();
#ifndef SKIP_PRO
        ph_prologue(C, lds, tid, lane, wave, vcu, G);
#endif
        SEAM(0); } }

#pragma unroll 1
    for (int l = 0; l < DEPTH; ++l) {
        const int pb = 1 + l * NPH_L;
        int lo = lo0, hi = hi0; asm volatile("" : "+s"(lo), "+s"(hi));
#define MODS_L ((const float*)(C.ws + WS_MODS) + (size_t)l * 3 * 12288)
#define WL ((const bf16*)(C.ws + WS_W) + (size_t)l * WLE_SIZE)
        if (IN(pb + 0)) { PHASE_ROOTS(); ph_norm(C.out, C.in[8] + l * D, MODS_L, 0, (bf16*)(C.ws + WS_H), lane, gw, NGW); SEAM(pb + 0); }
        if (IN(pb + 1)) { PHASE_ROOTS();
            pg8::Gemm g{(const bf16*)(C.ws + WS_H), WL + WLE_IN, M, IN_WP, D}; pg8::StaticOrder S; S.init(M, IN_WP, G, bx);
            pg8::EpiF32 E{(float*)(C.ws + WS_U), IN_WP};
            pg8::gemm_phase<pg8::EpiF32, pg8::StaticOrder, true, true>(lds, g, S, E);
            SEAM(pb + 1);
        }
        if (IN(pb + 2)) { PHASE_ROOTS();
#ifndef SKIP_PREP
            ph_prep(C, l, lane, gw, NGW);
#endif
            SEAM(pb + 2); }
        if (IN(pb + 3)) {
            { PHASE_ROOTS(); pg8::Gemm g{(const bf16*)(C.ws + WS_CQN), WL + WLE_UQ, M, 1536, 768}; pg8::StaticOrder S; S.init(M, 1536, G, bx);
              pg8::EpiF32 E{(float*)(C.ws + WS_QRAW), 1536};
              pg8::gemm_phase<pg8::EpiF32, pg8::StaticOrder, true, true>(lds, g, S, E); }
            { PHASE_ROOTS(); pg8::Gemm g{(const bf16*)(C.ws + WS_CKVN), WL + WLE_KV, MK, 1024, 512}; pg8::StaticOrder S; S.init(MK, 1024, G, bx);
              pg8::EpiF32 E{(float*)(C.ws + WS_KN), 1024};
              pg8::gemm_phase<pg8::EpiF32, pg8::StaticOrder, true, true>(lds, g, S, E); }
            { PHASE_ROOTS(); pg8::Gemm g{WL + WLE_KV + (size_t)1024 * 512, (const bf16*)(C.ws + WS_CKVN), 1024, MK, 512}; pg8::StaticOrder S; S.init(1024, MK, G, bx);
              pg8::EpiBf16 E{(bf16*)(C.ws + WS_VT), MK};
              pg8::gemm_phase<pg8::EpiBf16, pg8::StaticOrder, true, true>(lds, g, S, E); }
            SEAM(pb + 3);
        }
        if (IN(pb + 4)) { PHASE_ROOTS();
#ifndef SKIP_FIN
            ph_finalize(C, l, lane, gw, NGW);
#endif
            SEAM(pb + 4); }
        if (IN(pb + 5)) {
#ifndef SKIP_GDN
            { PHASE_ROOTS(); ph_gdn_scan(C, l, lds, tid, vcu, G); }
#endif
            __syncthreads();
#ifndef SKIP_SSD
            { PHASE_ROOTS(); ph_ssd_scan(C, l, lds, lane, wave, vcu, G); }
#endif
            __syncthreads();
#ifndef SKIP_ATTN
            { PHASE_ROOTS(); ph_attn(C, lds, lane, wave, gw, NGW); }
#endif
            SEAM(pb + 5);
        }
        if (IN(pb + 6)) { PHASE_ROOTS();
#ifndef SKIP_POST
            ph_post(C, l, lane, gw, NGW);
#endif
            SEAM(pb + 6); }
        if (IN(pb + 7)) { PHASE_ROOTS();
            pg8::Gemm g{(const bf16*)(C.ws + WS_MIX), WL + WLE_OUT, M, D, D}; pg8::StaticOrder S; S.init(M, D, G, bx);
            pg8::EpiResid E{C.out, D, MODS_L + 2 * 2048};
            pg8::gemm_phase<pg8::EpiResid, pg8::StaticOrder, true, true>(lds, g, S, E);
            SEAM(pb + 7);
        }
        if (IN(pb + 8)) { PHASE_ROOTS(); ph_norm(C.out, C.in[9] + l * D, MODS_L, 3, (bf16*)(C.ws + WS_H), lane, gw, NGW); SEAM(pb + 8); }
        if (IN(pb + 9)) { PHASE_ROOTS();
            pg8::Gemm g{(const bf16*)(C.ws + WS_H), WL + WLE_GU, M, 2 * FF, D}; pg8::StaticOrder S; S.init(M, 2 * FF, G, bx);
            pg8::EpiSwiglu E{(bf16*)(C.ws + WS_ACT), FF};
            pg8::gemm_phase<pg8::EpiSwiglu, pg8::StaticOrder, true, true>(lds, g, S, E);
            SEAM(pb + 9);
        }
        if (IN(pb + 10)) { PHASE_ROOTS();
            pg8::Gemm g{(const bf16*)(C.ws + WS_ACT), WL + WLE_DN, M, D, FF}; pg8::StaticOrder S; S.init(M, D, G, bx);
            pg8::EpiResid E{C.out, D, MODS_L + 5 * 2048};
            pg8::gemm_phase<pg8::EpiResid, pg8::StaticOrder, true, true>(lds, g, S, E);
            SEAM(pb + 10);
        }
    }
#undef IN
#undef SEAM
}

extern "C" void kernel_launch(void* const* d_in, const int* in_sizes, int n_in, void* d_out, int out_size, void* d_ws, size_t ws_size, hipStream_t stream) {
    static int grid = 0;
    if (grid == 0) {
        if (n_in != 32 || out_size != 73400320 || ws_size < WS_END) { fprintf(stderr, "kernel_launch: built for 32 inputs, 73400320 outputs, >= %zu bytes of workspace; got n_in %d, out %d, ws %zu; nothing launched\n", (size_t)WS_END, n_in, out_size, ws_size); grid = -1; return; }
        int dev = 0, cus = 0, per_cu = 0;
        if (hipGetDevice(&dev) != hipSuccess || hipDeviceGetAttribute(&cus, hipDeviceAttributeMultiprocessorCount, dev) != hipSuccess) { fprintf(stderr, "kernel_launch: device query failed\n"); grid = -1; return; }
        if (hipFuncSetAttribute((const void*)mk_fwd, hipFuncAttributeMaxDynamicSharedMemorySize, LDS_BYTES) != hipSuccess) { fprintf(stderr, "kernel_launch: hipFuncSetAttribute failed\n"); grid = -1; return; }
        if (hipOccupancyMaxActiveBlocksPerMultiprocessor(&per_cu, (const void*)mk_fwd, NWAVES * 64, LDS_BYTES) != hipSuccess || per_cu < 1)
            fprintf(stderr, "kernel_launch: note: occupancy query reports %d workgroups per CU\n", per_cu);
        (void)hipGetLastError();
        grid = cus;
    }
    if (grid < 0) return;
    if (hipMemsetAsync((char*)d_ws + WS_CTL, 0, CTL_ZERO_BYTES, stream) != hipSuccess) { fprintf(stderr, "kernel_launch: memset failed\n"); return; }
    Args a{};
    for (int i = 0; i < 32; ++i) a.in[i] = (const float*)d_in[i];
    a.out = (float*)d_out; a.ws = (unsigned char*)d_ws;
#if MK_ONE_LAUNCH
    a.ph_lo = 0; a.ph_hi = NPHASES;
    hipLaunchKernelGGL(mk_fwd, dim3(grid), dim3(NWAVES * 64), LDS_BYTES, stream, a);
#else
    for (int p = 0; p < NPHASES; ++p) { a.ph_lo = p; a.ph_hi = p + 1; hipLaunchKernelGGL(mk_fwd, dim3(grid), dim3(NWAVES * 64), LDS_BYTES, stream, a); }
#endif
    const hipError_t le = hipPeekAtLastError();
    if (le != hipSuccess) fprintf(stderr, "kernel_launch: launch failed: %s\n", hipGetErrorName(le));
}
```

```cpp
#include <hip/hip_runtime.h>
#include <cstdio>
#include <cstdint>
#include <cstddef>
#ifndef MK_ONE_LAUNCH
#define MK_ONE_LAUNCH 1
#endif
namespace pg8 {
#define PG8_LAS __attribute__((address_space(3)))
typedef unsigned short bf16_t;
typedef short bf16x8 __attribute__((ext_vector_type(8)));
typedef float f32x4 __attribute__((ext_vector_type(4)));
typedef unsigned u32x4 __attribute__((ext_vector_type(4)));
constexpr int BM = 256, BK = 64, HALF = 128, HTB = HALF * BK * 2  , STAGE_BYTES = 8 * HTB, NXCD = 8, WGM = 8;

__host__ __device__ __forceinline__ int lds_byte(int r, int c) { const int st = (r >> 4) * 2 + (c >> 5), rr = r & 15, cc = c & 31, ob = rr * 64 + cc * 2; return st * 1024 + (ob ^ (((ob >> 9) & 1) << 5)); }
__host__ __device__ __forceinline__ void stage_rc(int b, int& R, int& C) { const int st = b / 1024, sb = b % 1024, swz = sb ^ (((sb >> 9) & 1) << 5); R = (st >> 1) * 16 + swz / 64; C = (st & 1) * 32 + (swz % 64) / 2; }
__host__ __device__ __forceinline__ int perm32(int rho) { const int n = rho >> 4, i = rho & 15; return 8 * (i >> 2) + 4 * n + (i & 3); }

struct Unit { int pm, pn; };
struct Gemm { const bf16_t* A; const bf16_t* Bt; int M, N, K; };

struct StaticOrder {
    int nM, nN, nwg, G, c;
    __host__ __device__ void init(int M, int N, int G_, int c_) { nM = M / BM; nN = N / BM; nwg = nM * nN; G = G_; c = c_; }
    __host__ __device__ bool next(int i, Unit& u) const {
        const long L = (long)i * G + c; if (L >= nwg) return false;
        int wgid = (int)L; { const int q = nwg / NXCD, r = nwg % NXCD, xcd = wgid % NXCD, off = wgid / NXCD; wgid = (xcd < r ? xcd * (q + 1) : r * (q + 1) + (xcd - r) * q) + off; }
        const int nig = WGM * nN, gid = wgid / nig, fm = gid * WGM, gsz = (nM - fm) < WGM ? (nM - fm) : WGM;
        u.pm = fm + ((wgid % nig) % gsz); u.pn = (wgid % nig) / gsz; return true;
    }
    __device__ __forceinline__ void a_ready(const Unit&) const {}
    __device__ __forceinline__ void done(const Unit&) const {}
};

__device__ __forceinline__ unsigned cvt_pk_bf16(float lo, float hi) { unsigned r; asm volatile("v_cvt_pk_bf16_f32 %0, %1, %2" : "=v"(r) : "v"(lo), "v"(hi)); return r; }
__device__ __forceinline__ float silu_f(float x) { return x * __builtin_amdgcn_rcpf(1.0f + __expf(-x)); }

struct EpiF32 {
    static constexpr bool PERM = false, AFTER_DRAIN = false;
    float* C; int ldc;
    __device__ __forceinline__ void operator()(const f32x4 (&acc)[2][2][4][2], const Unit& u, int wr, int wc, int fr, int fq) const {
        const int row0 = u.pm * BM + wr * 64 + fr, col0 = u.pn * BM + wc * 32 + 4 * fq;
#pragma unroll
        for (int ai = 0; ai < 2; ++ai)
#pragma unroll
            for (int m = 0; m < 4; ++m) { float* rowp = C + (size_t)(row0 + ai * HALF + m * 16) * ldc + col0;
#pragma unroll
                for (int bj = 0; bj < 2; ++bj)
#pragma unroll
                    for (int n = 0; n < 2; ++n) *(f32x4*)(rowp + bj * HALF + n * 16) = acc[ai][bj][m][n]; }
    }
};
struct EpiBf16 {
    static constexpr bool PERM = true, AFTER_DRAIN = false;
    bf16_t* O; int ldc;
    __device__ __forceinline__ void operator()(const f32x4 (&acc)[2][2][4][2], const Unit& u, int wr, int wc, int fr, int fq) const {
        const int row0 = u.pm * BM + wr * 64 + fr; const int col0 = u.pn * BM + wc * 32 + 8 * fq;
#pragma unroll
        for (int ai = 0; ai < 2; ++ai)
#pragma unroll
            for (int m = 0; m < 4; ++m) { bf16_t* rowp = O + (size_t)(row0 + ai * HALF + m * 16) * ldc + col0;
#pragma unroll
                for (int bj = 0; bj < 2; ++bj) { const f32x4 v0 = acc[ai][bj][m][0], v1 = acc[ai][bj][m][1];
                    u32x4 w; w.x = cvt_pk_bf16(v0[0], v0[1]); w.y = cvt_pk_bf16(v0[2], v0[3]); w.z = cvt_pk_bf16(v1[0], v1[1]); w.w = cvt_pk_bf16(v1[2], v1[3]);
                    *(u32x4*)(rowp + bj * HALF) = w; } }
    }
};
struct EpiResid {
    static constexpr bool PERM = false, AFTER_DRAIN = false;
    float* X; int ldc; const float* gate;
    __device__ __forceinline__ void operator()(const f32x4 (&acc)[2][2][4][2], const Unit& u, int wr, int wc, int fr, int fq) const {
        const int row0 = u.pm * BM + wr * 64 + fr, col0 = u.pn * BM + wc * 32 + 4 * fq;
        const int cr = u.pm < 32 ? 0 : 1 + ((u.pm - 32) >> 2);
        const float* gp = gate + (size_t)cr * 12288 + col0;
        f32x4 gv[2][2];
#pragma unroll
        for (int bj = 0; bj < 2; ++bj)
#pragma unroll
            for (int n = 0; n < 2; ++n) gv[bj][n] = *(const f32x4*)(gp + bj * HALF + n * 16);
#pragma unroll
        for (int ai = 0; ai < 2; ++ai)
#pragma unroll
            for (int m = 0; m < 4; ++m) { float* rowp = X + (size_t)(row0 + ai * HALF + m * 16) * ldc + col0;
#pragma unroll
                for (int bj = 0; bj < 2; ++bj)
#pragma unroll
                    for (int n = 0; n < 2; ++n) { f32x4 x = *(const f32x4*)(rowp + bj * HALF + n * 16); x = x + gv[bj][n] * acc[ai][bj][m][n]; *(f32x4*)(rowp + bj * HALF + n * 16) = x; } }
    }
};
struct EpiSwiglu {
    static constexpr bool PERM = true, AFTER_DRAIN = false;
    bf16_t* O; int ldc;
    __device__ __forceinline__ void operator()(const f32x4 (&acc)[2][2][4][2], const Unit& u, int wr, int wc, int fr, int fq) const {
        const int row0 = u.pm * BM + wr * 64 + fr; const int col0 = u.pn * HALF + wc * 32 + 8 * fq;
#pragma unroll
        for (int ai = 0; ai < 2; ++ai)
#pragma unroll
            for (int m = 0; m < 4; ++m) { bf16_t* rowp = O + (size_t)(row0 + ai * HALF + m * 16) * ldc + col0;
                f32x4 v0, v1;
#pragma unroll
                for (int j = 0; j < 4; ++j) { v0[j] = silu_f(acc[ai][0][m][0][j]) * acc[ai][1][m][0][j]; v1[j] = silu_f(acc[ai][0][m][1][j]) * acc[ai][1][m][1][j]; }
                u32x4 w; w.x = cvt_pk_bf16(v0[0], v0[1]); w.y = cvt_pk_bf16(v0[2], v0[3]); w.z = cvt_pk_bf16(v1[0], v1[1]); w.w = cvt_pk_bf16(v1[2], v1[3]);
                *(u32x4*)rowp = w; }
    }
};

template <class Epi, class Sched, bool ALIGN_EPI = false, bool SP2 = false>
__device__ __forceinline__ void gemm_phase(PG8_LAS unsigned char* lds, const Gemm g, const Sched& S, const Epi& E) {
    int tid_l = threadIdx.x; asm volatile("" : "+v"(tid_l)); const int tid = tid_l, wid = __builtin_amdgcn_readfirstlane(tid >> 6), lane = tid & 63, wr = wid >> 2, wc = wid & 3, fr = lane & 15, fq = lane >> 4;
    const int K = g.K, nt = K / BK;
    unsigned voffA[2], voffB[2];
#pragma unroll
    for (int i = 0; i < 2; ++i) { int R, C; stage_rc(tid * 16 + i * 8192, R, C); const int Rb = Epi::PERM ? ((R & ~31) + perm32(R & 31)) : R;
        voffA[i] = (unsigned)(R * K + C) * 2u; voffB[i] = (unsigned)(Rb * K + C) * 2u; }
    const size_t kstep = (size_t)(BK * 2);
    const size_t hstep = (size_t)HALF * K * 2;
    const size_t tstep = 2 * hstep;
    const unsigned ldsw = (unsigned)wid * 1024u;
    const int aoff = lds_byte(wr * 64 + fr, fq * 8), boff = lds_byte(wc * 32 + fr, fq * 8);
#define PG8_SA(b, h) (((b) * 2 + (h)) * HTB)
#define PG8_SB(b, h) ((4 + (b) * 2 + (h)) * HTB)
#define PG8_STAGE(bufoff, gbase, voff) do { _Pragma("unroll") for (int _i = 0; _i < 2; ++_i) \
        __builtin_amdgcn_global_load_lds((const unsigned*)((const char*)(gbase) + (voff)[_i]), (PG8_LAS unsigned*)(lds + (bufoff) + ldsw + _i * 8192), 16, 0, 0); } while (0)
#define PG8_LDA(dst, b, h) do { _Pragma("unroll") for (int m = 0; m < 4; ++m) _Pragma("unroll") for (int k = 0; k < 2; ++k) dst[m][k] = *(const PG8_LAS bf16x8*)(lds + PG8_SA(b, h) + aoff + m * 2048 + k * 1024); } while (0)
#define PG8_LDB(dst, b, h) do { _Pragma("unroll") for (int n = 0; n < 2; ++n) _Pragma("unroll") for (int k = 0; k < 2; ++k) dst[n][k] = *(const PG8_LAS bf16x8*)(lds + PG8_SB(b, h) + boff + n * 2048 + k * 1024); } while (0)
#define PG8_MMA(ai, bj, At, Bt) do { __builtin_amdgcn_s_setprio(1); _Pragma("unroll") for (int m = 0; m < 4; ++m) _Pragma("unroll") for (int n = 0; n < 2; ++n) _Pragma("unroll") for (int k = 0; k < 2; ++k) \
        acc[ai][bj][m][n] = __builtin_amdgcn_mfma_f32_16x16x32_bf16(Bt[n][k], At[m][k], acc[ai][bj][m][n], 0, 0, 0); __builtin_amdgcn_s_setprio(0); } while (0)
#define PG8_WAIT_V(n) asm volatile("s_waitcnt vmcnt(" #n ")" ::: "memory")
#define PG8_WAIT_L(n) asm volatile("s_waitcnt lgkmcnt(" #n ")" ::: "memory")
#define PG8_BAR __builtin_amdgcn_s_barrier()
#define PG8_SCHED __builtin_amdgcn_sched_barrier(0)
    Unit cur, nxt; int ui = 0;
    if (!S.next(0, cur)) return;
    f32x4 acc[2][2][4][2];
#pragma unroll
    for (int a = 0; a < 2; ++a)
#pragma unroll
        for (int b = 0; b < 2; ++b)
#pragma unroll
            for (int m = 0; m < 4; ++m)
#pragma unroll
                for (int n = 0; n < 2; ++n) acc[a][b][m][n] = (f32x4){0.f, 0.f, 0.f, 0.f};
    bf16x8 At[4][2], B0[2][2], B1[2][2];
    const char* cA = (const char*)g.A + (size_t)cur.pm * tstep; const char* cB = (const char*)g.Bt + (size_t)cur.pn * tstep;
    S.a_ready(cur);
    if constexpr (SP2) {
        PG8_STAGE(PG8_SB(0, 0), cB, voffB); PG8_STAGE(PG8_SB(0, 1), cB + hstep, voffB); PG8_STAGE(PG8_SA(0, 0), cA, voffA); PG8_STAGE(PG8_SA(0, 1), cA + hstep, voffA);
        if (wr == 1) PG8_BAR;
        PG8_WAIT_V(2); PG8_BAR;
        PG8_STAGE(PG8_SB(1, 0), cB + kstep, voffB); PG8_STAGE(PG8_SA(1, 0), cA + kstep, voffA); PG8_STAGE(PG8_SB(1, 1), cB + hstep + kstep, voffB);
        PG8_WAIT_V(6); PG8_BAR;
    } else {
        PG8_STAGE(PG8_SB(0, 0), cB, voffB); PG8_STAGE(PG8_SA(0, 0), cA, voffA); PG8_STAGE(PG8_SB(0, 1), cB + hstep, voffB); PG8_STAGE(PG8_SA(0, 1), cA + hstep, voffA);
        if (wr == 1) PG8_BAR;
        PG8_WAIT_V(4); PG8_BAR;
        PG8_STAGE(PG8_SB(1, 0), cB + kstep, voffB); PG8_STAGE(PG8_SA(1, 0), cA + kstep, voffA); PG8_STAGE(PG8_SB(1, 1), cB + hstep + kstep, voffB);
        PG8_WAIT_V(6); PG8_BAR;
    }
    for (;;) {
        const bool has_next = S.next(ui + 1, nxt);
        const char* nA = has_next ? (const char*)g.A + (size_t)nxt.pm * tstep : cA; const char* nB = has_next ? (const char*)g.Bt + (size_t)nxt.pn * tstep : cB;
        for (int t = 0; t < nt; t += 2) {
            const bool last = (t == nt - 2);
            const char* a1 = cA + (size_t)(t + 1) * kstep;
            const char* a2 = last ? nA : cA + (size_t)(t + 2) * kstep; const char* b2 = last ? nB : cB + (size_t)(t + 2) * kstep;
            const char* a3 = a2 + kstep; const char* b3 = b2 + kstep;
            if (last && has_next) S.a_ready(nxt);
            if constexpr (SP2) {
            PG8_LDB(B0, 0, 0); PG8_LDB(B1, 0, 1); PG8_SCHED; PG8_LDA(At, 0, 0); PG8_STAGE(PG8_SA(1, 1), a1 + hstep, voffA);
            PG8_WAIT_V(8); PG8_WAIT_L(0); PG8_BAR; PG8_MMA(0, 0, At, B0); PG8_MMA(0, 1, At, B1); PG8_BAR; PG8_SCHED;
            PG8_LDA(At, 0, 1); PG8_STAGE(PG8_SB(0, 0), b2, voffB); PG8_STAGE(PG8_SB(0, 1), b2 + hstep, voffB); PG8_STAGE(PG8_SA(0, 0), a2, voffA);
            PG8_WAIT_V(8); PG8_WAIT_L(0); PG8_BAR; PG8_MMA(1, 0, At, B0); PG8_MMA(1, 1, At, B1); PG8_BAR; PG8_SCHED;
            PG8_LDB(B0, 1, 0); PG8_LDB(B1, 1, 1); PG8_SCHED; PG8_LDA(At, 1, 0); PG8_STAGE(PG8_SA(0, 1), a2 + hstep, voffA);
            PG8_WAIT_V(8); PG8_WAIT_L(0); PG8_BAR; PG8_MMA(0, 0, At, B0); PG8_MMA(0, 1, At, B1); PG8_BAR; PG8_SCHED;
            PG8_LDA(At, 1, 1); PG8_STAGE(PG8_SB(1, 0), b3, voffB); PG8_STAGE(PG8_SB(1, 1), b3 + hstep, voffB); PG8_STAGE(PG8_SA(1, 0), a3, voffA);
            PG8_WAIT_V(8); PG8_WAIT_L(0); PG8_BAR; PG8_MMA(1, 0, At, B0); PG8_MMA(1, 1, At, B1); PG8_BAR; PG8_SCHED;
            } else {
            PG8_LDB(B0, 0, 0); PG8_SCHED; PG8_LDA(At, 0, 0); PG8_STAGE(PG8_SA(1, 1), a1 + hstep, voffA);
            PG8_WAIT_L(8); PG8_BAR; PG8_WAIT_L(0); PG8_MMA(0, 0, At, B0); PG8_BAR; PG8_SCHED;
            PG8_LDB(B1, 0, 1); PG8_STAGE(PG8_SB(0, 0), b2, voffB);
            PG8_BAR; PG8_WAIT_L(0); PG8_MMA(0, 1, At, B1); PG8_BAR;
            PG8_LDA(At, 0, 1); PG8_STAGE(PG8_SA(0, 0), a2, voffA);
            PG8_BAR; PG8_WAIT_L(0); PG8_MMA(1, 0, At, B0); PG8_BAR; PG8_SCHED;
            PG8_STAGE(PG8_SB(0, 1), b2 + hstep, voffB);
            PG8_WAIT_V(6); PG8_BAR; PG8_MMA(1, 1, At, B1); PG8_BAR;
            PG8_LDB(B0, 1, 0); PG8_SCHED; PG8_LDA(At, 1, 0); PG8_STAGE(PG8_SA(0, 1), a2 + hstep, voffA);
            PG8_WAIT_L(8); PG8_BAR; PG8_WAIT_L(0); PG8_MMA(0, 0, At, B0); PG8_BAR; PG8_SCHED;
            PG8_LDB(B1, 1, 1); PG8_STAGE(PG8_SB(1, 0), b3, voffB);
            PG8_BAR; PG8_WAIT_L(0); PG8_MMA(0, 1, At, B1); PG8_BAR;
            PG8_LDA(At, 1, 1); PG8_STAGE(PG8_SA(1, 0), a3, voffA);
            PG8_BAR; PG8_WAIT_L(0); PG8_MMA(1, 0, At, B0); PG8_BAR; PG8_SCHED;
            PG8_STAGE(PG8_SB(1, 1), b3 + hstep, voffB);
            PG8_WAIT_V(6); PG8_BAR; PG8_MMA(1, 1, At, B1); PG8_BAR;
            }
        }
        if constexpr (ALIGN_EPI) { if (wr == 0) PG8_BAR; }
        if constexpr (!Epi::AFTER_DRAIN) { E(acc, cur, wr, wc, fr, fq); S.done(cur); }
        if (!has_next) break;
#pragma unroll
        for (int a = 0; a < 2; ++a)
#pragma unroll
            for (int b = 0; b < 2; ++b)
#pragma unroll
                for (int m = 0; m < 4; ++m)
#pragma unroll
                    for (int n = 0; n < 2; ++n) acc[a][b][m][n] = (f32x4){0.f, 0.f, 0.f, 0.f};
        cur = nxt; cA = nA; cB = nB; ++ui;
        if constexpr (ALIGN_EPI) { if (wr == 1) PG8_BAR; }
    }
    PG8_WAIT_V(0);
    if constexpr (!ALIGN_EPI) { if (wr == 0) PG8_BAR; }
    PG8_BAR;
    if constexpr (Epi::AFTER_DRAIN) { E.fused(acc, cur, wr, wc, fr, fq, lds, wid, lane); S.done(cur); }
#undef PG8_SA
#undef PG8_SB
#undef PG8_STAGE
#undef PG8_LDA
#undef PG8_LDB
#undef PG8_MMA
#undef PG8_WAIT_V
#undef PG8_WAIT_L
#undef PG8_BAR
#undef PG8_SCHED
}
}
constexpr int D = 2048, NCTX = 8192, M = 10240, MK = 10752, DEPTH = 4, NWAVES = 8;
constexpr int IN_W = 4960, IN_WP = 5120, FF = 5632;
constexpr int U_CQ = 0, U_CKV = 768, U_KR = 1280, U_GQKV = 1344, U_GZ = 1344 + 1536, U_GB = 1344 + 2048, U_GA = 1344 + 2056, U_SZ = 3408, U_SXBC = 3408 + 512, U_SDT = 3408 + 1536;
constexpr float EPS = 1e-6f;
constexpr int NPH_L = 11, NPHASES = 1 + DEPTH * NPH_L;
constexpr size_t O_YP = 0, O_YS = 16777216, O_CKV = 20971520, O_KR = 37748736, O_SG = 39845888, O_SS = 56623104;
constexpr size_t MiB = 1u << 20;
constexpr size_t WS_CTL = 0, CTL_ZERO_BYTES = 1 * MiB;
constexpr size_t WL_IN = 0, WL_UQ = WL_IN + (size_t)IN_WP * D * 2, WL_UKV = WL_UQ + (size_t)1536 * 768 * 2, WL_OUT = WL_UKV + (size_t)2048 * 512 * 2,
                 WL_GU = WL_OUT + (size_t)D * D * 2, WL_DN = WL_GU + (size_t)2 * FF * D * 2, WL_SIZE = WL_DN + (size_t)D * FF * 2;
constexpr size_t WS_W = 2 * MiB;
constexpr size_t WS_MODS = WS_W + 4 * WL_SIZE;
constexpr size_t WS_H = WS_MODS + 1 * MiB;
constexpr size_t WS_U = WS_H + (size_t)M * D * 2;
constexpr size_t WS_CQN = WS_U + (size_t)M * IN_WP * 4;
constexpr size_t WS_CKVN = WS_CQN + (size_t)M * 768 * 2;
constexpr size_t WS_QRAW = WS_CKVN + (size_t)MK * 512 * 2;
constexpr size_t WS_KN = WS_QRAW + (size_t)M * 1536 * 4;
constexpr size_t WS_VT = WS_KN + (size_t)MK * 1024 * 4;
constexpr size_t WS_QB = WS_VT + (size_t)1024 * MK * 2;
constexpr size_t WS_KB = WS_QB + (size_t)M * 1536 * 2;
constexpr size_t WS_GQ = WS_KB + (size_t)MK * 1536 * 2;
constexpr size_t WS_GBG = WS_GQ + (size_t)3 * M * 512 * 4;
constexpr size_t WS_GO = WS_GBG + (size_t)2 * M * 8 * 4;
constexpr size_t WS_XBC = WS_GO + (size_t)2 * M * 512 * 4;
constexpr size_t WS_SDT = WS_XBC + (size_t)M * 1024 * 4;
constexpr size_t WS_SY = WS_SDT + (size_t)2 * M * 16 * 4;
constexpr size_t WS_MIX = WS_SY + (size_t)2 * M * 512 * 4;
constexpr size_t WS_ACT = WS_MIX + (size_t)M * D * 2;
constexpr size_t WS_GCH = WS_ACT + (size_t)M * FF * 2;
constexpr size_t WS_SREC = WS_GCH + (size_t)1280 * 90368;
constexpr size_t WS_SSH = WS_SREC + (size_t)1280 * 66560;
constexpr size_t WS_END = WS_SSH + (size_t)160 * 65536;
constexpr int CW_BAR = 4096;
constexpr int RING_BYTES = 131072, LDSCTL_OFF = RING_BYTES, MISC_OFF = LDSCTL_OFF + 320, LDS_BYTES = 147456;

#define GAS __attribute__((address_space(1)))
#define LAS __attribute__((address_space(3)))
typedef unsigned short bf16;
typedef unsigned v4u __attribute__((ext_vector_type(4)));
typedef unsigned v2u __attribute__((ext_vector_type(2)));
typedef float f32x4 __attribute__((ext_vector_type(4)));
typedef float f32x2 __attribute__((ext_vector_type(2)));
typedef short bf16x8 __attribute__((ext_vector_type(8)));
typedef GAS unsigned gu32;
#define RLX_AGENT __ATOMIC_RELAXED, __HIP_MEMORY_SCOPE_AGENT
#define LDS_WAIT() asm volatile("s_waitcnt lgkmcnt(0)" ::: "memory")
#define VM_WAIT() asm volatile("s_waitcnt vmcnt(0)" ::: "memory")
__device__ __forceinline__ unsigned f2bf(float f) { unsigned u = __builtin_bit_cast(unsigned, f); return (u + 0x7fffu + ((u >> 16) & 1u)) >> 16; }
__device__ __forceinline__ unsigned pk2(float lo, float hi) { return f2bf(lo) | (f2bf(hi) << 16); }
__device__ __forceinline__ float wave_sum(float v) {
#pragma unroll
    for (int o = 1; o < 64; o <<= 1) v += __shfl_xor(v, o);
    return v;
}
__device__ __forceinline__ float half_sum(float v) {
#pragma unroll
    for (int o = 1; o < 32; o <<= 1) v += __shfl_xor(v, o);
    return v;
}
__device__ __forceinline__ float silu(float x) { return x / (1.0f + expf(-x)); }
__device__ __forceinline__ float softplus(float x) { return x > 20.f ? x : log1pf(expf(x)); }

#define XB_TMO      128
#define XB_XCNT(j)  (256  + 64 * (j))
#define XB_XSUB(j)  (1280 + 64 * (j))
#define XB_XGEN(j)  (2304 + 64 * (j))
#define XB_TOP      3328
#define XB_TOPGEN   3392
#define XCD_BAR_WORDS 3456
#define XB_SPIN_CAP (1u << 18)

__device__ __forceinline__ unsigned xb_ld(unsigned* p)              { return __hip_atomic_load(p, __ATOMIC_RELAXED, __HIP_MEMORY_SCOPE_AGENT); }
__device__ __forceinline__ unsigned xb_add(unsigned* p, unsigned v) { return __hip_atomic_fetch_add(p, v, __ATOMIC_RELAXED, __HIP_MEMORY_SCOPE_AGENT); }
__device__ __forceinline__ unsigned xb_xcc_id() { return (unsigned)__builtin_amdgcn_s_getreg((3 << 11) | 20) & 0xFu; }
#define XB_SPIN(cond, bar) do { unsigned _sp = 0; while (cond) { __builtin_amdgcn_s_sleep(1); \
    if ((++_sp & 255u) == 0u) { if (xb_ld(&(bar)[XB_TMO])) break; if (_sp > XB_SPIN_CAP) { atomicAdd(&(bar)[XB_TMO], 1u); break; } } } } while (0)

struct XcdBarrier {
    unsigned* bar; unsigned x;
    volatile LAS unsigned* st;
};

__device__ __forceinline__ XcdBarrier xcd_barrier_post(unsigned* bar, volatile LAS unsigned* st) {
    XcdBarrier b; b.bar = bar; b.x = xb_xcc_id(); b.st = st;
    if (threadIdx.x == 0) (void)xb_add(&bar[XB_XCNT(b.x)], 1u);
    return b;
}
__device__ __forceinline__ void xcd_barrier_complete(unsigned* bar, unsigned x, unsigned& nloc, unsigned& nx) {
    const unsigned G = gridDim.x * gridDim.y * gridDim.z;
    unsigned sum, cnt, mine, sp = 0u;
    for (;;) {
        sum = 0u; cnt = 0u; mine = 0u;
#pragma unroll
        for (unsigned j = 0; j < 16; ++j) { const unsigned c = xb_ld(&bar[XB_XCNT(j)]); sum += c; cnt += (c > 0u) ? 1u : 0u; mine = (j == x) ? c : mine; }
        if (sum == G) break;
        __builtin_amdgcn_s_sleep(1);
        if ((++sp & 255u) == 0u) { if (xb_ld(&bar[XB_TMO])) break; if (sp > XB_SPIN_CAP) { atomicAdd(&bar[XB_TMO], 1u); break; } }
    }
    nloc = mine > 0u ? mine : 1u; nx = cnt > 0u ? cnt : 1u;
}

__device__ __forceinline__ void xcd_barrier(const XcdBarrier& b) {
    asm volatile("s_waitcnt vmcnt(0)" ::: "memory");
    __syncthreads();
    if (threadIdx.x == 0) {
        unsigned* bar = b.bar;
        __builtin_amdgcn_s_waitcnt(0);
        unsigned nloc = b.st[0], nx = b.st[1];
        if (nloc == 0u) { xcd_barrier_complete(bar, b.x, nloc, nx); b.st[0] = nloc; b.st[1] = nx; }
        const unsigned old = xb_add(&bar[XB_XSUB(b.x)], 1u);
        const unsigned gen = old / nloc;
        if (old + 1u == (gen + 1u) * nloc) {
            __builtin_amdgcn_fence(__ATOMIC_RELEASE, "agent");
            asm volatile("s_waitcnt vmcnt(0)" ::: "memory");
            const unsigned og = xb_add(&bar[XB_TOP], 1u);
            const unsigned tg = og / nx;
            if (og + 1u == (tg + 1u) * nx) xb_add(&bar[XB_TOPGEN], 1u);
            else XB_SPIN(xb_ld(&bar[XB_TOPGEN]) == tg, bar);
            __builtin_amdgcn_fence(__ATOMIC_ACQUIRE, "agent");
            xb_add(&bar[XB_XGEN(b.x)], 1u);
            asm volatile("s_waitcnt vmcnt(0)" ::: "memory");
        } else {
            XB_SPIN(xb_ld(&bar[XB_XGEN(b.x)]) == gen, bar);
            __builtin_amdgcn_fence(__ATOMIC_ACQUIRE, "agent");
            asm volatile("s_waitcnt vmcnt(0)" ::: "memory");
        }
    }
    __syncthreads();
}
struct Args { const float* in[32]; float* out; unsigned char* ws; int ph_lo, ph_hi; };
#define CAS __attribute__((address_space(4)))
typedef const float* const CAS* kin_t;
struct Ctx { kin_t in; float* out; unsigned char* ws; };

__device__ __forceinline__ void transpose_item(const float* __restrict__ W, int K, int N, bf16* WT, int k0, int n0, int drow0, LAS float* scr, int lane) {
#pragma unroll 8
    for (int i = 0; i < 32; ++i) { const int kk = 2 * i + (lane >> 5); scr[kk * 33 + (lane & 31)] = W[(size_t)(k0 + kk) * N + n0 + (lane & 31)]; }
    LDS_WAIT(); asm volatile("" ::: "memory");
    const int c = lane & 7;
#pragma unroll
    for (int j = 0; j < 4; ++j) { const int n = (lane >> 3) + 8 * j; const LAS float* s = scr + (8 * c) * 33 + n;
        v4u o; o.x = pk2(s[0 * 33], s[1 * 33]); o.y = pk2(s[2 * 33], s[3 * 33]); o.z = pk2(s[4 * 33], s[5 * 33]); o.w = pk2(s[6 * 33], s[7 * 33]);
        *(GAS v4u*)(WT + (size_t)(drow0 + n) * K + k0 + 8 * c) = o; }
    LDS_WAIT(); asm volatile("" ::: "memory");
}
constexpr size_t WLE_IN = 0, WLE_UQ = WLE_IN + (size_t)IN_WP * D, WLE_KV = WLE_UQ + (size_t)1536 * 768, WLE_OUT = WLE_KV + (size_t)2048 * 512,
                 WLE_GU = WLE_OUT + (size_t)D * D, WLE_DN = WLE_GU + (size_t)2 * FF * D, WLE_SIZE = WLE_DN + (size_t)D * FF;
static_assert(WLE_SIZE * 2 == WL_SIZE, "weight map");

__device__ __forceinline__ void ph_prologue(const Ctx& A, LAS unsigned char* lds, int tid, int lane, int wave, int vcu, int G) {
    const int gw = vcu * NWAVES + wave, NGW = G * NWAVES;
    LAS float* scr = (LAS float*)(lds + wave * 8704);
    constexpr int I_IN = 32 * 155, I_UQ = 12 * 48, I_KV = 8 * 64, I_OUT = 32 * 64, I_GU = 32 * 352, I_DN = 88 * 64, I_L = I_IN + I_UQ + I_KV + I_OUT + I_GU + I_DN;
    for (int it = gw; it < DEPTH * I_L; it += NGW) {
        const int l = it / I_L; int r = it - l * I_L;
        bf16* wl = (bf16*)(A.ws + WS_W) + (size_t)l * WLE_SIZE;
        if (r < I_IN) { const int kb = r / 155, nb = r - kb * 155; transpose_item(A.in[12] + (size_t)l * D * IN_W, D, IN_W, wl + WLE_IN, 64 * kb, 32 * nb, 32 * nb, scr, lane); continue; } r -= I_IN;
        if (r < I_UQ) { const int kb = r / 48, nb = r - kb * 48; transpose_item(A.in[15] + (size_t)l * 768 * 1536, 768, 1536, wl + WLE_UQ, 64 * kb, 32 * nb, 32 * nb, scr, lane); continue; } r -= I_UQ;
        if (r < I_KV) { const int kb = r / 64, nb = r - kb * 64; const int n0 = 32 * nb, hh = n0 >> 8, c = n0 & 255; const int dr = (c < 128 ? 0 : 1024) + hh * 128 + (c & 127);
                        transpose_item(A.in[17] + (size_t)l * 512 * 2048, 512, 2048, wl + WLE_KV, 64 * kb, n0, dr, scr, lane); continue; } r -= I_KV;
        if (r < I_OUT) { const int kb = r / 64, nb = r - kb * 64; transpose_item(A.in[13] + (size_t)l * D * D, D, D, wl + WLE_OUT, 64 * kb, 32 * nb, 32 * nb, scr, lane); continue; } r -= I_OUT;
        if (r < I_GU) { const int kb = r / 352, nb = r - kb * 352; const int n0 = 32 * nb; int dr; if (n0 < FF) dr = (n0 >> 7) * 256 + (n0 & 127); else { const int n1 = n0 - FF; dr = (n1 >> 7) * 256 + 128 + (n1 & 127); }
                        transpose_item(A.in[30] + (size_t)l * D * 2 * FF, D, 2 * FF, wl + WLE_GU, 64 * kb, n0, dr, scr, lane); continue; } r -= I_GU;
        { const int kb = r / 64, nb = r - kb * 64; transpose_item(A.in[31] + (size_t)l * FF * D, FF, D, wl + WLE_DN, 64 * kb, 32 * nb, 32 * nb, scr, lane); }
    }
    { const int gt = vcu * 512 + tid, NGT = G * 512;
      for (int i = gt; i < DEPTH * 40960; i += NGT) { const int l = i / 40960, r = i - l * 40960; *(GAS v4u*)((bf16*)(A.ws + WS_W) + (size_t)l * WLE_SIZE + WLE_IN + (size_t)IN_W * D + (size_t)r * 8) = (v4u){0u, 0u, 0u, 0u}; }
      const f32x4* xp = (const f32x4*)A.in[0]; const f32x4* xs = (const f32x4*)A.in[1]; f32x4* o = (f32x4*)A.out;
      for (int i = gt; i < 4194304; i += NGT) o[i] = xp[i];
      for (int i = gt; i < 1048576; i += NGT) o[4194304 + i] = xs[i]; }
    LAS float* scond = (LAS float*)(lds + 81920);
    LAS float* red = (LAS float*)(lds + 81920 + 24576);
    for (int i = tid; i < 3 * 2048; i += 512) { const int r = i >> 11, k = i & 2047; const float c = r == 0 ? A.in[7][k] : A.in[6][(r - 1) * 2048 + k]; scond[i] = silu(c); }
    __syncthreads();
    float* mods = (float*)(A.ws + WS_MODS);
    for (int item = vcu; item < 384; item += G) {
        const int l = item / 96, j0 = (item - l * 96) * 128;
        const float* w = A.in[10] + (size_t)l * 2048 * 12288 + j0 + 2 * lane;
        float a0x = 0, a0y = 0, a1x = 0, a1y = 0, a2x = 0, a2y = 0;
        const int kbeg = wave * 256;
#pragma unroll 8
        for (int k = kbeg; k < kbeg + 256; ++k) { const f32x2 v = *(const f32x2*)(w + (size_t)k * 12288); const float c0 = scond[k], c1 = scond[2048 + k], c2 = scond[4096 + k];
            a0x += c0 * v.x; a0y += c0 * v.y; a1x += c1 * v.x; a1y += c1 * v.y; a2x += c2 * v.x; a2y += c2 * v.y; }
        red[(wave * 3 + 0) * 128 + 2 * lane] = a0x; red[(wave * 3 + 0) * 128 + 2 * lane + 1] = a0y;
        red[(wave * 3 + 1) * 128 + 2 * lane] = a1x; red[(wave * 3 + 1) * 128 + 2 * lane + 1] = a1y;
        red[(wave * 3 + 2) * 128 + 2 * lane] = a2x; red[(wave * 3 + 2) * 128 + 2 * lane + 1] = a2y;
        __syncthreads();
        if (tid < 384) { const int r = tid >> 7, j = tid & 127; float s = 0.f;
#pragma unroll
            for (int w8 = 0; w8 < 8; ++w8) s += red[(w8 * 3 + r) * 128 + j];
            mods[(size_t)(l * 3 + r) * 12288 + j0 + j] = s + A.in[11][(size_t)l * 12288 + j0 + j]; }
        __syncthreads();
    }
}

__device__ __forceinline__ void ph_norm(const float* X, const float* g, const float* mods_l, int shift_idx, bf16* H, int lane, int gw, int NGW) {
    for (int m = gw; m < M; m += NGW) {
        const int cr = m < NCTX ? 0 : 1 + ((m - NCTX) >> 10);
        const f32x4* xr = (const f32x4*)(X + (size_t)m * D) + lane;
        f32x4 v[8]; float ss = 0.f;
#pragma unroll
        for (int j = 0; j < 8; ++j) { v[j] = xr[64 * j]; ss += (v[j].x * v[j].x + v[j].y * v[j].y) + (v[j].z * v[j].z + v[j].w * v[j].w); }
        const float rstd = 1.0f / sqrtf(wave_sum(ss) * (1.0f / D) + EPS);
        const float* sh = mods_l + (size_t)cr * 12288 + shift_idx * 2048; const float* sc = sh + 2048;
#pragma unroll
        for (int j = 0; j < 8; ++j) { const int c = 4 * lane + 256 * j; const f32x4 g4 = *(const f32x4*)(g + c), s4 = *(const f32x4*)(sc + c), h4 = *(const f32x4*)(sh + c);
            const f32x4 o = v[j] * rstd * g4 * (s4 + 1.0f) + h4; v2u w; w.x = pk2(o.x, o.y); w.y = pk2(o.z, o.w); *(GAS v2u*)(H + (size_t)m * D + c) = w; }
    }
}

__device__ __forceinline__ void ph_prep(const Ctx& A, int l, int lane, int gw, int NGW) {
    const float* U = (const float*)(A.ws + WS_U);
    bf16* CQN = (bf16*)(A.ws + WS_CQN); bf16* CKVN = (bf16*)(A.ws + WS_CKVN);
    float* GQ = (float*)(A.ws + WS_GQ); float* GK = GQ + (size_t)M * 512; float* GV = GK + (size_t)M * 512;
    float* GBETA = (float*)(A.ws + WS_GBG); float* GG = GBETA + (size_t)M * 8;
    float* XBC = (float*)(A.ws + WS_XBC); float* SDT = (float*)(A.ws + WS_SDT); float* SDA = SDT + (size_t)M * 16;
    const float* qn_g = A.in[14] + l * 768; const float* kvn_g = A.in[16] + l * 512;
    const float* gconv = A.in[20] + (size_t)l * 5 * 1536; const float* sconv = A.in[24] + (size_t)l * 5 * 1024; const float* sconvb = A.in[25] + l * 1024;
    for (int m = gw; m < MK; m += NGW) {
        if (m >= M) {
            const int j = m - M, b = j >> 8, t = j & 255; const float* src = A.in[2] + ((size_t)(b * 4 + l) * 256 + t) * 512;
#pragma unroll
            for (int i = 0; i < 2; ++i) { const int c = 4 * lane + 256 * i; const f32x4 v = *(const f32x4*)(src + c); v2u w; w.x = pk2(v.x, v.y); w.y = pk2(v.z, v.w); *(GAS v2u*)(CKVN + (size_t)m * 512 + c) = w; }
            continue;
        }
        const bool ctx = m < NCTX; const int t = ctx ? (m & 255) : ((m - NCTX) & 1023), T = ctx ? 256 : 1024;
        const float* u = U + (size_t)m * IN_WP;
        { f32x4 v[3]; float ss = 0.f;
#pragma unroll
          for (int i = 0; i < 3; ++i) { v[i] = *(const f32x4*)(u + U_CQ + 4 * lane + 256 * i); ss += (v[i].x * v[i].x + v[i].y * v[i].y) + (v[i].z * v[i].z + v[i].w * v[i].w); }
          const float rstd = 1.0f / sqrtf(wave_sum(ss) * (1.0f / 768.f) + EPS);
#pragma unroll
          for (int i = 0; i < 3; ++i) { const int c = 4 * lane + 256 * i; const f32x4 o = v[i] * rstd * *(const f32x4*)(qn_g + c); v2u w; w.x = pk2(o.x, o.y); w.y = pk2(o.z, o.w); *(GAS v2u*)(CQN + (size_t)m * 768 + c) = w; } }
        { f32x4 v[2]; float ss = 0.f;
#pragma unroll
          for (int i = 0; i < 2; ++i) { v[i] = *(const f32x4*)(u + U_CKV + 4 * lane + 256 * i); ss += (v[i].x * v[i].x + v[i].y * v[i].y) + (v[i].z * v[i].z + v[i].w * v[i].w); }
          const float rstd = 1.0f / sqrtf(wave_sum(ss) * (1.0f / 512.f) + EPS);
          const int b = m >> 8;
#pragma unroll
          for (int i = 0; i < 2; ++i) { const int c = 4 * lane + 256 * i; const f32x4 o = v[i] * rstd * *(const f32x4*)(kvn_g + c); v2u w; w.x = pk2(o.x, o.y); w.y = pk2(o.z, o.w); *(GAS v2u*)(CKVN + (size_t)m * 512 + c) = w;
              if (ctx) *(f32x4*)(A.out + O_CKV + ((size_t)(b * 4 + l) * 256 + t) * 512 + c) = o; }
          if (ctx) A.out[O_KR + ((size_t)(b * 4 + l) * 256 + t) * 64 + lane] = u[U_KR + lane]; }
        {
#pragma unroll
          for (int i = 0; i < 6; ++i) { const int c = 4 * lane + 256 * i; f32x4 acc = (f32x4){0.f, 0.f, 0.f, 0.f};
#pragma unroll
              for (int j = 0; j < 5; ++j) { const int tt = t + j - 2; if (tt >= 0 && tt < T) acc += *(const f32x4*)(gconv + j * 1536 + c) * *(const f32x4*)(u + (ptrdiff_t)(j - 2) * IN_WP + U_GQKV + c); }
              acc.x = silu(acc.x); acc.y = silu(acc.y); acc.z = silu(acc.z); acc.w = silu(acc.w);
              if (i < 4) { const float ss = half_sum((acc.x * acc.x + acc.y * acc.y) + (acc.z * acc.z + acc.w * acc.w)); acc = acc * (1.0f / sqrtf(ss + EPS)); }
              float* dst = i < 2 ? GQ + (size_t)m * 512 + c : (i < 4 ? GK + (size_t)m * 512 + (c - 512) : GV + (size_t)m * 512 + (c - 1024));
              *(f32x4*)dst = acc; }
          if (lane < 8) { const float bi = u[U_GB + lane], ai = u[U_GA + lane]; GBETA[(size_t)m * 8 + lane] = 1.0f / (1.0f + expf(-bi));
              GG[(size_t)m * 8 + lane] = -expf(A.in[21][l * 8 + lane]) * softplus(ai + A.in[22][l * 8 + lane]); } }
        {
#pragma unroll
          for (int i = 0; i < 4; ++i) { const int c = 4 * lane + 256 * i; f32x4 acc = *(const f32x4*)(sconvb + c);
#pragma unroll
              for (int j = 0; j < 5; ++j) { const int tt = t + j - 2; if (tt >= 0 && tt < T) acc += *(const f32x4*)(sconv + j * 1024 + c) * *(const f32x4*)(u + (ptrdiff_t)(j - 2) * IN_WP + U_SXBC + c); }
              acc.x = silu(acc.x); acc.y = silu(acc.y); acc.z = silu(acc.z); acc.w = silu(acc.w);
              *(f32x4*)(XBC + (size_t)m * 1024 + c) = acc; }
          if (lane < 16) { const float dt = softplus(u[U_SDT + lane] + A.in[27][l * 16 + lane]); SDT[(size_t)m * 16 + lane] = dt; SDA[(size_t)m * 16 + lane] = -expf(A.in[26][l * 16 + lane]) * dt; } }
    }
}

__device__ __forceinline__ void ph_finalize(const Ctx& A, int l, int lane, int gw, int NGW) {
    const float* U = (const float*)(A.ws + WS_U); const float* QRAW = (const float*)(A.ws + WS_QRAW); const float* KN = (const float*)(A.ws + WS_KN);
    bf16* QB = (bf16*)(A.ws + WS_QB); bf16* KB = (bf16*)(A.ws + WS_KB);
    const float* q_g = A.in[18] + l * 192; const float* k_g = A.in[19] + l * 192;
    const float QS = 0.07216878364870322f * 1.4426950408889634f;
    const float inv_f = powf(10000.f, -(float)(lane & 15) * (1.0f / 16.f));
    const float qg0 = q_g[lane], qg1 = q_g[64 + lane], qg2 = q_g[128 + lane], kg0 = k_g[lane], kg1 = k_g[64 + lane], kg2 = k_g[128 + lane];
    for (int m = gw; m < MK; m += NGW) {
        const bool fresh = m < M, latent = fresh && m >= NCTX;
        float cs = 1.f, sn = 0.f;
        if (latent) { const int t = (m - NCTX) & 1023; const float pos = (float)((lane >> 5) ? (t & 63) : (t >> 6)); const float ang = pos * inv_f; cs = cosf(ang); sn = sinf(ang); }
        const bool hi = (lane >> 4) & 1;
        const float* krp = fresh ? U + (size_t)m * IN_WP + U_KR : A.in[3] + ((size_t)(((m - M) >> 8) * 4 + l) * 256 + ((m - M) & 255)) * 64;
        const float kr_raw = krp[lane];
        for (int h = 0; h < 8; ++h) {
            if (fresh) { const float* q = QRAW + (size_t)m * 1536 + h * 192; float x0 = q[lane], x1 = q[64 + lane], x2 = q[128 + lane];
                const float rstd = 1.0f / sqrtf(wave_sum(x0 * x0 + x1 * x1 + x2 * x2) * (1.0f / 192.f) + EPS);
                x0 *= rstd * qg0; x1 *= rstd * qg1; x2 *= rstd * qg2;
                if (latent) { const float p = __shfl_xor(x2, 16); x2 = hi ? x2 * cs + p * sn : x2 * cs - p * sn; }
                bf16* dst = QB + ((size_t)m * 8 + h) * 192; dst[lane] = (bf16)f2bf(x0 * QS); dst[64 + lane] = (bf16)f2bf(x1 * QS); dst[128 + lane] = (bf16)f2bf(x2 * QS); }
            { const float* kn = KN + (size_t)m * 1024 + h * 128; float x0 = kn[lane], x1 = kn[64 + lane], x2 = kr_raw;
                const float rstd = 1.0f / sqrtf(wave_sum(x0 * x0 + x1 * x1 + x2 * x2) * (1.0f / 192.f) + EPS);
                x0 *= rstd * kg0; x1 *= rstd * kg1; x2 *= rstd * kg2;
                if (latent) { const float p = __shfl_xor(x2, 16); x2 = hi ? x2 * cs + p * sn : x2 * cs - p * sn; }
                bf16* dst = KB + ((size_t)m * 8 + h) * 192; dst[lane] = (bf16)f2bf(x0); dst[64 + lane] = (bf16)f2bf(x1); dst[128 + lane] = (bf16)f2bf(x2); }
        }
    }
}

__device__ __forceinline__ void attn_item(const bf16* __restrict__ QB, const bf16* __restrict__ KB, const bf16* __restrict__ VT, bf16* MIX, int qrow0, int h, int mkA, int nA, int mkB, int nB, LAS unsigned char* plds, int lane) {
    const int fr = lane & 15, fq = lane >> 4;
    bf16x8 qf[6];
#pragma unroll
    for (int d = 0; d < 6; ++d) qf[d] = *(const bf16x8*)(QB + ((size_t)(qrow0 + fr) * 8 + h) * 192 + d * 32 + fq * 8);
    f32x4 o[8];
#pragma unroll
    for (int i = 0; i < 8; ++i) o[i] = (f32x4){0.f, 0.f, 0.f, 0.f};
    float mrow[4] = {-1e30f, -1e30f, -1e30f, -1e30f}, lrow[4] = {0.f, 0.f, 0.f, 0.f};
    for (int seg = 0; seg < 2; ++seg) {
        const int mk0 = seg ? mkB : mkA, n = seg ? nB : nA;
        for (int kt = 0; kt < n; kt += 32) {
            f32x4 s0 = (f32x4){0.f, 0.f, 0.f, 0.f}, s1 = s0;
            const bf16* kp0 = KB + ((size_t)(mk0 + kt + fr) * 8 + h) * 192 + fq * 8; const bf16* kp1 = kp0 + (size_t)16 * 8 * 192;
#pragma unroll
            for (int d = 0; d < 6; ++d) { const bf16x8 k0 = *(const bf16x8*)(kp0 + d * 32), k1 = *(const bf16x8*)(kp1 + d * 32);
                s0 = __builtin_amdgcn_mfma_f32_16x16x32_bf16(qf[d], k0, s0, 0, 0, 0); s1 = __builtin_amdgcn_mfma_f32_16x16x32_bf16(qf[d], k1, s1, 0, 0, 0); }
            float al[4];
#pragma unroll
            for (int r = 0; r < 4; ++r) { float v = fmaxf(s0[r], s1[r]);
                v = fmaxf(v, __shfl_xor(v, 1)); v = fmaxf(v, __shfl_xor(v, 2)); v = fmaxf(v, __shfl_xor(v, 4)); v = fmaxf(v, __shfl_xor(v, 8));
                const float mnew = fmaxf(mrow[r], v); al[r] = exp2f(mrow[r] - mnew); mrow[r] = mnew;
                s0[r] = exp2f(s0[r] - mnew); s1[r] = exp2f(s1[r] - mnew); lrow[r] = lrow[r] * al[r] + s0[r] + s1[r]; }
#pragma unroll
            for (int i = 0; i < 8; ++i) { o[i][0] *= al[0]; o[i][1] *= al[1]; o[i][2] *= al[2]; o[i][3] *= al[3]; }
#pragma unroll
            for (int r = 0; r < 4; ++r) { *(LAS bf16*)(plds + (4 * fq + r) * 64 + fr * 2) = (bf16)f2bf(s0[r]); *(LAS bf16*)(plds + (4 * fq + r) * 64 + 32 + fr * 2) = (bf16)f2bf(s1[r]); }
            asm volatile("s_waitcnt lgkmcnt(0)" ::: "memory");
            const bf16x8 pf = *(const LAS bf16x8*)(plds + fr * 64 + fq * 16);
            asm volatile("s_waitcnt lgkmcnt(0)" ::: "memory");
#pragma unroll
            for (int i = 0; i < 8; ++i) { const bf16x8 vf = *(const bf16x8*)(VT + (size_t)(h * 128 + i * 16 + fr) * MK + mk0 + kt + fq * 8);
                o[i] = __builtin_amdgcn_mfma_f32_16x16x32_bf16(pf, vf, o[i], 0, 0, 0); }
        }
    }
#pragma unroll
    for (int r = 0; r < 4; ++r) { float lt = lrow[r]; lt += __shfl_xor(lt, 1); lt += __shfl_xor(lt, 2); lt += __shfl_xor(lt, 4); lt += __shfl_xor(lt, 8);
        const float inv = 1.0f / lt; bf16* dst = MIX + (size_t)(qrow0 + 4 * fq + r) * D + h * 128 + fr;
#pragma unroll
        for (int i = 0; i < 8; ++i) dst[i * 16] = (bf16)f2bf(o[i][r] * inv); }
}
__device__ __forceinline__ void ph_attn(const Ctx& A, LAS unsigned char* lds, int lane, int wave, int gw, int NGW) {
    const bf16* QB = (const bf16*)(A.ws + WS_QB); const bf16* KB = (const bf16*)(A.ws + WS_KB); const bf16* VT = (const bf16*)(A.ws + WS_VT); bf16* MIX = (bf16*)(A.ws + WS_MIX);
    LAS unsigned char* plds = lds + wave * 1024;
    for (int slot = gw; slot < 2048; slot += NGW) {
        if (slot < 1024) { const int b = slot >> 9, rem = slot & 511, h = rem >> 6, qt = rem & 63;
            attn_item(QB, KB, VT, MIX, NCTX + b * 1024 + qt * 16, h, M + b * 256, 256, NCTX + b * 1024, 1024, plds, lane); }
        else { const int s2 = slot - 1024;
            for (int i = 0; i < 4; ++i) { const int ci = s2 * 4 + i, b = ci >> 7, rem = ci & 127, h = rem >> 4, qt = rem & 15;
                attn_item(QB, KB, VT, MIX, b * 256 + qt * 16, h, b * 256, 256, 0, 0, plds, lane); } }
    }
}

__device__ __forceinline__ void ph_gdn_scan(const Ctx& A, int l, LAS unsigned char* lds, int tid, int vcu, int G) {
    const float* GQ = (const float*)(A.ws + WS_GQ); const float* GK = GQ + (size_t)M * 512; const float* GV = GK + (size_t)M * 512;
    const float* GBETA = (const float*)(A.ws + WS_GBG); const float* GG = GBETA + (size_t)M * 8; float* GO = (float*)(A.ws + WS_GO);
    const int grp = tid >> 7, j = tid & 127;
    const int item = grp * G + vcu;
    const bool active = item < 272;
    int T = 0, row0 = 0, h = 0, dir = 0, b = 0; bool lat = false;
    if (active) { if (item < 256) { b = item >> 3; h = (item >> 1) & 3; dir = item & 1; T = 256; row0 = b * 256; }
                  else { const int q = item - 256; b = q >> 3; h = (q >> 1) & 3; dir = q & 1; T = 1024; row0 = NCTX + b * 1024; lat = true; } }
    int Tmax = 0;
    for (int p = 0; p < 4; ++p) { const int it = p * G + vcu; if (it < 272) { const int tt = it < 256 ? 256 : 1024; Tmax = tt > Tmax ? tt : Tmax; } }
    float S[128];
    if (lat) { const float* s0 = A.in[4] + ((size_t)(((b * 4 + l) * 2 + dir) * 4 + h) * 128) * 128 + j;
#pragma unroll
        for (int i = 0; i < 128; ++i) S[i] = s0[(size_t)i * 128]; }
    else {
#pragma unroll
        for (int i = 0; i < 128; ++i) S[i] = 0.f; }
    LAS float* sk = (LAS float*)(lds + grp * 24832); LAS float* sq = sk + 2048; LAS float* sv = sk + 4096; LAS float* sg = sk + 6144; LAS float* sb = sk + 6160;
    for (int t0 = 0; t0 < Tmax; t0 += 16) {
        const bool on = active && t0 < T;
        if (on) {
#pragma unroll 4
            for (int s = 0; s < 16; ++s) { const int tok = dir ? T - 1 - (t0 + s) : t0 + s; const size_t mo = (size_t)(row0 + tok) * 512 + h * 128 + j;
                sk[s * 128 + j] = GK[mo]; sq[s * 128 + j] = GQ[mo]; sv[s * 128 + j] = GV[mo]; }
            if (j < 16) { const int tok = dir ? T - 1 - (t0 + j) : t0 + j; const size_t mo = (size_t)(row0 + tok) * 8 + dir * 4 + h; sg[j] = GG[mo]; sb[j] = GBETA[mo]; }
        }
        __syncthreads();
        if (on) {
#pragma unroll 1
            for (int s = 0; s < 16; ++s) {
                const float dec = expf(sg[s]);
                float kS = 0.f;
#pragma unroll
                for (int i = 0; i < 128; i += 4) { const f32x4 k4 = *(const LAS f32x4*)(sk + s * 128 + i); kS += k4.x * S[i] + k4.y * S[i + 1] + k4.z * S[i + 2] + k4.w * S[i + 3];
                    if ((i & 15) == 12) asm volatile("" ::: "memory"); }
                const float vn = sb[s] * (sv[s * 128 + j] - dec * kS);
                float o = 0.f;
#pragma unroll
                for (int i = 0; i < 128; i += 4) { const f32x4 k4 = *(const LAS f32x4*)(sk + s * 128 + i); const f32x4 q4 = *(const LAS f32x4*)(sq + s * 128 + i);
                    S[i] = dec * S[i] + k4.x * vn; S[i + 1] = dec * S[i + 1] + k4.y * vn; S[i + 2] = dec * S[i + 2] + k4.z * vn; S[i + 3] = dec * S[i + 3] + k4.w * vn;
                    o += q4.x * S[i] + q4.y * S[i + 1] + q4.z * S[i + 2] + q4.w * S[i + 3];
                    if ((i & 15) == 12) asm volatile("" ::: "memory"); }
                const int tok = dir ? T - 1 - (t0 + s) : t0 + s;
                GO[((size_t)dir * M + row0 + tok) * 512 + h * 128 + j] = o * 0.08838834764831845f;
            }
        }
        __syncthreads();
    }
    if (active && !lat) { float* dst = A.out + O_SG + ((size_t)(((b * 4 + l) * 2 + dir) * 4 + h) * 128) * 128 + j;
#pragma unroll
        for (int i = 0; i < 128; ++i) dst[(size_t)i * 128] = S[i]; }
}

__device__ __forceinline__ void ph_ssd_scan(const Ctx& A, int l, LAS unsigned char* lds, int lane, int wave, int vcu, int G) {
    const float* XBC = (const float*)(A.ws + WS_XBC); const float* SDT = (const float*)(A.ws + WS_SDT); const float* SDA = SDT + (size_t)M * 16; float* SY = (float*)(A.ws + WS_SY);
    int b, h, dir, T, row0; bool lat = false;
    if (wave < 2) { const int item = wave * G + vcu; if (item >= 512) return; b = item >> 4; h = (item >> 1) & 7; dir = item & 1; T = 256; row0 = b * 256; }
    else if (wave == 2) { const int q = vcu - 16; if (q < 0 || q >= 32) return; b = q >> 4; h = (q >> 1) & 7; dir = q & 1; T = 1024; row0 = NCTX + b * 1024; lat = true; }
    else return;
    float S[128];
    if (lat) { const float* s0 = A.in[5] + ((size_t)(((b * 4 + l) * 2 + dir) * 8 + h) * 64 + lane) * 128;
#pragma unroll
        for (int n = 0; n < 128; n += 4) { const f32x4 v = *(const f32x4*)(s0 + n); S[n] = v.x; S[n + 1] = v.y; S[n + 2] = v.z; S[n + 3] = v.w; } }
    else {
#pragma unroll
        for (int n = 0; n < 128; ++n) S[n] = 0.f; }
    LAS float* sB = (LAS float*)(lds + wave * 10496); LAS float* sC = sB + 1024; LAS float* sx = sB + 2048; LAS float* sdt = sB + 2560; LAS float* sda = sB + 2568;
    const int g = h >> 2;
    for (int t0 = 0; t0 < T; t0 += 8) {
#pragma unroll 4
        for (int s = 0; s < 8; ++s) { const int tok = dir ? T - 1 - (t0 + s) : t0 + s; const float* xr = XBC + (size_t)(row0 + tok) * 1024;
            sB[s * 128 + lane] = xr[512 + g * 128 + lane]; sB[s * 128 + 64 + lane] = xr[512 + g * 128 + 64 + lane];
            sC[s * 128 + lane] = xr[768 + g * 128 + lane]; sC[s * 128 + 64 + lane] = xr[768 + g * 128 + 64 + lane];
            sx[s * 64 + lane] = xr[h * 64 + lane]; }
        if (lane < 8) { const int tok = dir ? T - 1 - (t0 + lane) : t0 + lane; const size_t mo = (size_t)(row0 + tok) * 16 + dir * 8 + h; sdt[lane] = SDT[mo]; sda[lane] = SDA[mo]; }
        asm volatile("s_waitcnt lgkmcnt(0)" ::: "memory");
#pragma unroll 1
        for (int s = 0; s < 8; ++s) {
            const float a = expf(sda[s]); const float xd = sx[s * 64 + lane] * sdt[s];
            float y = 0.f;
#pragma unroll
            for (int n = 0; n < 128; n += 4) { const f32x4 b4 = *(const LAS f32x4*)(sB + s * 128 + n); const f32x4 c4 = *(const LAS f32x4*)(sC + s * 128 + n);
                S[n] = a * S[n] + xd * b4.x; S[n + 1] = a * S[n + 1] + xd * b4.y; S[n + 2] = a * S[n + 2] + xd * b4.z; S[n + 3] = a * S[n + 3] + xd * b4.w;
                y += S[n] * c4.x + S[n + 1] * c4.y + S[n + 2] * c4.z + S[n + 3] * c4.w; }
            const int tok = dir ? T - 1 - (t0 + s) : t0 + s;
            SY[((size_t)dir * M + row0 + tok) * 512 + h * 64 + lane] = y;
        }
        asm volatile("s_waitcnt lgkmcnt(0)" ::: "memory");
    }
    if (!lat) { float* dst = A.out + O_SS + ((size_t)(((b * 4 + l) * 2 + dir) * 8 + h) * 64 + lane) * 128;
#pragma unroll
        for (int n = 0; n < 128; n += 4) *(f32x4*)(dst + n) = (f32x4){S[n], S[n + 1], S[n + 2], S[n + 3]}; }
}

__device__ __forceinline__ void ph_post(const Ctx& A, int l, int lane, int gw, int NGW) {
    const float* U = (const float*)(A.ws + WS_U); const float* GO = (const float*)(A.ws + WS_GO); const float* SY = (const float*)(A.ws + WS_SY); const float* XBC = (const float*)(A.ws + WS_XBC);
    bf16* MIX = (bf16*)(A.ws + WS_MIX);
    const float* gng = A.in[23] + l * 128; const float* sd = A.in[28] + l * 8; const float* sng = A.in[29] + l * 512;
    for (int m = gw; m < M; m += NGW) {
        const float* u = U + (size_t)m * IN_WP;
#pragma unroll
        for (int i = 0; i < 2; ++i) { const int c = 4 * lane + 256 * i;
            f32x4 o = *(const f32x4*)(GO + (size_t)m * 512 + c) + *(const f32x4*)(GO + ((size_t)M + m) * 512 + c);
            const float ss = half_sum((o.x * o.x + o.y * o.y) + (o.z * o.z + o.w * o.w)); const float rstd = 1.0f / sqrtf(ss * (1.0f / 128.f) + EPS);
            const f32x4 g4 = *(const f32x4*)(gng + (c & 127)); const f32x4 z = *(const f32x4*)(u + U_GZ + c);
            o = o * rstd * g4; o.x *= silu(z.x); o.y *= silu(z.y); o.z *= silu(z.z); o.w *= silu(z.w);
            v2u w; w.x = pk2(o.x, o.y); w.y = pk2(o.z, o.w); *(GAS v2u*)(MIX + (size_t)m * D + 1024 + c) = w; }
#pragma unroll
        for (int i = 0; i < 2; ++i) { const int c = 4 * lane + 256 * i;
            f32x4 y = *(const f32x4*)(SY + (size_t)m * 512 + c) + *(const f32x4*)(SY + ((size_t)M + m) * 512 + c) + *(const f32x4*)(XBC + (size_t)m * 1024 + c) * sd[c >> 6];
            const f32x4 z = *(const f32x4*)(u + U_SZ + c);
            y.x *= silu(z.x); y.y *= silu(z.y); y.z *= silu(z.z); y.w *= silu(z.w);
            const float ss = wave_sum((y.x * y.x + y.y * y.y) + (y.z * y.z + y.w * y.w)); const float rstd = 1.0f / sqrtf(ss * (1.0f / 256.f) + EPS);
            y = y * rstd * *(const f32x4*)(sng + c);
            v2u w; w.x = pk2(y.x, y.y); w.y = pk2(y.z, y.w); *(GAS v2u*)(MIX + (size_t)m * D + 1536 + c) = w; }
    }
}

constexpr size_t GCH_W = 0, GCH_QG = 16384, GCH_KD = 32768, GCH_QK = 49152, GCH_UT = 57344, GCH_DEC = 90112, GCH_BYTES = 90368;
constexpr int NGCH = 160;
template <int DIR>
__device__ __forceinline__ void gdn_solve(const float* GQ, const float* GK, const float* GV, unsigned char* GCH, const LAS float* Ad, const LAS float* gcd, const LAS float* bd, int gch, int h, int row0, int wave, int lane) {
    const int c = (wave & 3) * 64 + lane, cc = c & 127; const bool isw = c < 128;
    unsigned char* rec = GCH + ((size_t)(DIR * NGCH + gch) * 4 + h) * GCH_BYTES;
    const float* src = (isw ? GK : GV) + (size_t)row0 * 512 + h * 128 + cc;
    { int z = 0; asm volatile("" : "+v"(z)); Ad += z; gcd += z; bd += z; }
    float x[64];
#pragma unroll
    for (int i = 0; i < 64; ++i) { const int p = DIR ? 63 - i : i; const float f = isw ? bd[p] * __expf(gcd[p]) : bd[p]; x[i] = src[(size_t)p * 512] * f; if ((i & 7) == 7) asm volatile("" ::: "memory"); }
#pragma unroll
    for (int i = 1; i < 64; ++i) { float s = x[i];
#pragma unroll
        for (int j = 0; j < i; j += 4) { const f32x4 a4 = *(const LAS f32x4*)(Ad + i * 64 + j);
            s -= a4.x * x[j]; if (j + 1 < i) s -= a4.y * x[j + 1]; if (j + 2 < i) s -= a4.z * x[j + 2]; if (j + 3 < i) s -= a4.w * x[j + 3]; }
        x[i] = s; if ((i & 7) == 7) asm volatile("" ::: "memory"); }
    if (isw) { bf16* wdst = (bf16*)(rec + GCH_W) + cc;
#pragma unroll
        for (int i = 0; i < 64; ++i) wdst[i * 128] = (bf16)f2bf(x[i]);
        const float gl = gcd[DIR ? 0 : 63]; bf16* kd = (bf16*)(rec + GCH_KD) + cc * 64;
#pragma unroll
        for (int i = 0; i < 64; i += 8) { float v[8];
#pragma unroll
            for (int u = 0; u < 8; ++u) { const int p = DIR ? 63 - (i + u) : i + u; v[u] = src[(size_t)p * 512] * __expf(gl - gcd[p]); }
            v4u w; w.x = pk2(v[0], v[1]); w.y = pk2(v[2], v[3]); w.z = pk2(v[4], v[5]); w.w = pk2(v[6], v[7]); *(GAS v4u*)(kd + i) = w; asm volatile("" ::: "memory"); }
        if (cc == 0) *(float*)(rec + GCH_DEC) = __expf(gl); }
    else { float* ut = (float*)(rec + GCH_UT) + cc * 64;
#pragma unroll
        for (int i = 0; i < 64; i += 4) *(f32x4*)(ut + i) = (f32x4){x[i], x[i + 1], x[i + 2], x[i + 3]};
        const float* qsrc = GQ + (size_t)row0 * 512 + h * 128 + cc; bf16* qg = (bf16*)(rec + GCH_QG) + cc;
#pragma unroll
        for (int i = 0; i < 64; ++i) { const int p = DIR ? 63 - i : i; qg[i * 128] = (bf16)f2bf(qsrc[(size_t)p * 512] * 0.08838834764831845f * __expf(gcd[p])); if ((i & 7) == 7) asm volatile("" ::: "memory"); } }
}
__device__ __forceinline__ void ph_gdn_local(const Ctx& A, int l, LAS unsigned char* lds, int tid, int lane, int wave, int vcu, int G) {
    const float* GQ = (const float*)(A.ws + WS_GQ); const float* GK = GQ + (size_t)M * 512; const float* GV = GK + (size_t)M * 512;
    const float* GBETA = (const float*)(A.ws + WS_GBG); const float* GG = GBETA + (size_t)M * 8;
    unsigned char* GCH = A.ws + WS_GCH;
    LAS bf16* kb16 = (LAS bf16*)lds; LAS bf16* qb16 = (LAS bf16*)(lds + 17408);
    LAS float* KK = (LAS float*)(lds + 34816); LAS float* QK = (LAS float*)(lds + 34816 + 16640);
    LAS float* Af = (LAS float*)(lds + 68096); LAS float* Ab = (LAS float*)(lds + 68096 + 16384);
    LAS float* sgcf = (LAS float*)(lds + 100864); LAS float* sgcb = sgcf + 64; LAS float* sbf = sgcf + 128; LAS float* sbb = sgcf + 192;
    const int fr = lane & 15, fq = lane >> 4;
    for (int it = vcu; it < NGCH * 4; it += G) {
        const int gch = it >> 2, h = it & 3, row0 = gch * 64;
        { const int r = tid >> 3, c0 = (tid & 7) * 16; const float* kp = GK + (size_t)(row0 + r) * 512 + h * 128 + c0; const float* qp = GQ + (size_t)(row0 + r) * 512 + h * 128 + c0;
          f32x4 kv[4], qv[4];
#pragma unroll
          for (int i = 0; i < 4; ++i) { kv[i] = *(const f32x4*)(kp + 4 * i); qv[i] = *(const f32x4*)(qp + 4 * i); }
          v4u w0, w1; w0.x = pk2(kv[0].x, kv[0].y); w0.y = pk2(kv[0].z, kv[0].w); w0.z = pk2(kv[1].x, kv[1].y); w0.w = pk2(kv[1].z, kv[1].w);
          w1.x = pk2(kv[2].x, kv[2].y); w1.y = pk2(kv[2].z, kv[2].w); w1.z = pk2(kv[3].x, kv[3].y); w1.w = pk2(kv[3].z, kv[3].w);
          *(LAS v4u*)(kb16 + r * 136 + c0) = w0; *(LAS v4u*)(kb16 + r * 136 + c0 + 8) = w1;
          w0.x = pk2(qv[0].x, qv[0].y); w0.y = pk2(qv[0].z, qv[0].w); w0.z = pk2(qv[1].x, qv[1].y); w0.w = pk2(qv[1].z, qv[1].w);
          w1.x = pk2(qv[2].x, qv[2].y); w1.y = pk2(qv[2].z, qv[2].w); w1.z = pk2(qv[3].x, qv[3].y); w1.w = pk2(qv[3].z, qv[3].w);
          *(LAS v4u*)(qb16 + r * 136 + c0) = w0; *(LAS v4u*)(qb16 + r * 136 + c0 + 8) = w1; }
        if (wave == 0) { const float gf = GG[(size_t)(row0 + lane) * 8 + h], gb = GG[(size_t)(row0 + lane) * 8 + 4 + h];
            float pf = gf, pb = gb;
#pragma unroll
            for (int o = 1; o < 64; o <<= 1) { const float tf = __shfl_up(pf, o), tb = __shfl_up(pb, o); if (lane >= o) { pf += tf; pb += tb; } }
            const float totb = __shfl(pb, 63);
            sgcf[lane] = pf; sgcb[lane] = totb - pb + gb;
            sbf[lane] = GBETA[(size_t)(row0 + lane) * 8 + h]; sbb[lane] = GBETA[(size_t)(row0 + lane) * 8 + 4 + h]; }
        __syncthreads();
        { const int tr = wave & 3; const LAS bf16* Aimg = (wave >> 2) ? qb16 : kb16; LAS float* Out = (wave >> 2) ? QK : KK;
          bf16x8 af[4];
#pragma unroll
          for (int ks = 0; ks < 4; ++ks) af[ks] = *(const LAS bf16x8*)(Aimg + (16 * tr + fr) * 136 + ks * 32 + fq * 8);
#pragma unroll
          for (int tc = 0; tc < 4; ++tc) { f32x4 acc = (f32x4){0.f, 0.f, 0.f, 0.f};
#pragma unroll
              for (int ks = 0; ks < 4; ++ks) { const bf16x8 bfr = *(const LAS bf16x8*)(kb16 + (16 * tc + fr) * 136 + ks * 32 + fq * 8); acc = __builtin_amdgcn_mfma_f32_16x16x32_bf16(af[ks], bfr, acc, 0, 0, 0); }
#pragma unroll
              for (int r = 0; r < 4; ++r) Out[(16 * tr + 4 * fq + r) * 65 + 16 * tc + fr] = acc[r]; } }
        __syncthreads();
        { unsigned char* recf = GCH + ((size_t)(0 * NGCH + gch) * 4 + h) * GCH_BYTES; unsigned char* recb = GCH + ((size_t)(1 * NGCH + gch) * 4 + h) * GCH_BYTES;
#pragma unroll 2
          for (int e = 0; e < 8; ++e) { const int idx = tid + 512 * e, i = idx >> 6, j = idx & 63, pi = 63 - i, pj = 63 - j;
              const float kkf = KK[i * 65 + j], qkf = QK[i * 65 + j], kkb = KK[pi * 65 + pj], qkb = QK[pi * 65 + pj];
              const float df = __expf(sgcf[i] - sgcf[j]), db = __expf(sgcb[pi] - sgcb[pj]);
              Af[idx] = (j < i) ? sbf[i] * kkf * df : 0.f; Ab[idx] = (j < i) ? sbb[pi] * kkb * db : 0.f;
              ((bf16*)(recf + GCH_QK))[idx] = (bf16)f2bf((j <= i) ? qkf * 0.08838834764831845f * df : 0.f);
              ((bf16*)(recb + GCH_QK))[idx] = (bf16)f2bf((j <= i) ? qkb * 0.08838834764831845f * db : 0.f); } }
        __syncthreads();
        if (wave < 4) gdn_solve<0>(GQ, GK, GV, GCH, Af, sgcf, sbf, gch, h, row0, wave, lane);
        else gdn_solve<1>(GQ, GK, GV, GCH, Ab, sgcb, sbb, gch, h, row0, wave, lane);
        __syncthreads();
    }
}

__device__ __forceinline__ void gdn_seq_item(const Ctx& A, int l, int b, int lat, int h, int dir, int dvs, LAS unsigned char* wl_, int lane) {
    const unsigned char* GCH = A.ws + WS_GCH; float* GO = (float*)(A.ws + WS_GO);
    const int fr = lane & 15, fq = lane >> 4;
    const int nch = lat ? 16 : 4, ch0 = lat ? 128 + b * 16 : b * 4;
    LAS bf16* simg = (LAS bf16*)wl_;
    LAS bf16* vimg = (LAS bf16*)(wl_ + 4352);
    f32x4 S[8];
    const size_t sidx = ((size_t)(((b * 4 + l) * 2 + dir) * 4 + h) * 128) * 128 + dvs * 16 + fr;
    if (lat) {
#pragma unroll
        for (int u = 0; u < 8; ++u)
#pragma unroll
            for (int r = 0; r < 4; ++r) S[u][r] = A.in[4][sidx + (size_t)(16 * u + 4 * fq + r) * 128]; }
    else {
#pragma unroll
        for (int u = 0; u < 8; ++u) S[u] = (f32x4){0.f, 0.f, 0.f, 0.f}; }
#pragma unroll 1
    for (int cc = 0; cc < nch; ++cc) {
        const int gch = dir ? ch0 + nch - 1 - cc : ch0 + cc;
        const unsigned char* rec = GCH + ((size_t)(dir * NGCH + gch) * 4 + h) * GCH_BYTES;
        const bf16* W = (const bf16*)(rec + GCH_W); const bf16* QG = (const bf16*)(rec + GCH_QG); const bf16* KD = (const bf16*)(rec + GCH_KD); const bf16* QKm = (const bf16*)(rec + GCH_QK);
        const float* UT = (const float*)(rec + GCH_UT); const float dec = *(const float*)(rec + GCH_DEC);
#pragma unroll
        for (int u = 0; u < 8; ++u) { v2u w; w.x = pk2(S[u][0], S[u][1]); w.y = pk2(S[u][2], S[u][3]); *(LAS v2u*)(simg + fr * 136 + 16 * u + 4 * fq) = w; }
        asm volatile("s_waitcnt lgkmcnt(0)" ::: "memory");
        bf16x8 BS[4];
#pragma unroll
        for (int ks = 0; ks < 4; ++ks) BS[ks] = *(const LAS bf16x8*)(simg + fr * 136 + ks * 32 + fq * 8);
        f32x4 vn[4];
#pragma unroll
        for (int t = 0; t < 4; ++t) { f32x4 acc = (f32x4){0.f, 0.f, 0.f, 0.f};
#pragma unroll
            for (int ks = 0; ks < 4; ++ks) { const bf16x8 af = *(const bf16x8*)(W + (16 * t + fr) * 128 + ks * 32 + fq * 8); acc = __builtin_amdgcn_mfma_f32_16x16x32_bf16(af, BS[ks], acc, 0, 0, 0); }
            const f32x4 uu = *(const f32x4*)(UT + (dvs * 16 + fr) * 64 + 16 * t + 4 * fq);
            vn[t] = uu - acc;
            v2u w; w.x = pk2(vn[t][0], vn[t][1]); w.y = pk2(vn[t][2], vn[t][3]); *(LAS v2u*)(vimg + fr * 72 + 16 * t + 4 * fq) = w; }
        asm volatile("s_waitcnt lgkmcnt(0)" ::: "memory");
        bf16x8 BV[2];
#pragma unroll
        for (int ks = 0; ks < 2; ++ks) BV[ks] = *(const LAS bf16x8*)(vimg + fr * 72 + ks * 32 + fq * 8);
        const int row0 = gch * 64;
#pragma unroll
        for (int t = 0; t < 4; ++t) { f32x4 acc = (f32x4){0.f, 0.f, 0.f, 0.f};
#pragma unroll
            for (int ks = 0; ks < 4; ++ks) { const bf16x8 af = *(const bf16x8*)(QG + (16 * t + fr) * 128 + ks * 32 + fq * 8); acc = __builtin_amdgcn_mfma_f32_16x16x32_bf16(af, BS[ks], acc, 0, 0, 0); }
#pragma unroll
            for (int ks = 0; ks < 2; ++ks) { const bf16x8 af = *(const bf16x8*)(QKm + (16 * t + fr) * 64 + ks * 32 + fq * 8); acc = __builtin_amdgcn_mfma_f32_16x16x32_bf16(af, BV[ks], acc, 0, 0, 0); }
#pragma unroll
            for (int r = 0; r < 4; ++r) { const int i = 16 * t + 4 * fq + r, p = dir ? 63 - i : i; GO[((size_t)dir * M + row0 + p) * 512 + h * 128 + dvs * 16 + fr] = acc[r]; } }
#pragma unroll
        for (int u = 0; u < 8; ++u) { f32x4 acc = S[u] * dec;
#pragma unroll
            for (int ks = 0; ks < 2; ++ks) { const bf16x8 af = *(const bf16x8*)(KD + (16 * u + fr) * 64 + ks * 32 + fq * 8); acc = __builtin_amdgcn_mfma_f32_16x16x32_bf16(af, BV[ks], acc, 0, 0, 0); }
            S[u] = acc; }
    }
    if (!lat) {
#pragma unroll
        for (int u = 0; u < 8; ++u)
#pragma unroll
            for (int r = 0; r < 4; ++r) A.out[O_SG + sidx + (size_t)(16 * u + 4 * fq + r) * 128] = S[u][r]; }
}
__device__ __forceinline__ void ph_gdn_seq(const Ctx& A, int l, LAS unsigned char* lds, int lane, int wave, int gw, int NGW) {
    LAS unsigned char* wl_ = lds + wave * 8192;
    for (int wi = gw; wi < 2176; wi += NGW) {
        if (wi < 128) { const int dvs = wi & 7, q = wi >> 3; gdn_seq_item(A, l, q >> 3, 1, (q >> 1) & 3, q & 1, dvs, wl_, lane); }
        else { const int w2 = wi - 128, dvs = w2 & 7, q = w2 >> 3; gdn_seq_item(A, l, q >> 3, 0, (q >> 1) & 3, q & 1, dvs, wl_, lane); }
    }
}

constexpr size_t SR_P = 0, SR_X1 = 32768, SR_X2 = 49152, SR_EA = 65536, SR_DEC = 66048, SR_BYTES = 66560;
constexpr size_t SS_C = 0, SS_BT = 32768, SS_BYTES = 65536;
constexpr int NSCH = 80;
__device__ __forceinline__ void ph_ssd_local(const Ctx& A, int l, LAS unsigned char* lds, int tid, int lane, int wave, int vcu, int G) {
    const float* XBC = (const float*)(A.ws + WS_XBC); const float* SDT = (const float*)(A.ws + WS_SDT); const float* SDA = SDT + (size_t)M * 16;
    unsigned char* SREC = A.ws + WS_SREC; unsigned char* SSH = A.ws + WS_SSH;
    LAS bf16* Cimg = (LAS bf16*)lds; LAS bf16* Bimg = (LAS bf16*)(lds + 34816);
    LAS float* sac = (LAS float*)(lds + 69632);
    LAS float* sdt = sac + 256;
    const int fr = lane & 15, fq = lane >> 4;
    for (int it = vcu; it < NSCH * 8; it += G) {
        const int ch = it >> 3, h = it & 7, g = h >> 2, row0 = ch * 128;
        unsigned char* shr = SSH + (size_t)(ch * 2 + g) * SS_BYTES;
        { const int r = tid >> 2, c0 = (tid & 3) * 32; const float* cp = XBC + (size_t)(row0 + r) * 1024 + 768 + g * 128 + c0; const float* bp = XBC + (size_t)(row0 + r) * 1024 + 512 + g * 128 + c0;
#pragma unroll
          for (int i = 0; i < 4; ++i) { const f32x4 a0 = *(const f32x4*)(cp + 8 * i), a1 = *(const f32x4*)(cp + 8 * i + 4), b0 = *(const f32x4*)(bp + 8 * i), b1 = *(const f32x4*)(bp + 8 * i + 4);
              v4u wc, wb; wc.x = pk2(a0.x, a0.y); wc.y = pk2(a0.z, a0.w); wc.z = pk2(a1.x, a1.y); wc.w = pk2(a1.z, a1.w);
              wb.x = pk2(b0.x, b0.y); wb.y = pk2(b0.z, b0.w); wb.z = pk2(b1.x, b1.y); wb.w = pk2(b1.z, b1.w);
              *(LAS v4u*)(Cimg + r * 136 + c0 + 8 * i) = wc; *(LAS v4u*)(Bimg + r * 136 + c0 + 8 * i) = wb;
              if ((h & 3) == 0) *(GAS v4u*)((bf16*)(shr + SS_C) + r * 128 + c0 + 8 * i) = wc; } }
        if (wave < 2) { const int d = wave; const size_t mo = (size_t)(row0 + 2 * lane) * 16 + d * 8 + h;
            const float a0 = SDA[mo], a1 = SDA[mo + 16]; float ps = a0 + a1;
#pragma unroll
            for (int o = 1; o < 64; o <<= 1) { const float t = __shfl_up(ps, o); if (lane >= o) ps += t; }
            const float tot = __shfl(ps, 63);
            if (d == 0) { sac[2 * lane] = ps - a1; sac[2 * lane + 1] = ps; }
            else { sac[128 + 2 * lane] = tot - ps + a0 + a1; sac[128 + 2 * lane + 1] = tot - ps + a1; }
            sdt[d * 128 + 2 * lane] = SDT[mo]; sdt[d * 128 + 2 * lane + 1] = SDT[mo + 16]; }
        __syncthreads();
        if ((h & 3) == 0) { const int n = tid >> 2, s0 = (tid & 3) * 32; bf16* dst = (bf16*)(shr + SS_BT) + n * 128 + s0;
#pragma unroll
            for (int i = 0; i < 4; ++i) { unsigned w[4];
#pragma unroll
                for (int j = 0; j < 4; ++j) w[j] = (unsigned)Bimg[(s0 + 8 * i + 2 * j) * 136 + n] | ((unsigned)Bimg[(s0 + 8 * i + 2 * j + 1) * 136 + n] << 16);
                *(GAS v4u*)(dst + 8 * i) = (v4u){w[0], w[1], w[2], w[3]}; } }
        { bf16x8 af[4];
#pragma unroll
          for (int ks = 0; ks < 4; ++ks) af[ks] = *(const LAS bf16x8*)(Cimg + (16 * wave + fr) * 136 + ks * 32 + fq * 8);
          bf16* Pf = (bf16*)(SREC + ((size_t)(0 * NSCH + ch) * 8 + h) * SR_BYTES + SR_P); bf16* Pb = (bf16*)(SREC + ((size_t)(1 * NSCH + ch) * 8 + h) * SR_BYTES + SR_P);
          float acf[4], acb[4];
#pragma unroll
          for (int r = 0; r < 4; ++r) { acf[r] = sac[16 * wave + 4 * fq + r]; acb[r] = sac[128 + 16 * wave + 4 * fq + r]; }
#pragma unroll
          for (int tc = 0; tc < 8; ++tc) { f32x4 acc = (f32x4){0.f, 0.f, 0.f, 0.f};
#pragma unroll
              for (int ks = 0; ks < 4; ++ks) { const bf16x8 bfr = *(const LAS bf16x8*)(Bimg + (16 * tc + fr) * 136 + ks * 32 + fq * 8); acc = __builtin_amdgcn_mfma_f32_16x16x32_bf16(af[ks], bfr, acc, 0, 0, 0); }
              const int s = 16 * tc + fr; const float asf = sac[s], asb = sac[128 + s];
#pragma unroll
              for (int r = 0; r < 4; ++r) { const int li = 16 * wave + 4 * fq + r;
                  Pf[li * 128 + s] = (bf16)f2bf((s <= li) ? acc[r] * __expf(acf[r] - asf) : 0.f);
                  Pb[li * 128 + s] = (bf16)f2bf((s >= li) ? acc[r] * __expf(acb[r] - asb) : 0.f); } } }
        { const int p = lane, s0 = wave * 16; const float* xp = XBC + (size_t)(row0 + s0) * 1024 + h * 64 + p;
          float xv[16];
#pragma unroll
          for (int j = 0; j < 16; ++j) xv[j] = xp[(size_t)j * 1024];
#pragma unroll
          for (int d = 0; d < 2; ++d) { unsigned char* rec = SREC + ((size_t)(d * NSCH + ch) * 8 + h) * SR_BYTES; const float aend = d ? sac[128] : sac[127];
              unsigned w1[8], w2[8];
#pragma unroll
              for (int j = 0; j < 16; j += 2) { const float u0 = xv[j] * sdt[d * 128 + s0 + j], u1 = xv[j + 1] * sdt[d * 128 + s0 + j + 1];
                  w1[j >> 1] = pk2(u0, u1); w2[j >> 1] = pk2(u0 * __expf(aend - sac[d * 128 + s0 + j]), u1 * __expf(aend - sac[d * 128 + s0 + j + 1])); }
              bf16* x1 = (bf16*)(rec + SR_X1) + p * 128 + s0; bf16* x2 = (bf16*)(rec + SR_X2) + p * 128 + s0;
              *(GAS v4u*)x1 = (v4u){w1[0], w1[1], w1[2], w1[3]}; *(GAS v4u*)(x1 + 8) = (v4u){w1[4], w1[5], w1[6], w1[7]};
              *(GAS v4u*)x2 = (v4u){w2[0], w2[1], w2[2], w2[3]}; *(GAS v4u*)(x2 + 8) = (v4u){w2[4], w2[5], w2[6], w2[7]};
              if (tid < 128) ((float*)(rec + SR_EA))[tid] = __expf(sac[d * 128 + tid]);
              if (tid == 0) *(float*)(rec + SR_DEC) = __expf(aend); } }
        __syncthreads();
    }
}

__device__ __forceinline__ void ssd_seq_item(const Ctx& A, int l, int b, int lat, int h, int dir, int ps, LAS unsigned char* wl_, int lane) {
    const unsigned char* SREC = A.ws + WS_SREC; const unsigned char* SSH = A.ws + WS_SSH; float* SY = (float*)(A.ws + WS_SY);
    const int fr = lane & 15, fq = lane >> 4, g = h >> 2;
    const int nch = lat ? 8 : 2, ch0 = lat ? 64 + b * 8 : b * 2;
    LAS bf16* simg = (LAS bf16*)wl_;
    f32x4 S[8];
    const size_t sidx = ((size_t)(((b * 4 + l) * 2 + dir) * 8 + h) * 64 + ps * 16 + fr) * 128 + 4 * fq;
    if (lat) {
#pragma unroll
        for (int u = 0; u < 8; ++u) S[u] = *(const f32x4*)(A.in[5] + sidx + 16 * u); }
    else {
#pragma unroll
        for (int u = 0; u < 8; ++u) S[u] = (f32x4){0.f, 0.f, 0.f, 0.f}; }
#pragma unroll 1
    for (int cc = 0; cc < nch; ++cc) {
        const int ch = dir ? ch0 + nch - 1 - cc : ch0 + cc;
        const unsigned char* rec = SREC + ((size_t)(dir * NSCH + ch) * 8 + h) * SR_BYTES; const unsigned char* shr = SSH + (size_t)(ch * 2 + g) * SS_BYTES;
        const bf16* P = (const bf16*)(rec + SR_P); const bf16* X1 = (const bf16*)(rec + SR_X1); const bf16* X2 = (const bf16*)(rec + SR_X2);
        const float* EA = (const float*)(rec + SR_EA); const float dec = *(const float*)(rec + SR_DEC);
        const bf16* C16 = (const bf16*)(shr + SS_C); const bf16* BT16 = (const bf16*)(shr + SS_BT);
#pragma unroll
        for (int u = 0; u < 8; ++u) { v2u w; w.x = pk2(S[u][0], S[u][1]); w.y = pk2(S[u][2], S[u][3]); *(LAS v2u*)(simg + fr * 136 + 16 * u + 4 * fq) = w; }
        asm volatile("s_waitcnt lgkmcnt(0)" ::: "memory");
        bf16x8 BS[4], BX1[4], BX2[4];
#pragma unroll
        for (int ks = 0; ks < 4; ++ks) { BS[ks] = *(const LAS bf16x8*)(simg + fr * 136 + ks * 32 + fq * 8);
            BX1[ks] = *(const bf16x8*)(X1 + (ps * 16 + fr) * 128 + ks * 32 + fq * 8); BX2[ks] = *(const bf16x8*)(X2 + (ps * 16 + fr) * 128 + ks * 32 + fq * 8); }
        const int row0 = ch * 128;
#pragma unroll 2
        for (int t = 0; t < 8; ++t) { f32x4 acc = (f32x4){0.f, 0.f, 0.f, 0.f};
#pragma unroll
            for (int ks = 0; ks < 4; ++ks) { const bf16x8 af = *(const bf16x8*)(C16 + (16 * t + fr) * 128 + ks * 32 + fq * 8); acc = __builtin_amdgcn_mfma_f32_16x16x32_bf16(af, BS[ks], acc, 0, 0, 0); }
            acc = acc * *(const f32x4*)(EA + 16 * t + 4 * fq);
#pragma unroll
            for (int ks = 0; ks < 4; ++ks) { const bf16x8 af = *(const bf16x8*)(P + (16 * t + fr) * 128 + ks * 32 + fq * 8); acc = __builtin_amdgcn_mfma_f32_16x16x32_bf16(af, BX1[ks], acc, 0, 0, 0); }
#pragma unroll
            for (int r = 0; r < 4; ++r) SY[((size_t)dir * M + row0 + 16 * t + 4 * fq + r) * 512 + h * 64 + ps * 16 + fr] = acc[r]; }
#pragma unroll 2
        for (int u = 0; u < 8; ++u) { f32x4 acc = S[u] * dec;
#pragma unroll
            for (int ks = 0; ks < 4; ++ks) { const bf16x8 af = *(const bf16x8*)(BT16 + (16 * u + fr) * 128 + ks * 32 + fq * 8); acc = __builtin_amdgcn_mfma_f32_16x16x32_bf16(af, BX2[ks], acc, 0, 0, 0); }
            S[u] = acc; }
    }
    if (!lat) {
#pragma unroll
        for (int u = 0; u < 8; ++u) *(f32x4*)(A.out + O_SS + sidx + 16 * u) = S[u]; }
}
__device__ __forceinline__ void ph_ssd_seq(const Ctx& A, int l, LAS unsigned char* lds, int lane, int wave, int gw, int NGW) {
    LAS unsigned char* wl_ = lds + wave * 8192;
    for (int wi0 = gw; wi0 < 2176; wi0 += NGW) {
        const int wi = (wi0 + 1024) % 2176;
        if (wi < 128) { const int ps = wi & 3, q = wi >> 2; ssd_seq_item(A, l, q >> 4, 1, (q >> 1) & 7, q & 1, ps, wl_, lane); }
        else { const int w2 = wi - 128, ps = w2 & 3, q = w2 >> 2; ssd_seq_item(A, l, q >> 4, 0, (q >> 1) & 7, q & 1, ps, wl_, lane); }
    }
}

#ifndef REP_ATTN
#define REP_ATTN 1
#endif
#ifndef REP_MIX
#define REP_MIX 1
#endif
#ifndef REP_PRO
#define REP_PRO 1
#endif
#ifndef REP_EW
#define REP_EW 1
#endif
#ifndef REP_GEMM
#define REP_GEMM 1
#endif
#ifndef MK_ONE_LAUNCH
#define MK_ONE_LAUNCH 0
#endif
__global__ void __launch_bounds__(NWAVES * 64, 2) mk_fwd(Args args) {
    extern __shared__ __attribute__((aligned(16))) unsigned char lds_raw[];
    LAS unsigned char* lds = (LAS unsigned char*)lds_raw;
    const int tid0 = threadIdx.x;
    for (int u = tid0; u < (LDS_BYTES - LDSCTL_OFF) / 4; u += NWAVES * 64) ((LAS unsigned*)(lds + LDSCTL_OFF))[u] = 0u;
    __syncthreads();
    const int lo0 = args.ph_lo, hi0 = args.ph_hi;
    XcdBarrier bar; bar.bar = (unsigned*)(args.ws + WS_CTL) + CW_BAR; bar.x = 0; bar.st = nullptr;
    if ((hi0 - lo0) > 1) bar = xcd_barrier_post((unsigned*)(args.ws + WS_CTL) + CW_BAR, (volatile LAS unsigned*)(lds + MISC_OFF) + 8);
#define IN(k) (lo <= (k) && (k) < hi)
#define SEAM(k) do { if (IN((k) + 1)) xcd_barrier(bar); } while (0)
#define PHASE_ROOTS() Ctx C; int G = (int)gridDim.x, bx = (int)blockIdx.x; int tid = tid0; asm volatile("" : "+v"(tid)); const int lane = tid & 63, wave = __builtin_amdgcn_readfirstlane(tid >> 6); (void)lane; (void)wave; \
    { unsigned long long kp_ = (unsigned long long)__builtin_amdgcn_kernarg_segment_ptr(); float* o_ = args.out; unsigned char* w_ = args.ws; \
      asm volatile("" : "+s"(kp_), "+s"(o_), "+s"(w_), "+s"(G), "+s"(bx)); C.in = (kin_t)kp_; C.out = o_; C.ws = w_; } \
    const int vcu = (G % 8 == 0) ? (bx % 8) * (G / 8) + bx / 8 : bx; const int gw = vcu * NWAVES + wave, NGW = G * NWAVES; (void)gw; (void)NGW; (void)vcu

    { int lo = lo0, hi = hi0;
    if (IN(0)) { for (int rep = 0; rep < REP_PRO; ++rep) { PHASE_ROOTS();
#ifndef SKIP_PRO
        ph_prologue(C, lds, tid, lane, wave, vcu, G);
#endif
        __syncthreads(); }
        SEAM(0); } }

#pragma unroll 1
    for (int l = 0; l < DEPTH; ++l) {
        const int pb = 1 + l * NPH_L;
        int lo = lo0, hi = hi0; asm volatile("" : "+s"(lo), "+s"(hi));
#define MODS_L ((const float*)(C.ws + WS_MODS) + (size_t)l * 3 * 12288)
#define WL ((const bf16*)(C.ws + WS_W) + (size_t)l * WLE_SIZE)
        if (IN(pb + 0)) { PHASE_ROOTS(); for (int rep = 0; rep < REP_EW; ++rep) ph_norm(C.out, C.in[8] + l * D, MODS_L, 0, (bf16*)(C.ws + WS_H), lane, gw, NGW); SEAM(pb + 0); }
        if (IN(pb + 1)) { PHASE_ROOTS();
            pg8::Gemm g{(const bf16*)(C.ws + WS_H), WL + WLE_IN, M, IN_WP, D}; pg8::StaticOrder S; S.init(M, IN_WP, G, bx);
            pg8::EpiF32 E{(float*)(C.ws + WS_U), IN_WP};
            pg8::gemm_phase<pg8::EpiF32, pg8::StaticOrder, true, true>(lds, g, S, E);
            SEAM(pb + 1);
        }
        if (IN(pb + 2)) { PHASE_ROOTS();
#ifndef SKIP_PREP
            for (int rep = 0; rep < REP_EW; ++rep) ph_prep(C, l, lane, gw, NGW);
#endif
            SEAM(pb + 2); }
        if (IN(pb + 3)) {
            { PHASE_ROOTS(); pg8::Gemm g{(const bf16*)(C.ws + WS_CQN), WL + WLE_UQ, M, 1536, 768}; pg8::StaticOrder S; S.init(M, 1536, G, bx);
              pg8::EpiF32 E{(float*)(C.ws + WS_QRAW), 1536};
              pg8::gemm_phase<pg8::EpiF32, pg8::StaticOrder, true, true>(lds, g, S, E); }
            { PHASE_ROOTS(); pg8::Gemm g{(const bf16*)(C.ws + WS_CKVN), WL + WLE_KV, MK, 1024, 512}; pg8::StaticOrder S; S.init(MK, 1024, G, bx);
              pg8::EpiF32 E{(float*)(C.ws + WS_KN), 1024};
              pg8::gemm_phase<pg8::EpiF32, pg8::StaticOrder, true, true>(lds, g, S, E); }
            { PHASE_ROOTS(); pg8::Gemm g{WL + WLE_KV + (size_t)1024 * 512, (const bf16*)(C.ws + WS_CKVN), 1024, MK, 512}; pg8::StaticOrder S; S.init(1024, MK, G, bx);
              pg8::EpiBf16 E{(bf16*)(C.ws + WS_VT), MK};
              pg8::gemm_phase<pg8::EpiBf16, pg8::StaticOrder, true, true>(lds, g, S, E); }
            SEAM(pb + 3);
        }
        if (IN(pb + 4)) { PHASE_ROOTS();
#ifndef SKIP_FIN
            for (int rep = 0; rep < REP_EW; ++rep) ph_finalize(C, l, lane, gw, NGW);
#endif
            ph_gdn_local(C, l, lds, tid, lane, wave, vcu, G);
            ph_ssd_local(C, l, lds, tid, lane, wave, vcu, G);
            SEAM(pb + 4); }
        if (IN(pb + 5)) { for (int rep = 0; rep < REP_MIX; ++rep) {
#ifndef SKIP_GDN
            { PHASE_ROOTS(); ph_gdn_seq(C, l, lds, lane, wave, gw, NGW); }
#endif
            __syncthreads();
#ifndef SKIP_SSD
            { PHASE_ROOTS(); ph_ssd_seq(C, l, lds, lane, wave, gw, NGW); }
#endif
            __syncthreads();
#ifndef SKIP_ATTN
            for (int rep2 = 0; rep2 < REP_ATTN; ++rep2) { PHASE_ROOTS(); ph_attn(C, lds, lane, wave, gw, NGW); }
#endif
            __syncthreads(); }
            SEAM(pb + 5);
        }
        if (IN(pb + 6)) { PHASE_ROOTS();
#ifndef SKIP_POST
            for (int rep = 0; rep < REP_EW; ++rep) ph_post(C, l, lane, gw, NGW);
#endif
            SEAM(pb + 6); }
        if (IN(pb + 7)) { PHASE_ROOTS();
            pg8::Gemm g{(const bf16*)(C.ws + WS_MIX), WL + WLE_OUT, M, D, D}; pg8::StaticOrder S; S.init(M, D, G, bx);
            pg8::EpiResid E{C.out, D, MODS_L + 2 * 2048};
            pg8::gemm_phase<pg8::EpiResid, pg8::StaticOrder, true, true>(lds, g, S, E);
            SEAM(pb + 7);
        }
        if (IN(pb + 8)) { PHASE_ROOTS(); for (int rep = 0; rep < REP_EW; ++rep) ph_norm(C.out, C.in[9] + l * D, MODS_L, 3, (bf16*)(C.ws + WS_H), lane, gw, NGW); SEAM(pb + 8); }
        if (IN(pb + 9)) { PHASE_ROOTS();
            pg8::Gemm g{(const bf16*)(C.ws + WS_H), WL + WLE_GU, M, 2 * FF, D}; pg8::StaticOrder S; S.init(M, 2 * FF, G, bx);
            pg8::EpiSwiglu E{(bf16*)(C.ws + WS_ACT), FF};
            pg8::gemm_phase<pg8::EpiSwiglu, pg8::StaticOrder, true, true>(lds, g, S, E);
            SEAM(pb + 9);
        }
        if (IN(pb + 10)) { PHASE_ROOTS();
            pg8::Gemm g{(const bf16*)(C.ws + WS_ACT), WL + WLE_DN, M, D, FF}; pg8::StaticOrder S; S.init(M, D, G, bx);
            pg8::EpiResid E{C.out, D, MODS_L + 5 * 2048};
            pg8::gemm_phase<pg8::EpiResid, pg8::StaticOrder, true, true>(lds, g, S, E);
            SEAM(pb + 10);
        }
    }
#undef IN
#undef SEAM
}

extern "C" void kernel_launch(void* const* d_in, const int* in_sizes, int n_in, void* d_out, int out_size, void* d_ws, size_t ws_size, hipStream_t stream) {
    static int grid = 0;
    if (grid == 0) {
        if (n_in != 32 || out_size != 73400320 || ws_size < WS_END) { fprintf(stderr, "kernel_launch: built for 32 inputs, 73400320 outputs, >= %zu bytes of workspace; got n_in %d, out %d, ws %zu; nothing launched\n", (size_t)WS_END, n_in, out_size, ws_size); grid = -1; return; }
        int dev = 0, cus = 0, per_cu = 0;
        if (hipGetDevice(&dev) != hipSuccess || hipDeviceGetAttribute(&cus, hipDeviceAttributeMultiprocessorCount, dev) != hipSuccess) { fprintf(stderr, "kernel_launch: device query failed\n"); grid = -1; return; }
        if (hipFuncSetAttribute((const void*)mk_fwd, hipFuncAttributeMaxDynamicSharedMemorySize, LDS_BYTES) != hipSuccess) { fprintf(stderr, "kernel_launch: hipFuncSetAttribute failed\n"); grid = -1; return; }
        if (hipOccupancyMaxActiveBlocksPerMultiprocessor(&per_cu, (const void*)mk_fwd, NWAVES * 64, LDS_BYTES) != hipSuccess || per_cu < 1)
            fprintf(stderr, "kernel_launch: note: occupancy query reports %d workgroups per CU\n", per_cu);
        (void)hipGetLastError();
        grid = cus;
    }
    if (grid < 0) return;
    if (hipMemsetAsync((char*)d_ws + WS_CTL, 0, CTL_ZERO_BYTES, stream) != hipSuccess) { fprintf(stderr, "kernel_launch: memset failed\n"); return; }
    Args a{};
    for (int i = 0; i < 32; ++i) a.in[i] = (const float*)d_in[i];
    a.out = (float*)d_out; a.ws = (unsigned char*)d_ws;
#if MK_ONE_LAUNCH
    a.ph_lo = 0; a.ph_hi = NPHASES;
    hipLaunchKernelGGL(mk_fwd, dim3(grid), dim3(NWAVES * 64), LDS_BYTES, stream, a);
#else
    for (int p = 0; p < NPHASES; ++p) { a.ph_lo = p; a.ph_hi = p + 1; hipLaunchKernelGGL(mk_fwd, dim3(grid), dim3(NWAVES * 64), LDS_BYTES, stream, a); }
#endif
    const hipError_t le = hipPeekAtLastError();
    if (le != hipSuccess) fprintf(stderr, "kernel_launch: launch failed: %s\n", hipGetErrorName(le));
}
```

```cpp
#include <hip/hip_runtime.h>
#include <cstdio>
#include <cstdint>
#include <cstddef>
#ifndef MK_ONE_LAUNCH
#define MK_ONE_LAUNCH 1
#endif
namespace pg8 {
#define PG8_LAS __attribute__((address_space(3)))
typedef unsigned short bf16_t;
typedef short bf16x8 __attribute__((ext_vector_type(8)));
typedef float f32x4 __attribute__((ext_vector_type(4)));
typedef unsigned u32x4 __attribute__((ext_vector_type(4)));
constexpr int BM = 256, BK = 64, HALF = 128, HTB = HALF * BK * 2  , STAGE_BYTES = 8 * HTB, NXCD = 8, WGM = 8;

__host__ __device__ __forceinline__ int lds_byte(int r, int c) { const int st = (r >> 4) * 2 + (c >> 5), rr = r & 15, cc = c & 31, ob = rr * 64 + cc * 2; return st * 1024 + (ob ^ (((ob >> 9) & 1) << 5)); }
__host__ __device__ __forceinline__ void stage_rc(int b, int& R, int& C) { const int st = b / 1024, sb = b % 1024, swz = sb ^ (((sb >> 9) & 1) << 5); R = (st >> 1) * 16 + swz / 64; C = (st & 1) * 32 + (swz % 64) / 2; }
__host__ __device__ __forceinline__ int perm32(int rho) { const int n = rho >> 4, i = rho & 15; return 8 * (i >> 2) + 4 * n + (i & 3); }

struct Unit { int pm, pn, k0; };
struct Gemm { const bf16_t* A; const bf16_t* Bt; int M, N, K, ld; };

struct StaticOrder {
    int nM, nN, nwg, G, c;
    __host__ __device__ void init(int M, int N, int G_, int c_) { nM = M / BM; nN = N / BM; nwg = nM * nN; G = G_; c = c_; }
    __host__ __device__ bool next(int i, Unit& u) const {
        const long L = (long)i * G + c; if (L >= nwg) return false;
        int wgid = (int)L; { const int q = nwg / NXCD, r = nwg % NXCD, xcd = wgid % NXCD, off = wgid / NXCD; wgid = (xcd < r ? xcd * (q + 1) : r * (q + 1) + (xcd - r) * q) + off; }
        const int nig = WGM * nN, gid = wgid / nig, fm = gid * WGM, gsz = (nM - fm) < WGM ? (nM - fm) : WGM;
        u.pm = fm + ((wgid % nig) % gsz); u.pn = (wgid % nig) / gsz; u.k0 = 0; return true;
    }
    __device__ __forceinline__ void a_ready(const Unit&) const {}
    __device__ __forceinline__ void done(const Unit&) const {}
};

__device__ __forceinline__ unsigned cvt_pk_bf16(float lo, float hi) { unsigned r; asm volatile("v_cvt_pk_bf16_f32 %0, %1, %2" : "=v"(r) : "v"(lo), "v"(hi)); return r; }
__device__ __forceinline__ float silu_f(float x) { return x * __builtin_amdgcn_rcpf(1.0f + __expf(-x)); }

struct EpiF32 {
    static constexpr bool PERM = false, AFTER_DRAIN = false;
    float* C; int ldc;
    __device__ __forceinline__ void operator()(const f32x4 (&acc)[2][2][4][2], const Unit& u, int wr, int wc, int fr, int fq) const {
        const int row0 = u.pm * BM + wr * 64 + fr, col0 = u.pn * BM + wc * 32 + 4 * fq;
#pragma unroll
        for (int ai = 0; ai < 2; ++ai)
#pragma unroll
            for (int m = 0; m < 4; ++m) { float* rowp = C + (size_t)(row0 + ai * HALF + m * 16) * ldc + col0;
#pragma unroll
                for (int bj = 0; bj < 2; ++bj)
#pragma unroll
                    for (int n = 0; n < 2; ++n) *(f32x4*)(rowp + bj * HALF + n * 16) = acc[ai][bj][m][n]; }
    }
};
struct EpiBf16 {
    static constexpr bool PERM = true, AFTER_DRAIN = false;
    bf16_t* O; int ldc;
    __device__ __forceinline__ void operator()(const f32x4 (&acc)[2][2][4][2], const Unit& u, int wr, int wc, int fr, int fq) const {
        const int row0 = u.pm * BM + wr * 64 + fr; const int col0 = u.pn * BM + wc * 32 + 8 * fq;
#pragma unroll
        for (int ai = 0; ai < 2; ++ai)
#pragma unroll
            for (int m = 0; m < 4; ++m) { bf16_t* rowp = O + (size_t)(row0 + ai * HALF + m * 16) * ldc + col0;
#pragma unroll
                for (int bj = 0; bj < 2; ++bj) { const f32x4 v0 = acc[ai][bj][m][0], v1 = acc[ai][bj][m][1];
                    u32x4 w; w.x = cvt_pk_bf16(v0[0], v0[1]); w.y = cvt_pk_bf16(v0[2], v0[3]); w.z = cvt_pk_bf16(v1[0], v1[1]); w.w = cvt_pk_bf16(v1[2], v1[3]);
                    *(u32x4*)(rowp + bj * HALF) = w; } }
    }
};
struct EpiResid {
    static constexpr bool PERM = false, AFTER_DRAIN = false;
    float* X; int ldc; const float* gate;
    __device__ __forceinline__ void operator()(const f32x4 (&acc)[2][2][4][2], const Unit& u, int wr, int wc, int fr, int fq) const {
        const int row0 = u.pm * BM + wr * 64 + fr, col0 = u.pn * BM + wc * 32 + 4 * fq;
        const int cr = u.pm < 32 ? 0 : 1 + ((u.pm - 32) >> 2);
        const float* gp = gate + (size_t)cr * 12288 + col0;
        f32x4 gv[2][2];
#pragma unroll
        for (int bj = 0; bj < 2; ++bj)
#pragma unroll
            for (int n = 0; n < 2; ++n) gv[bj][n] = *(const f32x4*)(gp + bj * HALF + n * 16);
#pragma unroll
        for (int ai = 0; ai < 2; ++ai)
#pragma unroll
            for (int m = 0; m < 4; ++m) { float* rowp = X + (size_t)(row0 + ai * HALF + m * 16) * ldc + col0;
#pragma unroll
                for (int bj = 0; bj < 2; ++bj)
#pragma unroll
                    for (int n = 0; n < 2; ++n) { f32x4 x = *(const f32x4*)(rowp + bj * HALF + n * 16); x = x + gv[bj][n] * acc[ai][bj][m][n]; *(f32x4*)(rowp + bj * HALF + n * 16) = x; } }
    }
};
struct EpiSwiglu {
    static constexpr bool PERM = true, AFTER_DRAIN = false;
    bf16_t* O; int ldc;
    __device__ __forceinline__ void operator()(const f32x4 (&acc)[2][2][4][2], const Unit& u, int wr, int wc, int fr, int fq) const {
        const int row0 = u.pm * BM + wr * 64 + fr; const int col0 = u.pn * HALF + wc * 32 + 8 * fq;
#pragma unroll
        for (int ai = 0; ai < 2; ++ai)
#pragma unroll
            for (int m = 0; m < 4; ++m) { bf16_t* rowp = O + (size_t)(row0 + ai * HALF + m * 16) * ldc + col0;
                f32x4 v0, v1;
#pragma unroll
                for (int j = 0; j < 4; ++j) { v0[j] = silu_f(acc[ai][0][m][0][j]) * acc[ai][1][m][0][j]; v1[j] = silu_f(acc[ai][0][m][1][j]) * acc[ai][1][m][1][j]; }
                u32x4 w; w.x = cvt_pk_bf16(v0[0], v0[1]); w.y = cvt_pk_bf16(v0[2], v0[3]); w.z = cvt_pk_bf16(v1[0], v1[1]); w.w = cvt_pk_bf16(v1[2], v1[3]);
                *(u32x4*)rowp = w; }
    }
};


struct PanelOrder {
    int c;
    __device__ bool next(int i, Unit& u) const { if (i != 0 || c >= 256) return false; u.pm = c >> 3; u.pn = c & 7; u.k0 = 0; return true; }
    __device__ __forceinline__ void a_ready(const Unit&) const {}
    __device__ __forceinline__ void done(const Unit&) const {}
};
struct TailOrder {
    int c, kq;
    __device__ bool next(int i, Unit& u) const { if (i != 0 || c >= 256) return false; const int t = c >> 2; u.pm = 32 + (t >> 3); u.pn = t & 7; u.k0 = (c & 3) * kq; return true; }
    __device__ __forceinline__ void a_ready(const Unit&) const {}
    __device__ __forceinline__ void done(const Unit&) const {}
};
struct EpiPart {
    static constexpr bool PERM = false, AFTER_DRAIN = false;
    float* P; int kq;
    __device__ __forceinline__ void operator()(const f32x4 (&acc)[2][2][4][2], const Unit& u, int wr, int wc, int fr, int fq) const {
        const int row0 = (u.pm - 32) * BM + wr * 64 + fr, col0 = u.pn * BM + wc * 32 + 4 * fq;
        float* base = P + (size_t)(u.k0 / kq) * 2048 * 2048;
#pragma unroll
        for (int ai = 0; ai < 2; ++ai)
#pragma unroll
            for (int m = 0; m < 4; ++m) { float* rowp = base + (size_t)(row0 + ai * HALF + m * 16) * 2048 + col0;
#pragma unroll
                for (int bj = 0; bj < 2; ++bj)
#pragma unroll
                    for (int n = 0; n < 2; ++n) *(f32x4*)(rowp + bj * HALF + n * 16) = acc[ai][bj][m][n]; }
    }
};
template <class Epi, class Sched, bool ALIGN_EPI = false, bool SP2 = false>
__device__ __forceinline__ void gemm_phase(PG8_LAS unsigned char* lds, const Gemm g, const Sched& S, const Epi& E) {
    int tid_l = threadIdx.x; asm volatile("" : "+v"(tid_l)); const int tid = tid_l, wid = __builtin_amdgcn_readfirstlane(tid >> 6), lane = tid & 63, wr = wid >> 2, wc = wid & 3, fr = lane & 15, fq = lane >> 4;
    const int K = g.ld ? g.ld : g.K, nt = g.K / BK;
    unsigned voffA[2], voffB[2];
#pragma unroll
    for (int i = 0; i < 2; ++i) { int R, C; stage_rc(tid * 16 + i * 8192, R, C); const int Rb = Epi::PERM ? ((R & ~31) + perm32(R & 31)) : R;
        voffA[i] = (unsigned)(R * K + C) * 2u; voffB[i] = (unsigned)(Rb * K + C) * 2u; }
    const size_t kstep = (size_t)(BK * 2);
    const size_t hstep = (size_t)HALF * K * 2;
    const size_t tstep = 2 * hstep;
    const unsigned ldsw = (unsigned)wid * 1024u;
    const int aoff = lds_byte(wr * 64 + fr, fq * 8), boff = lds_byte(wc * 32 + fr, fq * 8);
#define PG8_SA(b, h) (((b) * 2 + (h)) * HTB)
#define PG8_SB(b, h) ((4 + (b) * 2 + (h)) * HTB)
#define PG8_STAGE(bufoff, gbase, voff) do { _Pragma("unroll") for (int _i = 0; _i < 2; ++_i) \
        __builtin_amdgcn_global_load_lds((const unsigned*)((const char*)(gbase) + (voff)[_i]), (PG8_LAS unsigned*)(lds + (bufoff) + ldsw + _i * 8192), 16, 0, 0); } while (0)
#define PG8_LDA(dst, b, h) do { _Pragma("unroll") for (int m = 0; m < 4; ++m) _Pragma("unroll") for (int k = 0; k < 2; ++k) dst[m][k] = *(const PG8_LAS bf16x8*)(lds + PG8_SA(b, h) + aoff + m * 2048 + k * 1024); } while (0)
#define PG8_LDB(dst, b, h) do { _Pragma("unroll") for (int n = 0; n < 2; ++n) _Pragma("unroll") for (int k = 0; k < 2; ++k) dst[n][k] = *(const PG8_LAS bf16x8*)(lds + PG8_SB(b, h) + boff + n * 2048 + k * 1024); } while (0)
#define PG8_MMA(ai, bj, At, Bt) do { __builtin_amdgcn_s_setprio(1); _Pragma("unroll") for (int m = 0; m < 4; ++m) _Pragma("unroll") for (int n = 0; n < 2; ++n) _Pragma("unroll") for (int k = 0; k < 2; ++k) \
        acc[ai][bj][m][n] = __builtin_amdgcn_mfma_f32_16x16x32_bf16(Bt[n][k], At[m][k], acc[ai][bj][m][n], 0, 0, 0); __builtin_amdgcn_s_setprio(0); } while (0)
#define PG8_WAIT_V(n) asm volatile("s_waitcnt vmcnt(" #n ")" ::: "memory")
#define PG8_WAIT_L(n) asm volatile("s_waitcnt lgkmcnt(" #n ")" ::: "memory")
#define PG8_BAR __builtin_amdgcn_s_barrier()
#define PG8_SCHED __builtin_amdgcn_sched_barrier(0)
    Unit cur, nxt; int ui = 0;
    if (!S.next(0, cur)) return;
    f32x4 acc[2][2][4][2];
#pragma unroll
    for (int a = 0; a < 2; ++a)
#pragma unroll
        for (int b = 0; b < 2; ++b)
#pragma unroll
            for (int m = 0; m < 4; ++m)
#pragma unroll
                for (int n = 0; n < 2; ++n) acc[a][b][m][n] = (f32x4){0.f, 0.f, 0.f, 0.f};
    bf16x8 At[4][2], B0[2][2], B1[2][2];
    const char* cA = (const char*)g.A + (size_t)cur.pm * tstep + (size_t)cur.k0 * 2; const char* cB = (const char*)g.Bt + (size_t)cur.pn * tstep + (size_t)cur.k0 * 2;
    S.a_ready(cur);
    if constexpr (SP2) {
        PG8_STAGE(PG8_SB(0, 0), cB, voffB); PG8_STAGE(PG8_SB(0, 1), cB + hstep, voffB); PG8_STAGE(PG8_SA(0, 0), cA, voffA); PG8_STAGE(PG8_SA(0, 1), cA + hstep, voffA);
        if (wr == 1) PG8_BAR;
        PG8_WAIT_V(2); PG8_BAR;
        PG8_STAGE(PG8_SB(1, 0), cB + kstep, voffB); PG8_STAGE(PG8_SA(1, 0), cA + kstep, voffA); PG8_STAGE(PG8_SB(1, 1), cB + hstep + kstep, voffB);
        PG8_WAIT_V(6); PG8_BAR;
    } else {
        PG8_STAGE(PG8_SB(0, 0), cB, voffB); PG8_STAGE(PG8_SA(0, 0), cA, voffA); PG8_STAGE(PG8_SB(0, 1), cB + hstep, voffB); PG8_STAGE(PG8_SA(0, 1), cA + hstep, voffA);
        if (wr == 1) PG8_BAR;
        PG8_WAIT_V(4); PG8_BAR;
        PG8_STAGE(PG8_SB(1, 0), cB + kstep, voffB); PG8_STAGE(PG8_SA(1, 0), cA + kstep, voffA); PG8_STAGE(PG8_SB(1, 1), cB + hstep + kstep, voffB);
        PG8_WAIT_V(6); PG8_BAR;
    }
    for (;;) {
        const bool has_next = S.next(ui + 1, nxt);
        const char* nA = has_next ? (const char*)g.A + (size_t)nxt.pm * tstep + (size_t)nxt.k0 * 2 : cA; const char* nB = has_next ? (const char*)g.Bt + (size_t)nxt.pn * tstep + (size_t)nxt.k0 * 2 : cB;
        for (int t = 0; t < nt; t += 2) {
            const bool last = (t == nt - 2);
            const char* a1 = cA + (size_t)(t + 1) * kstep;
            const char* a2 = last ? nA : cA + (size_t)(t + 2) * kstep; const char* b2 = last ? nB : cB + (size_t)(t + 2) * kstep;
            const char* a3 = a2 + kstep; const char* b3 = b2 + kstep;
            if (last && has_next) S.a_ready(nxt);
            if constexpr (SP2) {
            PG8_LDB(B0, 0, 0); PG8_LDB(B1, 0, 1); PG8_SCHED; PG8_LDA(At, 0, 0); PG8_STAGE(PG8_SA(1, 1), a1 + hstep, voffA);
            PG8_WAIT_V(8); PG8_WAIT_L(0); PG8_BAR; PG8_MMA(0, 0, At, B0); PG8_MMA(0, 1, At, B1); PG8_BAR; PG8_SCHED;
            PG8_LDA(At, 0, 1); PG8_STAGE(PG8_SB(0, 0), b2, voffB); PG8_STAGE(PG8_SB(0, 1), b2 + hstep, voffB); PG8_STAGE(PG8_SA(0, 0), a2, voffA);
            PG8_WAIT_V(8); PG8_WAIT_L(0); PG8_BAR; PG8_MMA(1, 0, At, B0); PG8_MMA(1, 1, At, B1); PG8_BAR; PG8_SCHED;
            PG8_LDB(B0, 1, 0); PG8_LDB(B1, 1, 1); PG8_SCHED; PG8_LDA(At, 1, 0); PG8_STAGE(PG8_SA(0, 1), a2 + hstep, voffA);
            PG8_WAIT_V(8); PG8_WAIT_L(0); PG8_BAR; PG8_MMA(0, 0, At, B0); PG8_MMA(0, 1, At, B1); PG8_BAR; PG8_SCHED;
            PG8_LDA(At, 1, 1); PG8_STAGE(PG8_SB(1, 0), b3, voffB); PG8_STAGE(PG8_SB(1, 1), b3 + hstep, voffB); PG8_STAGE(PG8_SA(1, 0), a3, voffA);
            PG8_WAIT_V(8); PG8_WAIT_L(0); PG8_BAR; PG8_MMA(1, 0, At, B0); PG8_MMA(1, 1, At, B1); PG8_BAR; PG8_SCHED;
            } else {
            PG8_LDB(B0, 0, 0); PG8_SCHED; PG8_LDA(At, 0, 0); PG8_STAGE(PG8_SA(1, 1), a1 + hstep, voffA);
            PG8_WAIT_L(8); PG8_BAR; PG8_WAIT_L(0); PG8_MMA(0, 0, At, B0); PG8_BAR; PG8_SCHED;
            PG8_LDB(B1, 0, 1); PG8_STAGE(PG8_SB(0, 0), b2, voffB);
            PG8_BAR; PG8_WAIT_L(0); PG8_MMA(0, 1, At, B1); PG8_BAR;
            PG8_LDA(At, 0, 1); PG8_STAGE(PG8_SA(0, 0), a2, voffA);
            PG8_BAR; PG8_WAIT_L(0); PG8_MMA(1, 0, At, B0); PG8_BAR; PG8_SCHED;
            PG8_STAGE(PG8_SB(0, 1), b2 + hstep, voffB);
            PG8_WAIT_V(6); PG8_BAR; PG8_MMA(1, 1, At, B1); PG8_BAR;
            PG8_LDB(B0, 1, 0); PG8_SCHED; PG8_LDA(At, 1, 0); PG8_STAGE(PG8_SA(0, 1), a2 + hstep, voffA);
            PG8_WAIT_L(8); PG8_BAR; PG8_WAIT_L(0); PG8_MMA(0, 0, At, B0); PG8_BAR; PG8_SCHED;
            PG8_LDB(B1, 1, 1); PG8_STAGE(PG8_SB(1, 0), b3, voffB);
            PG8_BAR; PG8_WAIT_L(0); PG8_MMA(0, 1, At, B1); PG8_BAR;
            PG8_LDA(At, 1, 1); PG8_STAGE(PG8_SA(1, 0), a3, voffA);
            PG8_BAR; PG8_WAIT_L(0); PG8_MMA(1, 0, At, B0); PG8_BAR; PG8_SCHED;
            PG8_STAGE(PG8_SB(1, 1), b3 + hstep, voffB);
            PG8_WAIT_V(6); PG8_BAR; PG8_MMA(1, 1, At, B1); PG8_BAR;
            }
        }
        if constexpr (ALIGN_EPI) { if (wr == 0) PG8_BAR; }
        if constexpr (!Epi::AFTER_DRAIN) { E(acc, cur, wr, wc, fr, fq); S.done(cur); }
        if (!has_next) break;
#pragma unroll
        for (int a = 0; a < 2; ++a)
#pragma unroll
            for (int b = 0; b < 2; ++b)
#pragma unroll
                for (int m = 0; m < 4; ++m)
#pragma unroll
                    for (int n = 0; n < 2; ++n) acc[a][b][m][n] = (f32x4){0.f, 0.f, 0.f, 0.f};
        cur = nxt; cA = nA; cB = nB; ++ui;
        if constexpr (ALIGN_EPI) { if (wr == 1) PG8_BAR; }
    }
    PG8_WAIT_V(0);
    if constexpr (!ALIGN_EPI) { if (wr == 0) PG8_BAR; }
    PG8_BAR;
    if constexpr (Epi::AFTER_DRAIN) { E.fused(acc, cur, wr, wc, fr, fq, lds, wid, lane); S.done(cur); }
#undef PG8_SA
#undef PG8_SB
#undef PG8_STAGE
#undef PG8_LDA
#undef PG8_LDB
#undef PG8_MMA
#undef PG8_WAIT_V
#undef PG8_WAIT_L
#undef PG8_BAR
#undef PG8_SCHED
}
}
#ifndef REP_LAT
#define REP_LAT 1
#endif
#ifndef REP_CTX
#define REP_CTX 1
#endif
constexpr int D = 2048, NCTX = 8192, M = 10240, MK = 10752, DEPTH = 4, NWAVES = 8;
constexpr int IN_W = 4960, IN_WP = 5120, FF = 5632;
constexpr int U_CQ = 0, U_CKV = 768, U_KR = 1280, U_GQKV = 1344, U_GZ = 1344 + 1536, U_GB = 1344 + 2048, U_GA = 1344 + 2056, U_SZ = 3408, U_SXBC = 3408 + 512, U_SDT = 3408 + 1536;
constexpr float EPS = 1e-6f;
constexpr int NPH_L = 11, NPHASES = 2 + DEPTH * NPH_L;
constexpr size_t O_YP = 0, O_YS = 16777216, O_CKV = 20971520, O_KR = 37748736, O_SG = 39845888, O_SS = 56623104;
constexpr size_t MiB = 1u << 20;
constexpr size_t WS_CTL = 0, CTL_ZERO_BYTES = 1 * MiB;
constexpr size_t WL_IN = 0, WL_UQ = WL_IN + (size_t)IN_WP * D * 2, WL_UKV = WL_UQ + (size_t)1536 * 768 * 2, WL_OUT = WL_UKV + (size_t)2048 * 512 * 2,
                 WL_GU = WL_OUT + (size_t)D * D * 2, WL_DN = WL_GU + (size_t)2 * FF * D * 2, WL_SIZE = WL_DN + (size_t)D * FF * 2;
constexpr size_t WS_W = 2 * MiB;
constexpr size_t WS_MODS = WS_W + 4 * WL_SIZE;
constexpr size_t WS_H = WS_MODS + 1 * MiB;
constexpr size_t WS_U = WS_H + (size_t)M * D * 2;
constexpr size_t WS_CQN = WS_U + (size_t)M * IN_WP * 4;
constexpr size_t WS_CKVN = WS_CQN + (size_t)M * 768 * 2;
constexpr size_t WS_QRAW = WS_CKVN + (size_t)MK * 512 * 2;
constexpr size_t WS_KN = WS_QRAW + (size_t)M * 1536 * 4;
constexpr size_t WS_VT = WS_KN + (size_t)MK * 1024 * 4;
constexpr size_t WS_QB = WS_VT + (size_t)1024 * MK * 2;
constexpr size_t WS_KB = WS_QB + (size_t)M * 1536 * 2;
constexpr size_t WS_GQ = WS_KB + (size_t)MK * 1536 * 2;
constexpr size_t WS_GBG = WS_GQ + (size_t)3 * M * 512 * 4;
constexpr size_t WS_GO = WS_GBG + (size_t)2 * M * 8 * 4;
constexpr size_t WS_XBC = WS_GO + (size_t)2 * M * 512 * 4;
constexpr size_t WS_SDT = WS_XBC + (size_t)M * 1024 * 4;
constexpr size_t WS_SY = WS_SDT + (size_t)2 * M * 16 * 4;
constexpr size_t WS_MIX = WS_SY + (size_t)2 * M * 512 * 4;
constexpr size_t WS_ACT = WS_MIX + (size_t)M * D * 2;
constexpr size_t WS_GCH = WS_ACT + (size_t)M * FF * 2;
constexpr size_t WS_SREC = WS_GCH + (size_t)1280 * 90368;
constexpr size_t WS_SSH = WS_SREC + (size_t)1280 * 66560;
constexpr size_t WS_PART = WS_SSH + (size_t)160 * 65536;
constexpr size_t WS_END = WS_PART + (size_t)4 * 2048 * 2048 * 4;
constexpr int CW_BAR = 4096;
constexpr int RING_BYTES = 131072, LDSCTL_OFF = RING_BYTES, MISC_OFF = LDSCTL_OFF + 320, LDS_BYTES = 147456;

#define GAS __attribute__((address_space(1)))
#define LAS __attribute__((address_space(3)))
typedef unsigned short bf16;
typedef unsigned v4u __attribute__((ext_vector_type(4)));
typedef unsigned v2u __attribute__((ext_vector_type(2)));
typedef float f32x4 __attribute__((ext_vector_type(4)));
typedef float f32x2 __attribute__((ext_vector_type(2)));
typedef short bf16x8 __attribute__((ext_vector_type(8)));
typedef GAS unsigned gu32;
#define RLX_AGENT __ATOMIC_RELAXED, __HIP_MEMORY_SCOPE_AGENT
#define MEMBAR() asm volatile("" ::: "memory")
#define LDS_WAIT() asm volatile("s_waitcnt lgkmcnt(0)" ::: "memory")
#define VM_WAIT() asm volatile("s_waitcnt vmcnt(0)" ::: "memory")
__device__ __forceinline__ unsigned f2bf(float f) { unsigned u = __builtin_bit_cast(unsigned, f); return (u + 0x7fffu + ((u >> 16) & 1u)) >> 16; }
__device__ __forceinline__ unsigned pk2(float lo, float hi) { return f2bf(lo) | (f2bf(hi) << 16); }
__device__ __forceinline__ float wave_sum(float v) {
#pragma unroll
    for (int o = 1; o < 64; o <<= 1) v += __shfl_xor(v, o);
    return v;
}
__device__ __forceinline__ float half_sum(float v) {
#pragma unroll
    for (int o = 1; o < 32; o <<= 1) v += __shfl_xor(v, o);
    return v;
}
__device__ __forceinline__ float silu(float x) { return x / (1.0f + expf(-x)); }
__device__ __forceinline__ float softplus(float x) { return x > 20.f ? x : log1pf(expf(x)); }

#define XB_TMO      128
#define XB_XCNT(j)  (256  + 64 * (j))
#define XB_XSUB(j)  (1280 + 64 * (j))
#define XB_XGEN(j)  (2304 + 64 * (j))
#define XB_TOP      3328
#define XB_TOPGEN   3392
#define XCD_BAR_WORDS 3456
#define XB_SPIN_CAP (1u << 18)

__device__ __forceinline__ unsigned xb_ld(unsigned* p)              { return __hip_atomic_load(p, __ATOMIC_RELAXED, __HIP_MEMORY_SCOPE_AGENT); }
__device__ __forceinline__ unsigned xb_add(unsigned* p, unsigned v) { return __hip_atomic_fetch_add(p, v, __ATOMIC_RELAXED, __HIP_MEMORY_SCOPE_AGENT); }
__device__ __forceinline__ unsigned xb_xcc_id() { return (unsigned)__builtin_amdgcn_s_getreg((3 << 11) | 20) & 0xFu; }
#define XB_SPIN(cond, bar) do { unsigned _sp = 0; while (cond) { __builtin_amdgcn_s_sleep(1); \
    if ((++_sp & 255u) == 0u) { if (xb_ld(&(bar)[XB_TMO])) break; if (_sp > XB_SPIN_CAP) { atomicAdd(&(bar)[XB_TMO], 1u); break; } } } } while (0)

struct XcdBarrier {
    unsigned* bar; unsigned x;
    volatile LAS unsigned* st;
};

__device__ __forceinline__ XcdBarrier xcd_barrier_post(unsigned* bar, volatile LAS unsigned* st) {
    XcdBarrier b; b.bar = bar; b.x = xb_xcc_id(); b.st = st;
    if (threadIdx.x == 0) (void)xb_add(&bar[XB_XCNT(b.x)], 1u);
    return b;
}
__device__ __forceinline__ void xcd_barrier_complete(unsigned* bar, unsigned x, unsigned& nloc, unsigned& nx) {
    const unsigned G = gridDim.x * gridDim.y * gridDim.z;
    unsigned sum, cnt, mine, sp = 0u;
    for (;;) {
        sum = 0u; cnt = 0u; mine = 0u;
#pragma unroll
        for (unsigned j = 0; j < 16; ++j) { const unsigned c = xb_ld(&bar[XB_XCNT(j)]); sum += c; cnt += (c > 0u) ? 1u : 0u; mine = (j == x) ? c : mine; }
        if (sum == G) break;
        __builtin_amdgcn_s_sleep(1);
        if ((++sp & 255u) == 0u) { if (xb_ld(&bar[XB_TMO])) break; if (sp > XB_SPIN_CAP) { atomicAdd(&bar[XB_TMO], 1u); break; } }
    }
    nloc = mine > 0u ? mine : 1u; nx = cnt > 0u ? cnt : 1u;
}

__device__ __forceinline__ void xcd_barrier(const XcdBarrier& b) {
    asm volatile("s_waitcnt vmcnt(0)" ::: "memory");
    __syncthreads();
    if (threadIdx.x == 0) {
        unsigned* bar = b.bar;
        __builtin_amdgcn_s_waitcnt(0);
        unsigned nloc = b.st[0], nx = b.st[1];
        if (nloc == 0u) { xcd_barrier_complete(bar, b.x, nloc, nx); b.st[0] = nloc; b.st[1] = nx; }
        const unsigned old = xb_add(&bar[XB_XSUB(b.x)], 1u);
        const unsigned gen = old / nloc;
        if (old + 1u == (gen + 1u) * nloc) {
            __builtin_amdgcn_fence(__ATOMIC_RELEASE, "agent");
            asm volatile("s_waitcnt vmcnt(0)" ::: "memory");
            const unsigned og = xb_add(&bar[XB_TOP], 1u);
            const unsigned tg = og / nx;
            if (og + 1u == (tg + 1u) * nx) xb_add(&bar[XB_TOPGEN], 1u);
            else XB_SPIN(xb_ld(&bar[XB_TOPGEN]) == tg, bar);
            __builtin_amdgcn_fence(__ATOMIC_ACQUIRE, "agent");
            xb_add(&bar[XB_XGEN(b.x)], 1u);
            asm volatile("s_waitcnt vmcnt(0)" ::: "memory");
        } else {
            XB_SPIN(xb_ld(&bar[XB_XGEN(b.x)]) == gen, bar);
            __builtin_amdgcn_fence(__ATOMIC_ACQUIRE, "agent");
            asm volatile("s_waitcnt vmcnt(0)" ::: "memory");
        }
    }
    __syncthreads();
}
struct Args { const float* in[32]; float* out; unsigned char* ws; int ph_lo, ph_hi; };
#define CAS __attribute__((address_space(4)))
typedef const float* const CAS* kin_t;
struct Ctx { kin_t in; float* out; unsigned char* ws; };

__device__ __forceinline__ void transpose_item(const float* __restrict__ W, int K, int N, bf16* WT, int k0, int n0, int drow0, LAS float* scr, int lane) {
#pragma unroll 8
    for (int i = 0; i < 32; ++i) { const int kk = 2 * i + (lane >> 5); scr[kk * 33 + (lane & 31)] = W[(size_t)(k0 + kk) * N + n0 + (lane & 31)]; }
    LDS_WAIT(); asm volatile("" ::: "memory");
    const int c = lane & 7;
#pragma unroll
    for (int j = 0; j < 4; ++j) { const int n = (lane >> 3) + 8 * j; const LAS float* s = scr + (8 * c) * 33 + n;
        v4u o; o.x = pk2(s[0 * 33], s[1 * 33]); o.y = pk2(s[2 * 33], s[3 * 33]); o.z = pk2(s[4 * 33], s[5 * 33]); o.w = pk2(s[6 * 33], s[7 * 33]);
        *(GAS v4u*)(WT + (size_t)(drow0 + n) * K + k0 + 8 * c) = o; }
    LDS_WAIT(); asm volatile("" ::: "memory");
}
constexpr size_t WLE_IN = 0, WLE_UQ = WLE_IN + (size_t)IN_WP * D, WLE_KV = WLE_UQ + (size_t)1536 * 768, WLE_OUT = WLE_KV + (size_t)2048 * 512,
                 WLE_GU = WLE_OUT + (size_t)D * D, WLE_DN = WLE_GU + (size_t)2 * FF * D, WLE_SIZE = WLE_DN + (size_t)D * FF;
static_assert(WLE_SIZE * 2 == WL_SIZE, "weight map");

__device__ __forceinline__ void ph_prologue(const Ctx& A, LAS unsigned char* lds, int tid, int lane, int wave, int vcu, int G) {
    const int gw = vcu * NWAVES + wave, NGW = G * NWAVES;
    LAS float* scr = (LAS float*)(lds + wave * 8704);
    constexpr int I_IN = 32 * 155, I_UQ = 12 * 48, I_KV = 8 * 64, I_OUT = 32 * 64, I_GU = 32 * 352, I_DN = 88 * 64, I_L = I_IN + I_UQ + I_KV + I_OUT + I_GU + I_DN;
    for (int it = gw; it < DEPTH * I_L; it += NGW) {
        const int l = it / I_L; int r = it - l * I_L;
        bf16* wl = (bf16*)(A.ws + WS_W) + (size_t)l * WLE_SIZE;
        if (r < I_IN) { const int kb = r / 155, nb = r - kb * 155; transpose_item(A.in[12] + (size_t)l * D * IN_W, D, IN_W, wl + WLE_IN, 64 * kb, 32 * nb, 32 * nb, scr, lane); continue; } r -= I_IN;
        if (r < I_UQ) { const int kb = r / 48, nb = r - kb * 48; transpose_item(A.in[15] + (size_t)l * 768 * 1536, 768, 1536, wl + WLE_UQ, 64 * kb, 32 * nb, 32 * nb, scr, lane); continue; } r -= I_UQ;
        if (r < I_KV) { const int kb = r / 64, nb = r - kb * 64; const int n0 = 32 * nb, hh = n0 >> 8, c = n0 & 255; const int dr = (c < 128 ? 0 : 1024) + hh * 128 + (c & 127);
                        transpose_item(A.in[17] + (size_t)l * 512 * 2048, 512, 2048, wl + WLE_KV, 64 * kb, n0, dr, scr, lane); continue; } r -= I_KV;
        if (r < I_OUT) { const int kb = r / 64, nb = r - kb * 64; transpose_item(A.in[13] + (size_t)l * D * D, D, D, wl + WLE_OUT, 64 * kb, 32 * nb, 32 * nb, scr, lane); continue; } r -= I_OUT;
        if (r < I_GU) { const int kb = r / 352, nb = r - kb * 352; const int n0 = 32 * nb; int dr; if (n0 < FF) dr = (n0 >> 7) * 256 + (n0 & 127); else { const int n1 = n0 - FF; dr = (n1 >> 7) * 256 + 128 + (n1 & 127); }
                        transpose_item(A.in[30] + (size_t)l * D * 2 * FF, D, 2 * FF, wl + WLE_GU, 64 * kb, n0, dr, scr, lane); continue; } r -= I_GU;
        { const int kb = r / 64, nb = r - kb * 64; transpose_item(A.in[31] + (size_t)l * FF * D, FF, D, wl + WLE_DN, 64 * kb, 32 * nb, 32 * nb, scr, lane); }
    }
    { const int gt = vcu * 512 + tid, NGT = G * 512;
      for (int i = gt; i < DEPTH * 40960; i += NGT) { const int l = i / 40960, r = i - l * 40960; *(GAS v4u*)((bf16*)(A.ws + WS_W) + (size_t)l * WLE_SIZE + WLE_IN + (size_t)IN_W * D + (size_t)r * 8) = (v4u){0u, 0u, 0u, 0u}; }
      const f32x4* xp = (const f32x4*)A.in[0]; const f32x4* xs = (const f32x4*)A.in[1]; f32x4* o = (f32x4*)A.out;
      for (int i = gt; i < 4194304; i += NGT) o[i] = xp[i];
      for (int i = gt; i < 1048576; i += NGT) o[4194304 + i] = xs[i]; }
    LAS float* scond = (LAS float*)(lds + 81920);
    LAS float* red = (LAS float*)(lds + 81920 + 24576);
    for (int i = tid; i < 3 * 2048; i += 512) { const int r = i >> 11, k = i & 2047; const float c = r == 0 ? A.in[7][k] : A.in[6][(r - 1) * 2048 + k]; scond[i] = silu(c); }
    __syncthreads();
    float* mods = (float*)(A.ws + WS_MODS);
    for (int item = vcu; item < 384; item += G) {
        const int l = item / 96, j0 = (item - l * 96) * 128;
        const float* w = A.in[10] + (size_t)l * 2048 * 12288 + j0 + 2 * lane;
        float a0x = 0, a0y = 0, a1x = 0, a1y = 0, a2x = 0, a2y = 0;
        const int kbeg = wave * 256;
#pragma unroll 8
        for (int k = kbeg; k < kbeg + 256; ++k) { const f32x2 v = *(const f32x2*)(w + (size_t)k * 12288); const float c0 = scond[k], c1 = scond[2048 + k], c2 = scond[4096 + k];
            a0x += c0 * v.x; a0y += c0 * v.y; a1x += c1 * v.x; a1y += c1 * v.y; a2x += c2 * v.x; a2y += c2 * v.y; }
        red[(wave * 3 + 0) * 128 + 2 * lane] = a0x; red[(wave * 3 + 0) * 128 + 2 * lane + 1] = a0y;
        red[(wave * 3 + 1) * 128 + 2 * lane] = a1x; red[(wave * 3 + 1) * 128 + 2 * lane + 1] = a1y;
        red[(wave * 3 + 2) * 128 + 2 * lane] = a2x; red[(wave * 3 + 2) * 128 + 2 * lane + 1] = a2y;
        __syncthreads();
        if (tid < 384) { const int r = tid >> 7, j = tid & 127; float s = 0.f;
#pragma unroll
            for (int w8 = 0; w8 < 8; ++w8) s += red[(w8 * 3 + r) * 128 + j];
            mods[(size_t)(l * 3 + r) * 12288 + j0 + j] = s + A.in[11][(size_t)l * 12288 + j0 + j]; }
        __syncthreads();
    }
}

__device__ __forceinline__ void ph_norm(float* X_, const float* g_, const float* mods_l_, int shift_idx, bf16* H_, const float* part_, const float* pgate_, int lane, int gw, int NGW) {
    GAS float* X = (GAS float*)X_; const GAS float* g = (const GAS float*)g_; const GAS float* mods_l = (const GAS float*)mods_l_; GAS bf16* H = (GAS bf16*)H_;
    const GAS float* part = (const GAS float*)part_; const GAS float* pgate = (const GAS float*)pgate_;
    constexpr size_t PS = (size_t)2048 * 2048;
    for (int m = gw; m < M; m += NGW) {
        const int cr = m < NCTX ? 0 : 1 + ((m - NCTX) >> 10);
        GAS f32x4* xr = (GAS f32x4*)(X + (size_t)m * D) + lane;
        f32x4 v[8]; float ss = 0.f;
#pragma unroll
        for (int j = 0; j < 8; ++j) v[j] = xr[64 * j];
        if (part_ != nullptr && m >= NCTX) {
            const GAS f32x4* pp = (const GAS f32x4*)(part + (size_t)(m - NCTX) * 2048) + lane; const GAS f32x4* gp = (const GAS f32x4*)(pgate + (size_t)cr * 12288) + lane;
#pragma unroll
            for (int j = 0; j < 8; ++j) { const f32x4 p = (pp[64 * j] + pp[PS / 4 + 64 * j]) + (pp[2 * (PS / 4) + 64 * j] + pp[3 * (PS / 4) + 64 * j]); v[j] = v[j] + gp[64 * j] * p; xr[64 * j] = v[j]; } }
#pragma unroll
        for (int j = 0; j < 8; ++j) ss += (v[j].x * v[j].x + v[j].y * v[j].y) + (v[j].z * v[j].z + v[j].w * v[j].w);
        const float rstd = 1.0f / sqrtf(wave_sum(ss) * (1.0f / D) + EPS);
        const GAS float* sh = mods_l + (size_t)cr * 12288 + shift_idx * 2048; const GAS float* sc = sh + 2048;
#pragma unroll
        for (int j = 0; j < 8; ++j) { const int c = 4 * lane + 256 * j; const f32x4 g4 = *(const GAS f32x4*)(g + c), s4 = *(const GAS f32x4*)(sc + c), h4 = *(const GAS f32x4*)(sh + c);
            const f32x4 o = v[j] * rstd * g4 * (s4 + 1.0f) + h4; v2u w; w.x = pk2(o.x, o.y); w.y = pk2(o.z, o.w); *(GAS v2u*)(H + (size_t)m * D + c) = w; }
    }
}
__device__ __forceinline__ void ph_final(float* X_, const float* part_, const float* pgate_, int lane, int gw, int NGW) {
    GAS float* X = (GAS float*)X_; const GAS float* part = (const GAS float*)part_; const GAS float* pgate = (const GAS float*)pgate_;
    constexpr size_t PS = (size_t)2048 * 2048;
    for (int m = NCTX + gw; m < M; m += NGW) {
        const int cr = 1 + ((m - NCTX) >> 10);
        GAS f32x4* xr = (GAS f32x4*)(X + (size_t)m * D) + lane;
        const GAS f32x4* pp = (const GAS f32x4*)(part + (size_t)(m - NCTX) * 2048) + lane; const GAS f32x4* gp = (const GAS f32x4*)(pgate + (size_t)cr * 12288) + lane;
#pragma unroll
        for (int j = 0; j < 8; ++j) { const f32x4 p = (pp[64 * j] + pp[PS / 4 + 64 * j]) + (pp[2 * (PS / 4) + 64 * j] + pp[3 * (PS / 4) + 64 * j]); xr[64 * j] = xr[64 * j] + gp[64 * j] * p; }
    }
}

__device__ __forceinline__ void ph_prep(const Ctx& A, int l, int lane, int gw, int NGW) {
    const float* U = (const float*)(A.ws + WS_U);
    bf16* CQN = (bf16*)(A.ws + WS_CQN); bf16* CKVN = (bf16*)(A.ws + WS_CKVN);
    float* GQ = (float*)(A.ws + WS_GQ); float* GK = GQ + (size_t)M * 512; float* GV = GK + (size_t)M * 512;
    float* GBETA = (float*)(A.ws + WS_GBG); float* GG = GBETA + (size_t)M * 8;
    float* XBC = (float*)(A.ws + WS_XBC); float* SDT = (float*)(A.ws + WS_SDT); float* SDA = SDT + (size_t)M * 16;
    const float* qn_g = A.in[14] + l * 768; const float* kvn_g = A.in[16] + l * 512;
    const float* gconv = A.in[20] + (size_t)l * 5 * 1536; const float* sconv = A.in[24] + (size_t)l * 5 * 1024; const float* sconvb = A.in[25] + l * 1024;
    for (int m = gw; m < MK; m += NGW) {
        if (m >= M) {
            const int j = m - M, b = j >> 8, t = j & 255; const float* src = A.in[2] + ((size_t)(b * 4 + l) * 256 + t) * 512;
#pragma unroll
            for (int i = 0; i < 2; ++i) { const int c = 4 * lane + 256 * i; const f32x4 v = *(const f32x4*)(src + c); v2u w; w.x = pk2(v.x, v.y); w.y = pk2(v.z, v.w); *(GAS v2u*)(CKVN + (size_t)m * 512 + c) = w; }
            continue;
        }
        const bool ctx = m < NCTX; const int t = ctx ? (m & 255) : ((m - NCTX) & 1023), T = ctx ? 256 : 1024;
        const float* u = U + (size_t)m * IN_WP;
        { f32x4 v[3]; float ss = 0.f;
#pragma unroll
          for (int i = 0; i < 3; ++i) { v[i] = *(const f32x4*)(u + U_CQ + 4 * lane + 256 * i); ss += (v[i].x * v[i].x + v[i].y * v[i].y) + (v[i].z * v[i].z + v[i].w * v[i].w); }
          const float rstd = 1.0f / sqrtf(wave_sum(ss) * (1.0f / 768.f) + EPS);
#pragma unroll
          for (int i = 0; i < 3; ++i) { const int c = 4 * lane + 256 * i; const f32x4 o = v[i] * rstd * *(const f32x4*)(qn_g + c); v2u w; w.x = pk2(o.x, o.y); w.y = pk2(o.z, o.w); *(GAS v2u*)(CQN + (size_t)m * 768 + c) = w; } }
        { f32x4 v[2]; float ss = 0.f;
#pragma unroll
          for (int i = 0; i < 2; ++i) { v[i] = *(const f32x4*)(u + U_CKV + 4 * lane + 256 * i); ss += (v[i].x * v[i].x + v[i].y * v[i].y) + (v[i].z * v[i].z + v[i].w * v[i].w); }
          const float rstd = 1.0f / sqrtf(wave_sum(ss) * (1.0f / 512.f) + EPS);
          const int b = m >> 8;
#pragma unroll
          for (int i = 0; i < 2; ++i) { const int c = 4 * lane + 256 * i; const f32x4 o = v[i] * rstd * *(const f32x4*)(kvn_g + c); v2u w; w.x = pk2(o.x, o.y); w.y = pk2(o.z, o.w); *(GAS v2u*)(CKVN + (size_t)m * 512 + c) = w;
              if (ctx) *(f32x4*)(A.out + O_CKV + ((size_t)(b * 4 + l) * 256 + t) * 512 + c) = o; }
          if (ctx) A.out[O_KR + ((size_t)(b * 4 + l) * 256 + t) * 64 + lane] = u[U_KR + lane]; }
        {
#pragma unroll
          for (int i = 0; i < 6; ++i) { const int c = 4 * lane + 256 * i; f32x4 acc = (f32x4){0.f, 0.f, 0.f, 0.f};
#pragma unroll
              for (int j = 0; j < 5; ++j) { const int tt = t + j - 2; if (tt >= 0 && tt < T) acc += *(const f32x4*)(gconv + j * 1536 + c) * *(const f32x4*)(u + (ptrdiff_t)(j - 2) * IN_WP + U_GQKV + c); }
              acc.x = silu(acc.x); acc.y = silu(acc.y); acc.z = silu(acc.z); acc.w = silu(acc.w);
              if (i < 4) { const float ss = half_sum((acc.x * acc.x + acc.y * acc.y) + (acc.z * acc.z + acc.w * acc.w)); acc = acc * (1.0f / sqrtf(ss + EPS)); }
              float* dst = i < 2 ? GQ + (size_t)m * 512 + c : (i < 4 ? GK + (size_t)m * 512 + (c - 512) : GV + (size_t)m * 512 + (c - 1024));
              *(f32x4*)dst = acc; }
          if (lane < 8) { const float bi = u[U_GB + lane], ai = u[U_GA + lane]; GBETA[(size_t)m * 8 + lane] = 1.0f / (1.0f + expf(-bi));
              GG[(size_t)m * 8 + lane] = -expf(A.in[21][l * 8 + lane]) * softplus(ai + A.in[22][l * 8 + lane]); } }
        {
#pragma unroll
          for (int i = 0; i < 4; ++i) { const int c = 4 * lane + 256 * i; f32x4 acc = *(const f32x4*)(sconvb + c);
#pragma unroll
              for (int j = 0; j < 5; ++j) { const int tt = t + j - 2; if (tt >= 0 && tt < T) acc += *(const f32x4*)(sconv + j * 1024 + c) * *(const f32x4*)(u + (ptrdiff_t)(j - 2) * IN_WP + U_SXBC + c); }
              acc.x = silu(acc.x); acc.y = silu(acc.y); acc.z = silu(acc.z); acc.w = silu(acc.w);
              *(f32x4*)(XBC + (size_t)m * 1024 + c) = acc; }
          if (lane < 16) { const float dt = softplus(u[U_SDT + lane] + A.in[27][l * 16 + lane]); SDT[(size_t)m * 16 + lane] = dt; SDA[(size_t)m * 16 + lane] = -expf(A.in[26][l * 16 + lane]) * dt; } }
    }
}

__device__ __forceinline__ void ph_finalize(const Ctx& A, int l, int lane, int gw, int NGW) {
    const float* U = (const float*)(A.ws + WS_U); const float* QRAW = (const float*)(A.ws + WS_QRAW); const float* KN = (const float*)(A.ws + WS_KN);
    bf16* QB = (bf16*)(A.ws + WS_QB); bf16* KB = (bf16*)(A.ws + WS_KB);
    const float* q_g = A.in[18] + l * 192; const float* k_g = A.in[19] + l * 192;
    const float QS = 0.07216878364870322f * 1.4426950408889634f;
    const float inv_f = powf(10000.f, -(float)(lane & 15) * (1.0f / 16.f));
    const float qg0 = q_g[lane], qg1 = q_g[64 + lane], qg2 = q_g[128 + lane], kg0 = k_g[lane], kg1 = k_g[64 + lane], kg2 = k_g[128 + lane];
    for (int m = gw; m < MK; m += NGW) {
        const bool fresh = m < M, latent = fresh && m >= NCTX;
        float cs = 1.f, sn = 0.f;
        if (latent) { const int t = (m - NCTX) & 1023; const float pos = (float)((lane >> 5) ? (t & 63) : (t >> 6)); const float ang = pos * inv_f; cs = cosf(ang); sn = sinf(ang); }
        const bool hi = (lane >> 4) & 1;
        const float* krp = fresh ? U + (size_t)m * IN_WP + U_KR : A.in[3] + ((size_t)(((m - M) >> 8) * 4 + l) * 256 + ((m - M) & 255)) * 64;
        const float kr_raw = krp[lane];
        for (int h = 0; h < 8; ++h) {
            if (fresh) { const float* q = QRAW + (size_t)m * 1536 + h * 192; float x0 = q[lane], x1 = q[64 + lane], x2 = q[128 + lane];
                const float rstd = 1.0f / sqrtf(wave_sum(x0 * x0 + x1 * x1 + x2 * x2) * (1.0f / 192.f) + EPS);
                x0 *= rstd * qg0; x1 *= rstd * qg1; x2 *= rstd * qg2;
                if (latent) { const float p = __shfl_xor(x2, 16); x2 = hi ? x2 * cs + p * sn : x2 * cs - p * sn; }
                bf16* dst = QB + ((size_t)m * 8 + h) * 192; dst[lane] = (bf16)f2bf(x0 * QS); dst[64 + lane] = (bf16)f2bf(x1 * QS); dst[128 + lane] = (bf16)f2bf(x2 * QS); }
            { const float* kn = KN + (size_t)m * 1024 + h * 128; float x0 = kn[lane], x1 = kn[64 + lane], x2 = kr_raw;
                const float rstd = 1.0f / sqrtf(wave_sum(x0 * x0 + x1 * x1 + x2 * x2) * (1.0f / 192.f) + EPS);
                x0 *= rstd * kg0; x1 *= rstd * kg1; x2 *= rstd * kg2;
                if (latent) { const float p = __shfl_xor(x2, 16); x2 = hi ? x2 * cs + p * sn : x2 * cs - p * sn; }
                bf16* dst = KB + ((size_t)m * 8 + h) * 192; dst[lane] = (bf16)f2bf(x0); dst[64 + lane] = (bf16)f2bf(x1); dst[128 + lane] = (bf16)f2bf(x2); }
        }
    }
}

__device__ __forceinline__ void attn_item(const bf16* QB_, const bf16* KB_, const bf16* VT_, bf16* MIX_, int qrow0, int h, int mkA, int nA, int mkB, int nB, LAS unsigned char* plds, int lane) {
    const GAS bf16* QB = (const GAS bf16*)QB_; const GAS bf16* KB = (const GAS bf16*)KB_; const GAS bf16* VT = (const GAS bf16*)VT_; GAS bf16* MIX = (GAS bf16*)MIX_;
    const int fr = lane & 15, fq = lane >> 4;
    bf16x8 qf[6];
#pragma unroll
    for (int d = 0; d < 6; ++d) qf[d] = *(const GAS bf16x8*)(QB + ((size_t)(qrow0 + fr) * 8 + h) * 192 + d * 32 + fq * 8);
    f32x4 o[8];
#pragma unroll
    for (int i = 0; i < 8; ++i) o[i] = (f32x4){0.f, 0.f, 0.f, 0.f};
    float mrow[4] = {-1e30f, -1e30f, -1e30f, -1e30f}, lrow[4] = {0.f, 0.f, 0.f, 0.f};
    const int ntA = nA >> 5, nt = (nA + nB) >> 5;
    bf16x8 kf[12];
    { const GAS bf16* kp0 = KB + ((size_t)(mkA + fr) * 8 + h) * 192 + fq * 8;
#pragma unroll
      for (int d = 0; d < 6; ++d) { kf[d] = *(const GAS bf16x8*)(kp0 + d * 32); kf[6 + d] = *(const GAS bf16x8*)(kp0 + (size_t)16 * 8 * 192 + d * 32); } }
    MEMBAR();
#pragma unroll 1
    for (int ti = 0; ti < nt; ++ti) {
        const int mk = (ti < ntA) ? mkA + ti * 32 : mkB + (ti - ntA) * 32;
        f32x4 s0 = (f32x4){0.f, 0.f, 0.f, 0.f}, s1 = s0;
#pragma unroll
        for (int d = 0; d < 6; ++d) { s0 = __builtin_amdgcn_mfma_f32_16x16x32_bf16(qf[d], kf[d], s0, 0, 0, 0); s1 = __builtin_amdgcn_mfma_f32_16x16x32_bf16(qf[d], kf[6 + d], s1, 0, 0, 0); }
        bf16x8 vf[8];
#pragma unroll
        for (int i = 0; i < 8; ++i) vf[i] = *(const GAS bf16x8*)(VT + (size_t)(h * 128 + i * 16 + fr) * MK + mk + fq * 8);
        if (ti + 1 < nt) { const int mkn = (ti + 1 < ntA) ? mkA + (ti + 1) * 32 : mkB + (ti + 1 - ntA) * 32; const GAS bf16* kp0 = KB + ((size_t)(mkn + fr) * 8 + h) * 192 + fq * 8;
#pragma unroll
            for (int d = 0; d < 6; ++d) { kf[d] = *(const GAS bf16x8*)(kp0 + d * 32); kf[6 + d] = *(const GAS bf16x8*)(kp0 + (size_t)16 * 8 * 192 + d * 32); } }
        MEMBAR();
        float al[4];
#pragma unroll
        for (int r = 0; r < 4; ++r) { float v = fmaxf(s0[r], s1[r]);
            v = fmaxf(v, __shfl_xor(v, 1)); v = fmaxf(v, __shfl_xor(v, 2)); v = fmaxf(v, __shfl_xor(v, 4)); v = fmaxf(v, __shfl_xor(v, 8));
            const float mnew = fmaxf(mrow[r], v); al[r] = exp2f(mrow[r] - mnew); mrow[r] = mnew;
            s0[r] = exp2f(s0[r] - mnew); s1[r] = exp2f(s1[r] - mnew); lrow[r] = lrow[r] * al[r] + s0[r] + s1[r]; }
#pragma unroll
        for (int i = 0; i < 8; ++i) { o[i][0] *= al[0]; o[i][1] *= al[1]; o[i][2] *= al[2]; o[i][3] *= al[3]; }
#pragma unroll
        for (int r = 0; r < 4; ++r) { *(LAS bf16*)(plds + (4 * fq + r) * 64 + fr * 2) = (bf16)f2bf(s0[r]); *(LAS bf16*)(plds + (4 * fq + r) * 64 + 32 + fr * 2) = (bf16)f2bf(s1[r]); }
        asm volatile("s_waitcnt lgkmcnt(0)" ::: "memory");
        const bf16x8 pf = *(const LAS bf16x8*)(plds + fr * 64 + fq * 16);
        asm volatile("s_waitcnt lgkmcnt(0)" ::: "memory");
#pragma unroll
        for (int i = 0; i < 8; ++i) o[i] = __builtin_amdgcn_mfma_f32_16x16x32_bf16(pf, vf[i], o[i], 0, 0, 0);
    }
#pragma unroll
    for (int r = 0; r < 4; ++r) { float lt = lrow[r]; lt += __shfl_xor(lt, 1); lt += __shfl_xor(lt, 2); lt += __shfl_xor(lt, 4); lt += __shfl_xor(lt, 8);
        const float inv = 1.0f / lt; GAS bf16* dst = MIX + (size_t)(qrow0 + 4 * fq + r) * D + h * 128 + fr;
#pragma unroll
        for (int i = 0; i < 8; ++i) dst[i * 16] = (bf16)f2bf(o[i][r] * inv); }
}
constexpr int AT_KROW = 400, AT_KBYTES = 32 * AT_KROW, AT_VBYTES = 128 * 64, AT_BUF = AT_KBYTES + AT_VBYTES;
__device__ __forceinline__ void attn_wg_item(const bf16* QB_, const bf16* KB_, const bf16* VT_, bf16* MIX_, int qrow0, int h, int mkA, int nA, int mkB, int nB, LAS unsigned char* lds, int tid, int lane, int wave) {
    const GAS bf16* QB = (const GAS bf16*)QB_; const GAS bf16* KB = (const GAS bf16*)KB_; const GAS bf16* VT = (const GAS bf16*)VT_; GAS bf16* MIX = (GAS bf16*)MIX_;
    const int fr = lane & 15, fq = lane >> 4;
    LAS unsigned char* plds = lds + 2 * AT_BUF + wave * 1024;
    const int qr = qrow0 + wave * 16;
    bf16x8 qf[6];
#pragma unroll
    for (int d = 0; d < 6; ++d) qf[d] = *(const GAS bf16x8*)(QB + ((size_t)(qr + fr) * 8 + h) * 192 + d * 32 + fq * 8);
    f32x4 o[8];
#pragma unroll
    for (int i = 0; i < 8; ++i) o[i] = (f32x4){0.f, 0.f, 0.f, 0.f};
    float mrow[4] = {-1e30f, -1e30f, -1e30f, -1e30f}, lrow[4] = {0.f, 0.f, 0.f, 0.f};
    const int ntA = nA >> 5, nt = (nA + nB) >> 5;
    const int kr0 = tid / 24, kc0 = tid % 24, kr1 = (512 + tid) / 24, kc1 = (512 + tid) % 24, vr = tid >> 2, vc = tid & 3;
    v4u sk0, sk1, sv;
#define AT_LOAD(mk_) do { sk0 = *(const GAS v4u*)(KB + ((size_t)((mk_) + kr0) * 8 + h) * 192 + kc0 * 8); \
        if (tid < 256) sk1 = *(const GAS v4u*)(KB + ((size_t)((mk_) + kr1) * 8 + h) * 192 + kc1 * 8); \
        sv = *(const GAS v4u*)(VT + (size_t)(h * 128 + vr) * MK + (mk_) + vc * 8); } while (0)
#define AT_STORE(buf_) do { LAS unsigned char* bb_ = lds + (buf_) * AT_BUF; *(LAS v4u*)(bb_ + kr0 * AT_KROW + kc0 * 16) = sk0; \
        if (tid < 256) *(LAS v4u*)(bb_ + kr1 * AT_KROW + kc1 * 16) = sk1; \
        *(LAS v4u*)(bb_ + AT_KBYTES + vr * 64 + vc * 16) = sv; } while (0)
    __syncthreads();
    AT_LOAD(mkA); AT_STORE(0);
    __syncthreads();
#pragma unroll 1
    for (int ti = 0; ti < nt; ++ti) {
        const int cur = ti & 1;
        if (ti + 1 < nt) { const int mkn = (ti + 1 < ntA) ? mkA + (ti + 1) * 32 : mkB + (ti + 1 - ntA) * 32; AT_LOAD(mkn); }
        MEMBAR();
        const LAS unsigned char* kb_ = lds + cur * AT_BUF; const LAS unsigned char* vb_ = kb_ + AT_KBYTES;
        f32x4 s0 = (f32x4){0.f, 0.f, 0.f, 0.f}, s1 = s0;
#pragma unroll
        for (int d = 0; d < 6; ++d) { const bf16x8 k0 = *(const LAS bf16x8*)(kb_ + fr * AT_KROW + d * 64 + fq * 16), k1 = *(const LAS bf16x8*)(kb_ + (16 + fr) * AT_KROW + d * 64 + fq * 16);
            s0 = __builtin_amdgcn_mfma_f32_16x16x32_bf16(qf[d], k0, s0, 0, 0, 0); s1 = __builtin_amdgcn_mfma_f32_16x16x32_bf16(qf[d], k1, s1, 0, 0, 0); }
        float al[4];
#pragma unroll
        for (int r = 0; r < 4; ++r) { float v = fmaxf(s0[r], s1[r]);
            v = fmaxf(v, __shfl_xor(v, 1)); v = fmaxf(v, __shfl_xor(v, 2)); v = fmaxf(v, __shfl_xor(v, 4)); v = fmaxf(v, __shfl_xor(v, 8));
            const float mnew = fmaxf(mrow[r], v); al[r] = exp2f(mrow[r] - mnew); mrow[r] = mnew;
            s0[r] = exp2f(s0[r] - mnew); s1[r] = exp2f(s1[r] - mnew); lrow[r] = lrow[r] * al[r] + s0[r] + s1[r]; }
#pragma unroll
        for (int i = 0; i < 8; ++i) { o[i][0] *= al[0]; o[i][1] *= al[1]; o[i][2] *= al[2]; o[i][3] *= al[3]; }
#pragma unroll
        for (int r = 0; r < 4; ++r) { *(LAS bf16*)(plds + (4 * fq + r) * 64 + fr * 2) = (bf16)f2bf(s0[r]); *(LAS bf16*)(plds + (4 * fq + r) * 64 + 32 + fr * 2) = (bf16)f2bf(s1[r]); }
        asm volatile("s_waitcnt lgkmcnt(0)" ::: "memory");
        const bf16x8 pf = *(const LAS bf16x8*)(plds + fr * 64 + fq * 16);
#pragma unroll
        for (int i = 0; i < 8; ++i) { const bf16x8 vf = *(const LAS bf16x8*)(vb_ + (i * 16 + fr) * 64 + fq * 16); o[i] = __builtin_amdgcn_mfma_f32_16x16x32_bf16(pf, vf, o[i], 0, 0, 0); }
        if (ti + 1 < nt) AT_STORE(cur ^ 1);
        __syncthreads();
    }
#undef AT_LOAD
#undef AT_STORE
#pragma unroll
    for (int r = 0; r < 4; ++r) { float lt = lrow[r]; lt += __shfl_xor(lt, 1); lt += __shfl_xor(lt, 2); lt += __shfl_xor(lt, 4); lt += __shfl_xor(lt, 8);
        const float inv = 1.0f / lt; GAS bf16* dst = MIX + (size_t)(qr + 4 * fq + r) * D + h * 128 + fr;
#pragma unroll
        for (int i = 0; i < 8; ++i) dst[i * 16] = (bf16)f2bf(o[i][r] * inv); }
}
__device__ __forceinline__ void ph_attn(const Ctx& A, LAS unsigned char* lds, int tid, int lane, int wave, int vcu, int G) {
    const bf16* QB = (const bf16*)(A.ws + WS_QB); const bf16* KB = (const bf16*)(A.ws + WS_KB); const bf16* VT = (const bf16*)(A.ws + WS_VT); bf16* MIX = (bf16*)(A.ws + WS_MIX);
    for (int slot = vcu; slot < 256; slot += G) {
        if (slot < 128) { const int b = slot >> 6, h = (slot >> 3) & 7, qb = slot & 7;
            attn_wg_item(QB, KB, VT, MIX, NCTX + b * 1024 + qb * 128, h, M + b * 256, 256, NCTX + b * 1024, 1024, lds, tid, lane, wave); }
        else { for (int i = 0; i < 4; ++i) { const int wgi = (slot - 128) * 4 + i, b = wgi >> 4, h = (wgi >> 1) & 7, qb = wgi & 1;
                attn_wg_item(QB, KB, VT, MIX, b * 256 + qb * 128, h, b * 256, 256, 0, 0, lds, tid, lane, wave); } }
    }
}

__device__ __forceinline__ void ph_gdn_scan(const Ctx& A, int l, LAS unsigned char* lds, int tid, int vcu, int G) {
    const float* GQ = (const float*)(A.ws + WS_GQ); const float* GK = GQ + (size_t)M * 512; const float* GV = GK + (size_t)M * 512;
    const float* GBETA = (const float*)(A.ws + WS_GBG); const float* GG = GBETA + (size_t)M * 8; float* GO = (float*)(A.ws + WS_GO);
    const int grp = tid >> 7, j = tid & 127;
    const int item = grp * G + vcu;
    const bool active = item < 272;
    int T = 0, row0 = 0, h = 0, dir = 0, b = 0; bool lat = false;
    if (active) { if (item < 256) { b = item >> 3; h = (item >> 1) & 3; dir = item & 1; T = 256; row0 = b * 256; }
                  else { const int q = item - 256; b = q >> 3; h = (q >> 1) & 3; dir = q & 1; T = 1024; row0 = NCTX + b * 1024; lat = true; } }
    int Tmax = 0;
    for (int p = 0; p < 4; ++p) { const int it = p * G + vcu; if (it < 272) { const int tt = it < 256 ? 256 : 1024; Tmax = tt > Tmax ? tt : Tmax; } }
    float S[128];
    if (lat) { const float* s0 = A.in[4] + ((size_t)(((b * 4 + l) * 2 + dir) * 4 + h) * 128) * 128 + j;
#pragma unroll
        for (int i = 0; i < 128; ++i) S[i] = s0[(size_t)i * 128]; }
    else {
#pragma unroll
        for (int i = 0; i < 128; ++i) S[i] = 0.f; }
    LAS float* sk = (LAS float*)(lds + grp * 24832); LAS float* sq = sk + 2048; LAS float* sv = sk + 4096; LAS float* sg = sk + 6144; LAS float* sb = sk + 6160;
    for (int t0 = 0; t0 < Tmax; t0 += 16) {
        const bool on = active && t0 < T;
        if (on) {
#pragma unroll 4
            for (int s = 0; s < 16; ++s) { const int tok = dir ? T - 1 - (t0 + s) : t0 + s; const size_t mo = (size_t)(row0 + tok) * 512 + h * 128 + j;
                sk[s * 128 + j] = GK[mo]; sq[s * 128 + j] = GQ[mo]; sv[s * 128 + j] = GV[mo]; }
            if (j < 16) { const int tok = dir ? T - 1 - (t0 + j) : t0 + j; const size_t mo = (size_t)(row0 + tok) * 8 + dir * 4 + h; sg[j] = GG[mo]; sb[j] = GBETA[mo]; }
        }
        __syncthreads();
        if (on) {
#pragma unroll 1
            for (int s = 0; s < 16; ++s) {
                const float dec = expf(sg[s]);
                float kS = 0.f;
#pragma unroll
                for (int i = 0; i < 128; i += 4) { const f32x4 k4 = *(const LAS f32x4*)(sk + s * 128 + i); kS += k4.x * S[i] + k4.y * S[i + 1] + k4.z * S[i + 2] + k4.w * S[i + 3];
                    if ((i & 15) == 12) asm volatile("" ::: "memory"); }
                const float vn = sb[s] * (sv[s * 128 + j] - dec * kS);
                float o = 0.f;
#pragma unroll
                for (int i = 0; i < 128; i += 4) { const f32x4 k4 = *(const LAS f32x4*)(sk + s * 128 + i); const f32x4 q4 = *(const LAS f32x4*)(sq + s * 128 + i);
                    S[i] = dec * S[i] + k4.x * vn; S[i + 1] = dec * S[i + 1] + k4.y * vn; S[i + 2] = dec * S[i + 2] + k4.z * vn; S[i + 3] = dec * S[i + 3] + k4.w * vn;
                    o += q4.x * S[i] + q4.y * S[i + 1] + q4.z * S[i + 2] + q4.w * S[i + 3];
                    if ((i & 15) == 12) asm volatile("" ::: "memory"); }
                const int tok = dir ? T - 1 - (t0 + s) : t0 + s;
                GO[((size_t)dir * M + row0 + tok) * 512 + h * 128 + j] = o * 0.08838834764831845f;
            }
        }
        __syncthreads();
    }
    if (active && !lat) { float* dst = A.out + O_SG + ((size_t)(((b * 4 + l) * 2 + dir) * 4 + h) * 128) * 128 + j;
#pragma unroll
        for (int i = 0; i < 128; ++i) dst[(size_t)i * 128] = S[i]; }
}

__device__ __forceinline__ void ph_ssd_scan(const Ctx& A, int l, LAS unsigned char* lds, int lane, int wave, int vcu, int G) {
    const float* XBC = (const float*)(A.ws + WS_XBC); const float* SDT = (const float*)(A.ws + WS_SDT); const float* SDA = SDT + (size_t)M * 16; float* SY = (float*)(A.ws + WS_SY);
    int b, h, dir, T, row0; bool lat = false;
    if (wave < 2) { const int item = wave * G + vcu; if (item >= 512) return; b = item >> 4; h = (item >> 1) & 7; dir = item & 1; T = 256; row0 = b * 256; }
    else if (wave == 2) { const int q = vcu - 16; if (q < 0 || q >= 32) return; b = q >> 4; h = (q >> 1) & 7; dir = q & 1; T = 1024; row0 = NCTX + b * 1024; lat = true; }
    else return;
    float S[128];
    if (lat) { const float* s0 = A.in[5] + ((size_t)(((b * 4 + l) * 2 + dir) * 8 + h) * 64 + lane) * 128;
#pragma unroll
        for (int n = 0; n < 128; n += 4) { const f32x4 v = *(const f32x4*)(s0 + n); S[n] = v.x; S[n + 1] = v.y; S[n + 2] = v.z; S[n + 3] = v.w; } }
    else {
#pragma unroll
        for (int n = 0; n < 128; ++n) S[n] = 0.f; }
    LAS float* sB = (LAS float*)(lds + wave * 10496); LAS float* sC = sB + 1024; LAS float* sx = sB + 2048; LAS float* sdt = sB + 2560; LAS float* sda = sB + 2568;
    const int g = h >> 2;
    for (int t0 = 0; t0 < T; t0 += 8) {
#pragma unroll 4
        for (int s = 0; s < 8; ++s) { const int tok = dir ? T - 1 - (t0 + s) : t0 + s; const float* xr = XBC + (size_t)(row0 + tok) * 1024;
            sB[s * 128 + lane] = xr[512 + g * 128 + lane]; sB[s * 128 + 64 + lane] = xr[512 + g * 128 + 64 + lane];
            sC[s * 128 + lane] = xr[768 + g * 128 + lane]; sC[s * 128 + 64 + lane] = xr[768 + g * 128 + 64 + lane];
            sx[s * 64 + lane] = xr[h * 64 + lane]; }
        if (lane < 8) { const int tok = dir ? T - 1 - (t0 + lane) : t0 + lane; const size_t mo = (size_t)(row0 + tok) * 16 + dir * 8 + h; sdt[lane] = SDT[mo]; sda[lane] = SDA[mo]; }
        asm volatile("s_waitcnt lgkmcnt(0)" ::: "memory");
#pragma unroll 1
        for (int s = 0; s < 8; ++s) {
            const float a = expf(sda[s]); const float xd = sx[s * 64 + lane] * sdt[s];
            float y = 0.f;
#pragma unroll
            for (int n = 0; n < 128; n += 4) { const f32x4 b4 = *(const LAS f32x4*)(sB + s * 128 + n); const f32x4 c4 = *(const LAS f32x4*)(sC + s * 128 + n);
                S[n] = a * S[n] + xd * b4.x; S[n + 1] = a * S[n + 1] + xd * b4.y; S[n + 2] = a * S[n + 2] + xd * b4.z; S[n + 3] = a * S[n + 3] + xd * b4.w;
                y += S[n] * c4.x + S[n + 1] * c4.y + S[n + 2] * c4.z + S[n + 3] * c4.w; }
            const int tok = dir ? T - 1 - (t0 + s) : t0 + s;
            SY[((size_t)dir * M + row0 + tok) * 512 + h * 64 + lane] = y;
        }
        asm volatile("s_waitcnt lgkmcnt(0)" ::: "memory");
    }
    if (!lat) { float* dst = A.out + O_SS + ((size_t)(((b * 4 + l) * 2 + dir) * 8 + h) * 64 + lane) * 128;
#pragma unroll
        for (int n = 0; n < 128; n += 4) *(f32x4*)(dst + n) = (f32x4){S[n], S[n + 1], S[n + 2], S[n + 3]}; }
}

__device__ __forceinline__ void ph_post(const Ctx& A, int l, int lane, int gw, int NGW) {
    const float* U = (const float*)(A.ws + WS_U); const float* GO = (const float*)(A.ws + WS_GO); const float* SY = (const float*)(A.ws + WS_SY); const float* XBC = (const float*)(A.ws + WS_XBC);
    bf16* MIX = (bf16*)(A.ws + WS_MIX);
    const float* gng = A.in[23] + l * 128; const float* sd = A.in[28] + l * 8; const float* sng = A.in[29] + l * 512;
    for (int m = gw; m < M; m += NGW) {
        const float* u = U + (size_t)m * IN_WP;
#pragma unroll
        for (int i = 0; i < 2; ++i) { const int c = 4 * lane + 256 * i;
            f32x4 o = *(const f32x4*)(GO + (size_t)m * 512 + c) + *(const f32x4*)(GO + ((size_t)M + m) * 512 + c);
            const float ss = half_sum((o.x * o.x + o.y * o.y) + (o.z * o.z + o.w * o.w)); const float rstd = 1.0f / sqrtf(ss * (1.0f / 128.f) + EPS);
            const f32x4 g4 = *(const f32x4*)(gng + (c & 127)); const f32x4 z = *(const f32x4*)(u + U_GZ + c);
            o = o * rstd * g4; o.x *= silu(z.x); o.y *= silu(z.y); o.z *= silu(z.z); o.w *= silu(z.w);
            v2u w; w.x = pk2(o.x, o.y); w.y = pk2(o.z, o.w); *(GAS v2u*)(MIX + (size_t)m * D + 1024 + c) = w; }
#pragma unroll
        for (int i = 0; i < 2; ++i) { const int c = 4 * lane + 256 * i;
            f32x4 y = *(const f32x4*)(SY + (size_t)m * 512 + c) + *(const f32x4*)(SY + ((size_t)M + m) * 512 + c) + *(const f32x4*)(XBC + (size_t)m * 1024 + c) * sd[c >> 6];
            const f32x4 z = *(const f32x4*)(u + U_SZ + c);
            y.x *= silu(z.x); y.y *= silu(z.y); y.z *= silu(z.z); y.w *= silu(z.w);
            const float ss = wave_sum((y.x * y.x + y.y * y.y) + (y.z * y.z + y.w * y.w)); const float rstd = 1.0f / sqrtf(ss * (1.0f / 256.f) + EPS);
            y = y * rstd * *(const f32x4*)(sng + c);
            v2u w; w.x = pk2(y.x, y.y); w.y = pk2(y.z, y.w); *(GAS v2u*)(MIX + (size_t)m * D + 1536 + c) = w; }
    }
}

constexpr size_t GCH_W = 0, GCH_QG = 16384, GCH_KD = 32768, GCH_QK = 49152, GCH_UT = 57344, GCH_DEC = 90112, GCH_BYTES = 90368;
constexpr int NGCH = 160;
template <int DIR>
__device__ __forceinline__ void gdn_solve(const float* GQ, const float* GK, const float* GV, unsigned char* GCH, const LAS float* Ad, const LAS float* gcd, const LAS float* bd, int gch, int h, int row0, int wave, int lane) {
    const int c = (wave & 3) * 64 + lane, cc = c & 127; const bool isw = c < 128;
    unsigned char* rec = GCH + ((size_t)(DIR * NGCH + gch) * 4 + h) * GCH_BYTES;
    const float* src = (isw ? GK : GV) + (size_t)row0 * 512 + h * 128 + cc;
    { int z = 0; asm volatile("" : "+v"(z)); Ad += z; gcd += z; bd += z; }
    float x[64];
#pragma unroll
    for (int i = 0; i < 64; ++i) { const int p = DIR ? 63 - i : i; const float f = isw ? bd[p] * __expf(gcd[p]) : bd[p]; x[i] = src[(size_t)p * 512] * f; if ((i & 7) == 7) asm volatile("" ::: "memory"); }
#pragma unroll
    for (int i = 1; i < 64; ++i) { float s = x[i];
#pragma unroll
        for (int j = 0; j < i; j += 4) { const f32x4 a4 = *(const LAS f32x4*)(Ad + i * 64 + j);
            s -= a4.x * x[j]; if (j + 1 < i) s -= a4.y * x[j + 1]; if (j + 2 < i) s -= a4.z * x[j + 2]; if (j + 3 < i) s -= a4.w * x[j + 3]; }
        x[i] = s; if ((i & 7) == 7) asm volatile("" ::: "memory"); }
    if (isw) { bf16* wdst = (bf16*)(rec + GCH_W) + cc;
#pragma unroll
        for (int i = 0; i < 64; ++i) wdst[i * 128] = (bf16)f2bf(x[i]);
        const float gl = gcd[DIR ? 0 : 63]; bf16* kd = (bf16*)(rec + GCH_KD) + cc * 64;
#pragma unroll
        for (int i = 0; i < 64; i += 8) { float v[8];
#pragma unroll
            for (int u = 0; u < 8; ++u) { const int p = DIR ? 63 - (i + u) : i + u; v[u] = src[(size_t)p * 512] * __expf(gl - gcd[p]); }
            v4u w; w.x = pk2(v[0], v[1]); w.y = pk2(v[2], v[3]); w.z = pk2(v[4], v[5]); w.w = pk2(v[6], v[7]); *(GAS v4u*)(kd + i) = w; asm volatile("" ::: "memory"); }
        if (cc == 0) *(float*)(rec + GCH_DEC) = __expf(gl); }
    else { float* ut = (float*)(rec + GCH_UT) + cc * 64;
#pragma unroll
        for (int i = 0; i < 64; i += 4) *(f32x4*)(ut + i) = (f32x4){x[i], x[i + 1], x[i + 2], x[i + 3]};
        const float* qsrc = GQ + (size_t)row0 * 512 + h * 128 + cc; bf16* qg = (bf16*)(rec + GCH_QG) + cc;
#pragma unroll
        for (int i = 0; i < 64; ++i) { const int p = DIR ? 63 - i : i; qg[i * 128] = (bf16)f2bf(qsrc[(size_t)p * 512] * 0.08838834764831845f * __expf(gcd[p])); if ((i & 7) == 7) asm volatile("" ::: "memory"); } }
}
__device__ __forceinline__ void ph_gdn_local(const Ctx& A, int l, LAS unsigned char* lds, int tid, int lane, int wave, int vcu, int G) {
    const float* GQ = (const float*)(A.ws + WS_GQ); const float* GK = GQ + (size_t)M * 512; const float* GV = GK + (size_t)M * 512;
    const float* GBETA = (const float*)(A.ws + WS_GBG); const float* GG = GBETA + (size_t)M * 8;
    unsigned char* GCH = A.ws + WS_GCH;
    LAS bf16* kb16 = (LAS bf16*)lds; LAS bf16* qb16 = (LAS bf16*)(lds + 17408);
    LAS float* KK = (LAS float*)(lds + 34816); LAS float* QK = (LAS float*)(lds + 34816 + 16640);
    LAS float* Af = (LAS float*)(lds + 68096); LAS float* Ab = (LAS float*)(lds + 68096 + 16384);
    LAS float* sgcf = (LAS float*)(lds + 100864); LAS float* sgcb = sgcf + 64; LAS float* sbf = sgcf + 128; LAS float* sbb = sgcf + 192;
    const int fr = lane & 15, fq = lane >> 4;
    for (int it = vcu; it < NGCH * 4; it += G) {
        const int gch = it >> 2, h = it & 3, row0 = gch * 64;
        { const int r = tid >> 3, c0 = (tid & 7) * 16; const float* kp = GK + (size_t)(row0 + r) * 512 + h * 128 + c0; const float* qp = GQ + (size_t)(row0 + r) * 512 + h * 128 + c0;
          f32x4 kv[4], qv[4];
#pragma unroll
          for (int i = 0; i < 4; ++i) { kv[i] = *(const f32x4*)(kp + 4 * i); qv[i] = *(const f32x4*)(qp + 4 * i); }
          v4u w0, w1; w0.x = pk2(kv[0].x, kv[0].y); w0.y = pk2(kv[0].z, kv[0].w); w0.z = pk2(kv[1].x, kv[1].y); w0.w = pk2(kv[1].z, kv[1].w);
          w1.x = pk2(kv[2].x, kv[2].y); w1.y = pk2(kv[2].z, kv[2].w); w1.z = pk2(kv[3].x, kv[3].y); w1.w = pk2(kv[3].z, kv[3].w);
          *(LAS v4u*)(kb16 + r * 136 + c0) = w0; *(LAS v4u*)(kb16 + r * 136 + c0 + 8) = w1;
          w0.x = pk2(qv[0].x, qv[0].y); w0.y = pk2(qv[0].z, qv[0].w); w0.z = pk2(qv[1].x, qv[1].y); w0.w = pk2(qv[1].z, qv[1].w);
          w1.x = pk2(qv[2].x, qv[2].y); w1.y = pk2(qv[2].z, qv[2].w); w1.z = pk2(qv[3].x, qv[3].y); w1.w = pk2(qv[3].z, qv[3].w);
          *(LAS v4u*)(qb16 + r * 136 + c0) = w0; *(LAS v4u*)(qb16 + r * 136 + c0 + 8) = w1; }
        if (wave == 0) { const float gf = GG[(size_t)(row0 + lane) * 8 + h], gb = GG[(size_t)(row0 + lane) * 8 + 4 + h];
            float pf = gf, pb = gb;
#pragma unroll
            for (int o = 1; o < 64; o <<= 1) { const float tf = __shfl_up(pf, o), tb = __shfl_up(pb, o); if (lane >= o) { pf += tf; pb += tb; } }
            const float totb = __shfl(pb, 63);
            sgcf[lane] = pf; sgcb[lane] = totb - pb + gb;
            sbf[lane] = GBETA[(size_t)(row0 + lane) * 8 + h]; sbb[lane] = GBETA[(size_t)(row0 + lane) * 8 + 4 + h]; }
        __syncthreads();
        { const int tr = wave & 3; const LAS bf16* Aimg = (wave >> 2) ? qb16 : kb16; LAS float* Out = (wave >> 2) ? QK : KK;
          bf16x8 af[4];
#pragma unroll
          for (int ks = 0; ks < 4; ++ks) af[ks] = *(const LAS bf16x8*)(Aimg + (16 * tr + fr) * 136 + ks * 32 + fq * 8);
#pragma unroll
          for (int tc = 0; tc < 4; ++tc) { f32x4 acc = (f32x4){0.f, 0.f, 0.f, 0.f};
#pragma unroll
              for (int ks = 0; ks < 4; ++ks) { const bf16x8 bfr = *(const LAS bf16x8*)(kb16 + (16 * tc + fr) * 136 + ks * 32 + fq * 8); acc = __builtin_amdgcn_mfma_f32_16x16x32_bf16(af[ks], bfr, acc, 0, 0, 0); }
#pragma unroll
              for (int r = 0; r < 4; ++r) Out[(16 * tr + 4 * fq + r) * 65 + 16 * tc + fr] = acc[r]; } }
        __syncthreads();
        { unsigned char* recf = GCH + ((size_t)(0 * NGCH + gch) * 4 + h) * GCH_BYTES; unsigned char* recb = GCH + ((size_t)(1 * NGCH + gch) * 4 + h) * GCH_BYTES;
#pragma unroll 2
          for (int e = 0; e < 8; ++e) { const int idx = tid + 512 * e, i = idx >> 6, j = idx & 63, pi = 63 - i, pj = 63 - j;
              const float kkf = KK[i * 65 + j], qkf = QK[i * 65 + j], kkb = KK[pi * 65 + pj], qkb = QK[pi * 65 + pj];
              const float df = __expf(sgcf[i] - sgcf[j]), db = __expf(sgcb[pi] - sgcb[pj]);
              Af[idx] = (j < i) ? sbf[i] * kkf * df : 0.f; Ab[idx] = (j < i) ? sbb[pi] * kkb * db : 0.f;
              ((bf16*)(recf + GCH_QK))[idx] = (bf16)f2bf((j <= i) ? qkf * 0.08838834764831845f * df : 0.f);
              ((bf16*)(recb + GCH_QK))[idx] = (bf16)f2bf((j <= i) ? qkb * 0.08838834764831845f * db : 0.f); } }
        __syncthreads();
        if (wave < 4) gdn_solve<0>(GQ, GK, GV, GCH, Af, sgcf, sbf, gch, h, row0, wave, lane);
        else gdn_solve<1>(GQ, GK, GV, GCH, Ab, sgcb, sbb, gch, h, row0, wave, lane);
        __syncthreads();
    }
}

__device__ __forceinline__ void gdn_seq_item(const Ctx& A, int l, int b, int lat, int h, int dir, int dvs, LAS unsigned char* wl_, int lane) {
    const GAS unsigned char* GCH = (const GAS unsigned char*)(A.ws + WS_GCH); GAS float* GO = (GAS float*)(A.ws + WS_GO);
    const int fr = lane & 15, fq = lane >> 4;
    const int nch = lat ? 16 : 4, ch0 = lat ? 128 + b * 16 : b * 4;
    LAS bf16* simg = (LAS bf16*)wl_;
    LAS bf16* vimg = (LAS bf16*)(wl_ + 4352);
    f32x4 S[8];
    const size_t sidx = ((size_t)(((b * 4 + l) * 2 + dir) * 4 + h) * 128) * 128 + dvs * 16 + fr;
    if (lat) {
#pragma unroll
        for (int u = 0; u < 8; ++u)
#pragma unroll
            for (int r = 0; r < 4; ++r) S[u][r] = A.in[4][sidx + (size_t)(16 * u + 4 * fq + r) * 128]; }
    else {
#pragma unroll
        for (int u = 0; u < 8; ++u) S[u] = (f32x4){0.f, 0.f, 0.f, 0.f}; }
#define GREC(cc_) (GCH + ((size_t)(dir * NGCH + (dir ? ch0 + nch - 1 - (cc_) : ch0 + (cc_))) * 4 + h) * GCH_BYTES)
#pragma unroll 1
    for (int cc = 0; cc < nch; ++cc) {
        const int gch = dir ? ch0 + nch - 1 - cc : ch0 + cc;
        const GAS unsigned char* rec = GREC(cc);
        const GAS bf16* QG = (const GAS bf16*)(rec + GCH_QG); const GAS bf16* KD = (const GAS bf16*)(rec + GCH_KD); const GAS bf16* QKm = (const GAS bf16*)(rec + GCH_QK);
        const float dec = *(const GAS float*)(rec + GCH_DEC);
        bf16x8 Wf[16]; f32x4 UTf[4];
        { const GAS bf16* W = (const GAS bf16*)(rec + GCH_W); const GAS float* UT = (const GAS float*)(rec + GCH_UT);
#pragma unroll
          for (int t = 0; t < 4; ++t) {
#pragma unroll
              for (int ks = 0; ks < 4; ++ks) Wf[t * 4 + ks] = *(const GAS bf16x8*)(W + (16 * t + fr) * 128 + ks * 32 + fq * 8);
              UTf[t] = *(const GAS f32x4*)(UT + (dvs * 16 + fr) * 64 + 16 * t + 4 * fq); } }
        MEMBAR();
#pragma unroll
        for (int u = 0; u < 8; ++u) { v2u w; w.x = pk2(S[u][0], S[u][1]); w.y = pk2(S[u][2], S[u][3]); *(LAS v2u*)(simg + fr * 136 + 16 * u + 4 * fq) = w; }
        asm volatile("s_waitcnt lgkmcnt(0)" ::: "memory");
        bf16x8 BS[4];
#pragma unroll
        for (int ks = 0; ks < 4; ++ks) BS[ks] = *(const LAS bf16x8*)(simg + fr * 136 + ks * 32 + fq * 8);
#pragma unroll
        for (int t = 0; t < 4; ++t) { f32x4 acc = (f32x4){0.f, 0.f, 0.f, 0.f};
#pragma unroll
            for (int ks = 0; ks < 4; ++ks) acc = __builtin_amdgcn_mfma_f32_16x16x32_bf16(Wf[t * 4 + ks], BS[ks], acc, 0, 0, 0);
            const f32x4 vn = UTf[t] - acc;
            v2u w; w.x = pk2(vn[0], vn[1]); w.y = pk2(vn[2], vn[3]); *(LAS v2u*)(vimg + fr * 72 + 16 * t + 4 * fq) = w; }
        asm volatile("s_waitcnt lgkmcnt(0)" ::: "memory");
        bf16x8 BV[2];
#pragma unroll
        for (int ks = 0; ks < 2; ++ks) BV[ks] = *(const LAS bf16x8*)(vimg + fr * 72 + ks * 32 + fq * 8);
        int zl = 0; asm volatile("" : "+v"(zl));
        GAS float* gob = GO + ((size_t)dir * M + gch * 64) * 512 + h * 128 + dvs * 16 + fr + zl;
#pragma unroll
        for (int th = 0; th < 2; ++th) {
            bf16x8 QGf[8], QKf[4];
#pragma unroll
            for (int t2 = 0; t2 < 2; ++t2) { const int t = 2 * th + t2;
#pragma unroll
                for (int ks = 0; ks < 4; ++ks) QGf[t2 * 4 + ks] = *(const GAS bf16x8*)(QG + (16 * t + fr) * 128 + ks * 32 + fq * 8);
#pragma unroll
                for (int ks = 0; ks < 2; ++ks) QKf[t2 * 2 + ks] = *(const GAS bf16x8*)(QKm + (16 * t + fr) * 64 + ks * 32 + fq * 8); }
            MEMBAR();
#pragma unroll
            for (int t2 = 0; t2 < 2; ++t2) { const int t = 2 * th + t2; f32x4 acc = (f32x4){0.f, 0.f, 0.f, 0.f};
#pragma unroll
                for (int ks = 0; ks < 4; ++ks) acc = __builtin_amdgcn_mfma_f32_16x16x32_bf16(QGf[t2 * 4 + ks], BS[ks], acc, 0, 0, 0);
#pragma unroll
                for (int ks = 0; ks < 2; ++ks) acc = __builtin_amdgcn_mfma_f32_16x16x32_bf16(QKf[t2 * 2 + ks], BV[ks], acc, 0, 0, 0);
#pragma unroll
                for (int r = 0; r < 4; ++r) { const int i = 16 * t + 4 * fq + r, p = dir ? 63 - i : i; gob[(ptrdiff_t)p * 512] = acc[r]; } }
            MEMBAR();
        }
        bf16x8 KDf[16];
#pragma unroll
        for (int u = 0; u < 8; ++u)
#pragma unroll
            for (int ks = 0; ks < 2; ++ks) KDf[u * 2 + ks] = *(const GAS bf16x8*)(KD + (16 * u + fr) * 64 + ks * 32 + fq * 8);
        MEMBAR();
#pragma unroll
        for (int u = 0; u < 8; ++u) { f32x4 acc = S[u] * dec;
#pragma unroll
            for (int ks = 0; ks < 2; ++ks) acc = __builtin_amdgcn_mfma_f32_16x16x32_bf16(KDf[u * 2 + ks], BV[ks], acc, 0, 0, 0);
            S[u] = acc; }
        MEMBAR();
    }
#undef GREC
    if (!lat) { int l2 = lane; asm volatile("" : "+v"(l2)); const int fr2 = l2 & 15, fq2 = l2 >> 4;
        float* so = A.out + O_SG + ((size_t)(((b * 4 + l) * 2 + dir) * 4 + h) * 128) * 128 + dvs * 16 + fr2 + (size_t)(4 * fq2) * 128;
#pragma unroll
        for (int u = 0; u < 8; ++u)
#pragma unroll
            for (int r = 0; r < 4; ++r) so[(16 * u + r) * 128] = S[u][r]; }
}
__device__ __forceinline__ void ph_gdn_seq(const Ctx& A, int l, LAS unsigned char* lds, int lane, int wave, int gw, int NGW) {
    LAS unsigned char* wl_ = lds + wave * 8192;
    for (int wi = gw; wi < 2176; wi += NGW) {
        if (wi < 128) { for (int rl = 0; rl < REP_LAT; ++rl) { const int dvs = wi & 7, q = wi >> 3; gdn_seq_item(A, l, q >> 3, 1, (q >> 1) & 3, q & 1, dvs, wl_, lane); } }
        else { for (int rc = 0; rc < REP_CTX; ++rc) { const int w2 = wi - 128, dvs = w2 & 7, q = w2 >> 3; gdn_seq_item(A, l, q >> 3, 0, (q >> 1) & 3, q & 1, dvs, wl_, lane); } }
    }
}

constexpr size_t SR_P = 0, SR_X1 = 32768, SR_X2 = 49152, SR_EA = 65536, SR_DEC = 66048, SR_BYTES = 66560;
constexpr size_t SS_C = 0, SS_BT = 32768, SS_BYTES = 65536;
constexpr int NSCH = 80;
__device__ __forceinline__ void ph_ssd_local(const Ctx& A, int l, LAS unsigned char* lds, int tid, int lane, int wave, int vcu, int G) {
    const float* XBC = (const float*)(A.ws + WS_XBC); const float* SDT = (const float*)(A.ws + WS_SDT); const float* SDA = SDT + (size_t)M * 16;
    unsigned char* SREC = A.ws + WS_SREC; unsigned char* SSH = A.ws + WS_SSH;
    LAS bf16* Cimg = (LAS bf16*)lds; LAS bf16* Bimg = (LAS bf16*)(lds + 34816);
    LAS float* sac = (LAS float*)(lds + 69632);
    LAS float* sdt = sac + 256;
    const int fr = lane & 15, fq = lane >> 4;
    for (int it = vcu; it < NSCH * 8; it += G) {
        const int ch = it >> 3, h = it & 7, g = h >> 2, row0 = ch * 128;
        unsigned char* shr = SSH + (size_t)(ch * 2 + g) * SS_BYTES;
        { const int r = tid >> 2, c0 = (tid & 3) * 32; const float* cp = XBC + (size_t)(row0 + r) * 1024 + 768 + g * 128 + c0; const float* bp = XBC + (size_t)(row0 + r) * 1024 + 512 + g * 128 + c0;
#pragma unroll
          for (int i = 0; i < 4; ++i) { const f32x4 a0 = *(const f32x4*)(cp + 8 * i), a1 = *(const f32x4*)(cp + 8 * i + 4), b0 = *(const f32x4*)(bp + 8 * i), b1 = *(const f32x4*)(bp + 8 * i + 4);
              v4u wc, wb; wc.x = pk2(a0.x, a0.y); wc.y = pk2(a0.z, a0.w); wc.z = pk2(a1.x, a1.y); wc.w = pk2(a1.z, a1.w);
              wb.x = pk2(b0.x, b0.y); wb.y = pk2(b0.z, b0.w); wb.z = pk2(b1.x, b1.y); wb.w = pk2(b1.z, b1.w);
              *(LAS v4u*)(Cimg + r * 136 + c0 + 8 * i) = wc; *(LAS v4u*)(Bimg + r * 136 + c0 + 8 * i) = wb;
              if ((h & 3) == 0) *(GAS v4u*)((bf16*)(shr + SS_C) + r * 128 + c0 + 8 * i) = wc; } }
        if (wave < 2) { const int d = wave; const size_t mo = (size_t)(row0 + 2 * lane) * 16 + d * 8 + h;
            const float a0 = SDA[mo], a1 = SDA[mo + 16]; float ps = a0 + a1;
#pragma unroll
            for (int o = 1; o < 64; o <<= 1) { const float t = __shfl_up(ps, o); if (lane >= o) ps += t; }
            const float tot = __shfl(ps, 63);
            if (d == 0) { sac[2 * lane] = ps - a1; sac[2 * lane + 1] = ps; }
            else { sac[128 + 2 * lane] = tot - ps + a0 + a1; sac[128 + 2 * lane + 1] = tot - ps + a1; }
            sdt[d * 128 + 2 * lane] = SDT[mo]; sdt[d * 128 + 2 * lane + 1] = SDT[mo + 16]; }
        __syncthreads();
        if ((h & 3) == 0) { const int n = tid >> 2, s0 = (tid & 3) * 32; bf16* dst = (bf16*)(shr + SS_BT) + n * 128 + s0;
#pragma unroll
            for (int i = 0; i < 4; ++i) { unsigned w[4];
#pragma unroll
                for (int j = 0; j < 4; ++j) w[j] = (unsigned)Bimg[(s0 + 8 * i + 2 * j) * 136 + n] | ((unsigned)Bimg[(s0 + 8 * i + 2 * j + 1) * 136 + n] << 16);
                *(GAS v4u*)(dst + 8 * i) = (v4u){w[0], w[1], w[2], w[3]}; } }
        { bf16x8 af[4];
#pragma unroll
          for (int ks = 0; ks < 4; ++ks) af[ks] = *(const LAS bf16x8*)(Cimg + (16 * wave + fr) * 136 + ks * 32 + fq * 8);
          bf16* Pf = (bf16*)(SREC + ((size_t)(0 * NSCH + ch) * 8 + h) * SR_BYTES + SR_P); bf16* Pb = (bf16*)(SREC + ((size_t)(1 * NSCH + ch) * 8 + h) * SR_BYTES + SR_P);
          float acf[4], acb[4];
#pragma unroll
          for (int r = 0; r < 4; ++r) { acf[r] = sac[16 * wave + 4 * fq + r]; acb[r] = sac[128 + 16 * wave + 4 * fq + r]; }
#pragma unroll
          for (int tc = 0; tc < 8; ++tc) { f32x4 acc = (f32x4){0.f, 0.f, 0.f, 0.f};
#pragma unroll
              for (int ks = 0; ks < 4; ++ks) { const bf16x8 bfr = *(const LAS bf16x8*)(Bimg + (16 * tc + fr) * 136 + ks * 32 + fq * 8); acc = __builtin_amdgcn_mfma_f32_16x16x32_bf16(af[ks], bfr, acc, 0, 0, 0); }
              const int s = 16 * tc + fr; const float asf = sac[s], asb = sac[128 + s];
#pragma unroll
              for (int r = 0; r < 4; ++r) { const int li = 16 * wave + 4 * fq + r;
                  Pf[li * 128 + s] = (bf16)f2bf((s <= li) ? acc[r] * __expf(acf[r] - asf) : 0.f);
                  Pb[li * 128 + s] = (bf16)f2bf((s >= li) ? acc[r] * __expf(acb[r] - asb) : 0.f); } } }
        { const int p = lane, s0 = wave * 16; const float* xp = XBC + (size_t)(row0 + s0) * 1024 + h * 64 + p;
          float xv[16];
#pragma unroll
          for (int j = 0; j < 16; ++j) xv[j] = xp[(size_t)j * 1024];
#pragma unroll
          for (int d = 0; d < 2; ++d) { unsigned char* rec = SREC + ((size_t)(d * NSCH + ch) * 8 + h) * SR_BYTES; const float aend = d ? sac[128] : sac[127];
              unsigned w1[8], w2[8];
#pragma unroll
              for (int j = 0; j < 16; j += 2) { const float u0 = xv[j] * sdt[d * 128 + s0 + j], u1 = xv[j + 1] * sdt[d * 128 + s0 + j + 1];
                  w1[j >> 1] = pk2(u0, u1); w2[j >> 1] = pk2(u0 * __expf(aend - sac[d * 128 + s0 + j]), u1 * __expf(aend - sac[d * 128 + s0 + j + 1])); }
              bf16* x1 = (bf16*)(rec + SR_X1) + p * 128 + s0; bf16* x2 = (bf16*)(rec + SR_X2) + p * 128 + s0;
              *(GAS v4u*)x1 = (v4u){w1[0], w1[1], w1[2], w1[3]}; *(GAS v4u*)(x1 + 8) = (v4u){w1[4], w1[5], w1[6], w1[7]};
              *(GAS v4u*)x2 = (v4u){w2[0], w2[1], w2[2], w2[3]}; *(GAS v4u*)(x2 + 8) = (v4u){w2[4], w2[5], w2[6], w2[7]};
              if (tid < 128) ((float*)(rec + SR_EA))[tid] = __expf(sac[d * 128 + tid]);
              if (tid == 0) *(float*)(rec + SR_DEC) = __expf(aend); } }
        __syncthreads();
    }
}

__device__ __forceinline__ void ssd_seq_item(const Ctx& A, int l, int b, int lat, int h, int dir, int ps, LAS unsigned char* wl_, int lane) {
    const GAS unsigned char* SREC = (const GAS unsigned char*)(A.ws + WS_SREC); const GAS unsigned char* SSH = (const GAS unsigned char*)(A.ws + WS_SSH); GAS float* SY = (GAS float*)(A.ws + WS_SY);
    const int fr = lane & 15, fq = lane >> 4, g = h >> 2;
    const int nch = lat ? 8 : 2, ch0 = lat ? 64 + b * 8 : b * 2;
    LAS bf16* simg = (LAS bf16*)wl_;
    f32x4 S[8];
    const size_t sidx = ((size_t)(((b * 4 + l) * 2 + dir) * 8 + h) * 64 + ps * 16 + fr) * 128 + 4 * fq;
    if (lat) {
#pragma unroll
        for (int u = 0; u < 8; ++u) S[u] = *(const GAS f32x4*)(A.in[5] + sidx + 16 * u); }
    else {
#pragma unroll
        for (int u = 0; u < 8; ++u) S[u] = (f32x4){0.f, 0.f, 0.f, 0.f}; }
#pragma unroll 1
    for (int cc = 0; cc < nch; ++cc) {
        const int ch = dir ? ch0 + nch - 1 - cc : ch0 + cc;
        const GAS unsigned char* rec = SREC + ((size_t)(dir * NSCH + ch) * 8 + h) * SR_BYTES; const GAS unsigned char* shr = SSH + (size_t)(ch * 2 + g) * SS_BYTES;
        const GAS bf16* P = (const GAS bf16*)(rec + SR_P); const GAS bf16* X1 = (const GAS bf16*)(rec + SR_X1); const GAS bf16* X2 = (const GAS bf16*)(rec + SR_X2);
        const GAS float* EA = (const GAS float*)(rec + SR_EA); const float dec = *(const GAS float*)(rec + SR_DEC);
        const GAS bf16* C16 = (const GAS bf16*)(shr + SS_C); const GAS bf16* BT16 = (const GAS bf16*)(shr + SS_BT);
        bf16x8 BX1[4], BX2[4];
#pragma unroll
        for (int ks = 0; ks < 4; ++ks) { BX1[ks] = *(const GAS bf16x8*)(X1 + (ps * 16 + fr) * 128 + ks * 32 + fq * 8); BX2[ks] = *(const GAS bf16x8*)(X2 + (ps * 16 + fr) * 128 + ks * 32 + fq * 8); }
        MEMBAR();
#pragma unroll
        for (int u = 0; u < 8; ++u) { v2u w; w.x = pk2(S[u][0], S[u][1]); w.y = pk2(S[u][2], S[u][3]); *(LAS v2u*)(simg + fr * 136 + 16 * u + 4 * fq) = w; }
        asm volatile("s_waitcnt lgkmcnt(0)" ::: "memory");
        bf16x8 BS[4];
#pragma unroll
        for (int ks = 0; ks < 4; ++ks) BS[ks] = *(const LAS bf16x8*)(simg + fr * 136 + ks * 32 + fq * 8);
        int zl = 0; asm volatile("" : "+v"(zl));
        GAS float* syb = SY + ((size_t)dir * M + ch * 128 + 4 * fq) * 512 + h * 64 + ps * 16 + fr + zl;
#pragma unroll 1
        for (int tp = 0; tp < 4; ++tp) {
            bf16x8 Cf[8], Pf[8]; f32x4 ea[2];
#pragma unroll
            for (int t2 = 0; t2 < 2; ++t2) { const int t = 2 * tp + t2;
#pragma unroll
                for (int ks = 0; ks < 4; ++ks) { Cf[t2 * 4 + ks] = *(const GAS bf16x8*)(C16 + (16 * t + fr) * 128 + ks * 32 + fq * 8); Pf[t2 * 4 + ks] = *(const GAS bf16x8*)(P + (16 * t + fr) * 128 + ks * 32 + fq * 8); }
                ea[t2] = *(const GAS f32x4*)(EA + 16 * t + 4 * fq); }
            MEMBAR();
#pragma unroll
            for (int t2 = 0; t2 < 2; ++t2) { const int t = 2 * tp + t2; f32x4 acc = (f32x4){0.f, 0.f, 0.f, 0.f};
#pragma unroll
                for (int ks = 0; ks < 4; ++ks) acc = __builtin_amdgcn_mfma_f32_16x16x32_bf16(Cf[t2 * 4 + ks], BS[ks], acc, 0, 0, 0);
                acc = acc * ea[t2];
#pragma unroll
                for (int ks = 0; ks < 4; ++ks) acc = __builtin_amdgcn_mfma_f32_16x16x32_bf16(Pf[t2 * 4 + ks], BX1[ks], acc, 0, 0, 0);
#pragma unroll
                for (int r = 0; r < 4; ++r) syb[(size_t)(16 * t + r) * 512] = acc[r]; }
            MEMBAR();
        }
#pragma unroll
        for (int uh = 0; uh < 2; ++uh) {
            bf16x8 Bf[16];
#pragma unroll
            for (int u2 = 0; u2 < 4; ++u2)
#pragma unroll
                for (int ks = 0; ks < 4; ++ks) Bf[u2 * 4 + ks] = *(const GAS bf16x8*)(BT16 + (16 * (4 * uh + u2) + fr) * 128 + ks * 32 + fq * 8);
            MEMBAR();
#pragma unroll
            for (int u2 = 0; u2 < 4; ++u2) { f32x4 acc = S[4 * uh + u2] * dec;
#pragma unroll
                for (int ks = 0; ks < 4; ++ks) acc = __builtin_amdgcn_mfma_f32_16x16x32_bf16(Bf[u2 * 4 + ks], BX2[ks], acc, 0, 0, 0);
                S[4 * uh + u2] = acc; }
        }
        MEMBAR();
    }
    if (!lat) {
#pragma unroll
        for (int u = 0; u < 8; ++u) *(GAS f32x4*)(A.out + O_SS + sidx + 16 * u) = S[u]; }
}
__device__ __forceinline__ void ph_ssd_seq(const Ctx& A, int l, LAS unsigned char* lds, int lane, int wave, int gw, int NGW) {
    LAS unsigned char* wl_ = lds + wave * 8192;
    for (int wi0 = gw; wi0 < 2176; wi0 += NGW) {
        const int wi = (wi0 + 1024) % 2176;
        if (wi < 128) { for (int rl = 0; rl < REP_LAT; ++rl) { const int ps = wi & 3, q = wi >> 2; ssd_seq_item(A, l, q >> 4, 1, (q >> 1) & 7, q & 1, ps, wl_, lane); } }
        else { for (int rc = 0; rc < REP_CTX; ++rc) { const int w2 = wi - 128, ps = w2 & 3, q = w2 >> 2; ssd_seq_item(A, l, q >> 4, 0, (q >> 1) & 7, q & 1, ps, wl_, lane); } }
    }
}

#ifndef REP_ATTN
#define REP_ATTN 1
#endif
#ifndef REP_LOC
#define REP_LOC 1
#endif
#ifndef REP_LAT
#define REP_LAT 1
#endif
#ifndef REP_CTX
#define REP_CTX 1
#endif
#ifndef REP_MIX
#define REP_MIX 1
#endif
#ifndef REP_PRO
#define REP_PRO 1
#endif
#ifndef REP_EW
#define REP_EW 1
#endif
#ifndef REP_GEMM
#define REP_GEMM 1
#endif
#ifndef MK_ONE_LAUNCH
#define MK_ONE_LAUNCH 0
#endif
#define IN(k) (lo <= (k) && (k) < hi)
#ifndef REP_BAR
#define REP_BAR 1
#endif
#define SEAM(k) do { if (IN((k) + 1)) { for (int rb_ = 0; rb_ < REP_BAR; ++rb_) xcd_barrier(bar); } } while (0)
#define PHASE_ROOTS() Ctx C; int G = (int)gridDim.x, bx = (int)blockIdx.x; int tid = tid0; asm volatile("" : "+v"(tid)); const int lane = tid & 63, wave = __builtin_amdgcn_readfirstlane(tid >> 6); (void)lane; (void)wave; \
    { unsigned long long kp_ = (unsigned long long)__builtin_amdgcn_kernarg_segment_ptr(); float* o_ = args.out; unsigned char* w_ = args.ws; \
      asm volatile("" : "+s"(kp_), "+s"(o_), "+s"(w_), "+s"(G), "+s"(bx)); C.in = (kin_t)kp_; C.out = o_; C.ws = w_; } \
    const int vcu = (G % 8 == 0) ? (bx % 8) * (G / 8) + bx / 8 : bx; const int gw = vcu * NWAVES + wave, NGW = G * NWAVES; (void)gw; (void)NGW; (void)vcu


template <int L> __device__ __forceinline__ void layer_phases(const Args& args, LAS unsigned char* lds, const int tid0, const int lo0, const int hi0, const XcdBarrier& bar) {
    constexpr int l = L;
        const int pb = 1 + l * NPH_L;
        int lo = lo0, hi = hi0; asm volatile("" : "+s"(lo), "+s"(hi));
#define MODS_L ((const float*)(C.ws + WS_MODS) + (size_t)l * 3 * 12288)
#define WL ((const bf16*)(C.ws + WS_W) + (size_t)l * WLE_SIZE)
        if (IN(pb + 0)) { PHASE_ROOTS(); for (int rep = 0; rep < REP_EW; ++rep) ph_norm(C.out, C.in[8] + l * D, MODS_L, 0, (bf16*)(C.ws + WS_H), l > 0 ? (const float*)(C.ws + WS_PART) : (const float*)nullptr, MODS_L - 3 * 12288 + 5 * 2048, lane, gw, NGW); SEAM(pb + 0); }
        if (IN(pb + 1)) { PHASE_ROOTS();
            pg8::Gemm g{(const bf16*)(C.ws + WS_H), WL + WLE_IN, M, IN_WP, D}; pg8::StaticOrder S; S.init(M, IN_WP, G, bx);
            pg8::EpiF32 E{(float*)(C.ws + WS_U), IN_WP};
            for (int rep = 0; rep < REP_GEMM; ++rep) pg8::gemm_phase<pg8::EpiF32, pg8::StaticOrder, true, true>(lds, g, S, E);
            SEAM(pb + 1);
        }
        if (IN(pb + 2)) { PHASE_ROOTS();
#ifndef SKIP_PREP
            for (int rep = 0; rep < REP_EW; ++rep) ph_prep(C, l, lane, gw, NGW);
#endif
            SEAM(pb + 2); }
        if (IN(pb + 3)) {
            { PHASE_ROOTS(); pg8::Gemm g{(const bf16*)(C.ws + WS_CQN), WL + WLE_UQ, M, 1536, 768}; pg8::StaticOrder S; S.init(M, 1536, G, bx);
              pg8::EpiF32 E{(float*)(C.ws + WS_QRAW), 1536};
              for (int rep = 0; rep < REP_GEMM; ++rep) pg8::gemm_phase<pg8::EpiF32, pg8::StaticOrder, true, true>(lds, g, S, E); }
            { PHASE_ROOTS(); pg8::Gemm g{(const bf16*)(C.ws + WS_CKVN), WL + WLE_KV, MK, 1024, 512}; pg8::StaticOrder S; S.init(MK, 1024, G, bx);
              pg8::EpiF32 E{(float*)(C.ws + WS_KN), 1024};
              for (int rep = 0; rep < REP_GEMM; ++rep) pg8::gemm_phase<pg8::EpiF32, pg8::StaticOrder, true, true>(lds, g, S, E); }
            { PHASE_ROOTS(); pg8::Gemm g{WL + WLE_KV + (size_t)1024 * 512, (const bf16*)(C.ws + WS_CKVN), 1024, MK, 512}; pg8::StaticOrder S; S.init(1024, MK, G, bx);
              pg8::EpiBf16 E{(bf16*)(C.ws + WS_VT), MK};
              for (int rep = 0; rep < REP_GEMM; ++rep) pg8::gemm_phase<pg8::EpiBf16, pg8::StaticOrder, true, true>(lds, g, S, E); }
            SEAM(pb + 3);
        }
        if (IN(pb + 4)) { PHASE_ROOTS();
#ifndef SKIP_FIN
            for (int rep = 0; rep < REP_EW; ++rep) ph_finalize(C, l, lane, gw, NGW);
#endif
            for (int rep = 0; rep < REP_LOC; ++rep) { ph_gdn_local(C, l, lds, tid, lane, wave, vcu, G);
            ph_ssd_local(C, l, lds, tid, lane, wave, vcu, G); }
            SEAM(pb + 4); }
        if (IN(pb + 5)) { for (int rep = 0; rep < REP_MIX; ++rep) {
#ifndef SKIP_GDN
            { PHASE_ROOTS(); ph_gdn_seq(C, l, lds, lane, wave, gw, NGW); }
#endif
            __syncthreads();
#ifndef SKIP_SSD
            { PHASE_ROOTS(); ph_ssd_seq(C, l, lds, lane, wave, gw, NGW); }
#endif
            __syncthreads();
#ifndef SKIP_ATTN
            for (int rep2 = 0; rep2 < REP_ATTN; ++rep2) { PHASE_ROOTS(); ph_attn(C, lds, tid, lane, wave, vcu, G); }
#endif
            __syncthreads(); }
            SEAM(pb + 5);
        }
        if (IN(pb + 6)) { PHASE_ROOTS();
#ifndef SKIP_POST
            for (int rep = 0; rep < REP_EW; ++rep) ph_post(C, l, lane, gw, NGW);
#endif
            SEAM(pb + 6); }
        if (IN(pb + 7)) { PHASE_ROOTS();
            { pg8::Gemm g{(const bf16*)(C.ws + WS_MIX), WL + WLE_OUT, M, D, D, 0}; pg8::PanelOrder S{bx};
              pg8::EpiResid E{C.out, D, MODS_L + 2 * 2048};
              pg8::gemm_phase<pg8::EpiResid, pg8::PanelOrder, true, true>(lds, g, S, E); }
            { PHASE_ROOTS(); pg8::Gemm g{(const bf16*)(C.ws + WS_MIX), WL + WLE_OUT, M, D, D / 4, D}; pg8::TailOrder S{bx, D / 4};
              pg8::EpiPart E{(float*)(C.ws + WS_PART), D / 4};
              pg8::gemm_phase<pg8::EpiPart, pg8::TailOrder, true, true>(lds, g, S, E); }
            SEAM(pb + 7);
        }
        if (IN(pb + 8)) { PHASE_ROOTS(); for (int rep = 0; rep < REP_EW; ++rep) ph_norm(C.out, C.in[9] + l * D, MODS_L, 3, (bf16*)(C.ws + WS_H), (const float*)(C.ws + WS_PART), MODS_L + 2 * 2048, lane, gw, NGW); SEAM(pb + 8); }
        if (IN(pb + 9)) { PHASE_ROOTS();
            pg8::Gemm g{(const bf16*)(C.ws + WS_H), WL + WLE_GU, M, 2 * FF, D}; pg8::StaticOrder S; S.init(M, 2 * FF, G, bx);
            pg8::EpiSwiglu E{(bf16*)(C.ws + WS_ACT), FF};
            for (int rep = 0; rep < REP_GEMM; ++rep) pg8::gemm_phase<pg8::EpiSwiglu, pg8::StaticOrder, true, true>(lds, g, S, E);
            SEAM(pb + 9);
        }
        if (IN(pb + 10)) { PHASE_ROOTS();
            { pg8::Gemm g{(const bf16*)(C.ws + WS_ACT), WL + WLE_DN, M, D, FF, 0}; pg8::PanelOrder S{bx};
              pg8::EpiResid E{C.out, D, MODS_L + 5 * 2048};
              pg8::gemm_phase<pg8::EpiResid, pg8::PanelOrder, true, true>(lds, g, S, E); }
            { PHASE_ROOTS(); pg8::Gemm g{(const bf16*)(C.ws + WS_ACT), WL + WLE_DN, M, D, FF / 4, FF}; pg8::TailOrder S{bx, FF / 4};
              pg8::EpiPart E{(float*)(C.ws + WS_PART), FF / 4};
              pg8::gemm_phase<pg8::EpiPart, pg8::TailOrder, true, true>(lds, g, S, E); }
            SEAM(pb + 10);
        }
    }

__global__ void __launch_bounds__(NWAVES * 64, 2) mk_fwd(Args args) {
    extern __shared__ __attribute__((aligned(16))) unsigned char lds_raw[];
    LAS unsigned char* lds = (LAS unsigned char*)lds_raw;
    const int tid0 = threadIdx.x;
    for (int u = tid0; u < (LDS_BYTES - LDSCTL_OFF) / 4; u += NWAVES * 64) ((LAS unsigned*)(lds + LDSCTL_OFF))[u] = 0u;
    __syncthreads();
    const int lo0 = args.ph_lo, hi0 = args.ph_hi;
    XcdBarrier bar; bar.bar = (unsigned*)(args.ws + WS_CTL) + CW_BAR; bar.x = 0; bar.st = nullptr;
    if ((hi0 - lo0) > 1) bar = xcd_barrier_post((unsigned*)(args.ws + WS_CTL) + CW_BAR, (volatile LAS unsigned*)(lds + MISC_OFF) + 8);
    { int lo = lo0, hi = hi0;
    if (IN(0)) { for (int rep = 0; rep < REP_PRO; ++rep) { PHASE_ROOTS();
#ifndef SKIP_PRO
        ph_prologue(C, lds, tid, lane, wave, vcu, G);
#endif
        __syncthreads(); }
        SEAM(0); } }

    layer_phases<0>(args, lds, tid0, lo0, hi0, bar);
    layer_phases<1>(args, lds, tid0, lo0, hi0, bar);
    layer_phases<2>(args, lds, tid0, lo0, hi0, bar);
    layer_phases<3>(args, lds, tid0, lo0, hi0, bar);
    { int lo = lo0, hi = hi0; if (IN(NPHASES - 1)) { PHASE_ROOTS(); ph_final(C.out, (const float*)(C.ws + WS_PART), (const float*)(C.ws + WS_MODS) + (size_t)3 * 3 * 12288 + 5 * 2048, lane, gw, NGW); } }
#undef IN
#undef SEAM
}

extern "C" void kernel_launch(void* const* d_in, const int* in_sizes, int n_in, void* d_out, int out_size, void* d_ws, size_t ws_size, hipStream_t stream) {
    static int grid = 0;
    if (grid == 0) {
        if (n_in != 32 || out_size != 73400320 || ws_size < WS_END) { fprintf(stderr, "kernel_launch: built for 32 inputs, 73400320 outputs, >= %zu bytes of workspace; got n_in %d, out %d, ws %zu; nothing launched\n", (size_t)WS_END, n_in, out_size, ws_size); grid = -1; return; }
        int dev = 0, cus = 0, per_cu = 0;
        if (hipGetDevice(&dev) != hipSuccess || hipDeviceGetAttribute(&cus, hipDeviceAttributeMultiprocessorCount, dev) != hipSuccess) { fprintf(stderr, "kernel_launch: device query failed\n"); grid = -1; return; }
        if (hipFuncSetAttribute((const void*)mk_fwd, hipFuncAttributeMaxDynamicSharedMemorySize, LDS_BYTES) != hipSuccess) { fprintf(stderr, "kernel_launch: hipFuncSetAttribute failed\n"); grid = -1; return; }
        if (hipOccupancyMaxActiveBlocksPerMultiprocessor(&per_cu, (const void*)mk_fwd, NWAVES * 64, LDS_BYTES) != hipSuccess || per_cu < 1)
            fprintf(stderr, "kernel_launch: note: occupancy query reports %d workgroups per CU\n", per_cu);
        (void)hipGetLastError();
        grid = cus;
    }
    if (grid < 0) return;
    if (hipMemsetAsync((char*)d_ws + WS_CTL, 0, CTL_ZERO_BYTES, stream) != hipSuccess) { fprintf(stderr, "kernel_launch: memset failed\n"); return; }
    Args a{};
    for (int i = 0; i < 32; ++i) a.in[i] = (const float*)d_in[i];
    a.out = (float*)d_out; a.ws = (unsigned char*)d_ws;
#if MK_ONE_LAUNCH
    a.ph_lo = 0; a.ph_hi = NPHASES;
    hipLaunchKernelGGL(mk_fwd, dim3(grid), dim3(NWAVES * 64), LDS_BYTES, stream, a);
#else
    for (int p = 0; p < NPHASES; ++p) { a.ph_lo = p; a.ph_hi = p + 1; hipLaunchKernelGGL(mk_fwd, dim3(grid), dim3(NWAVES * 64), LDS_BYTES, stream, a); }
#endif
    const hipError_t le = hipPeekAtLastError();
    if (le != hipSuccess) fprintf(stderr, "kernel_launch: launch failed: %s\n", hipGetErrorName(le));
}
```

```cpp
#include <hip/hip_runtime.h>
#include <cstdio>
#include <cstdint>
#include <cstddef>
#ifndef MK_ONE_LAUNCH
#define MK_ONE_LAUNCH 1
#endif
namespace pg8 {
#define PG8_LAS __attribute__((address_space(3)))
typedef unsigned short bf16_t;
typedef short bf16x8 __attribute__((ext_vector_type(8)));
typedef float f32x4 __attribute__((ext_vector_type(4)));
typedef unsigned u32x4 __attribute__((ext_vector_type(4)));
constexpr int BM = 256, BK = 64, HALF = 128, HTB = HALF * BK * 2  , STAGE_BYTES = 8 * HTB, NXCD = 8, WGM = 8;

__host__ __device__ __forceinline__ int lds_byte(int r, int c) { const int st = (r >> 4) * 2 + (c >> 5), rr = r & 15, cc = c & 31, ob = rr * 64 + cc * 2; return st * 1024 + (ob ^ (((ob >> 9) & 1) << 5)); }
__host__ __device__ __forceinline__ void stage_rc(int b, int& R, int& C) { const int st = b / 1024, sb = b % 1024, swz = sb ^ (((sb >> 9) & 1) << 5); R = (st >> 1) * 16 + swz / 64; C = (st & 1) * 32 + (swz % 64) / 2; }
__host__ __device__ __forceinline__ int perm32(int rho) { const int n = rho >> 4, i = rho & 15; return 8 * (i >> 2) + 4 * n + (i & 3); }

struct Unit { int pm, pn, k0; };
struct Gemm { const bf16_t* A; const bf16_t* Bt; int M, N, K, ld; };

struct StaticOrder {
    int nM, nN, nwg, G, c;
    __host__ __device__ void init(int M, int N, int G_, int c_) { nM = M / BM; nN = N / BM; nwg = nM * nN; G = G_; c = c_; }
    __host__ __device__ bool next(int i, Unit& u) const {
        const long L = (long)i * G + c; if (L >= nwg) return false;
        int wgid = (int)L; { const int q = nwg / NXCD, r = nwg % NXCD, xcd = wgid % NXCD, off = wgid / NXCD; wgid = (xcd < r ? xcd * (q + 1) : r * (q + 1) + (xcd - r) * q) + off; }
        const int nig = WGM * nN, gid = wgid / nig, fm = gid * WGM, gsz = (nM - fm) < WGM ? (nM - fm) : WGM;
        u.pm = fm + ((wgid % nig) % gsz); u.pn = (wgid % nig) / gsz; u.k0 = 0; return true;
    }
    __device__ __forceinline__ void a_ready(const Unit&) const {}
    __device__ __forceinline__ void done(const Unit&) const {}
};

__device__ __forceinline__ unsigned cvt_pk_bf16(float lo, float hi) { unsigned r; asm volatile("v_cvt_pk_bf16_f32 %0, %1, %2" : "=v"(r) : "v"(lo), "v"(hi)); return r; }
__device__ __forceinline__ float silu_f(float x) { return x * __builtin_amdgcn_rcpf(1.0f + __expf(-x)); }

struct EpiF32 {
    static constexpr bool PERM = false, AFTER_DRAIN = false;
    float* C; int ldc;
    __device__ __forceinline__ void operator()(const f32x4 (&acc)[2][2][4][2], const Unit& u, int wr, int wc, int fr, int fq) const {
        const int row0 = u.pm * BM + wr * 64 + fr, col0 = u.pn * BM + wc * 32 + 4 * fq;
#pragma unroll
        for (int ai = 0; ai < 2; ++ai)
#pragma unroll
            for (int m = 0; m < 4; ++m) { float* rowp = C + (size_t)(row0 + ai * HALF + m * 16) * ldc + col0;
#pragma unroll
                for (int bj = 0; bj < 2; ++bj)
#pragma unroll
                    for (int n = 0; n < 2; ++n) *(f32x4*)(rowp + bj * HALF + n * 16) = acc[ai][bj][m][n]; }
    }
};
struct EpiBf16 {
    static constexpr bool PERM = true, AFTER_DRAIN = false;
    bf16_t* O; int ldc;
    __device__ __forceinline__ void operator()(const f32x4 (&acc)[2][2][4][2], const Unit& u, int wr, int wc, int fr, int fq) const {
        const int row0 = u.pm * BM + wr * 64 + fr; const int col0 = u.pn * BM + wc * 32 + 8 * fq;
#pragma unroll
        for (int ai = 0; ai < 2; ++ai)
#pragma unroll
            for (int m = 0; m < 4; ++m) { bf16_t* rowp = O + (size_t)(row0 + ai * HALF + m * 16) * ldc + col0;
#pragma unroll
                for (int bj = 0; bj < 2; ++bj) { const f32x4 v0 = acc[ai][bj][m][0], v1 = acc[ai][bj][m][1];
                    u32x4 w; w.x = cvt_pk_bf16(v0[0], v0[1]); w.y = cvt_pk_bf16(v0[2], v0[3]); w.z = cvt_pk_bf16(v1[0], v1[1]); w.w = cvt_pk_bf16(v1[2], v1[3]);
                    *(u32x4*)(rowp + bj * HALF) = w; } }
    }
};
struct EpiResid {
    static constexpr bool PERM = false, AFTER_DRAIN = false;
    float* X; int ldc; const float* gate;
    __device__ __forceinline__ void operator()(const f32x4 (&acc)[2][2][4][2], const Unit& u, int wr, int wc, int fr, int fq) const {
        const int row0 = u.pm * BM + wr * 64 + fr, col0 = u.pn * BM + wc * 32 + 4 * fq;
        const int cr = u.pm < 32 ? 0 : 1 + ((u.pm - 32) >> 2);
        const float* gp = gate + (size_t)cr * 12288 + col0;
        f32x4 gv[2][2];
#pragma unroll
        for (int bj = 0; bj < 2; ++bj)
#pragma unroll
            for (int n = 0; n < 2; ++n) gv[bj][n] = *(const f32x4*)(gp + bj * HALF + n * 16);
#pragma unroll
        for (int ai = 0; ai < 2; ++ai)
#pragma unroll
            for (int m = 0; m < 4; ++m) { float* rowp = X + (size_t)(row0 + ai * HALF + m * 16) * ldc + col0;
#pragma unroll
                for (int bj = 0; bj < 2; ++bj)
#pragma unroll
                    for (int n = 0; n < 2; ++n) { f32x4 x = *(const f32x4*)(rowp + bj * HALF + n * 16); x = x + gv[bj][n] * acc[ai][bj][m][n]; *(f32x4*)(rowp + bj * HALF + n * 16) = x; } }
    }
};
struct EpiSwiglu {
    static constexpr bool PERM = true, AFTER_DRAIN = false;
    bf16_t* O; int ldc;
    __device__ __forceinline__ void operator()(const f32x4 (&acc)[2][2][4][2], const Unit& u, int wr, int wc, int fr, int fq) const {
        const int row0 = u.pm * BM + wr * 64 + fr; const int col0 = u.pn * HALF + wc * 32 + 8 * fq;
#pragma unroll
        for (int ai = 0; ai < 2; ++ai)
#pragma unroll
            for (int m = 0; m < 4; ++m) { bf16_t* rowp = O + (size_t)(row0 + ai * HALF + m * 16) * ldc + col0;
                f32x4 v0, v1;
#pragma unroll
                for (int j = 0; j < 4; ++j) { v0[j] = silu_f(acc[ai][0][m][0][j]) * acc[ai][1][m][0][j]; v1[j] = silu_f(acc[ai][0][m][1][j]) * acc[ai][1][m][1][j]; }
                u32x4 w; w.x = cvt_pk_bf16(v0[0], v0[1]); w.y = cvt_pk_bf16(v0[2], v0[3]); w.z = cvt_pk_bf16(v1[0], v1[1]); w.w = cvt_pk_bf16(v1[2], v1[3]);
                *(u32x4*)rowp = w; }
    }
};


struct PanelOrder {
    int c;
    __device__ bool next(int i, Unit& u) const { if (i != 0 || c >= 256) return false; u.pm = c >> 3; u.pn = c & 7; u.k0 = 0; return true; }
    __device__ __forceinline__ void a_ready(const Unit&) const {}
    __device__ __forceinline__ void done(const Unit&) const {}
};
struct TailOrder {
    int c, kq;
    __device__ bool next(int i, Unit& u) const { if (i != 0 || c >= 256) return false; const int t = c >> 2; u.pm = 32 + (t >> 3); u.pn = t & 7; u.k0 = (c & 3) * kq; return true; }
    __device__ __forceinline__ void a_ready(const Unit&) const {}
    __device__ __forceinline__ void done(const Unit&) const {}
};
struct EpiPart {
    static constexpr bool PERM = false, AFTER_DRAIN = false;
    float* P; int kq;
    __device__ __forceinline__ void operator()(const f32x4 (&acc)[2][2][4][2], const Unit& u, int wr, int wc, int fr, int fq) const {
        const int row0 = (u.pm - 32) * BM + wr * 64 + fr, col0 = u.pn * BM + wc * 32 + 4 * fq;
        float* base = P + (size_t)(u.k0 / kq) * 2048 * 2048;
#pragma unroll
        for (int ai = 0; ai < 2; ++ai)
#pragma unroll
            for (int m = 0; m < 4; ++m) { float* rowp = base + (size_t)(row0 + ai * HALF + m * 16) * 2048 + col0;
#pragma unroll
                for (int bj = 0; bj < 2; ++bj)
#pragma unroll
                    for (int n = 0; n < 2; ++n) *(f32x4*)(rowp + bj * HALF + n * 16) = acc[ai][bj][m][n]; }
    }
};
template <class Epi, class Sched, bool ALIGN_EPI = false, bool SP2 = false>
__device__ __forceinline__ void gemm_phase(PG8_LAS unsigned char* lds, const Gemm g, const Sched& S, const Epi& E) {
    int tid_l = threadIdx.x; asm volatile("" : "+v"(tid_l)); const int tid = tid_l, wid = __builtin_amdgcn_readfirstlane(tid >> 6), lane = tid & 63, wr = wid >> 2, wc = wid & 3, fr = lane & 15, fq = lane >> 4;
    const int K = g.ld ? g.ld : g.K, nt = g.K / BK;
    unsigned voffA[2], voffB[2];
#pragma unroll
    for (int i = 0; i < 2; ++i) { int R, C; stage_rc(tid * 16 + i * 8192, R, C); const int Rb = Epi::PERM ? ((R & ~31) + perm32(R & 31)) : R;
        voffA[i] = (unsigned)(R * K + C) * 2u; voffB[i] = (unsigned)(Rb * K + C) * 2u; }
    const size_t kstep = (size_t)(BK * 2);
    const size_t hstep = (size_t)HALF * K * 2;
    const size_t tstep = 2 * hstep;
    const unsigned ldsw = (unsigned)wid * 1024u;
    const int aoff = lds_byte(wr * 64 + fr, fq * 8), boff = lds_byte(wc * 32 + fr, fq * 8);
#define PG8_SA(b, h) (((b) * 2 + (h)) * HTB)
#define PG8_SB(b, h) ((4 + (b) * 2 + (h)) * HTB)
#define PG8_STAGE(bufoff, gbase, voff) do { _Pragma("unroll") for (int _i = 0; _i < 2; ++_i) \
        __builtin_amdgcn_global_load_lds((const unsigned*)((const char*)(gbase) + (voff)[_i]), (PG8_LAS unsigned*)(lds + (bufoff) + ldsw + _i * 8192), 16, 0, 0); } while (0)
#define PG8_LDA(dst, b, h) do { _Pragma("unroll") for (int m = 0; m < 4; ++m) _Pragma("unroll") for (int k = 0; k < 2; ++k) dst[m][k] = *(const PG8_LAS bf16x8*)(lds + PG8_SA(b, h) + aoff + m * 2048 + k * 1024); } while (0)
#define PG8_LDB(dst, b, h) do { _Pragma("unroll") for (int n = 0; n < 2; ++n) _Pragma("unroll") for (int k = 0; k < 2; ++k) dst[n][k] = *(const PG8_LAS bf16x8*)(lds + PG8_SB(b, h) + boff + n * 2048 + k * 1024); } while (0)
#define PG8_MMA(ai, bj, At, Bt) do { __builtin_amdgcn_s_setprio(1); _Pragma("unroll") for (int m = 0; m < 4; ++m) _Pragma("unroll") for (int n = 0; n < 2; ++n) _Pragma("unroll") for (int k = 0; k < 2; ++k) \
        acc[ai][bj][m][n] = __builtin_amdgcn_mfma_f32_16x16x32_bf16(Bt[n][k], At[m][k], acc[ai][bj][m][n], 0, 0, 0); __builtin_amdgcn_s_setprio(0); } while (0)
#define PG8_WAIT_V(n) asm volatile("s_waitcnt vmcnt(" #n ")" ::: "memory")
#define PG8_WAIT_L(n) asm volatile("s_waitcnt lgkmcnt(" #n ")" ::: "memory")
#define PG8_BAR __builtin_amdgcn_s_barrier()
#define PG8_SCHED __builtin_amdgcn_sched_barrier(0)
    Unit cur, nxt; int ui = 0;
    if (!S.next(0, cur)) return;
    f32x4 acc[2][2][4][2];
#pragma unroll
    for (int a = 0; a < 2; ++a)
#pragma unroll
        for (int b = 0; b < 2; ++b)
#pragma unroll
            for (int m = 0; m < 4; ++m)
#pragma unroll
                for (int n = 0; n < 2; ++n) acc[a][b][m][n] = (f32x4){0.f, 0.f, 0.f, 0.f};
    bf16x8 At[4][2], B0[2][2], B1[2][2];
    const char* cA = (const char*)g.A + (size_t)cur.pm * tstep + (size_t)cur.k0 * 2; const char* cB = (const char*)g.Bt + (size_t)cur.pn * tstep + (size_t)cur.k0 * 2;
    S.a_ready(cur);
    if constexpr (SP2) {
        PG8_STAGE(PG8_SB(0, 0), cB, voffB); PG8_STAGE(PG8_SB(0, 1), cB + hstep, voffB); PG8_STAGE(PG8_SA(0, 0), cA, voffA); PG8_STAGE(PG8_SA(0, 1), cA + hstep, voffA);
        if (wr == 1) PG8_BAR;
        PG8_WAIT_V(2); PG8_BAR;
        PG8_STAGE(PG8_SB(1, 0), cB + kstep, voffB); PG8_STAGE(PG8_SA(1, 0), cA + kstep, voffA); PG8_STAGE(PG8_SB(1, 1), cB + hstep + kstep, voffB);
        PG8_WAIT_V(6); PG8_BAR;
    } else {
        PG8_STAGE(PG8_SB(0, 0), cB, voffB); PG8_STAGE(PG8_SA(0, 0), cA, voffA); PG8_STAGE(PG8_SB(0, 1), cB + hstep, voffB); PG8_STAGE(PG8_SA(0, 1), cA + hstep, voffA);
        if (wr == 1) PG8_BAR;
        PG8_WAIT_V(4); PG8_BAR;
        PG8_STAGE(PG8_SB(1, 0), cB + kstep, voffB); PG8_STAGE(PG8_SA(1, 0), cA + kstep, voffA); PG8_STAGE(PG8_SB(1, 1), cB + hstep + kstep, voffB);
        PG8_WAIT_V(6); PG8_BAR;
    }
    for (;;) {
        const bool has_next = S.next(ui + 1, nxt);
        const char* nA = has_next ? (const char*)g.A + (size_t)nxt.pm * tstep + (size_t)nxt.k0 * 2 : cA; const char* nB = has_next ? (const char*)g.Bt + (size_t)nxt.pn * tstep + (size_t)nxt.k0 * 2 : cB;
        for (int t = 0; t < nt; t += 2) {
            const bool last = (t == nt - 2);
            const char* a1 = cA + (size_t)(t + 1) * kstep;
            const char* a2 = last ? nA : cA + (size_t)(t + 2) * kstep; const char* b2 = last ? nB : cB + (size_t)(t + 2) * kstep;
            const char* a3 = a2 + kstep; const char* b3 = b2 + kstep;
            if (last && has_next) S.a_ready(nxt);
            if constexpr (SP2) {
            PG8_LDB(B0, 0, 0); PG8_LDB(B1, 0, 1); PG8_SCHED; PG8_LDA(At, 0, 0); PG8_STAGE(PG8_SA(1, 1), a1 + hstep, voffA);
            PG8_WAIT_V(8); PG8_WAIT_L(0); PG8_BAR; PG8_MMA(0, 0, At, B0); PG8_MMA(0, 1, At, B1); PG8_BAR; PG8_SCHED;
            PG8_LDA(At, 0, 1); PG8_STAGE(PG8_SB(0, 0), b2, voffB); PG8_STAGE(PG8_SB(0, 1), b2 + hstep, voffB); PG8_STAGE(PG8_SA(0, 0), a2, voffA);
            PG8_WAIT_V(8); PG8_WAIT_L(0); PG8_BAR; PG8_MMA(1, 0, At, B0); PG8_MMA(1, 1, At, B1); PG8_BAR; PG8_SCHED;
            PG8_LDB(B0, 1, 0); PG8_LDB(B1, 1, 1); PG8_SCHED; PG8_LDA(At, 1, 0); PG8_STAGE(PG8_SA(0, 1), a2 + hstep, voffA);
            PG8_WAIT_V(8); PG8_WAIT_L(0); PG8_BAR; PG8_MMA(0, 0, At, B0); PG8_MMA(0, 1, At, B1); PG8_BAR; PG8_SCHED;
            PG8_LDA(At, 1, 1); PG8_STAGE(PG8_SB(1, 0), b3, voffB); PG8_STAGE(PG8_SB(1, 1), b3 + hstep, voffB); PG8_STAGE(PG8_SA(1, 0), a3, voffA);
            PG8_WAIT_V(8); PG8_WAIT_L(0); PG8_BAR; PG8_MMA(1, 0, At, B0); PG8_MMA(1, 1, At, B1); PG8_BAR; PG8_SCHED;
            } else {
            PG8_LDB(B0, 0, 0); PG8_SCHED; PG8_LDA(At, 0, 0); PG8_STAGE(PG8_SA(1, 1), a1 + hstep, voffA);
            PG8_WAIT_L(8); PG8_BAR; PG8_WAIT_L(0); PG8_MMA(0, 0, At, B0); PG8_BAR; PG8_SCHED;
            PG8_LDB(B1, 0, 1); PG8_STAGE(PG8_SB(0, 0), b2, voffB);
            PG8_BAR; PG8_WAIT_L(0); PG8_MMA(0, 1, At, B1); PG8_BAR;
            PG8_LDA(At, 0, 1); PG8_STAGE(PG8_SA(0, 0), a2, voffA);
            PG8_BAR; PG8_WAIT_L(0); PG8_MMA(1, 0, At, B0); PG8_BAR; PG8_SCHED;
            PG8_STAGE(PG8_SB(0, 1), b2 + hstep, voffB);
            PG8_WAIT_V(6); PG8_BAR; PG8_MMA(1, 1, At, B1); PG8_BAR;
            PG8_LDB(B0, 1, 0); PG8_SCHED; PG8_LDA(At, 1, 0); PG8_STAGE(PG8_SA(0, 1), a2 + hstep, voffA);
            PG8_WAIT_L(8); PG8_BAR; PG8_WAIT_L(0); PG8_MMA(0, 0, At, B0); PG8_BAR; PG8_SCHED;
            PG8_LDB(B1, 1, 1); PG8_STAGE(PG8_SB(1, 0), b3, voffB);
            PG8_BAR; PG8_WAIT_L(0); PG8_MMA(0, 1, At, B1); PG8_BAR;
            PG8_LDA(At, 1, 1); PG8_STAGE(PG8_SA(1, 0), a3, voffA);
            PG8_BAR; PG8_WAIT_L(0); PG8_MMA(1, 0, At, B0); PG8_BAR; PG8_SCHED;
            PG8_STAGE(PG8_SB(1, 1), b3 + hstep, voffB);
            PG8_WAIT_V(6); PG8_BAR; PG8_MMA(1, 1, At, B1); PG8_BAR;
            }
        }
        if constexpr (ALIGN_EPI) { if (wr == 0) PG8_BAR; }
        if constexpr (!Epi::AFTER_DRAIN) { E(acc, cur, wr, wc, fr, fq); S.done(cur); }
        if (!has_next) break;
#pragma unroll
        for (int a = 0; a < 2; ++a)
#pragma unroll
            for (int b = 0; b < 2; ++b)
#pragma unroll
                for (int m = 0; m < 4; ++m)
#pragma unroll
                    for (int n = 0; n < 2; ++n) acc[a][b][m][n] = (f32x4){0.f, 0.f, 0.f, 0.f};
        cur = nxt; cA = nA; cB = nB; ++ui;
        if constexpr (ALIGN_EPI) { if (wr == 1) PG8_BAR; }
    }
    PG8_WAIT_V(0);
    if constexpr (!ALIGN_EPI) { if (wr == 0) PG8_BAR; }
    PG8_BAR;
    if constexpr (Epi::AFTER_DRAIN) { E.fused(acc, cur, wr, wc, fr, fq, lds, wid, lane); S.done(cur); }
#undef PG8_SA
#undef PG8_SB
#undef PG8_STAGE
#undef PG8_LDA
#undef PG8_LDB
#undef PG8_MMA
#undef PG8_WAIT_V
#undef PG8_WAIT_L
#undef PG8_BAR
#undef PG8_SCHED
}
}
#ifndef REP_LAT
#define REP_LAT 1
#endif
#ifndef REP_CTX
#define REP_CTX 1
#endif
constexpr int D = 2048, NCTX = 8192, M = 10240, MK = 10752, DEPTH = 4, NWAVES = 8;
constexpr int IN_W = 4960, IN_WP = 5120, FF = 5632;
constexpr int U_CQ = 0, U_CKV = 768, U_KR = 1280, U_GQKV = 1344, U_GZ = 1344 + 1536, U_GB = 1344 + 2048, U_GA = 1344 + 2056, U_SZ = 3408, U_SXBC = 3408 + 512, U_SDT = 3408 + 1536;
constexpr float EPS = 1e-6f;
constexpr int NPH_L = 11, NPHASES = 2 + DEPTH * NPH_L;
constexpr size_t O_YP = 0, O_YS = 16777216, O_CKV = 20971520, O_KR = 37748736, O_SG = 39845888, O_SS = 56623104;
constexpr size_t MiB = 1u << 20;
constexpr size_t WS_CTL = 0, CTL_ZERO_BYTES = 1 * MiB;
constexpr size_t WL_IN = 0, WL_UQ = WL_IN + (size_t)IN_WP * D * 2, WL_UKV = WL_UQ + (size_t)1536 * 768 * 2, WL_OUT = WL_UKV + (size_t)2048 * 512 * 2,
                 WL_GU = WL_OUT + (size_t)D * D * 2, WL_DN = WL_GU + (size_t)2 * FF * D * 2, WL_SIZE = WL_DN + (size_t)D * FF * 2;
constexpr size_t WS_W = 2 * MiB;
constexpr size_t WS_MODS = WS_W + 4 * WL_SIZE;
constexpr size_t WS_H = WS_MODS + 1 * MiB;
constexpr size_t WS_U = WS_H + (size_t)M * D * 2;
constexpr size_t WS_CQN = WS_U + (size_t)M * IN_WP * 4;
constexpr size_t WS_CKVN = WS_CQN + (size_t)M * 768 * 2;
constexpr size_t WS_QRAW = WS_CKVN + (size_t)MK * 512 * 2;
constexpr size_t WS_KN = WS_QRAW + (size_t)M * 1536 * 4;
constexpr size_t WS_VT = WS_KN + (size_t)MK * 1024 * 4;
constexpr size_t WS_QB = WS_VT + (size_t)1024 * MK * 2;
constexpr size_t WS_KB = WS_QB + (size_t)M * 1536 * 2;
constexpr size_t WS_GQ = WS_KB + (size_t)MK * 1536 * 2;
constexpr size_t WS_GBG = WS_GQ + (size_t)3 * M * 512 * 4;
constexpr size_t WS_GO = WS_GBG + (size_t)2 * M * 8 * 4;
constexpr size_t WS_XBC = WS_GO + (size_t)2 * M * 512 * 4;
constexpr size_t WS_SDT = WS_XBC + (size_t)M * 1024 * 4;
constexpr size_t WS_SY = WS_SDT + (size_t)2 * M * 16 * 4;
constexpr size_t WS_MIX = WS_SY + (size_t)2 * M * 512 * 4;
constexpr size_t WS_ACT = WS_MIX + (size_t)M * D * 2;
constexpr size_t WS_GCH = WS_ACT + (size_t)M * FF * 2;
constexpr size_t WS_SREC = WS_GCH + (size_t)1280 * 90368;
constexpr size_t WS_SSH = WS_SREC + (size_t)1280 * 66560;
constexpr size_t WS_PART = WS_SSH + (size_t)160 * 65536;
constexpr size_t WS_END = WS_PART + (size_t)4 * 2048 * 2048 * 4;
constexpr int CW_BAR = 4096;
constexpr int RING_BYTES = 131072, LDS_BYTES = 163840, LDSCTL_OFF = LDS_BYTES - 512, MISC_OFF = LDSCTL_OFF + 320;

#define GAS __attribute__((address_space(1)))
#define LAS __attribute__((address_space(3)))
typedef unsigned short bf16;
typedef unsigned v4u __attribute__((ext_vector_type(4)));
typedef unsigned v2u __attribute__((ext_vector_type(2)));
typedef float f32x4 __attribute__((ext_vector_type(4)));
typedef float f32x2 __attribute__((ext_vector_type(2)));
typedef short bf16x8 __attribute__((ext_vector_type(8)));
typedef GAS unsigned gu32;
#define RLX_AGENT __ATOMIC_RELAXED, __HIP_MEMORY_SCOPE_AGENT
#define MEMBAR() asm volatile("" ::: "memory")
#define LDS_WAIT() asm volatile("s_waitcnt lgkmcnt(0)" ::: "memory")
#define VM_WAIT() asm volatile("s_waitcnt vmcnt(0)" ::: "memory")
__device__ __forceinline__ unsigned f2bf(float f) { unsigned u = __builtin_bit_cast(unsigned, f); return (u + 0x7fffu + ((u >> 16) & 1u)) >> 16; }
__device__ __forceinline__ unsigned pk2(float lo, float hi) { return f2bf(lo) | (f2bf(hi) << 16); }
__device__ __forceinline__ float wave_sum(float v) {
#pragma unroll
    for (int o = 1; o < 64; o <<= 1) v += __shfl_xor(v, o);
    return v;
}
__device__ __forceinline__ float half_sum(float v) {
#pragma unroll
    for (int o = 1; o < 32; o <<= 1) v += __shfl_xor(v, o);
    return v;
}
__device__ __forceinline__ float silu(float x) { return x / (1.0f + expf(-x)); }
__device__ __forceinline__ float softplus(float x) { return x > 20.f ? x : log1pf(expf(x)); }

#define XB_TMO      128
#define XB_XCNT(j)  (256  + 64 * (j))
#define XB_XSUB(j)  (1280 + 64 * (j))
#define XB_XGEN(j)  (2304 + 64 * (j))
#define XB_TOP      3328
#define XB_TOPGEN   3392
#define XCD_BAR_WORDS 3456
#define XB_SPIN_CAP (1u << 18)

__device__ __forceinline__ unsigned xb_ld(unsigned* p)              { return __hip_atomic_load(p, __ATOMIC_RELAXED, __HIP_MEMORY_SCOPE_AGENT); }
__device__ __forceinline__ unsigned xb_add(unsigned* p, unsigned v) { return __hip_atomic_fetch_add(p, v, __ATOMIC_RELAXED, __HIP_MEMORY_SCOPE_AGENT); }
__device__ __forceinline__ unsigned xb_xcc_id() { return (unsigned)__builtin_amdgcn_s_getreg((3 << 11) | 20) & 0xFu; }
#define XB_SPIN(cond, bar) do { unsigned _sp = 0; while (cond) { __builtin_amdgcn_s_sleep(1); \
    if ((++_sp & 255u) == 0u) { if (xb_ld(&(bar)[XB_TMO])) break; if (_sp > XB_SPIN_CAP) { atomicAdd(&(bar)[XB_TMO], 1u); break; } } } } while (0)

struct XcdBarrier {
    unsigned* bar; unsigned x;
    volatile LAS unsigned* st;
};

__device__ __forceinline__ XcdBarrier xcd_barrier_post(unsigned* bar, volatile LAS unsigned* st) {
    XcdBarrier b; b.bar = bar; b.x = xb_xcc_id(); b.st = st;
    if (threadIdx.x == 0) (void)xb_add(&bar[XB_XCNT(b.x)], 1u);
    return b;
}
__device__ __forceinline__ void xcd_barrier_complete(unsigned* bar, unsigned x, unsigned& nloc, unsigned& nx) {
    const unsigned G = gridDim.x * gridDim.y * gridDim.z;
    unsigned sum, cnt, mine, sp = 0u;
    for (;;) {
        sum = 0u; cnt = 0u; mine = 0u;
#pragma unroll
        for (unsigned j = 0; j < 16; ++j) { const unsigned c = xb_ld(&bar[XB_XCNT(j)]); sum += c; cnt += (c > 0u) ? 1u : 0u; mine = (j == x) ? c : mine; }
        if (sum == G) break;
        __builtin_amdgcn_s_sleep(1);
        if ((++sp & 255u) == 0u) { if (xb_ld(&bar[XB_TMO])) break; if (sp > XB_SPIN_CAP) { atomicAdd(&bar[XB_TMO], 1u); break; } }
    }
    nloc = mine > 0u ? mine : 1u; nx = cnt > 0u ? cnt : 1u;
}

__device__ __forceinline__ void xcd_barrier(const XcdBarrier& b) {
    asm volatile("s_waitcnt vmcnt(0)" ::: "memory");
    __syncthreads();
    if (threadIdx.x == 0) {
        unsigned* bar = b.bar;
        __builtin_amdgcn_s_waitcnt(0);
        unsigned nloc = b.st[0], nx = b.st[1];
        if (nloc == 0u) { xcd_barrier_complete(bar, b.x, nloc, nx); b.st[0] = nloc; b.st[1] = nx; }
        const unsigned old = xb_add(&bar[XB_XSUB(b.x)], 1u);
        const unsigned gen = old / nloc;
        if (old + 1u == (gen + 1u) * nloc) {
            __builtin_amdgcn_fence(__ATOMIC_RELEASE, "agent");
            asm volatile("s_waitcnt vmcnt(0)" ::: "memory");
            const unsigned og = xb_add(&bar[XB_TOP], 1u);
            const unsigned tg = og / nx;
            if (og + 1u == (tg + 1u) * nx) xb_add(&bar[XB_TOPGEN], 1u);
            else XB_SPIN(xb_ld(&bar[XB_TOPGEN]) == tg, bar);
            __builtin_amdgcn_fence(__ATOMIC_ACQUIRE, "agent");
            xb_add(&bar[XB_XGEN(b.x)], 1u);
            asm volatile("s_waitcnt vmcnt(0)" ::: "memory");
        } else {
            XB_SPIN(xb_ld(&bar[XB_XGEN(b.x)]) == gen, bar);
            __builtin_amdgcn_fence(__ATOMIC_ACQUIRE, "agent");
            asm volatile("s_waitcnt vmcnt(0)" ::: "memory");
        }
    }
    __syncthreads();
}
struct Args { const float* in[32]; float* out; unsigned char* ws; int ph_lo, ph_hi; };
#define CAS __attribute__((address_space(4)))
typedef const float* const CAS* kin_t;
struct Ctx { kin_t in; float* out; unsigned char* ws; };

__device__ __forceinline__ void transpose_item(const float* __restrict__ W, int K, int N, bf16* WT, int k0, int n0, int drow0, LAS float* scr, int lane) {
#pragma unroll 8
    for (int i = 0; i < 32; ++i) { const int kk = 2 * i + (lane >> 5); scr[kk * 33 + (lane & 31)] = W[(size_t)(k0 + kk) * N + n0 + (lane & 31)]; }
    LDS_WAIT(); asm volatile("" ::: "memory");
    const int c = lane & 7;
#pragma unroll
    for (int j = 0; j < 4; ++j) { const int n = (lane >> 3) + 8 * j; const LAS float* s = scr + (8 * c) * 33 + n;
        v4u o; o.x = pk2(s[0 * 33], s[1 * 33]); o.y = pk2(s[2 * 33], s[3 * 33]); o.z = pk2(s[4 * 33], s[5 * 33]); o.w = pk2(s[6 * 33], s[7 * 33]);
        *(GAS v4u*)(WT + (size_t)(drow0 + n) * K + k0 + 8 * c) = o; }
    LDS_WAIT(); asm volatile("" ::: "memory");
}
constexpr size_t WLE_IN = 0, WLE_UQ = WLE_IN + (size_t)IN_WP * D, WLE_KV = WLE_UQ + (size_t)1536 * 768, WLE_OUT = WLE_KV + (size_t)2048 * 512,
                 WLE_GU = WLE_OUT + (size_t)D * D, WLE_DN = WLE_GU + (size_t)2 * FF * D, WLE_SIZE = WLE_DN + (size_t)D * FF;
static_assert(WLE_SIZE * 2 == WL_SIZE, "weight map");

__device__ __forceinline__ void ph_prologue(const Ctx& A, LAS unsigned char* lds, int tid, int lane, int wave, int vcu, int G) {
    const int gw = vcu * NWAVES + wave, NGW = G * NWAVES;
    LAS float* scr = (LAS float*)(lds + wave * 8704);
    constexpr int I_IN = 32 * 155, I_UQ = 12 * 48, I_KV = 8 * 64, I_OUT = 32 * 64, I_GU = 32 * 352, I_DN = 88 * 64, I_L = I_IN + I_UQ + I_KV + I_OUT + I_GU + I_DN;
    for (int it = gw; it < DEPTH * I_L; it += NGW) {
        const int l = it / I_L; int r = it - l * I_L;
        bf16* wl = (bf16*)(A.ws + WS_W) + (size_t)l * WLE_SIZE;
        if (r < I_IN) { const int kb = r / 155, nb = r - kb * 155; transpose_item(A.in[12] + (size_t)l * D * IN_W, D, IN_W, wl + WLE_IN, 64 * kb, 32 * nb, 32 * nb, scr, lane); continue; } r -= I_IN;
        if (r < I_UQ) { const int kb = r / 48, nb = r - kb * 48; transpose_item(A.in[15] + (size_t)l * 768 * 1536, 768, 1536, wl + WLE_UQ, 64 * kb, 32 * nb, 32 * nb, scr, lane); continue; } r -= I_UQ;
        if (r < I_KV) { const int kb = r / 64, nb = r - kb * 64; const int n0 = 32 * nb, hh = n0 >> 8, c = n0 & 255; const int dr = (c < 128 ? 0 : 1024) + hh * 128 + (c & 127);
                        transpose_item(A.in[17] + (size_t)l * 512 * 2048, 512, 2048, wl + WLE_KV, 64 * kb, n0, dr, scr, lane); continue; } r -= I_KV;
        if (r < I_OUT) { const int kb = r / 64, nb = r - kb * 64; transpose_item(A.in[13] + (size_t)l * D * D, D, D, wl + WLE_OUT, 64 * kb, 32 * nb, 32 * nb, scr, lane); continue; } r -= I_OUT;
        if (r < I_GU) { const int kb = r / 352, nb = r - kb * 352; const int n0 = 32 * nb; int dr; if (n0 < FF) dr = (n0 >> 7) * 256 + (n0 & 127); else { const int n1 = n0 - FF; dr = (n1 >> 7) * 256 + 128 + (n1 & 127); }
                        transpose_item(A.in[30] + (size_t)l * D * 2 * FF, D, 2 * FF, wl + WLE_GU, 64 * kb, n0, dr, scr, lane); continue; } r -= I_GU;
        { const int kb = r / 64, nb = r - kb * 64; transpose_item(A.in[31] + (size_t)l * FF * D, FF, D, wl + WLE_DN, 64 * kb, 32 * nb, 32 * nb, scr, lane); }
    }
    { const int gt = vcu * 512 + tid, NGT = G * 512;
      for (int i = gt; i < DEPTH * 40960; i += NGT) { const int l = i / 40960, r = i - l * 40960; *(GAS v4u*)((bf16*)(A.ws + WS_W) + (size_t)l * WLE_SIZE + WLE_IN + (size_t)IN_W * D + (size_t)r * 8) = (v4u){0u, 0u, 0u, 0u}; }
      const f32x4* xp = (const f32x4*)A.in[0]; const f32x4* xs = (const f32x4*)A.in[1]; f32x4* o = (f32x4*)A.out;
      for (int i = gt; i < 4194304; i += NGT) o[i] = xp[i];
      for (int i = gt; i < 1048576; i += NGT) o[4194304 + i] = xs[i]; }
    LAS float* scond = (LAS float*)(lds + 81920);
    LAS float* red = (LAS float*)(lds + 81920 + 24576);
    for (int i = tid; i < 3 * 2048; i += 512) { const int r = i >> 11, k = i & 2047; const float c = r == 0 ? A.in[7][k] : A.in[6][(r - 1) * 2048 + k]; scond[i] = silu(c); }
    __syncthreads();
    float* mods = (float*)(A.ws + WS_MODS);
    for (int item = vcu; item < 384; item += G) {
        const int l = item / 96, j0 = (item - l * 96) * 128;
        const float* w = A.in[10] + (size_t)l * 2048 * 12288 + j0 + 2 * lane;
        float a0x = 0, a0y = 0, a1x = 0, a1y = 0, a2x = 0, a2y = 0;
        const int kbeg = wave * 256;
#pragma unroll 8
        for (int k = kbeg; k < kbeg + 256; ++k) { const f32x2 v = *(const f32x2*)(w + (size_t)k * 12288); const float c0 = scond[k], c1 = scond[2048 + k], c2 = scond[4096 + k];
            a0x += c0 * v.x; a0y += c0 * v.y; a1x += c1 * v.x; a1y += c1 * v.y; a2x += c2 * v.x; a2y += c2 * v.y; }
        red[(wave * 3 + 0) * 128 + 2 * lane] = a0x; red[(wave * 3 + 0) * 128 + 2 * lane + 1] = a0y;
        red[(wave * 3 + 1) * 128 + 2 * lane] = a1x; red[(wave * 3 + 1) * 128 + 2 * lane + 1] = a1y;
        red[(wave * 3 + 2) * 128 + 2 * lane] = a2x; red[(wave * 3 + 2) * 128 + 2 * lane + 1] = a2y;
        __syncthreads();
        if (tid < 384) { const int r = tid >> 7, j = tid & 127; float s = 0.f;
#pragma unroll
            for (int w8 = 0; w8 < 8; ++w8) s += red[(w8 * 3 + r) * 128 + j];
            mods[(size_t)(l * 3 + r) * 12288 + j0 + j] = s + A.in[11][(size_t)l * 12288 + j0 + j]; }
        __syncthreads();
    }
}

__device__ __forceinline__ void ph_norm(float* X_, const float* g_, const float* mods_l_, int shift_idx, bf16* H_, const float* part_, const float* pgate_, int lane, int gw, int NGW) {
    GAS float* X = (GAS float*)X_; const GAS float* g = (const GAS float*)g_; const GAS float* mods_l = (const GAS float*)mods_l_; GAS bf16* H = (GAS bf16*)H_;
    const GAS float* part = (const GAS float*)part_; const GAS float* pgate = (const GAS float*)pgate_;
    constexpr size_t PS = (size_t)2048 * 2048;
    for (int m = gw; m < M; m += NGW) {
        const int cr = m < NCTX ? 0 : 1 + ((m - NCTX) >> 10);
        GAS f32x4* xr = (GAS f32x4*)(X + (size_t)m * D) + lane;
        f32x4 v[8]; float ss = 0.f;
#pragma unroll
        for (int j = 0; j < 8; ++j) v[j] = xr[64 * j];
        if (part_ != nullptr && m >= NCTX) {
            const GAS f32x4* pp = (const GAS f32x4*)(part + (size_t)(m - NCTX) * 2048) + lane; const GAS f32x4* gp = (const GAS f32x4*)(pgate + (size_t)cr * 12288) + lane;
#pragma unroll
            for (int j = 0; j < 8; ++j) { const f32x4 p = (pp[64 * j] + pp[PS / 4 + 64 * j]) + (pp[2 * (PS / 4) + 64 * j] + pp[3 * (PS / 4) + 64 * j]); v[j] = v[j] + gp[64 * j] * p; xr[64 * j] = v[j]; } }
#pragma unroll
        for (int j = 0; j < 8; ++j) ss += (v[j].x * v[j].x + v[j].y * v[j].y) + (v[j].z * v[j].z + v[j].w * v[j].w);
        const float rstd = 1.0f / sqrtf(wave_sum(ss) * (1.0f / D) + EPS);
        const GAS float* sh = mods_l + (size_t)cr * 12288 + shift_idx * 2048; const GAS float* sc = sh + 2048;
#pragma unroll
        for (int j = 0; j < 8; ++j) { const int c = 4 * lane + 256 * j; const f32x4 g4 = *(const GAS f32x4*)(g + c), s4 = *(const GAS f32x4*)(sc + c), h4 = *(const GAS f32x4*)(sh + c);
            const f32x4 o = v[j] * rstd * g4 * (s4 + 1.0f) + h4; v2u w; w.x = pk2(o.x, o.y); w.y = pk2(o.z, o.w); *(GAS v2u*)(H + (size_t)m * D + c) = w; }
    }
}
__device__ __forceinline__ void ph_final(float* X_, const float* part_, const float* pgate_, int lane, int gw, int NGW) {
    GAS float* X = (GAS float*)X_; const GAS float* part = (const GAS float*)part_; const GAS float* pgate = (const GAS float*)pgate_;
    constexpr size_t PS = (size_t)2048 * 2048;
    for (int m = NCTX + gw; m < M; m += NGW) {
        const int cr = 1 + ((m - NCTX) >> 10);
        GAS f32x4* xr = (GAS f32x4*)(X + (size_t)m * D) + lane;
        const GAS f32x4* pp = (const GAS f32x4*)(part + (size_t)(m - NCTX) * 2048) + lane; const GAS f32x4* gp = (const GAS f32x4*)(pgate + (size_t)cr * 12288) + lane;
#pragma unroll
        for (int j = 0; j < 8; ++j) { const f32x4 p = (pp[64 * j] + pp[PS / 4 + 64 * j]) + (pp[2 * (PS / 4) + 64 * j] + pp[3 * (PS / 4) + 64 * j]); xr[64 * j] = xr[64 * j] + gp[64 * j] * p; }
    }
}

__device__ __forceinline__ void ph_prep(const Ctx& A, int l, int lane, int gw, int NGW) {
    const float* U = (const float*)(A.ws + WS_U);
    bf16* CQN = (bf16*)(A.ws + WS_CQN); bf16* CKVN = (bf16*)(A.ws + WS_CKVN);
    float* GQ = (float*)(A.ws + WS_GQ); float* GK = GQ + (size_t)M * 512; float* GV = GK + (size_t)M * 512;
    float* GBETA = (float*)(A.ws + WS_GBG); float* GG = GBETA + (size_t)M * 8;
    float* XBC = (float*)(A.ws + WS_XBC); float* SDT = (float*)(A.ws + WS_SDT); float* SDA = SDT + (size_t)M * 16;
    const float* qn_g = A.in[14] + l * 768; const float* kvn_g = A.in[16] + l * 512;
    const float* gconv = A.in[20] + (size_t)l * 5 * 1536; const float* sconv = A.in[24] + (size_t)l * 5 * 1024; const float* sconvb = A.in[25] + l * 1024;
    for (int m = gw; m < MK; m += NGW) {
        if (m >= M) {
            const int j = m - M, b = j >> 8, t = j & 255; const float* src = A.in[2] + ((size_t)(b * 4 + l) * 256 + t) * 512;
#pragma unroll
            for (int i = 0; i < 2; ++i) { const int c = 4 * lane + 256 * i; const f32x4 v = *(const f32x4*)(src + c); v2u w; w.x = pk2(v.x, v.y); w.y = pk2(v.z, v.w); *(GAS v2u*)(CKVN + (size_t)m * 512 + c) = w; }
            continue;
        }
        const bool ctx = m < NCTX; const int t = ctx ? (m & 255) : ((m - NCTX) & 1023), T = ctx ? 256 : 1024;
        const float* u = U + (size_t)m * IN_WP;
        { f32x4 v[3]; float ss = 0.f;
#pragma unroll
          for (int i = 0; i < 3; ++i) { v[i] = *(const f32x4*)(u + U_CQ + 4 * lane + 256 * i); ss += (v[i].x * v[i].x + v[i].y * v[i].y) + (v[i].z * v[i].z + v[i].w * v[i].w); }
          const float rstd = 1.0f / sqrtf(wave_sum(ss) * (1.0f / 768.f) + EPS);
#pragma unroll
          for (int i = 0; i < 3; ++i) { const int c = 4 * lane + 256 * i; const f32x4 o = v[i] * rstd * *(const f32x4*)(qn_g + c); v2u w; w.x = pk2(o.x, o.y); w.y = pk2(o.z, o.w); *(GAS v2u*)(CQN + (size_t)m * 768 + c) = w; } }
        { f32x4 v[2]; float ss = 0.f;
#pragma unroll
          for (int i = 0; i < 2; ++i) { v[i] = *(const f32x4*)(u + U_CKV + 4 * lane + 256 * i); ss += (v[i].x * v[i].x + v[i].y * v[i].y) + (v[i].z * v[i].z + v[i].w * v[i].w); }
          const float rstd = 1.0f / sqrtf(wave_sum(ss) * (1.0f / 512.f) + EPS);
          const int b = m >> 8;
#pragma unroll
          for (int i = 0; i < 2; ++i) { const int c = 4 * lane + 256 * i; const f32x4 o = v[i] * rstd * *(const f32x4*)(kvn_g + c); v2u w; w.x = pk2(o.x, o.y); w.y = pk2(o.z, o.w); *(GAS v2u*)(CKVN + (size_t)m * 512 + c) = w;
              if (ctx) *(f32x4*)(A.out + O_CKV + ((size_t)(b * 4 + l) * 256 + t) * 512 + c) = o; }
          if (ctx) A.out[O_KR + ((size_t)(b * 4 + l) * 256 + t) * 64 + lane] = u[U_KR + lane]; }
        {
#pragma unroll
          for (int i = 0; i < 6; ++i) { const int c = 4 * lane + 256 * i; f32x4 acc = (f32x4){0.f, 0.f, 0.f, 0.f};
#pragma unroll
              for (int j = 0; j < 5; ++j) { const int tt = t + j - 2; if (tt >= 0 && tt < T) acc += *(const f32x4*)(gconv + j * 1536 + c) * *(const f32x4*)(u + (ptrdiff_t)(j - 2) * IN_WP + U_GQKV + c); }
              acc.x = silu(acc.x); acc.y = silu(acc.y); acc.z = silu(acc.z); acc.w = silu(acc.w);
              if (i < 4) { const float ss = half_sum((acc.x * acc.x + acc.y * acc.y) + (acc.z * acc.z + acc.w * acc.w)); acc = acc * (1.0f / sqrtf(ss + EPS)); }
              float* dst = i < 2 ? GQ + (size_t)m * 512 + c : (i < 4 ? GK + (size_t)m * 512 + (c - 512) : GV + (size_t)m * 512 + (c - 1024));
              *(f32x4*)dst = acc; }
          if (lane < 8) { const float bi = u[U_GB + lane], ai = u[U_GA + lane]; GBETA[(size_t)m * 8 + lane] = 1.0f / (1.0f + expf(-bi));
              GG[(size_t)m * 8 + lane] = -expf(A.in[21][l * 8 + lane]) * softplus(ai + A.in[22][l * 8 + lane]); } }
        {
#pragma unroll
          for (int i = 0; i < 4; ++i) { const int c = 4 * lane + 256 * i; f32x4 acc = *(const f32x4*)(sconvb + c);
#pragma unroll
              for (int j = 0; j < 5; ++j) { const int tt = t + j - 2; if (tt >= 0 && tt < T) acc += *(const f32x4*)(sconv + j * 1024 + c) * *(const f32x4*)(u + (ptrdiff_t)(j - 2) * IN_WP + U_SXBC + c); }
              acc.x = silu(acc.x); acc.y = silu(acc.y); acc.z = silu(acc.z); acc.w = silu(acc.w);
              *(f32x4*)(XBC + (size_t)m * 1024 + c) = acc; }
          if (lane < 16) { const float dt = softplus(u[U_SDT + lane] + A.in[27][l * 16 + lane]); SDT[(size_t)m * 16 + lane] = dt; SDA[(size_t)m * 16 + lane] = -expf(A.in[26][l * 16 + lane]) * dt; } }
    }
}

__device__ __forceinline__ void ph_finalize(const Ctx& A, int l, int lane, int gw, int NGW) {
    const float* U = (const float*)(A.ws + WS_U); const float* QRAW = (const float*)(A.ws + WS_QRAW); const float* KN = (const float*)(A.ws + WS_KN);
    bf16* QB = (bf16*)(A.ws + WS_QB); bf16* KB = (bf16*)(A.ws + WS_KB);
    const float* q_g = A.in[18] + l * 192; const float* k_g = A.in[19] + l * 192;
    const float QS = 0.07216878364870322f * 1.4426950408889634f;
    const float inv_f = powf(10000.f, -(float)(lane & 15) * (1.0f / 16.f));
    const float qg0 = q_g[lane], qg1 = q_g[64 + lane], qg2 = q_g[128 + lane], kg0 = k_g[lane], kg1 = k_g[64 + lane], kg2 = k_g[128 + lane];
    for (int m = gw; m < MK; m += NGW) {
        const bool fresh = m < M, latent = fresh && m >= NCTX;
        float cs = 1.f, sn = 0.f;
        if (latent) { const int t = (m - NCTX) & 1023; const float pos = (float)((lane >> 5) ? (t & 63) : (t >> 6)); const float ang = pos * inv_f; cs = cosf(ang); sn = sinf(ang); }
        const bool hi = (lane >> 4) & 1;
        const float* krp = fresh ? U + (size_t)m * IN_WP + U_KR : A.in[3] + ((size_t)(((m - M) >> 8) * 4 + l) * 256 + ((m - M) & 255)) * 64;
        const float kr_raw = krp[lane];
        for (int h = 0; h < 8; ++h) {
            if (fresh) { const float* q = QRAW + (size_t)m * 1536 + h * 192; float x0 = q[lane], x1 = q[64 + lane], x2 = q[128 + lane];
                const float rstd = 1.0f / sqrtf(wave_sum(x0 * x0 + x1 * x1 + x2 * x2) * (1.0f / 192.f) + EPS);
                x0 *= rstd * qg0; x1 *= rstd * qg1; x2 *= rstd * qg2;
                if (latent) { const float p = __shfl_xor(x2, 16); x2 = hi ? x2 * cs + p * sn : x2 * cs - p * sn; }
                bf16* dst = QB + ((size_t)m * 8 + h) * 192; dst[lane] = (bf16)f2bf(x0 * QS); dst[64 + lane] = (bf16)f2bf(x1 * QS); dst[128 + lane] = (bf16)f2bf(x2 * QS); }
            { const float* kn = KN + (size_t)m * 1024 + h * 128; float x0 = kn[lane], x1 = kn[64 + lane], x2 = kr_raw;
                const float rstd = 1.0f / sqrtf(wave_sum(x0 * x0 + x1 * x1 + x2 * x2) * (1.0f / 192.f) + EPS);
                x0 *= rstd * kg0; x1 *= rstd * kg1; x2 *= rstd * kg2;
                if (latent) { const float p = __shfl_xor(x2, 16); x2 = hi ? x2 * cs + p * sn : x2 * cs - p * sn; }
                bf16* dst = KB + ((size_t)m * 8 + h) * 192; dst[lane] = (bf16)f2bf(x0); dst[64 + lane] = (bf16)f2bf(x1); dst[128 + lane] = (bf16)f2bf(x2); }
        }
    }
}

__device__ __forceinline__ void attn_item(const bf16* QB_, const bf16* KB_, const bf16* VT_, bf16* MIX_, int qrow0, int h, int mkA, int nA, int mkB, int nB, LAS unsigned char* plds, int lane) {
    const GAS bf16* QB = (const GAS bf16*)QB_; const GAS bf16* KB = (const GAS bf16*)KB_; const GAS bf16* VT = (const GAS bf16*)VT_; GAS bf16* MIX = (GAS bf16*)MIX_;
    const int fr = lane & 15, fq = lane >> 4;
    bf16x8 qf[6];
#pragma unroll
    for (int d = 0; d < 6; ++d) qf[d] = *(const GAS bf16x8*)(QB + ((size_t)(qrow0 + fr) * 8 + h) * 192 + d * 32 + fq * 8);
    f32x4 o[8];
#pragma unroll
    for (int i = 0; i < 8; ++i) o[i] = (f32x4){0.f, 0.f, 0.f, 0.f};
    float mrow[4] = {-1e30f, -1e30f, -1e30f, -1e30f}, lrow[4] = {0.f, 0.f, 0.f, 0.f};
    const int ntA = nA >> 5, nt = (nA + nB) >> 5;
    bf16x8 kf[12];
    { const GAS bf16* kp0 = KB + ((size_t)(mkA + fr) * 8 + h) * 192 + fq * 8;
#pragma unroll
      for (int d = 0; d < 6; ++d) { kf[d] = *(const GAS bf16x8*)(kp0 + d * 32); kf[6 + d] = *(const GAS bf16x8*)(kp0 + (size_t)16 * 8 * 192 + d * 32); } }
    MEMBAR();
#pragma unroll 1
    for (int ti = 0; ti < nt; ++ti) {
        const int mk = (ti < ntA) ? mkA + ti * 32 : mkB + (ti - ntA) * 32;
        f32x4 s0 = (f32x4){0.f, 0.f, 0.f, 0.f}, s1 = s0;
#pragma unroll
        for (int d = 0; d < 6; ++d) { s0 = __builtin_amdgcn_mfma_f32_16x16x32_bf16(qf[d], kf[d], s0, 0, 0, 0); s1 = __builtin_amdgcn_mfma_f32_16x16x32_bf16(qf[d], kf[6 + d], s1, 0, 0, 0); }
        bf16x8 vf[8];
#pragma unroll
        for (int i = 0; i < 8; ++i) vf[i] = *(const GAS bf16x8*)(VT + (size_t)(h * 128 + i * 16 + fr) * MK + mk + fq * 8);
        if (ti + 1 < nt) { const int mkn = (ti + 1 < ntA) ? mkA + (ti + 1) * 32 : mkB + (ti + 1 - ntA) * 32; const GAS bf16* kp0 = KB + ((size_t)(mkn + fr) * 8 + h) * 192 + fq * 8;
#pragma unroll
            for (int d = 0; d < 6; ++d) { kf[d] = *(const GAS bf16x8*)(kp0 + d * 32); kf[6 + d] = *(const GAS bf16x8*)(kp0 + (size_t)16 * 8 * 192 + d * 32); } }
        MEMBAR();
        float al[4];
#pragma unroll
        for (int r = 0; r < 4; ++r) { float v = fmaxf(s0[r], s1[r]);
            v = fmaxf(v, __shfl_xor(v, 1)); v = fmaxf(v, __shfl_xor(v, 2)); v = fmaxf(v, __shfl_xor(v, 4)); v = fmaxf(v, __shfl_xor(v, 8));
            const float mnew = fmaxf(mrow[r], v); al[r] = exp2f(mrow[r] - mnew); mrow[r] = mnew;
            s0[r] = exp2f(s0[r] - mnew); s1[r] = exp2f(s1[r] - mnew); lrow[r] = lrow[r] * al[r] + s0[r] + s1[r]; }
#pragma unroll
        for (int i = 0; i < 8; ++i) { o[i][0] *= al[0]; o[i][1] *= al[1]; o[i][2] *= al[2]; o[i][3] *= al[3]; }
#pragma unroll
        for (int r = 0; r < 4; ++r) { *(LAS bf16*)(plds + (4 * fq + r) * 64 + fr * 2) = (bf16)f2bf(s0[r]); *(LAS bf16*)(plds + (4 * fq + r) * 64 + 32 + fr * 2) = (bf16)f2bf(s1[r]); }
        asm volatile("s_waitcnt lgkmcnt(0)" ::: "memory");
        const bf16x8 pf = *(const LAS bf16x8*)(plds + fr * 64 + fq * 16);
        asm volatile("s_waitcnt lgkmcnt(0)" ::: "memory");
#pragma unroll
        for (int i = 0; i < 8; ++i) o[i] = __builtin_amdgcn_mfma_f32_16x16x32_bf16(pf, vf[i], o[i], 0, 0, 0);
    }
#pragma unroll
    for (int r = 0; r < 4; ++r) { float lt = lrow[r]; lt += __shfl_xor(lt, 1); lt += __shfl_xor(lt, 2); lt += __shfl_xor(lt, 4); lt += __shfl_xor(lt, 8);
        const float inv = 1.0f / lt; GAS bf16* dst = MIX + (size_t)(qrow0 + 4 * fq + r) * D + h * 128 + fr;
#pragma unroll
        for (int i = 0; i < 8; ++i) dst[i * 16] = (bf16)f2bf(o[i][r] * inv); }
}
constexpr int AT_KROW = 400, AT_KBYTES = 32 * AT_KROW, AT_VBYTES = 128 * 64, AT_BUF = AT_KBYTES + AT_VBYTES;
__device__ __forceinline__ void attn_wg_item(const bf16* QB_, const bf16* KB_, const bf16* VT_, bf16* MIX_, int qrow0, int h, int mkA, int nA, int mkB, int nB, LAS unsigned char* lds, int tid, int lane, int wave) {
    const GAS bf16* QB = (const GAS bf16*)QB_; const GAS bf16* KB = (const GAS bf16*)KB_; const GAS bf16* VT = (const GAS bf16*)VT_; GAS bf16* MIX = (GAS bf16*)MIX_;
    const int fr = lane & 15, fq = lane >> 4;
    LAS unsigned char* plds = lds + 2 * AT_BUF + wave * 1024;
    const int qr = qrow0 + wave * 16;
    bf16x8 qf[6];
#pragma unroll
    for (int d = 0; d < 6; ++d) qf[d] = *(const GAS bf16x8*)(QB + ((size_t)(qr + fr) * 8 + h) * 192 + d * 32 + fq * 8);
    f32x4 o[8];
#pragma unroll
    for (int i = 0; i < 8; ++i) o[i] = (f32x4){0.f, 0.f, 0.f, 0.f};
    float mrow[4] = {-1e30f, -1e30f, -1e30f, -1e30f}, lrow[4] = {0.f, 0.f, 0.f, 0.f};
    const int ntA = nA >> 5, nt = (nA + nB) >> 5;
    const int kr0 = tid / 24, kc0 = tid % 24, kr1 = (512 + tid) / 24, kc1 = (512 + tid) % 24, vr = tid >> 2, vc = tid & 3;
    v4u sk0, sk1, sv;
#define AT_LOAD(mk_) do { sk0 = *(const GAS v4u*)(KB + ((size_t)((mk_) + kr0) * 8 + h) * 192 + kc0 * 8); \
        if (tid < 256) sk1 = *(const GAS v4u*)(KB + ((size_t)((mk_) + kr1) * 8 + h) * 192 + kc1 * 8); \
        sv = *(const GAS v4u*)(VT + (size_t)(h * 128 + vr) * MK + (mk_) + vc * 8); } while (0)
#define AT_STORE(buf_) do { LAS unsigned char* bb_ = lds + (buf_) * AT_BUF; *(LAS v4u*)(bb_ + kr0 * AT_KROW + kc0 * 16) = sk0; \
        if (tid < 256) *(LAS v4u*)(bb_ + kr1 * AT_KROW + kc1 * 16) = sk1; \
        *(LAS v4u*)(bb_ + AT_KBYTES + vr * 64 + vc * 16) = sv; } while (0)
    __syncthreads();
    AT_LOAD(mkA); AT_STORE(0);
    __syncthreads();
#pragma unroll 1
    for (int ti = 0; ti < nt; ++ti) {
        const int cur = ti & 1;
        if (ti + 1 < nt) { const int mkn = (ti + 1 < ntA) ? mkA + (ti + 1) * 32 : mkB + (ti + 1 - ntA) * 32; AT_LOAD(mkn); }
        MEMBAR();
        const LAS unsigned char* kb_ = lds + cur * AT_BUF; const LAS unsigned char* vb_ = kb_ + AT_KBYTES;
        f32x4 s0 = (f32x4){0.f, 0.f, 0.f, 0.f}, s1 = s0;
#pragma unroll
        for (int d = 0; d < 6; ++d) { const bf16x8 k0 = *(const LAS bf16x8*)(kb_ + fr * AT_KROW + d * 64 + fq * 16), k1 = *(const LAS bf16x8*)(kb_ + (16 + fr) * AT_KROW + d * 64 + fq * 16);
            s0 = __builtin_amdgcn_mfma_f32_16x16x32_bf16(qf[d], k0, s0, 0, 0, 0); s1 = __builtin_amdgcn_mfma_f32_16x16x32_bf16(qf[d], k1, s1, 0, 0, 0); }
        float al[4];
#pragma unroll
        for (int r = 0; r < 4; ++r) { float v = fmaxf(s0[r], s1[r]);
            v = fmaxf(v, __shfl_xor(v, 1)); v = fmaxf(v, __shfl_xor(v, 2)); v = fmaxf(v, __shfl_xor(v, 4)); v = fmaxf(v, __shfl_xor(v, 8));
            const float mnew = fmaxf(mrow[r], v); al[r] = exp2f(mrow[r] - mnew); mrow[r] = mnew;
            s0[r] = exp2f(s0[r] - mnew); s1[r] = exp2f(s1[r] - mnew); lrow[r] = lrow[r] * al[r] + s0[r] + s1[r]; }
#pragma unroll
        for (int i = 0; i < 8; ++i) { o[i][0] *= al[0]; o[i][1] *= al[1]; o[i][2] *= al[2]; o[i][3] *= al[3]; }
#pragma unroll
        for (int r = 0; r < 4; ++r) { *(LAS bf16*)(plds + (4 * fq + r) * 64 + fr * 2) = (bf16)f2bf(s0[r]); *(LAS bf16*)(plds + (4 * fq + r) * 64 + 32 + fr * 2) = (bf16)f2bf(s1[r]); }
        asm volatile("s_waitcnt lgkmcnt(0)" ::: "memory");
        const bf16x8 pf = *(const LAS bf16x8*)(plds + fr * 64 + fq * 16);
#pragma unroll
        for (int i = 0; i < 8; ++i) { const bf16x8 vf = *(const LAS bf16x8*)(vb_ + (i * 16 + fr) * 64 + fq * 16); o[i] = __builtin_amdgcn_mfma_f32_16x16x32_bf16(pf, vf, o[i], 0, 0, 0); }
        if (ti + 1 < nt) AT_STORE(cur ^ 1);
        __syncthreads();
    }
#undef AT_LOAD
#undef AT_STORE
#pragma unroll
    for (int r = 0; r < 4; ++r) { float lt = lrow[r]; lt += __shfl_xor(lt, 1); lt += __shfl_xor(lt, 2); lt += __shfl_xor(lt, 4); lt += __shfl_xor(lt, 8);
        const float inv = 1.0f / lt; GAS bf16* dst = MIX + (size_t)(qr + 4 * fq + r) * D + h * 128 + fr;
#pragma unroll
        for (int i = 0; i < 8; ++i) dst[i * 16] = (bf16)f2bf(o[i][r] * inv); }
}
__device__ __forceinline__ void ph_attn(const Ctx& A, LAS unsigned char* lds, int tid, int lane, int wave, int vcu, int G) {
    const bf16* QB = (const bf16*)(A.ws + WS_QB); const bf16* KB = (const bf16*)(A.ws + WS_KB); const bf16* VT = (const bf16*)(A.ws + WS_VT); bf16* MIX = (bf16*)(A.ws + WS_MIX);
    for (int slot = vcu; slot < 256; slot += G) {
        if (slot < 128) { const int b = slot >> 6, h = (slot >> 3) & 7, qb = slot & 7;
            attn_wg_item(QB, KB, VT, MIX, NCTX + b * 1024 + qb * 128, h, M + b * 256, 256, NCTX + b * 1024, 1024, lds, tid, lane, wave); }
        else { for (int i = 0; i < 4; ++i) { const int wgi = (slot - 128) * 4 + i, b = wgi >> 4, h = (wgi >> 1) & 7, qb = wgi & 1;
                attn_wg_item(QB, KB, VT, MIX, b * 256 + qb * 128, h, b * 256, 256, 0, 0, lds, tid, lane, wave); } }
    }
}

__device__ __forceinline__ void ph_gdn_scan(const Ctx& A, int l, LAS unsigned char* lds, int tid, int vcu, int G) {
    const float* GQ = (const float*)(A.ws + WS_GQ); const float* GK = GQ + (size_t)M * 512; const float* GV = GK + (size_t)M * 512;
    const float* GBETA = (const float*)(A.ws + WS_GBG); const float* GG = GBETA + (size_t)M * 8; float* GO = (float*)(A.ws + WS_GO);
    const int grp = tid >> 7, j = tid & 127;
    const int item = grp * G + vcu;
    const bool active = item < 272;
    int T = 0, row0 = 0, h = 0, dir = 0, b = 0; bool lat = false;
    if (active) { if (item < 256) { b = item >> 3; h = (item >> 1) & 3; dir = item & 1; T = 256; row0 = b * 256; }
                  else { const int q = item - 256; b = q >> 3; h = (q >> 1) & 3; dir = q & 1; T = 1024; row0 = NCTX + b * 1024; lat = true; } }
    int Tmax = 0;
    for (int p = 0; p < 4; ++p) { const int it = p * G + vcu; if (it < 272) { const int tt = it < 256 ? 256 : 1024; Tmax = tt > Tmax ? tt : Tmax; } }
    float S[128];
    if (lat) { const float* s0 = A.in[4] + ((size_t)(((b * 4 + l) * 2 + dir) * 4 + h) * 128) * 128 + j;
#pragma unroll
        for (int i = 0; i < 128; ++i) S[i] = s0[(size_t)i * 128]; }
    else {
#pragma unroll
        for (int i = 0; i < 128; ++i) S[i] = 0.f; }
    LAS float* sk = (LAS float*)(lds + grp * 24832); LAS float* sq = sk + 2048; LAS float* sv = sk + 4096; LAS float* sg = sk + 6144; LAS float* sb = sk + 6160;
    for (int t0 = 0; t0 < Tmax; t0 += 16) {
        const bool on = active && t0 < T;
        if (on) {
#pragma unroll 4
            for (int s = 0; s < 16; ++s) { const int tok = dir ? T - 1 - (t0 + s) : t0 + s; const size_t mo = (size_t)(row0 + tok) * 512 + h * 128 + j;
                sk[s * 128 + j] = GK[mo]; sq[s * 128 + j] = GQ[mo]; sv[s * 128 + j] = GV[mo]; }
            if (j < 16) { const int tok = dir ? T - 1 - (t0 + j) : t0 + j; const size_t mo = (size_t)(row0 + tok) * 8 + dir * 4 + h; sg[j] = GG[mo]; sb[j] = GBETA[mo]; }
        }
        __syncthreads();
        if (on) {
#pragma unroll 1
            for (int s = 0; s < 16; ++s) {
                const float dec = expf(sg[s]);
                float kS = 0.f;
#pragma unroll
                for (int i = 0; i < 128; i += 4) { const f32x4 k4 = *(const LAS f32x4*)(sk + s * 128 + i); kS += k4.x * S[i] + k4.y * S[i + 1] + k4.z * S[i + 2] + k4.w * S[i + 3];
                    if ((i & 15) == 12) asm volatile("" ::: "memory"); }
                const float vn = sb[s] * (sv[s * 128 + j] - dec * kS);
                float o = 0.f;
#pragma unroll
                for (int i = 0; i < 128; i += 4) { const f32x4 k4 = *(const LAS f32x4*)(sk + s * 128 + i); const f32x4 q4 = *(const LAS f32x4*)(sq + s * 128 + i);
                    S[i] = dec * S[i] + k4.x * vn; S[i + 1] = dec * S[i + 1] + k4.y * vn; S[i + 2] = dec * S[i + 2] + k4.z * vn; S[i + 3] = dec * S[i + 3] + k4.w * vn;
                    o += q4.x * S[i] + q4.y * S[i + 1] + q4.z * S[i + 2] + q4.w * S[i + 3];
                    if ((i & 15) == 12) asm volatile("" ::: "memory"); }
                const int tok = dir ? T - 1 - (t0 + s) : t0 + s;
                GO[((size_t)dir * M + row0 + tok) * 512 + h * 128 + j] = o * 0.08838834764831845f;
            }
        }
        __syncthreads();
    }
    if (active && !lat) { float* dst = A.out + O_SG + ((size_t)(((b * 4 + l) * 2 + dir) * 4 + h) * 128) * 128 + j;
#pragma unroll
        for (int i = 0; i < 128; ++i) dst[(size_t)i * 128] = S[i]; }
}

__device__ __forceinline__ void ph_ssd_scan(const Ctx& A, int l, LAS unsigned char* lds, int lane, int wave, int vcu, int G) {
    const float* XBC = (const float*)(A.ws + WS_XBC); const float* SDT = (const float*)(A.ws + WS_SDT); const float* SDA = SDT + (size_t)M * 16; float* SY = (float*)(A.ws + WS_SY);
    int b, h, dir, T, row0; bool lat = false;
    if (wave < 2) { const int item = wave * G + vcu; if (item >= 512) return; b = item >> 4; h = (item >> 1) & 7; dir = item & 1; T = 256; row0 = b * 256; }
    else if (wave == 2) { const int q = vcu - 16; if (q < 0 || q >= 32) return; b = q >> 4; h = (q >> 1) & 7; dir = q & 1; T = 1024; row0 = NCTX + b * 1024; lat = true; }
    else return;
    float S[128];
    if (lat) { const float* s0 = A.in[5] + ((size_t)(((b * 4 + l) * 2 + dir) * 8 + h) * 64 + lane) * 128;
#pragma unroll
        for (int n = 0; n < 128; n += 4) { const f32x4 v = *(const f32x4*)(s0 + n); S[n] = v.x; S[n + 1] = v.y; S[n + 2] = v.z; S[n + 3] = v.w; } }
    else {
#pragma unroll
        for (int n = 0; n < 128; ++n) S[n] = 0.f; }
    LAS float* sB = (LAS float*)(lds + wave * 10496); LAS float* sC = sB + 1024; LAS float* sx = sB + 2048; LAS float* sdt = sB + 2560; LAS float* sda = sB + 2568;
    const int g = h >> 2;
    for (int t0 = 0; t0 < T; t0 += 8) {
#pragma unroll 4
        for (int s = 0; s < 8; ++s) { const int tok = dir ? T - 1 - (t0 + s) : t0 + s; const float* xr = XBC + (size_t)(row0 + tok) * 1024;
            sB[s * 128 + lane] = xr[512 + g * 128 + lane]; sB[s * 128 + 64 + lane] = xr[512 + g * 128 + 64 + lane];
            sC[s * 128 + lane] = xr[768 + g * 128 + lane]; sC[s * 128 + 64 + lane] = xr[768 + g * 128 + 64 + lane];
            sx[s * 64 + lane] = xr[h * 64 + lane]; }
        if (lane < 8) { const int tok = dir ? T - 1 - (t0 + lane) : t0 + lane; const size_t mo = (size_t)(row0 + tok) * 16 + dir * 8 + h; sdt[lane] = SDT[mo]; sda[lane] = SDA[mo]; }
        asm volatile("s_waitcnt lgkmcnt(0)" ::: "memory");
#pragma unroll 1
        for (int s = 0; s < 8; ++s) {
            const float a = expf(sda[s]); const float xd = sx[s * 64 + lane] * sdt[s];
            float y = 0.f;
#pragma unroll
            for (int n = 0; n < 128; n += 4) { const f32x4 b4 = *(const LAS f32x4*)(sB + s * 128 + n); const f32x4 c4 = *(const LAS f32x4*)(sC + s * 128 + n);
                S[n] = a * S[n] + xd * b4.x; S[n + 1] = a * S[n + 1] + xd * b4.y; S[n + 2] = a * S[n + 2] + xd * b4.z; S[n + 3] = a * S[n + 3] + xd * b4.w;
                y += S[n] * c4.x + S[n + 1] * c4.y + S[n + 2] * c4.z + S[n + 3] * c4.w; }
            const int tok = dir ? T - 1 - (t0 + s) : t0 + s;
            SY[((size_t)dir * M + row0 + tok) * 512 + h * 64 + lane] = y;
        }
        asm volatile("s_waitcnt lgkmcnt(0)" ::: "memory");
    }
    if (!lat) { float* dst = A.out + O_SS + ((size_t)(((b * 4 + l) * 2 + dir) * 8 + h) * 64 + lane) * 128;
#pragma unroll
        for (int n = 0; n < 128; n += 4) *(f32x4*)(dst + n) = (f32x4){S[n], S[n + 1], S[n + 2], S[n + 3]}; }
}

__device__ __forceinline__ void ph_post(const Ctx& A, int l, int lane, int gw, int NGW) {
    const float* U = (const float*)(A.ws + WS_U); const float* GO = (const float*)(A.ws + WS_GO); const float* SY = (const float*)(A.ws + WS_SY); const float* XBC = (const float*)(A.ws + WS_XBC);
    bf16* MIX = (bf16*)(A.ws + WS_MIX);
    const float* gng = A.in[23] + l * 128; const float* sd = A.in[28] + l * 8; const float* sng = A.in[29] + l * 512;
    for (int m = gw; m < M; m += NGW) {
        const float* u = U + (size_t)m * IN_WP;
#pragma unroll
        for (int i = 0; i < 2; ++i) { const int c = 4 * lane + 256 * i;
            f32x4 o = *(const f32x4*)(GO + (size_t)m * 512 + c) + *(const f32x4*)(GO + ((size_t)M + m) * 512 + c);
            const float ss = half_sum((o.x * o.x + o.y * o.y) + (o.z * o.z + o.w * o.w)); const float rstd = 1.0f / sqrtf(ss * (1.0f / 128.f) + EPS);
            const f32x4 g4 = *(const f32x4*)(gng + (c & 127)); const f32x4 z = *(const f32x4*)(u + U_GZ + c);
            o = o * rstd * g4; o.x *= silu(z.x); o.y *= silu(z.y); o.z *= silu(z.z); o.w *= silu(z.w);
            v2u w; w.x = pk2(o.x, o.y); w.y = pk2(o.z, o.w); *(GAS v2u*)(MIX + (size_t)m * D + 1024 + c) = w; }
#pragma unroll
        for (int i = 0; i < 2; ++i) { const int c = 4 * lane + 256 * i;
            f32x4 y = *(const f32x4*)(SY + (size_t)m * 512 + c) + *(const f32x4*)(SY + ((size_t)M + m) * 512 + c) + *(const f32x4*)(XBC + (size_t)m * 1024 + c) * sd[c >> 6];
            const f32x4 z = *(const f32x4*)(u + U_SZ + c);
            y.x *= silu(z.x); y.y *= silu(z.y); y.z *= silu(z.z); y.w *= silu(z.w);
            const float ss = wave_sum((y.x * y.x + y.y * y.y) + (y.z * y.z + y.w * y.w)); const float rstd = 1.0f / sqrtf(ss * (1.0f / 256.f) + EPS);
            y = y * rstd * *(const f32x4*)(sng + c);
            v2u w; w.x = pk2(y.x, y.y); w.y = pk2(y.z, y.w); *(GAS v2u*)(MIX + (size_t)m * D + 1536 + c) = w; }
    }
}

constexpr size_t GCH_W = 0, GCH_QG = 16384, GCH_KD = 32768, GCH_QK = 49152, GCH_UT = 57344, GCH_DEC = 90112, GCH_BYTES = 90368;
constexpr int NGCH = 160;
template <int DIR>
__device__ __forceinline__ void gdn_solve(const float* GQ, const float* GK, const float* GV, unsigned char* GCH, const LAS float* Ad, const LAS float* gcd, const LAS float* bd, int gch, int h, int row0, int wave, int lane) {
    const int c = (wave & 3) * 64 + lane, cc = c & 127; const bool isw = c < 128;
    unsigned char* rec = GCH + ((size_t)(DIR * NGCH + gch) * 4 + h) * GCH_BYTES;
    const float* src = (isw ? GK : GV) + (size_t)row0 * 512 + h * 128 + cc;
    { int z = 0; asm volatile("" : "+v"(z)); Ad += z; gcd += z; bd += z; }
    float x[64];
#pragma unroll
    for (int i = 0; i < 64; ++i) { const int p = DIR ? 63 - i : i; const float f = isw ? bd[p] * __expf(gcd[p]) : bd[p]; x[i] = src[(size_t)p * 512] * f; if ((i & 7) == 7) asm volatile("" ::: "memory"); }
#pragma unroll
    for (int i = 1; i < 64; ++i) { float s = x[i];
#pragma unroll
        for (int j = 0; j < i; j += 4) { const f32x4 a4 = *(const LAS f32x4*)(Ad + i * 64 + j);
            s -= a4.x * x[j]; if (j + 1 < i) s -= a4.y * x[j + 1]; if (j + 2 < i) s -= a4.z * x[j + 2]; if (j + 3 < i) s -= a4.w * x[j + 3]; }
        x[i] = s; if ((i & 7) == 7) asm volatile("" ::: "memory"); }
    if (isw) { bf16* wdst = (bf16*)(rec + GCH_W) + cc;
#pragma unroll
        for (int i = 0; i < 64; ++i) wdst[i * 128] = (bf16)f2bf(x[i]);
        const float gl = gcd[DIR ? 0 : 63]; bf16* kd = (bf16*)(rec + GCH_KD) + cc * 64;
#pragma unroll
        for (int i = 0; i < 64; i += 8) { float v[8];
#pragma unroll
            for (int u = 0; u < 8; ++u) { const int p = DIR ? 63 - (i + u) : i + u; v[u] = src[(size_t)p * 512] * __expf(gl - gcd[p]); }
            v4u w; w.x = pk2(v[0], v[1]); w.y = pk2(v[2], v[3]); w.z = pk2(v[4], v[5]); w.w = pk2(v[6], v[7]); *(GAS v4u*)(kd + i) = w; asm volatile("" ::: "memory"); }
        if (cc == 0) *(float*)(rec + GCH_DEC) = __expf(gl); }
    else { float* ut = (float*)(rec + GCH_UT) + cc * 64;
#pragma unroll
        for (int i = 0; i < 64; i += 4) *(f32x4*)(ut + i) = (f32x4){x[i], x[i + 1], x[i + 2], x[i + 3]};
        const float* qsrc = GQ + (size_t)row0 * 512 + h * 128 + cc; bf16* qg = (bf16*)(rec + GCH_QG) + cc;
#pragma unroll
        for (int i = 0; i < 64; ++i) { const int p = DIR ? 63 - i : i; qg[i * 128] = (bf16)f2bf(qsrc[(size_t)p * 512] * 0.08838834764831845f * __expf(gcd[p])); if ((i & 7) == 7) asm volatile("" ::: "memory"); } }
}
__device__ __forceinline__ void ph_gdn_local(const Ctx& A, int l, LAS unsigned char* lds, int tid, int lane, int wave, int vcu, int G) {
    const float* GQ = (const float*)(A.ws + WS_GQ); const float* GK = GQ + (size_t)M * 512; const float* GV = GK + (size_t)M * 512;
    const float* GBETA = (const float*)(A.ws + WS_GBG); const float* GG = GBETA + (size_t)M * 8;
    unsigned char* GCH = A.ws + WS_GCH;
    LAS bf16* kb16 = (LAS bf16*)lds; LAS bf16* qb16 = (LAS bf16*)(lds + 17408);
    LAS float* KK = (LAS float*)(lds + 34816); LAS float* QK = (LAS float*)(lds + 34816 + 16640);
    LAS float* Af = (LAS float*)(lds + 68096); LAS float* Ab = (LAS float*)(lds + 68096 + 16384);
    LAS float* sgcf = (LAS float*)(lds + 100864); LAS float* sgcb = sgcf + 64; LAS float* sbf = sgcf + 128; LAS float* sbb = sgcf + 192;
    const int fr = lane & 15, fq = lane >> 4;
    for (int it = vcu; it < NGCH * 4; it += G) {
        const int gch = it >> 2, h = it & 3, row0 = gch * 64;
        { const int r = tid >> 3, c0 = (tid & 7) * 16; const float* kp = GK + (size_t)(row0 + r) * 512 + h * 128 + c0; const float* qp = GQ + (size_t)(row0 + r) * 512 + h * 128 + c0;
          f32x4 kv[4], qv[4];
#pragma unroll
          for (int i = 0; i < 4; ++i) { kv[i] = *(const f32x4*)(kp + 4 * i); qv[i] = *(const f32x4*)(qp + 4 * i); }
          v4u w0, w1; w0.x = pk2(kv[0].x, kv[0].y); w0.y = pk2(kv[0].z, kv[0].w); w0.z = pk2(kv[1].x, kv[1].y); w0.w = pk2(kv[1].z, kv[1].w);
          w1.x = pk2(kv[2].x, kv[2].y); w1.y = pk2(kv[2].z, kv[2].w); w1.z = pk2(kv[3].x, kv[3].y); w1.w = pk2(kv[3].z, kv[3].w);
          *(LAS v4u*)(kb16 + r * 136 + c0) = w0; *(LAS v4u*)(kb16 + r * 136 + c0 + 8) = w1;
          w0.x = pk2(qv[0].x, qv[0].y); w0.y = pk2(qv[0].z, qv[0].w); w0.z = pk2(qv[1].x, qv[1].y); w0.w = pk2(qv[1].z, qv[1].w);
          w1.x = pk2(qv[2].x, qv[2].y); w1.y = pk2(qv[2].z, qv[2].w); w1.z = pk2(qv[3].x, qv[3].y); w1.w = pk2(qv[3].z, qv[3].w);
          *(LAS v4u*)(qb16 + r * 136 + c0) = w0; *(LAS v4u*)(qb16 + r * 136 + c0 + 8) = w1; }
        if (wave == 0) { const float gf = GG[(size_t)(row0 + lane) * 8 + h], gb = GG[(size_t)(row0 + lane) * 8 + 4 + h];
            float pf = gf, pb = gb;
#pragma unroll
            for (int o = 1; o < 64; o <<= 1) { const float tf = __shfl_up(pf, o), tb = __shfl_up(pb, o); if (lane >= o) { pf += tf; pb += tb; } }
            const float totb = __shfl(pb, 63);
            sgcf[lane] = pf; sgcb[lane] = totb - pb + gb;
            sbf[lane] = GBETA[(size_t)(row0 + lane) * 8 + h]; sbb[lane] = GBETA[(size_t)(row0 + lane) * 8 + 4 + h]; }
        __syncthreads();
        { const int tr = wave & 3; const LAS bf16* Aimg = (wave >> 2) ? qb16 : kb16; LAS float* Out = (wave >> 2) ? QK : KK;
          bf16x8 af[4];
#pragma unroll
          for (int ks = 0; ks < 4; ++ks) af[ks] = *(const LAS bf16x8*)(Aimg + (16 * tr + fr) * 136 + ks * 32 + fq * 8);
#pragma unroll
          for (int tc = 0; tc < 4; ++tc) { f32x4 acc = (f32x4){0.f, 0.f, 0.f, 0.f};
#pragma unroll
              for (int ks = 0; ks < 4; ++ks) { const bf16x8 bfr = *(const LAS bf16x8*)(kb16 + (16 * tc + fr) * 136 + ks * 32 + fq * 8); acc = __builtin_amdgcn_mfma_f32_16x16x32_bf16(af[ks], bfr, acc, 0, 0, 0); }
#pragma unroll
              for (int r = 0; r < 4; ++r) Out[(16 * tr + 4 * fq + r) * 65 + 16 * tc + fr] = acc[r]; } }
        __syncthreads();
        { unsigned char* recf = GCH + ((size_t)(0 * NGCH + gch) * 4 + h) * GCH_BYTES; unsigned char* recb = GCH + ((size_t)(1 * NGCH + gch) * 4 + h) * GCH_BYTES;
#pragma unroll 2
          for (int e = 0; e < 8; ++e) { const int idx = tid + 512 * e, i = idx >> 6, j = idx & 63, pi = 63 - i, pj = 63 - j;
              const float kkf = KK[i * 65 + j], qkf = QK[i * 65 + j], kkb = KK[pi * 65 + pj], qkb = QK[pi * 65 + pj];
              const float df = __expf(sgcf[i] - sgcf[j]), db = __expf(sgcb[pi] - sgcb[pj]);
              Af[idx] = (j < i) ? sbf[i] * kkf * df : 0.f; Ab[idx] = (j < i) ? sbb[pi] * kkb * db : 0.f;
              ((bf16*)(recf + GCH_QK))[idx] = (bf16)f2bf((j <= i) ? qkf * 0.08838834764831845f * df : 0.f);
              ((bf16*)(recb + GCH_QK))[idx] = (bf16)f2bf((j <= i) ? qkb * 0.08838834764831845f * db : 0.f); } }
        __syncthreads();
        if (wave < 4) gdn_solve<0>(GQ, GK, GV, GCH, Af, sgcf, sbf, gch, h, row0, wave, lane);
        else gdn_solve<1>(GQ, GK, GV, GCH, Ab, sgcb, sbb, gch, h, row0, wave, lane);
        __syncthreads();
    }
}

constexpr int GS_W = 0, GS_QG = 17408, GS_KD = 34816, GS_QK = 53248, GS_IMG = 62464;
__device__ __forceinline__ void gdn_seq_wg(const Ctx& A, int l, int b, int lat, int h, int dir, LAS unsigned char* lds, int tid, int lane, int wave) {
    const GAS unsigned char* GCH = (const GAS unsigned char*)(A.ws + WS_GCH); GAS float* GO = (GAS float*)(A.ws + WS_GO);
    const int fr = lane & 15, fq = lane >> 4, dvs = wave;
    const int nch = lat ? 16 : 4, ch0 = lat ? 128 + b * 16 : b * 4;
    LAS bf16* simg = (LAS bf16*)(lds + GS_IMG + wave * 4352);
    const LAS bf16* sW = (const LAS bf16*)(lds + GS_W); const LAS bf16* sQG = (const LAS bf16*)(lds + GS_QG); const LAS bf16* sKD = (const LAS bf16*)(lds + GS_KD); const LAS bf16* sQK = (const LAS bf16*)(lds + GS_QK);
    f32x4 S[8];
    const size_t sidx = ((size_t)(((b * 4 + l) * 2 + dir) * 4 + h) * 128) * 128 + dvs * 16 + fr;
    if (lat) {
#pragma unroll
        for (int u = 0; u < 8; ++u)
#pragma unroll
            for (int r = 0; r < 4; ++r) S[u][r] = *(const GAS float*)(A.in[4] + sidx + (size_t)(16 * u + 4 * fq + r) * 128); }
    else {
#pragma unroll
        for (int u = 0; u < 8; ++u) S[u] = (f32x4){0.f, 0.f, 0.f, 0.f}; }
#define GREC(cc_) (GCH + ((size_t)(dir * NGCH + (dir ? ch0 + nch - 1 - (cc_) : ch0 + (cc_))) * 4 + h) * GCH_BYTES)
    const int r16a = tid >> 4, c16 = tid & 15, r8a = tid >> 3, c8 = tid & 7;
    v4u pw0, pw1, pq0, pq1, pk0, pk1, pqk; f32x4 UTn[4], UTc[4];
#define GS_LOAD(cc_) do { const GAS unsigned char* rec_ = GREC(cc_); \
        pw0 = *(const GAS v4u*)(rec_ + GCH_W + (r16a * 128 + c16 * 8) * 2); pw1 = *(const GAS v4u*)(rec_ + GCH_W + ((r16a + 32) * 128 + c16 * 8) * 2); \
        pq0 = *(const GAS v4u*)(rec_ + GCH_QG + (r16a * 128 + c16 * 8) * 2); pq1 = *(const GAS v4u*)(rec_ + GCH_QG + ((r16a + 32) * 128 + c16 * 8) * 2); \
        pk0 = *(const GAS v4u*)(rec_ + GCH_KD + (r8a * 64 + c8 * 8) * 2); pk1 = *(const GAS v4u*)(rec_ + GCH_KD + ((r8a + 64) * 64 + c8 * 8) * 2); \
        pqk = *(const GAS v4u*)(rec_ + GCH_QK + (r8a * 64 + c8 * 8) * 2); \
        _Pragma("unroll") for (int t_ = 0; t_ < 4; ++t_) UTn[t_] = *(const GAS f32x4*)((const GAS float*)(rec_ + GCH_UT) + (dvs * 16 + fr) * 64 + 16 * t_ + 4 * fq); } while (0)
#define GS_STORE() do { *(LAS v4u*)(lds + GS_W + r16a * 272 + c16 * 16) = pw0; *(LAS v4u*)(lds + GS_W + (r16a + 32) * 272 + c16 * 16) = pw1; \
        *(LAS v4u*)(lds + GS_QG + r16a * 272 + c16 * 16) = pq0; *(LAS v4u*)(lds + GS_QG + (r16a + 32) * 272 + c16 * 16) = pq1; \
        *(LAS v4u*)(lds + GS_KD + r8a * 144 + c8 * 16) = pk0; *(LAS v4u*)(lds + GS_KD + (r8a + 64) * 144 + c8 * 16) = pk1; \
        *(LAS v4u*)(lds + GS_QK + r8a * 144 + c8 * 16) = pqk; \
        _Pragma("unroll") for (int t_ = 0; t_ < 4; ++t_) UTc[t_] = UTn[t_]; } while (0)
    __syncthreads();
    GS_LOAD(0); GS_STORE();
    __syncthreads();
#pragma unroll 1
    for (int cc = 0; cc < nch; ++cc) {
        const int gch = dir ? ch0 + nch - 1 - cc : ch0 + cc;
        const float dec = *(const GAS float*)(GREC(cc) + GCH_DEC);
        if (cc + 1 < nch) GS_LOAD(cc + 1);
        MEMBAR();
#pragma unroll
        for (int u = 0; u < 8; ++u) { v2u w; w.x = pk2(S[u][0], S[u][1]); w.y = pk2(S[u][2], S[u][3]); *(LAS v2u*)(simg + fr * 136 + 16 * u + 4 * fq) = w; }
        asm volatile("s_waitcnt lgkmcnt(0)" ::: "memory");
        bf16x8 BS[4];
#pragma unroll
        for (int ks = 0; ks < 4; ++ks) BS[ks] = *(const LAS bf16x8*)(simg + fr * 136 + ks * 32 + fq * 8);
        asm volatile("s_waitcnt lgkmcnt(0)" ::: "memory");
#pragma unroll
        for (int t = 0; t < 4; ++t) { f32x4 acc = (f32x4){0.f, 0.f, 0.f, 0.f};
#pragma unroll
            for (int ks = 0; ks < 4; ++ks) { const bf16x8 af = *(const LAS bf16x8*)(sW + (16 * t + fr) * 136 + ks * 32 + fq * 8); acc = __builtin_amdgcn_mfma_f32_16x16x32_bf16(af, BS[ks], acc, 0, 0, 0); }
            const f32x4 vn = UTc[t] - acc;
            v2u w; w.x = pk2(vn[0], vn[1]); w.y = pk2(vn[2], vn[3]); *(LAS v2u*)(simg + fr * 72 + 16 * t + 4 * fq) = w; }
        asm volatile("s_waitcnt lgkmcnt(0)" ::: "memory");
        bf16x8 BV[2];
#pragma unroll
        for (int ks = 0; ks < 2; ++ks) BV[ks] = *(const LAS bf16x8*)(simg + fr * 72 + ks * 32 + fq * 8);
        int zl = 0; asm volatile("" : "+v"(zl));
        GAS float* gob = GO + ((size_t)dir * M + gch * 64) * 512 + h * 128 + dvs * 16 + fr + zl;
#pragma unroll
        for (int t = 0; t < 4; ++t) { f32x4 acc = (f32x4){0.f, 0.f, 0.f, 0.f};
#pragma unroll
            for (int ks = 0; ks < 4; ++ks) { const bf16x8 af = *(const LAS bf16x8*)(sQG + (16 * t + fr) * 136 + ks * 32 + fq * 8); acc = __builtin_amdgcn_mfma_f32_16x16x32_bf16(af, BS[ks], acc, 0, 0, 0); }
#pragma unroll
            for (int ks = 0; ks < 2; ++ks) { const bf16x8 af = *(const LAS bf16x8*)(sQK + (16 * t + fr) * 72 + ks * 32 + fq * 8); acc = __builtin_amdgcn_mfma_f32_16x16x32_bf16(af, BV[ks], acc, 0, 0, 0); }
#pragma unroll
            for (int r = 0; r < 4; ++r) { const int i = 16 * t + 4 * fq + r, p = dir ? 63 - i : i; gob[(ptrdiff_t)p * 512] = acc[r]; } }
#pragma unroll
        for (int u = 0; u < 8; ++u) { f32x4 acc = S[u] * dec;
#pragma unroll
            for (int ks = 0; ks < 2; ++ks) { const bf16x8 af = *(const LAS bf16x8*)(sKD + (16 * u + fr) * 72 + ks * 32 + fq * 8); acc = __builtin_amdgcn_mfma_f32_16x16x32_bf16(af, BV[ks], acc, 0, 0, 0); }
            S[u] = acc; }
        __syncthreads();
        if (cc + 1 < nch) GS_STORE();
        __syncthreads();
    }
#undef GREC
#undef GS_LOAD
#undef GS_STORE
    if (!lat) { int l2 = lane; asm volatile("" : "+v"(l2)); const int fr2 = l2 & 15, fq2 = l2 >> 4;
        GAS float* so = (GAS float*)(A.out + O_SG + ((size_t)(((b * 4 + l) * 2 + dir) * 4 + h) * 128) * 128 + dvs * 16 + fr2 + (size_t)(4 * fq2) * 128);
#pragma unroll
        for (int u = 0; u < 8; ++u)
#pragma unroll
            for (int r = 0; r < 4; ++r) so[(16 * u + r) * 128] = S[u][r]; }
}
__device__ __forceinline__ void ph_gdn_seq(const Ctx& A, int l, LAS unsigned char* lds, int tid, int lane, int wave, int vcu, int G) {
    for (int it = vcu; it < 272; it += G) {
        if (it < 16) gdn_seq_wg(A, l, it >> 3, 1, (it >> 1) & 3, it & 1, lds, tid, lane, wave);
        else { const int q = it - 16; gdn_seq_wg(A, l, q >> 3, 0, (q >> 1) & 3, q & 1, lds, tid, lane, wave); }
    }
}

constexpr size_t SR_P = 0, SR_X1 = 32768, SR_X2 = 49152, SR_EA = 65536, SR_DEC = 66048, SR_BYTES = 66560;
constexpr size_t SS_C = 0, SS_BT = 32768, SS_BYTES = 65536;
constexpr int NSCH = 80;
__device__ __forceinline__ void ph_ssd_local(const Ctx& A, int l, LAS unsigned char* lds, int tid, int lane, int wave, int vcu, int G) {
    const float* XBC = (const float*)(A.ws + WS_XBC); const float* SDT = (const float*)(A.ws + WS_SDT); const float* SDA = SDT + (size_t)M * 16;
    unsigned char* SREC = A.ws + WS_SREC; unsigned char* SSH = A.ws + WS_SSH;
    LAS bf16* Cimg = (LAS bf16*)lds; LAS bf16* Bimg = (LAS bf16*)(lds + 34816);
    LAS float* sac = (LAS float*)(lds + 69632);
    LAS float* sdt = sac + 256;
    const int fr = lane & 15, fq = lane >> 4;
    for (int it = vcu; it < NSCH * 8; it += G) {
        const int ch = it >> 3, h = it & 7, g = h >> 2, row0 = ch * 128;
        unsigned char* shr = SSH + (size_t)(ch * 2 + g) * SS_BYTES;
        { const int r = tid >> 2, c0 = (tid & 3) * 32; const float* cp = XBC + (size_t)(row0 + r) * 1024 + 768 + g * 128 + c0; const float* bp = XBC + (size_t)(row0 + r) * 1024 + 512 + g * 128 + c0;
#pragma unroll
          for (int i = 0; i < 4; ++i) { const f32x4 a0 = *(const f32x4*)(cp + 8 * i), a1 = *(const f32x4*)(cp + 8 * i + 4), b0 = *(const f32x4*)(bp + 8 * i), b1 = *(const f32x4*)(bp + 8 * i + 4);
              v4u wc, wb; wc.x = pk2(a0.x, a0.y); wc.y = pk2(a0.z, a0.w); wc.z = pk2(a1.x, a1.y); wc.w = pk2(a1.z, a1.w);
              wb.x = pk2(b0.x, b0.y); wb.y = pk2(b0.z, b0.w); wb.z = pk2(b1.x, b1.y); wb.w = pk2(b1.z, b1.w);
              *(LAS v4u*)(Cimg + r * 136 + c0 + 8 * i) = wc; *(LAS v4u*)(Bimg + r * 136 + c0 + 8 * i) = wb;
              if ((h & 3) == 0) *(GAS v4u*)((bf16*)(shr + SS_C) + r * 128 + c0 + 8 * i) = wc; } }
        if (wave < 2) { const int d = wave; const size_t mo = (size_t)(row0 + 2 * lane) * 16 + d * 8 + h;
            const float a0 = SDA[mo], a1 = SDA[mo + 16]; float ps = a0 + a1;
#pragma unroll
            for (int o = 1; o < 64; o <<= 1) { const float t = __shfl_up(ps, o); if (lane >= o) ps += t; }
            const float tot = __shfl(ps, 63);
            if (d == 0) { sac[2 * lane] = ps - a1; sac[2 * lane + 1] = ps; }
            else { sac[128 + 2 * lane] = tot - ps + a0 + a1; sac[128 + 2 * lane + 1] = tot - ps + a1; }
            sdt[d * 128 + 2 * lane] = SDT[mo]; sdt[d * 128 + 2 * lane + 1] = SDT[mo + 16]; }
        __syncthreads();
        if ((h & 3) == 0) { const int n = tid >> 2, s0 = (tid & 3) * 32; bf16* dst = (bf16*)(shr + SS_BT) + n * 128 + s0;
#pragma unroll
            for (int i = 0; i < 4; ++i) { unsigned w[4];
#pragma unroll
                for (int j = 0; j < 4; ++j) w[j] = (unsigned)Bimg[(s0 + 8 * i + 2 * j) * 136 + n] | ((unsigned)Bimg[(s0 + 8 * i + 2 * j + 1) * 136 + n] << 16);
                *(GAS v4u*)(dst + 8 * i) = (v4u){w[0], w[1], w[2], w[3]}; } }
        { bf16x8 af[4];
#pragma unroll
          for (int ks = 0; ks < 4; ++ks) af[ks] = *(const LAS bf16x8*)(Cimg + (16 * wave + fr) * 136 + ks * 32 + fq * 8);
          bf16* Pf = (bf16*)(SREC + ((size_t)(0 * NSCH + ch) * 8 + h) * SR_BYTES + SR_P); bf16* Pb = (bf16*)(SREC + ((size_t)(1 * NSCH + ch) * 8 + h) * SR_BYTES + SR_P);
          float acf[4], acb[4];
#pragma unroll
          for (int r = 0; r < 4; ++r) { acf[r] = sac[16 * wave + 4 * fq + r]; acb[r] = sac[128 + 16 * wave + 4 * fq + r]; }
#pragma unroll
          for (int tc = 0; tc < 8; ++tc) { f32x4 acc = (f32x4){0.f, 0.f, 0.f, 0.f};
#pragma unroll
              for (int ks = 0; ks < 4; ++ks) { const bf16x8 bfr = *(const LAS bf16x8*)(Bimg + (16 * tc + fr) * 136 + ks * 32 + fq * 8); acc = __builtin_amdgcn_mfma_f32_16x16x32_bf16(af[ks], bfr, acc, 0, 0, 0); }
              const int s = 16 * tc + fr; const float asf = sac[s], asb = sac[128 + s];
#pragma unroll
              for (int r = 0; r < 4; ++r) { const int li = 16 * wave + 4 * fq + r;
                  Pf[li * 128 + s] = (bf16)f2bf((s <= li) ? acc[r] * __expf(acf[r] - asf) : 0.f);
                  Pb[li * 128 + s] = (bf16)f2bf((s >= li) ? acc[r] * __expf(acb[r] - asb) : 0.f); } } }
        { const int p = lane, s0 = wave * 16; const float* xp = XBC + (size_t)(row0 + s0) * 1024 + h * 64 + p;
          float xv[16];
#pragma unroll
          for (int j = 0; j < 16; ++j) xv[j] = xp[(size_t)j * 1024];
#pragma unroll
          for (int d = 0; d < 2; ++d) { unsigned char* rec = SREC + ((size_t)(d * NSCH + ch) * 8 + h) * SR_BYTES; const float aend = d ? sac[128] : sac[127];
              unsigned w1[8], w2[8];
#pragma unroll
              for (int j = 0; j < 16; j += 2) { const float u0 = xv[j] * sdt[d * 128 + s0 + j], u1 = xv[j + 1] * sdt[d * 128 + s0 + j + 1];
                  w1[j >> 1] = pk2(u0, u1); w2[j >> 1] = pk2(u0 * __expf(aend - sac[d * 128 + s0 + j]), u1 * __expf(aend - sac[d * 128 + s0 + j + 1])); }
              bf16* x1 = (bf16*)(rec + SR_X1) + p * 128 + s0; bf16* x2 = (bf16*)(rec + SR_X2) + p * 128 + s0;
              *(GAS v4u*)x1 = (v4u){w1[0], w1[1], w1[2], w1[3]}; *(GAS v4u*)(x1 + 8) = (v4u){w1[4], w1[5], w1[6], w1[7]};
              *(GAS v4u*)x2 = (v4u){w2[0], w2[1], w2[2], w2[3]}; *(GAS v4u*)(x2 + 8) = (v4u){w2[4], w2[5], w2[6], w2[7]};
              if (tid < 128) ((float*)(rec + SR_EA))[tid] = __expf(sac[d * 128 + tid]);
              if (tid == 0) *(float*)(rec + SR_DEC) = __expf(aend); } }
        __syncthreads();
    }
}

constexpr int SQ_C = 0, SQ_P = 34816, SQ_BT = 69632, SQ_X1 = 104448, SQ_X2 = 121856, SQ_IMG = 139264;
__device__ __forceinline__ void ssd_seq_wg(const Ctx& A, int l, int b, int lat, int h, int dir, LAS unsigned char* lds, int tid, int lane, int wave) {
    const GAS unsigned char* SREC = (const GAS unsigned char*)(A.ws + WS_SREC); const GAS unsigned char* SSH = (const GAS unsigned char*)(A.ws + WS_SSH); GAS float* SY = (GAS float*)(A.ws + WS_SY);
    const int fr = lane & 15, fq = lane >> 4, g = h >> 2, ps = wave & 3, hf = wave >> 2;
    const int nch = lat ? 8 : 2, ch0 = lat ? 64 + b * 8 : b * 2;
    LAS bf16* simg = (LAS bf16*)(lds + SQ_IMG + ps * 4352);
    const LAS bf16* sC = (const LAS bf16*)(lds + SQ_C); const LAS bf16* sP = (const LAS bf16*)(lds + SQ_P); const LAS bf16* sBT = (const LAS bf16*)(lds + SQ_BT);
    const LAS bf16* sX1 = (const LAS bf16*)(lds + SQ_X1); const LAS bf16* sX2 = (const LAS bf16*)(lds + SQ_X2);
    f32x4 S[4];
    const size_t sidx = ((size_t)(((b * 4 + l) * 2 + dir) * 8 + h) * 64 + ps * 16 + fr) * 128 + 64 * hf + 4 * fq;
    if (lat) {
#pragma unroll
        for (int u = 0; u < 4; ++u) S[u] = *(const GAS f32x4*)(A.in[5] + sidx + 16 * u); }
    else {
#pragma unroll
        for (int u = 0; u < 4; ++u) S[u] = (f32x4){0.f, 0.f, 0.f, 0.f}; }
#define SCH(cc_) (dir ? ch0 + nch - 1 - (cc_) : ch0 + (cc_))
    const int r16 = tid >> 4, c16 = tid & 15;
    v4u pc[4], pp[4], pb[4], px1[2], px2[2];
#define SQ_LOAD(cc_) do { const int ch_ = SCH(cc_); const GAS unsigned char* rec_ = SREC + ((size_t)(dir * NSCH + ch_) * 8 + h) * SR_BYTES; const GAS unsigned char* shr_ = SSH + (size_t)(ch_ * 2 + g) * SS_BYTES; \
        _Pragma("unroll") for (int j_ = 0; j_ < 4; ++j_) { const int off_ = ((r16 + 32 * j_) * 128 + c16 * 8) * 2; pc[j_] = *(const GAS v4u*)(shr_ + SS_C + off_); pp[j_] = *(const GAS v4u*)(rec_ + SR_P + off_); pb[j_] = *(const GAS v4u*)(shr_ + SS_BT + off_); } \
        _Pragma("unroll") for (int j_ = 0; j_ < 2; ++j_) { const int off_ = ((r16 + 32 * j_) * 128 + c16 * 8) * 2; px1[j_] = *(const GAS v4u*)(rec_ + SR_X1 + off_); px2[j_] = *(const GAS v4u*)(rec_ + SR_X2 + off_); } } while (0)
#define SQ_STORE() do { \
        _Pragma("unroll") for (int j_ = 0; j_ < 4; ++j_) { const int off_ = (r16 + 32 * j_) * 272 + c16 * 16; *(LAS v4u*)(lds + SQ_C + off_) = pc[j_]; *(LAS v4u*)(lds + SQ_P + off_) = pp[j_]; *(LAS v4u*)(lds + SQ_BT + off_) = pb[j_]; } \
        _Pragma("unroll") for (int j_ = 0; j_ < 2; ++j_) { const int off_ = (r16 + 32 * j_) * 272 + c16 * 16; *(LAS v4u*)(lds + SQ_X1 + off_) = px1[j_]; *(LAS v4u*)(lds + SQ_X2 + off_) = px2[j_]; } } while (0)
    __syncthreads();
    SQ_LOAD(0); SQ_STORE();
    __syncthreads();
#pragma unroll 1
    for (int cc = 0; cc < nch; ++cc) {
        const int ch = SCH(cc);
        const GAS unsigned char* rec = SREC + ((size_t)(dir * NSCH + ch) * 8 + h) * SR_BYTES;
        const GAS float* EA = (const GAS float*)(rec + SR_EA); const float dec = *(const GAS float*)(rec + SR_DEC);
        f32x4 ea[4];
#pragma unroll
        for (int t2 = 0; t2 < 4; ++t2) ea[t2] = *(const GAS f32x4*)(EA + 16 * (4 * hf + t2) + 4 * fq);
        if (cc + 1 < nch) SQ_LOAD(cc + 1);
        MEMBAR();
#pragma unroll
        for (int u = 0; u < 4; ++u) { v2u w; w.x = pk2(S[u][0], S[u][1]); w.y = pk2(S[u][2], S[u][3]); *(LAS v2u*)(simg + fr * 136 + 64 * hf + 16 * u + 4 * fq) = w; }
        __syncthreads();
        bf16x8 BS[4], BX1[4], BX2[4];
#pragma unroll
        for (int ks = 0; ks < 4; ++ks) { BS[ks] = *(const LAS bf16x8*)(simg + fr * 136 + ks * 32 + fq * 8);
            BX1[ks] = *(const LAS bf16x8*)(sX1 + (ps * 16 + fr) * 136 + ks * 32 + fq * 8); BX2[ks] = *(const LAS bf16x8*)(sX2 + (ps * 16 + fr) * 136 + ks * 32 + fq * 8); }
        int zl = 0; asm volatile("" : "+v"(zl));
        GAS float* syb = SY + ((size_t)dir * M + ch * 128 + 64 * hf + 4 * fq) * 512 + h * 64 + ps * 16 + fr + zl;
#pragma unroll
        for (int t2 = 0; t2 < 4; ++t2) { const int t = 4 * hf + t2; f32x4 acc = (f32x4){0.f, 0.f, 0.f, 0.f};
#pragma unroll
            for (int ks = 0; ks < 4; ++ks) { const bf16x8 af = *(const LAS bf16x8*)(sC + (16 * t + fr) * 136 + ks * 32 + fq * 8); acc = __builtin_amdgcn_mfma_f32_16x16x32_bf16(af, BS[ks], acc, 0, 0, 0); }
            acc = acc * ea[t2];
#pragma unroll
            for (int ks = 0; ks < 4; ++ks) { const bf16x8 af = *(const LAS bf16x8*)(sP + (16 * t + fr) * 136 + ks * 32 + fq * 8); acc = __builtin_amdgcn_mfma_f32_16x16x32_bf16(af, BX1[ks], acc, 0, 0, 0); }
#pragma unroll
            for (int r = 0; r < 4; ++r) syb[(size_t)(16 * t2 + r) * 512] = acc[r]; }
#pragma unroll
        for (int u = 0; u < 4; ++u) { f32x4 acc = S[u] * dec;
#pragma unroll
            for (int ks = 0; ks < 4; ++ks) { const bf16x8 af = *(const LAS bf16x8*)(sBT + (64 * hf + 16 * u + fr) * 136 + ks * 32 + fq * 8); acc = __builtin_amdgcn_mfma_f32_16x16x32_bf16(af, BX2[ks], acc, 0, 0, 0); }
            S[u] = acc; }
        __syncthreads();
        if (cc + 1 < nch) SQ_STORE();
        __syncthreads();
    }
#undef SCH
#undef SQ_LOAD
#undef SQ_STORE
    if (!lat) {
#pragma unroll
        for (int u = 0; u < 4; ++u) *(GAS f32x4*)(A.out + O_SS + sidx + 16 * u) = S[u]; }
}
__device__ __forceinline__ void ph_ssd_seq(const Ctx& A, int l, LAS unsigned char* lds, int tid, int lane, int wave, int vcu, int G) {
    const int v2 = (vcu + G / 2) % G;
    for (int it = v2; it < 544; it += G) {
        if (it < 512) ssd_seq_wg(A, l, it >> 4, 0, (it >> 1) & 7, it & 1, lds, tid, lane, wave);
        else { const int q = it - 512; ssd_seq_wg(A, l, q >> 4, 1, (q >> 1) & 7, q & 1, lds, tid, lane, wave); }
    }
}

#ifndef REP_ATTN
#define REP_ATTN 1
#endif
#ifndef REP_LOC
#define REP_LOC 1
#endif
#ifndef REP_LAT
#define REP_LAT 1
#endif
#ifndef REP_CTX
#define REP_CTX 1
#endif
#ifndef REP_MIX
#define REP_MIX 1
#endif
#ifndef REP_PRO
#define REP_PRO 1
#endif
#ifndef REP_EW
#define REP_EW 1
#endif
#ifndef REP_GEMM
#define REP_GEMM 1
#endif
#ifndef MK_ONE_LAUNCH
#define MK_ONE_LAUNCH 0
#endif
#define IN(k) (lo <= (k) && (k) < hi)
#ifndef REP_BAR
#define REP_BAR 1
#endif
#define SEAM(k) do { if (IN((k) + 1)) { for (int rb_ = 0; rb_ < REP_BAR; ++rb_) xcd_barrier(bar); } } while (0)
#define PHASE_ROOTS() Ctx C; int G = (int)gridDim.x, bx = (int)blockIdx.x; int tid = tid0; asm volatile("" : "+v"(tid)); const int lane = tid & 63, wave = __builtin_amdgcn_readfirstlane(tid >> 6); (void)lane; (void)wave; \
    { unsigned long long kp_ = (unsigned long long)__builtin_amdgcn_kernarg_segment_ptr(); float* o_ = args.out; unsigned char* w_ = args.ws; \
      asm volatile("" : "+s"(kp_), "+s"(o_), "+s"(w_), "+s"(G), "+s"(bx)); C.in = (kin_t)kp_; C.out = o_; C.ws = w_; } \
    const int vcu = (G % 8 == 0) ? (bx % 8) * (G / 8) + bx / 8 : bx; const int gw = vcu * NWAVES + wave, NGW = G * NWAVES; (void)gw; (void)NGW; (void)vcu


template <int L> __device__ __forceinline__ void layer_phases(const Args& args, LAS unsigned char* lds, const int tid0, const int lo0, const int hi0, const XcdBarrier& bar) {
    constexpr int l = L;
        const int pb = 1 + l * NPH_L;
        int lo = lo0, hi = hi0; asm volatile("" : "+s"(lo), "+s"(hi));
#define MODS_L ((const float*)(C.ws + WS_MODS) + (size_t)l * 3 * 12288)
#define WL ((const bf16*)(C.ws + WS_W) + (size_t)l * WLE_SIZE)
        if (IN(pb + 0)) { PHASE_ROOTS(); for (int rep = 0; rep < REP_EW; ++rep) ph_norm(C.out, C.in[8] + l * D, MODS_L, 0, (bf16*)(C.ws + WS_H), l > 0 ? (const float*)(C.ws + WS_PART) : (const float*)nullptr, MODS_L - 3 * 12288 + 5 * 2048, lane, gw, NGW); SEAM(pb + 0); }
        if (IN(pb + 1)) { PHASE_ROOTS();
            pg8::Gemm g{(const bf16*)(C.ws + WS_H), WL + WLE_IN, M, IN_WP, D}; pg8::StaticOrder S; S.init(M, IN_WP, G, bx);
            pg8::EpiF32 E{(float*)(C.ws + WS_U), IN_WP};
            for (int rep = 0; rep < REP_GEMM; ++rep) pg8::gemm_phase<pg8::EpiF32, pg8::StaticOrder, true, true>(lds, g, S, E);
            SEAM(pb + 1);
        }
        if (IN(pb + 2)) { PHASE_ROOTS();
#ifndef SKIP_PREP
            for (int rep = 0; rep < REP_EW; ++rep) ph_prep(C, l, lane, gw, NGW);
#endif
            SEAM(pb + 2); }
        if (IN(pb + 3)) {
            { PHASE_ROOTS(); pg8::Gemm g{(const bf16*)(C.ws + WS_CQN), WL + WLE_UQ, M, 1536, 768}; pg8::StaticOrder S; S.init(M, 1536, G, bx);
              pg8::EpiF32 E{(float*)(C.ws + WS_QRAW), 1536};
              for (int rep = 0; rep < REP_GEMM; ++rep) pg8::gemm_phase<pg8::EpiF32, pg8::StaticOrder, true, true>(lds, g, S, E); }
            { PHASE_ROOTS(); pg8::Gemm g{(const bf16*)(C.ws + WS_CKVN), WL + WLE_KV, MK, 1024, 512}; pg8::StaticOrder S; S.init(MK, 1024, G, bx);
              pg8::EpiF32 E{(float*)(C.ws + WS_KN), 1024};
              for (int rep = 0; rep < REP_GEMM; ++rep) pg8::gemm_phase<pg8::EpiF32, pg8::StaticOrder, true, true>(lds, g, S, E); }
            { PHASE_ROOTS(); pg8::Gemm g{WL + WLE_KV + (size_t)1024 * 512, (const bf16*)(C.ws + WS_CKVN), 1024, MK, 512}; pg8::StaticOrder S; S.init(1024, MK, G, bx);
              pg8::EpiBf16 E{(bf16*)(C.ws + WS_VT), MK};
              for (int rep = 0; rep < REP_GEMM; ++rep) pg8::gemm_phase<pg8::EpiBf16, pg8::StaticOrder, true, true>(lds, g, S, E); }
            SEAM(pb + 3);
        }
        if (IN(pb + 4)) { PHASE_ROOTS();
#ifndef SKIP_FIN
            for (int rep = 0; rep < REP_EW; ++rep) ph_finalize(C, l, lane, gw, NGW);
#endif
            for (int rep = 0; rep < REP_LOC; ++rep) { ph_gdn_local(C, l, lds, tid, lane, wave, vcu, G);
            ph_ssd_local(C, l, lds, tid, lane, wave, vcu, G); }
            SEAM(pb + 4); }
        if (IN(pb + 5)) { for (int rep = 0; rep < REP_MIX; ++rep) {
#ifndef SKIP_GDN
            { PHASE_ROOTS(); ph_gdn_seq(C, l, lds, tid, lane, wave, vcu, G); }
#endif
            __syncthreads();
#ifndef SKIP_SSD
            { PHASE_ROOTS(); ph_ssd_seq(C, l, lds, tid, lane, wave, vcu, G); }
#endif
            __syncthreads();
#ifndef SKIP_ATTN
            for (int rep2 = 0; rep2 < REP_ATTN; ++rep2) { PHASE_ROOTS(); ph_attn(C, lds, tid, lane, wave, vcu, G); }
#endif
            __syncthreads(); }
            SEAM(pb + 5);
        }
        if (IN(pb + 6)) { PHASE_ROOTS();
#ifndef SKIP_POST
            for (int rep = 0; rep < REP_EW; ++rep) ph_post(C, l, lane, gw, NGW);
#endif
            SEAM(pb + 6); }
        if (IN(pb + 7)) { PHASE_ROOTS();
            { pg8::Gemm g{(const bf16*)(C.ws + WS_MIX), WL + WLE_OUT, M, D, D, 0}; pg8::PanelOrder S{bx};
              pg8::EpiResid E{C.out, D, MODS_L + 2 * 2048};
              pg8::gemm_phase<pg8::EpiResid, pg8::PanelOrder, true, true>(lds, g, S, E); }
            { PHASE_ROOTS(); pg8::Gemm g{(const bf16*)(C.ws + WS_MIX), WL + WLE_OUT, M, D, D / 4, D}; pg8::TailOrder S{bx, D / 4};
              pg8::EpiPart E{(float*)(C.ws + WS_PART), D / 4};
              pg8::gemm_phase<pg8::EpiPart, pg8::TailOrder, true, true>(lds, g, S, E); }
            SEAM(pb + 7);
        }
        if (IN(pb + 8)) { PHASE_ROOTS(); for (int rep = 0; rep < REP_EW; ++rep) ph_norm(C.out, C.in[9] + l * D, MODS_L, 3, (bf16*)(C.ws + WS_H), (const float*)(C.ws + WS_PART), MODS_L + 2 * 2048, lane, gw, NGW); SEAM(pb + 8); }
        if (IN(pb + 9)) { PHASE_ROOTS();
            pg8::Gemm g{(const bf16*)(C.ws + WS_H), WL + WLE_GU, M, 2 * FF, D}; pg8::StaticOrder S; S.init(M, 2 * FF, G, bx);
            pg8::EpiSwiglu E{(bf16*)(C.ws + WS_ACT), FF};
            for (int rep = 0; rep < REP_GEMM; ++rep) pg8::gemm_phase<pg8::EpiSwiglu, pg8::StaticOrder, true, true>(lds, g, S, E);
            SEAM(pb + 9);
        }
        if (IN(pb + 10)) { PHASE_ROOTS();
            { pg8::Gemm g{(const bf16*)(C.ws + WS_ACT), WL + WLE_DN, M, D, FF, 0}; pg8::PanelOrder S{bx};
              pg8::EpiResid E{C.out, D, MODS_L + 5 * 2048};
              pg8::gemm_phase<pg8::EpiResid, pg8::PanelOrder, true, true>(lds, g, S, E); }
            { PHASE_ROOTS(); pg8::Gemm g{(const bf16*)(C.ws + WS_ACT), WL + WLE_DN, M, D, FF / 4, FF}; pg8::TailOrder S{bx, FF / 4};
              pg8::EpiPart E{(float*)(C.ws + WS_PART), FF / 4};
              pg8::gemm_phase<pg8::EpiPart, pg8::TailOrder, true, true>(lds, g, S, E); }
            SEAM(pb + 10);
        }
    }

__global__ void __launch_bounds__(NWAVES * 64, 2) mk_fwd(Args args) {
    extern __shared__ __attribute__((aligned(16))) unsigned char lds_raw[];
    LAS unsigned char* lds = (LAS unsigned char*)lds_raw;
    const int tid0 = threadIdx.x;
    for (int u = tid0; u < (LDS_BYTES - LDSCTL_OFF) / 4; u += NWAVES * 64) ((LAS unsigned*)(lds + LDSCTL_OFF))[u] = 0u;
    __syncthreads();
    const int lo0 = args.ph_lo, hi0 = args.ph_hi;
    XcdBarrier bar; bar.bar = (unsigned*)(args.ws + WS_CTL) + CW_BAR; bar.x = 0; bar.st = nullptr;
    if ((hi0 - lo0) > 1) bar = xcd_barrier_post((unsigned*)(args.ws + WS_CTL) + CW_BAR, (volatile LAS unsigned*)(lds + MISC_OFF) + 8);
    { int lo = lo0, hi = hi0;
    if (IN(0)) { for (int rep = 0; rep < REP_PRO; ++rep) { PHASE_ROOTS();
#ifndef SKIP_PRO
        ph_prologue(C, lds, tid, lane, wave, vcu, G);
#endif
        __syncthreads(); }
        SEAM(0); } }

    layer_phases<0>(args, lds, tid0, lo0, hi0, bar);
    layer_phases<1>(args, lds, tid0, lo0, hi0, bar);
    layer_phases<2>(args, lds, tid0, lo0, hi0, bar);
    layer_phases<3>(args, lds, tid0, lo0, hi0, bar);
    { int lo = lo0, hi = hi0; if (IN(NPHASES - 1)) { PHASE_ROOTS(); ph_final(C.out, (const float*)(C.ws + WS_PART), (const float*)(C.ws + WS_MODS) + (size_t)3 * 3 * 12288 + 5 * 2048, lane, gw, NGW); } }
#undef IN
#undef SEAM
}

extern "C" void kernel_launch(void* const* d_in, const int* in_sizes, int n_in, void* d_out, int out_size, void* d_ws, size_t ws_size, hipStream_t stream) {
    static int grid = 0;
    if (grid == 0) {
        if (n_in != 32 || out_size != 73400320 || ws_size < WS_END) { fprintf(stderr, "kernel_launch: built for 32 inputs, 73400320 outputs, >= %zu bytes of workspace; got n_in %d, out %d, ws %zu; nothing launched\n", (size_t)WS_END, n_in, out_size, ws_size); grid = -1; return; }
        int dev = 0, cus = 0, per_cu = 0;
        if (hipGetDevice(&dev) != hipSuccess || hipDeviceGetAttribute(&cus, hipDeviceAttributeMultiprocessorCount, dev) != hipSuccess) { fprintf(stderr, "kernel_launch: device query failed\n"); grid = -1; return; }
        if (hipFuncSetAttribute((const void*)mk_fwd, hipFuncAttributeMaxDynamicSharedMemorySize, LDS_BYTES) != hipSuccess) { fprintf(stderr, "kernel_launch: hipFuncSetAttribute failed\n"); grid = -1; return; }
        if (hipOccupancyMaxActiveBlocksPerMultiprocessor(&per_cu, (const void*)mk_fwd, NWAVES * 64, LDS_BYTES) != hipSuccess || per_cu < 1)
            fprintf(stderr, "kernel_launch: note: occupancy query reports %d workgroups per CU\n", per_cu);
        (void)hipGetLastError();
        grid = cus;
    }
    if (grid < 0) return;
    if (hipMemsetAsync((char*)d_ws + WS_CTL, 0, CTL_ZERO_BYTES, stream) != hipSuccess) { fprintf(stderr, "kernel_launch: memset failed\n"); return; }
    Args a{};
    for (int i = 0; i < 32; ++i) a.in[i] = (const float*)d_in[i];
    a.out = (float*)d_out; a.ws = (unsigned char*)d_ws;
#if MK_ONE_LAUNCH
    a.ph_lo = 0; a.ph_hi = NPHASES;
    hipLaunchKernelGGL(mk_fwd, dim3(grid), dim3(NWAVES * 64), LDS_BYTES, stream, a);
#else
    for (int p = 0; p < NPHASES; ++p) { a.ph_lo = p; a.ph_hi = p + 1; hipLaunchKernelGGL(mk_fwd, dim3(grid), dim3(NWAVES * 64), LDS_BYTES, stream, a); }
#endif
    const hipError_t le = hipPeekAtLastError();
    if (le != hipSuccess) fprintf(stderr, "kernel_launch: launch failed: %s\n", hipGetErrorName(le));
}
```

```cpp
#include <hip/hip_runtime.h>
#include <cstdio>
#include <cstdint>
#include <cstddef>
#ifndef MK_ONE_LAUNCH
#define MK_ONE_LAUNCH 1
#endif
namespace pg8 {
#define PG8_LAS __attribute__((address_space(3)))
typedef unsigned short bf16_t;
typedef short bf16x8 __attribute__((ext_vector_type(8)));
typedef float f32x4 __attribute__((ext_vector_type(4)));
typedef unsigned u32x4 __attribute__((ext_vector_type(4)));
constexpr int BM = 256, BK = 64, HALF = 128, HTB = HALF * BK * 2  , STAGE_BYTES = 8 * HTB, NXCD = 8, WGM = 8;

__host__ __device__ __forceinline__ int lds_byte(int r, int c) { const int st = (r >> 4) * 2 + (c >> 5), rr = r & 15, cc = c & 31, ob = rr * 64 + cc * 2; return st * 1024 + (ob ^ (((ob >> 9) & 1) << 5)); }
__host__ __device__ __forceinline__ void stage_rc(int b, int& R, int& C) { const int st = b / 1024, sb = b % 1024, swz = sb ^ (((sb >> 9) & 1) << 5); R = (st >> 1) * 16 + swz / 64; C = (st & 1) * 32 + (swz % 64) / 2; }
__host__ __device__ __forceinline__ int perm32(int rho) { const int n = rho >> 4, i = rho & 15; return 8 * (i >> 2) + 4 * n + (i & 3); }

struct Unit { int pm, pn, k0; };
struct Gemm { const bf16_t* A; const bf16_t* Bt; int M, N, K, ld; };

struct StaticOrder {
    int nM, nN, nwg, G, c;
    __host__ __device__ void init(int M, int N, int G_, int c_) { nM = M / BM; nN = N / BM; nwg = nM * nN; G = G_; c = c_; }
    __host__ __device__ bool next(int i, Unit& u) const {
        const long L = (long)i * G + c; if (L >= nwg) return false;
        int wgid = (int)L; { const int q = nwg / NXCD, r = nwg % NXCD, xcd = wgid % NXCD, off = wgid / NXCD; wgid = (xcd < r ? xcd * (q + 1) : r * (q + 1) + (xcd - r) * q) + off; }
        const int nig = WGM * nN, gid = wgid / nig, fm = gid * WGM, gsz = (nM - fm) < WGM ? (nM - fm) : WGM;
        u.pm = fm + ((wgid % nig) % gsz); u.pn = (wgid % nig) / gsz; u.k0 = 0; return true;
    }
    __device__ __forceinline__ void a_ready(const Unit&) const {}
    __device__ __forceinline__ void done(const Unit&) const {}
};

__device__ __forceinline__ unsigned cvt_pk_bf16(float lo, float hi) { unsigned r; asm volatile("v_cvt_pk_bf16_f32 %0, %1, %2" : "=v"(r) : "v"(lo), "v"(hi)); return r; }
__device__ __forceinline__ float silu_f(float x) { return x * __builtin_amdgcn_rcpf(1.0f + __expf(-x)); }

struct EpiF32 {
    static constexpr bool PERM = false, AFTER_DRAIN = false;
    float* C; int ldc;
    __device__ __forceinline__ void operator()(const f32x4 (&acc)[2][2][4][2], const Unit& u, int wr, int wc, int fr, int fq) const {
        const int row0 = u.pm * BM + wr * 64 + fr, col0 = u.pn * BM + wc * 32 + 4 * fq;
#pragma unroll
        for (int ai = 0; ai < 2; ++ai)
#pragma unroll
            for (int m = 0; m < 4; ++m) { float* rowp = C + (size_t)(row0 + ai * HALF + m * 16) * ldc + col0;
#pragma unroll
                for (int bj = 0; bj < 2; ++bj)
#pragma unroll
                    for (int n = 0; n < 2; ++n) *(f32x4*)(rowp + bj * HALF + n * 16) = acc[ai][bj][m][n]; }
    }
};
struct EpiBf16 {
    static constexpr bool PERM = true, AFTER_DRAIN = false;
    bf16_t* O; int ldc;
    __device__ __forceinline__ void operator()(const f32x4 (&acc)[2][2][4][2], const Unit& u, int wr, int wc, int fr, int fq) const {
        const int row0 = u.pm * BM + wr * 64 + fr; const int col0 = u.pn * BM + wc * 32 + 8 * fq;
#pragma unroll
        for (int ai = 0; ai < 2; ++ai)
#pragma unroll
            for (int m = 0; m < 4; ++m) { bf16_t* rowp = O + (size_t)(row0 + ai * HALF + m * 16) * ldc + col0;
#pragma unroll
                for (int bj = 0; bj < 2; ++bj) { const f32x4 v0 = acc[ai][bj][m][0], v1 = acc[ai][bj][m][1];
                    u32x4 w; w.x = cvt_pk_bf16(v0[0], v0[1]); w.y = cvt_pk_bf16(v0[2], v0[3]); w.z = cvt_pk_bf16(v1[0], v1[1]); w.w = cvt_pk_bf16(v1[2], v1[3]);
                    *(u32x4*)(rowp + bj * HALF) = w; } }
    }
};
typedef unsigned u32x2 __attribute__((ext_vector_type(2)));
template <bool F32OUT> struct EpiResidT {
    static constexpr bool PERM = false, AFTER_DRAIN = false;
    bf16_t* X; float* OUT; int ldc; const float* gate;
    __device__ __forceinline__ void operator()(const f32x4 (&acc)[2][2][4][2], const Unit& u, int wr, int wc, int fr, int fq) const {
        const int row0 = u.pm * BM + wr * 64 + fr, col0 = u.pn * BM + wc * 32 + 4 * fq;
        const int cr = u.pm < 32 ? 0 : 1 + ((u.pm - 32) >> 2);
        const float* gp = gate + (size_t)cr * 12288 + col0;
        f32x4 gv[2][2];
#pragma unroll
        for (int bj = 0; bj < 2; ++bj)
#pragma unroll
            for (int n = 0; n < 2; ++n) gv[bj][n] = *(const f32x4*)(gp + bj * HALF + n * 16);
#pragma unroll
        for (int ai = 0; ai < 2; ++ai)
#pragma unroll
            for (int m = 0; m < 4; ++m) { const size_t ro = (size_t)(row0 + ai * HALF + m * 16) * ldc + col0;
#pragma unroll
                for (int bj = 0; bj < 2; ++bj)
#pragma unroll
                    for (int n = 0; n < 2; ++n) { const size_t off = ro + bj * HALF + n * 16; const u32x2 xb = *(const u32x2*)(X + off);
                        f32x4 x; x[0] = __builtin_bit_cast(float, xb.x << 16); x[1] = __builtin_bit_cast(float, xb.x & 0xffff0000u); x[2] = __builtin_bit_cast(float, xb.y << 16); x[3] = __builtin_bit_cast(float, xb.y & 0xffff0000u);
                        x = x + gv[bj][n] * acc[ai][bj][m][n];
                        if (F32OUT) *(f32x4*)(OUT + off) = x; else { u32x2 w; w.x = cvt_pk_bf16(x[0], x[1]); w.y = cvt_pk_bf16(x[2], x[3]); *(u32x2*)(X + off) = w; } } }
    }
};
struct EpiSwiglu {
    static constexpr bool PERM = true, AFTER_DRAIN = false;
    bf16_t* O; int ldc;
    __device__ __forceinline__ void operator()(const f32x4 (&acc)[2][2][4][2], const Unit& u, int wr, int wc, int fr, int fq) const {
        const int row0 = u.pm * BM + wr * 64 + fr; const int col0 = u.pn * HALF + wc * 32 + 8 * fq;
#pragma unroll
        for (int ai = 0; ai < 2; ++ai)
#pragma unroll
            for (int m = 0; m < 4; ++m) { bf16_t* rowp = O + (size_t)(row0 + ai * HALF + m * 16) * ldc + col0;
                f32x4 v0, v1;
#pragma unroll
                for (int j = 0; j < 4; ++j) { v0[j] = silu_f(acc[ai][0][m][0][j]) * acc[ai][1][m][0][j]; v1[j] = silu_f(acc[ai][0][m][1][j]) * acc[ai][1][m][1][j]; }
                u32x4 w; w.x = cvt_pk_bf16(v0[0], v0[1]); w.y = cvt_pk_bf16(v0[2], v0[3]); w.z = cvt_pk_bf16(v1[0], v1[1]); w.w = cvt_pk_bf16(v1[2], v1[3]);
                *(u32x4*)rowp = w; }
    }
};


struct PanelOrder {
    int c;
    __device__ bool next(int i, Unit& u) const { if (i != 0 || c >= 256) return false; const int x = c & 7, j = c >> 3; u.pm = 4 * x + (j >> 3); u.pn = j & 7; u.k0 = 0; return true; }
    __device__ __forceinline__ void a_ready(const Unit&) const {}
    __device__ __forceinline__ void done(const Unit&) const {}
};
struct TailOrder {
    int c, kq;
    __device__ bool next(int i, Unit& u) const { if (i != 0 || c >= 256) return false; const int x = c & 7, j = c >> 3; u.pm = 32 + x; u.pn = j & 7; u.k0 = (j >> 3) * kq; return true; }
    __device__ __forceinline__ void a_ready(const Unit&) const {}
    __device__ __forceinline__ void done(const Unit&) const {}
};
struct EpiPart {
    static constexpr bool PERM = true, AFTER_DRAIN = false;
    bf16_t* P; int kq;
    __device__ __forceinline__ void operator()(const f32x4 (&acc)[2][2][4][2], const Unit& u, int wr, int wc, int fr, int fq) const {
        const int row0 = (u.pm - 32) * BM + wr * 64 + fr, col0 = u.pn * BM + wc * 32 + 8 * fq;
        bf16_t* base = P + (size_t)(u.k0 / kq) * 2048 * 2048;
#pragma unroll
        for (int ai = 0; ai < 2; ++ai)
#pragma unroll
            for (int m = 0; m < 4; ++m) { bf16_t* rowp = base + (size_t)(row0 + ai * HALF + m * 16) * 2048 + col0;
#pragma unroll
                for (int bj = 0; bj < 2; ++bj) { const f32x4 v0 = acc[ai][bj][m][0], v1 = acc[ai][bj][m][1];
                    u32x4 w; w.x = cvt_pk_bf16(v0[0], v0[1]); w.y = cvt_pk_bf16(v0[2], v0[3]); w.z = cvt_pk_bf16(v1[0], v1[1]); w.w = cvt_pk_bf16(v1[2], v1[3]);
                    *(u32x4*)(rowp + bj * HALF) = w; } }
    }
};

struct EpiU {
    static constexpr bool PERM = true, AFTER_DRAIN = false;
    bf16_t* O; int ldc; float* side;
    __device__ __forceinline__ void operator()(const f32x4 (&acc)[2][2][4][2], const Unit& u, int wr, int wc, int fr, int fq) const {
        const int row0 = u.pm * BM + wr * 64 + fr; const int col0 = u.pn * BM + wc * 32 + 8 * fq;
        const bool sd = (wc == 2) && ((u.pn == 13 && fq < 2) || (u.pn == 19 && fq >= 2));
        const int sc0 = (u.pn == 13) ? 8 * fq : 16 + 8 * (fq - 2);
#pragma unroll
        for (int ai = 0; ai < 2; ++ai)
#pragma unroll
            for (int m = 0; m < 4; ++m) { const int row = row0 + ai * HALF + m * 16; bf16_t* rowp = O + (size_t)row * ldc + col0;
#pragma unroll
                for (int bj = 0; bj < 2; ++bj) { const f32x4 v0 = acc[ai][bj][m][0], v1 = acc[ai][bj][m][1];
                    u32x4 w; w.x = cvt_pk_bf16(v0[0], v0[1]); w.y = cvt_pk_bf16(v0[2], v0[3]); w.z = cvt_pk_bf16(v1[0], v1[1]); w.w = cvt_pk_bf16(v1[2], v1[3]);
                    *(u32x4*)(rowp + bj * HALF) = w; }
                if (sd) { float* sp = side + (size_t)row * 32 + sc0; *(f32x4*)sp = acc[ai][0][m][0]; *(f32x4*)(sp + 4) = acc[ai][0][m][1]; } }
    }
};

struct InOrder {
    StaticOrder so;
    __device__ void init(int M, int G_, int c_) { so.init(M, 18 * BM, G_, c_); }
    __device__ bool next(int i, Unit& u) const { if (!so.next(i, u)) return false; u.pn = u.pn < 12 ? u.pn : (u.pn == 12 ? 13 : u.pn + 2); return true; }
    __device__ __forceinline__ void a_ready(const Unit&) const {}
    __device__ __forceinline__ void done(const Unit&) const {}
};
struct DeferOrder {
    int c;
    __device__ bool next(int i, Unit& u) const { const int d = c - 168; if (i != 0 || d < 0 || d >= 80) return false; u.pm = d >> 1; u.pn = (d & 1) ? 14 : 12; u.k0 = 0; return true; }
    __device__ __forceinline__ void a_ready(const Unit&) const {}
    __device__ __forceinline__ void done(const Unit&) const {}
};
template <class Epi, class Sched, bool ALIGN_EPI = false, bool SP2 = false>
__device__ __forceinline__ void gemm_phase(PG8_LAS unsigned char* lds, const Gemm g, const Sched& S, const Epi& E, int tid_in) {
    int tid_l = tid_in; asm volatile("" : "+v"(tid_l)); const int tid = tid_l, wid = __builtin_amdgcn_readfirstlane(tid >> 6), lane = tid & 63, wr = wid >> 2, wc = wid & 3, fr = lane & 15, fq = lane >> 4;
    const int K = g.ld ? g.ld : g.K, nt = g.K / BK;
    unsigned voffA[2], voffB[2];
#pragma unroll
    for (int i = 0; i < 2; ++i) { int R, C; stage_rc(tid * 16 + i * 8192, R, C); const int Rb = Epi::PERM ? ((R & ~31) + perm32(R & 31)) : R;
        voffA[i] = (unsigned)(R * K + C) * 2u; voffB[i] = (unsigned)(Rb * K + C) * 2u; }
    const size_t kstep = (size_t)(BK * 2);
    const size_t hstep = (size_t)HALF * K * 2;
    const size_t tstep = 2 * hstep;
    const unsigned ldsw = (unsigned)wid * 1024u;
    const int aoff = lds_byte(wr * 64 + fr, fq * 8), boff = lds_byte(wc * 32 + fr, fq * 8);
#define PG8_SA(b, h) (((b) * 2 + (h)) * HTB)
#define PG8_SB(b, h) ((4 + (b) * 2 + (h)) * HTB)
#define PG8_STAGE(bufoff, gbase, voff) do { _Pragma("unroll") for (int _i = 0; _i < 2; ++_i) \
        __builtin_amdgcn_global_load_lds((const unsigned*)((const char*)(gbase) + (voff)[_i]), (PG8_LAS unsigned*)(lds + (bufoff) + ldsw + _i * 8192), 16, 0, 0); } while (0)
#define PG8_LDA(dst, b, h) do { _Pragma("unroll") for (int m = 0; m < 4; ++m) _Pragma("unroll") for (int k = 0; k < 2; ++k) dst[m][k] = *(const PG8_LAS bf16x8*)(lds + PG8_SA(b, h) + aoff + m * 2048 + k * 1024); } while (0)
#define PG8_LDB(dst, b, h) do { _Pragma("unroll") for (int n = 0; n < 2; ++n) _Pragma("unroll") for (int k = 0; k < 2; ++k) dst[n][k] = *(const PG8_LAS bf16x8*)(lds + PG8_SB(b, h) + boff + n * 2048 + k * 1024); } while (0)
#define PG8_MMA(ai, bj, At, Bt) do { __builtin_amdgcn_s_setprio(1); _Pragma("unroll") for (int m = 0; m < 4; ++m) _Pragma("unroll") for (int n = 0; n < 2; ++n) _Pragma("unroll") for (int k = 0; k < 2; ++k) \
        acc[ai][bj][m][n] = __builtin_amdgcn_mfma_f32_16x16x32_bf16(Bt[n][k], At[m][k], acc[ai][bj][m][n], 0, 0, 0); __builtin_amdgcn_s_setprio(0); } while (0)
#define PG8_WAIT_V(n) asm volatile("s_waitcnt vmcnt(" #n ")" ::: "memory")
#define PG8_WAIT_L(n) asm volatile("s_waitcnt lgkmcnt(" #n ")" ::: "memory")
#define PG8_BAR __builtin_amdgcn_s_barrier()
#define PG8_SCHED __builtin_amdgcn_sched_barrier(0)
    Unit cur, nxt; int ui = 0;
    if (!S.next(0, cur)) return;
    f32x4 acc[2][2][4][2];
#pragma unroll
    for (int a = 0; a < 2; ++a)
#pragma unroll
        for (int b = 0; b < 2; ++b)
#pragma unroll
            for (int m = 0; m < 4; ++m)
#pragma unroll
                for (int n = 0; n < 2; ++n) acc[a][b][m][n] = (f32x4){0.f, 0.f, 0.f, 0.f};
    bf16x8 At[4][2], B0[2][2], B1[2][2];
    const char* cA = (const char*)g.A + (size_t)cur.pm * tstep + (size_t)cur.k0 * 2; const char* cB = (const char*)g.Bt + (size_t)cur.pn * tstep + (size_t)cur.k0 * 2;
    S.a_ready(cur);
    if constexpr (SP2) {
        PG8_STAGE(PG8_SB(0, 0), cB, voffB); PG8_STAGE(PG8_SB(0, 1), cB + hstep, voffB); PG8_STAGE(PG8_SA(0, 0), cA, voffA); PG8_STAGE(PG8_SA(0, 1), cA + hstep, voffA);
        if (wr == 1) PG8_BAR;
        PG8_WAIT_V(2); PG8_BAR;
        PG8_STAGE(PG8_SB(1, 0), cB + kstep, voffB); PG8_STAGE(PG8_SA(1, 0), cA + kstep, voffA); PG8_STAGE(PG8_SB(1, 1), cB + hstep + kstep, voffB);
        PG8_WAIT_V(6); PG8_BAR;
    } else {
        PG8_STAGE(PG8_SB(0, 0), cB, voffB); PG8_STAGE(PG8_SA(0, 0), cA, voffA); PG8_STAGE(PG8_SB(0, 1), cB + hstep, voffB); PG8_STAGE(PG8_SA(0, 1), cA + hstep, voffA);
        if (wr == 1) PG8_BAR;
        PG8_WAIT_V(4); PG8_BAR;
        PG8_STAGE(PG8_SB(1, 0), cB + kstep, voffB); PG8_STAGE(PG8_SA(1, 0), cA + kstep, voffA); PG8_STAGE(PG8_SB(1, 1), cB + hstep + kstep, voffB);
        PG8_WAIT_V(6); PG8_BAR;
    }
    for (;;) {
        const bool has_next = S.next(ui + 1, nxt);
        const char* nA = has_next ? (const char*)g.A + (size_t)nxt.pm * tstep + (size_t)nxt.k0 * 2 : cA; const char* nB = has_next ? (const char*)g.Bt + (size_t)nxt.pn * tstep + (size_t)nxt.k0 * 2 : cB;
        for (int t = 0; t < nt; t += 2) {
            const bool last = (t == nt - 2);
            const char* a1 = cA + (size_t)(t + 1) * kstep;
            const char* a2 = last ? nA : cA + (size_t)(t + 2) * kstep; const char* b2 = last ? nB : cB + (size_t)(t + 2) * kstep;
            const char* a3 = a2 + kstep; const char* b3 = b2 + kstep;
            if (last && has_next) S.a_ready(nxt);
            if constexpr (SP2) {
            PG8_LDB(B0, 0, 0); PG8_LDB(B1, 0, 1); PG8_SCHED; PG8_LDA(At, 0, 0); PG8_STAGE(PG8_SA(1, 1), a1 + hstep, voffA);
            PG8_WAIT_V(8); PG8_WAIT_L(0); PG8_BAR; PG8_MMA(0, 0, At, B0); PG8_MMA(0, 1, At, B1); PG8_BAR; PG8_SCHED;
            PG8_LDA(At, 0, 1); PG8_STAGE(PG8_SB(0, 0), b2, voffB); PG8_STAGE(PG8_SB(0, 1), b2 + hstep, voffB); PG8_STAGE(PG8_SA(0, 0), a2, voffA);
            PG8_WAIT_V(8); PG8_WAIT_L(0); PG8_BAR; PG8_MMA(1, 0, At, B0); PG8_MMA(1, 1, At, B1); PG8_BAR; PG8_SCHED;
            PG8_LDB(B0, 1, 0); PG8_LDB(B1, 1, 1); PG8_SCHED; PG8_LDA(At, 1, 0); PG8_STAGE(PG8_SA(0, 1), a2 + hstep, voffA);
            PG8_WAIT_V(8); PG8_WAIT_L(0); PG8_BAR; PG8_MMA(0, 0, At, B0); PG8_MMA(0, 1, At, B1); PG8_BAR; PG8_SCHED;
            PG8_LDA(At, 1, 1); PG8_STAGE(PG8_SB(1, 0), b3, voffB); PG8_STAGE(PG8_SB(1, 1), b3 + hstep, voffB); PG8_STAGE(PG8_SA(1, 0), a3, voffA);
            PG8_WAIT_V(8); PG8_WAIT_L(0); PG8_BAR; PG8_MMA(1, 0, At, B0); PG8_MMA(1, 1, At, B1); PG8_BAR; PG8_SCHED;
            } else {
            PG8_LDB(B0, 0, 0); PG8_SCHED; PG8_LDA(At, 0, 0); PG8_STAGE(PG8_SA(1, 1), a1 + hstep, voffA);
            PG8_WAIT_L(8); PG8_BAR; PG8_WAIT_L(0); PG8_MMA(0, 0, At, B0); PG8_BAR; PG8_SCHED;
            PG8_LDB(B1, 0, 1); PG8_STAGE(PG8_SB(0, 0), b2, voffB);
            PG8_BAR; PG8_WAIT_L(0); PG8_MMA(0, 1, At, B1); PG8_BAR;
            PG8_LDA(At, 0, 1); PG8_STAGE(PG8_SA(0, 0), a2, voffA);
            PG8_BAR; PG8_WAIT_L(0); PG8_MMA(1, 0, At, B0); PG8_BAR; PG8_SCHED;
            PG8_STAGE(PG8_SB(0, 1), b2 + hstep, voffB);
            PG8_WAIT_V(6); PG8_BAR; PG8_MMA(1, 1, At, B1); PG8_BAR;
            PG8_LDB(B0, 1, 0); PG8_SCHED; PG8_LDA(At, 1, 0); PG8_STAGE(PG8_SA(0, 1), a2 + hstep, voffA);
            PG8_WAIT_L(8); PG8_BAR; PG8_WAIT_L(0); PG8_MMA(0, 0, At, B0); PG8_BAR; PG8_SCHED;
            PG8_LDB(B1, 1, 1); PG8_STAGE(PG8_SB(1, 0), b3, voffB);
            PG8_BAR; PG8_WAIT_L(0); PG8_MMA(0, 1, At, B1); PG8_BAR;
            PG8_LDA(At, 1, 1); PG8_STAGE(PG8_SA(1, 0), a3, voffA);
            PG8_BAR; PG8_WAIT_L(0); PG8_MMA(1, 0, At, B0); PG8_BAR; PG8_SCHED;
            PG8_STAGE(PG8_SB(1, 1), b3 + hstep, voffB);
            PG8_WAIT_V(6); PG8_BAR; PG8_MMA(1, 1, At, B1); PG8_BAR;
            }
        }
        if constexpr (ALIGN_EPI) { if (wr == 0) PG8_BAR; }
        if constexpr (!Epi::AFTER_DRAIN) { E(acc, cur, wr, wc, fr, fq); S.done(cur); }
        if (!has_next) break;
#pragma unroll
        for (int a = 0; a < 2; ++a)
#pragma unroll
            for (int b = 0; b < 2; ++b)
#pragma unroll
                for (int m = 0; m < 4; ++m)
#pragma unroll
                    for (int n = 0; n < 2; ++n) acc[a][b][m][n] = (f32x4){0.f, 0.f, 0.f, 0.f};
        cur = nxt; cA = nA; cB = nB; ++ui;
        if constexpr (ALIGN_EPI) { if (wr == 1) PG8_BAR; }
    }
    PG8_WAIT_V(0);
    if constexpr (!ALIGN_EPI) { if (wr == 0) PG8_BAR; }
    PG8_BAR;
    if constexpr (Epi::AFTER_DRAIN) { E.fused(acc, cur, wr, wc, fr, fq, lds, wid, lane); S.done(cur); }
#undef PG8_SA
#undef PG8_SB
#undef PG8_STAGE
#undef PG8_LDA
#undef PG8_LDB
#undef PG8_MMA
#undef PG8_WAIT_V
#undef PG8_WAIT_L
#undef PG8_BAR
#undef PG8_SCHED
}
}
#ifndef REP_LAT
#define REP_LAT 1
#endif
#ifndef REP_CTX
#define REP_CTX 1
#endif
constexpr int D = 2048, NCTX = 8192, M = 10240, MK = 10752, DEPTH = 4, NWAVES = 8;
constexpr int IN_W = 4960, IN_WP = 5120, FF = 5632;
constexpr int U_CQ = 0, U_CKV = 768, U_KR = 1280, U_GQKV = 1344, U_GZ = 1344 + 1536, U_GB = 1344 + 2048, U_GA = 1344 + 2056, U_SZ = 3408, U_SXBC = 3408 + 512, U_SDT = 3408 + 1536;
constexpr float EPS = 1e-6f;
constexpr int NPH_L = 11, NPHASES = 2 + DEPTH * NPH_L;
constexpr size_t O_YP = 0, O_YS = 16777216, O_CKV = 20971520, O_KR = 37748736, O_SG = 39845888, O_SS = 56623104;
constexpr size_t MiB = 1u << 20;
constexpr size_t WS_CTL = 0, CTL_ZERO_BYTES = 1 * MiB;
constexpr size_t WL_IN = 0, WL_UQ = WL_IN + (size_t)IN_WP * D * 2, WL_UKV = WL_UQ + (size_t)1536 * 768 * 2, WL_OUT = WL_UKV + (size_t)2048 * 512 * 2,
                 WL_GU = WL_OUT + (size_t)D * D * 2, WL_DN = WL_GU + (size_t)2 * FF * D * 2, WL_SIZE = WL_DN + (size_t)D * FF * 2;
constexpr size_t WS_W = 2 * MiB;
constexpr size_t WS_MODS = WS_W + 4 * WL_SIZE;
constexpr size_t WS_H = WS_MODS + 1 * MiB;
constexpr size_t WS_U = WS_H + (size_t)M * D * 2;
constexpr size_t WS_USIDE = WS_U + (size_t)M * IN_WP * 2;
constexpr size_t WS_CQN = WS_USIDE + (size_t)M * 32 * 4;
constexpr size_t WS_CKVN = WS_CQN + (size_t)M * 768 * 2;
constexpr size_t WS_QRAW = WS_CKVN + (size_t)MK * 512 * 2;
constexpr size_t WS_KN = WS_QRAW + (size_t)M * 1536 * 4;
constexpr size_t WS_VT = WS_KN + (size_t)MK * 1024 * 4;
constexpr size_t WS_QB = WS_VT + (size_t)1024 * MK * 2;
constexpr size_t WS_KB = WS_QB + (size_t)M * 1536 * 2;
constexpr size_t WS_GQ = WS_KB + (size_t)MK * 1536 * 2;
constexpr size_t WS_GBG = WS_GQ + (size_t)3 * M * 512 * 4;
constexpr size_t WS_GO = WS_GBG + (size_t)2 * M * 8 * 4;
constexpr size_t WS_XBC = WS_GO + (size_t)2 * M * 512 * 4;
constexpr size_t WS_SDT = WS_XBC + (size_t)M * 1024 * 4;
constexpr size_t WS_SY = WS_SDT + (size_t)2 * M * 16 * 4;
constexpr size_t WS_MIX = WS_SY + (size_t)2 * M * 512 * 4;
constexpr size_t WS_ACT = WS_MIX + (size_t)M * D * 2;
constexpr size_t WS_GCH = WS_ACT + (size_t)M * FF * 2;
constexpr size_t WS_SREC = WS_GCH + (size_t)1280 * 90368;
constexpr size_t WS_SSH = WS_SREC + (size_t)1280 * 66560;
constexpr size_t WS_PART = WS_SSH + (size_t)160 * 65536;
constexpr size_t WS_X = WS_PART + (size_t)4 * 2048 * 2048 * 4;
constexpr size_t WS_END = WS_X + (size_t)M * D * 2;
constexpr int CW_BAR = 4096;
constexpr int RING_BYTES = 131072, LDS_BYTES = 163840, LDSCTL_OFF = LDS_BYTES - 512, MISC_OFF = LDSCTL_OFF + 320;

#define GAS __attribute__((address_space(1)))
#define LAS __attribute__((address_space(3)))
typedef unsigned short bf16;
typedef unsigned v4u __attribute__((ext_vector_type(4)));
typedef unsigned v2u __attribute__((ext_vector_type(2)));
typedef float f32x4 __attribute__((ext_vector_type(4)));
typedef float f32x2 __attribute__((ext_vector_type(2)));
typedef short bf16x8 __attribute__((ext_vector_type(8)));
typedef GAS unsigned gu32;
#define RLX_AGENT __ATOMIC_RELAXED, __HIP_MEMORY_SCOPE_AGENT
#define MEMBAR() asm volatile("" ::: "memory")
#define WG_BAR() do { asm volatile("s_waitcnt lgkmcnt(0)" ::: "memory"); __builtin_amdgcn_s_barrier(); asm volatile("" ::: "memory"); } while (0)
#define LDS_WAIT() asm volatile("s_waitcnt lgkmcnt(0)" ::: "memory")
#define VM_WAIT() asm volatile("s_waitcnt vmcnt(0)" ::: "memory")
__device__ __forceinline__ unsigned pk2(float lo, float hi) { unsigned r; asm("v_cvt_pk_bf16_f32 %0, %1, %2" : "=v"(r) : "v"(lo), "v"(hi)); return r; }
__device__ __forceinline__ unsigned f2bf(float f) { return pk2(f, 0.f) & 0xffffu; }
__device__ __forceinline__ float wave_sum(float v) {
#pragma unroll
    for (int o = 1; o < 64; o <<= 1) v += __shfl_xor(v, o);
    return v;
}
__device__ __forceinline__ float half_sum(float v) {
#pragma unroll
    for (int o = 1; o < 32; o <<= 1) v += __shfl_xor(v, o);
    return v;
}
__device__ __forceinline__ f32x4 bf4(v2u w) { f32x4 r; r.x = __builtin_bit_cast(float, w.x << 16); r.y = __builtin_bit_cast(float, w.x & 0xffff0000u); r.z = __builtin_bit_cast(float, w.y << 16); r.w = __builtin_bit_cast(float, w.y & 0xffff0000u); return r; }
__device__ __forceinline__ float bf1(bf16 v) { return __builtin_bit_cast(float, (unsigned)v << 16); }
__device__ __forceinline__ float silu(float x) { return x * __builtin_amdgcn_rcpf(1.0f + __expf(-x)); }
__device__ __forceinline__ float softplus(float x) { return x > 20.f ? x : log1pf(expf(x)); }

#define XB_TMO      128
#define XB_XCNT(j)  (256  + 64 * (j))
#define XB_XSUB(j)  (1280 + 64 * (j))
#define XB_XGEN(j)  (2304 + 64 * (j))
#define XB_TOP      3328
#define XB_TOPGEN   3392
#define XCD_BAR_WORDS 3456
#define XB_SPIN_CAP (1u << 18)

__device__ __forceinline__ unsigned xb_ld(unsigned* p)              { return __hip_atomic_load(p, __ATOMIC_RELAXED, __HIP_MEMORY_SCOPE_AGENT); }
__device__ __forceinline__ unsigned xb_add(unsigned* p, unsigned v) { return __hip_atomic_fetch_add(p, v, __ATOMIC_RELAXED, __HIP_MEMORY_SCOPE_AGENT); }
__device__ __forceinline__ unsigned xb_xcc_id() { return (unsigned)__builtin_amdgcn_s_getreg((3 << 11) | 20) & 0xFu; }
#define XB_SPIN(cond, bar) do { unsigned _sp = 0; while (cond) { __builtin_amdgcn_s_sleep(1); \
    if ((++_sp & 255u) == 0u) { if (xb_ld(&(bar)[XB_TMO])) break; if (_sp > XB_SPIN_CAP) { atomicAdd(&(bar)[XB_TMO], 1u); break; } } } } while (0)

struct XcdBarrier {
    unsigned* bar; unsigned x;
    volatile LAS unsigned* st;
    int wv;
};

__device__ __forceinline__ XcdBarrier xcd_barrier_post(unsigned* bar, volatile LAS unsigned* st) {
    XcdBarrier b; b.bar = bar; b.x = xb_xcc_id(); b.st = st;
    if (threadIdx.x == 0) (void)xb_add(&bar[XB_XCNT(b.x)], 1u);
    return b;
}
__device__ __forceinline__ void xcd_barrier_complete(unsigned* bar, unsigned x, unsigned& nloc, unsigned& nx) {
    const unsigned G = gridDim.x * gridDim.y * gridDim.z;
    unsigned sum, cnt, mine, sp = 0u;
    for (;;) {
        sum = 0u; cnt = 0u; mine = 0u;
#pragma unroll
        for (unsigned j = 0; j < 16; ++j) { const unsigned c = xb_ld(&bar[XB_XCNT(j)]); sum += c; cnt += (c > 0u) ? 1u : 0u; mine = (j == x) ? c : mine; }
        if (sum == G) break;
        __builtin_amdgcn_s_sleep(1);
        if ((++sp & 255u) == 0u) { if (xb_ld(&bar[XB_TMO])) break; if (sp > XB_SPIN_CAP) { atomicAdd(&bar[XB_TMO], 1u); break; } }
    }
    nloc = mine > 0u ? mine : 1u; nx = cnt > 0u ? cnt : 1u;
}

__device__ __forceinline__ void xcd_barrier(const XcdBarrier& b) {
    asm volatile("s_waitcnt vmcnt(0)" ::: "memory");
    __syncthreads();
    unsigned xm_ = ~0u; asm volatile("" : "+s"(xm_));
    if (b.wv == 0 && __builtin_amdgcn_mbcnt_hi(xm_, __builtin_amdgcn_mbcnt_lo(xm_, 0u)) == 0u) {
        unsigned* bar = b.bar;
        __builtin_amdgcn_s_waitcnt(0);
        unsigned nloc = b.st[0], nx = b.st[1];
        if (nloc == 0u) { xcd_barrier_complete(bar, b.x, nloc, nx); b.st[0] = nloc; b.st[1] = nx; }
        const unsigned old = xb_add(&bar[XB_XSUB(b.x)], 1u);
        const unsigned gen = old / nloc;
        if (old + 1u == (gen + 1u) * nloc) {
            __builtin_amdgcn_fence(__ATOMIC_RELEASE, "agent");
            asm volatile("s_waitcnt vmcnt(0)" ::: "memory");
            const unsigned og = xb_add(&bar[XB_TOP], 1u);
            const unsigned tg = og / nx;
            if (og + 1u == (tg + 1u) * nx) xb_add(&bar[XB_TOPGEN], 1u);
            else XB_SPIN(xb_ld(&bar[XB_TOPGEN]) == tg, bar);
            __builtin_amdgcn_fence(__ATOMIC_ACQUIRE, "agent");
            xb_add(&bar[XB_XGEN(b.x)], 1u);
            asm volatile("s_waitcnt vmcnt(0)" ::: "memory");
        } else {
            XB_SPIN(xb_ld(&bar[XB_XGEN(b.x)]) == gen, bar);
            __builtin_amdgcn_fence(__ATOMIC_ACQUIRE, "agent");
            asm volatile("s_waitcnt vmcnt(0)" ::: "memory");
        }
    }
    __syncthreads();
}
struct Args { const float* in[32]; float* out; unsigned char* ws; int ph_lo, ph_hi; };
#define CAS __attribute__((address_space(4)))
typedef const float* const CAS* kin_t;
struct Ctx { kin_t in; float* out; unsigned char* ws; };

__device__ __forceinline__ void transpose_item(const float* __restrict__ W, int K, int N, bf16* WT, int k0, int n0, int drow0, LAS float* scr, int lane) {
    { const GAS float* wp = (const GAS float*)W + (size_t)(k0 + (lane >> 5)) * N + n0 + (lane & 31); LAS float* sp = scr + (lane >> 5) * 33 + (lane & 31);
      float v[32];
#pragma unroll
      for (int i = 0; i < 32; ++i) v[i] = wp[(size_t)(2 * i) * N];
      MEMBAR();
#pragma unroll
      for (int i = 0; i < 32; ++i) sp[2 * i * 33] = v[i]; }
    LDS_WAIT(); asm volatile("" ::: "memory");
    const int c = lane & 7;
#pragma unroll
    for (int j = 0; j < 4; ++j) { const int n = (lane >> 3) + 8 * j; const LAS float* s = scr + (8 * c) * 33 + n;
        v4u o; o.x = pk2(s[0 * 33], s[1 * 33]); o.y = pk2(s[2 * 33], s[3 * 33]); o.z = pk2(s[4 * 33], s[5 * 33]); o.w = pk2(s[6 * 33], s[7 * 33]);
        *(GAS v4u*)(WT + (size_t)(drow0 + n) * K + k0 + 8 * c) = o; }
    LDS_WAIT(); asm volatile("" ::: "memory");
}
constexpr size_t WLE_IN = 0, WLE_UQ = WLE_IN + (size_t)IN_WP * D, WLE_KV = WLE_UQ + (size_t)1536 * 768, WLE_OUT = WLE_KV + (size_t)2048 * 512,
                 WLE_GU = WLE_OUT + (size_t)D * D, WLE_DN = WLE_GU + (size_t)2 * FF * D, WLE_SIZE = WLE_DN + (size_t)D * FF;
static_assert(WLE_SIZE * 2 == WL_SIZE, "weight map");

__device__ __forceinline__ void ph_prologue(const Ctx& A, LAS unsigned char* lds, int tid, int lane, int wave, int vcu, int G) {
    const int gw = vcu * NWAVES + wave, NGW = G * NWAVES;
    LAS float* scr = (LAS float*)(lds + wave * 8704);
    constexpr int I_IN = 32 * 155, I_UQ = 12 * 48, I_KV = 8 * 64, I_OUT = 32 * 64, I_GU = 32 * 352, I_DN = 88 * 64, I_L = I_IN + I_UQ + I_KV + I_OUT + I_GU + I_DN;
    for (int it = gw; it < DEPTH * I_L; it += NGW) {
        const int l = it / I_L; int r = it - l * I_L;
        bf16* wl = (bf16*)(A.ws + WS_W) + (size_t)l * WLE_SIZE;
        if (r < I_IN) { const int kb = r / 155, nb = r - kb * 155; transpose_item(A.in[12] + (size_t)l * D * IN_W, D, IN_W, wl + WLE_IN, 64 * kb, 32 * nb, 32 * nb, scr, lane); continue; } r -= I_IN;
        if (r < I_UQ) { const int kb = r / 48, nb = r - kb * 48; transpose_item(A.in[15] + (size_t)l * 768 * 1536, 768, 1536, wl + WLE_UQ, 64 * kb, 32 * nb, 32 * nb, scr, lane); continue; } r -= I_UQ;
        if (r < I_KV) { const int kb = r / 64, nb = r - kb * 64; const int n0 = 32 * nb, hh = n0 >> 8, c = n0 & 255; const int dr = (c < 128 ? 0 : 1024) + hh * 128 + (c & 127);
                        transpose_item(A.in[17] + (size_t)l * 512 * 2048, 512, 2048, wl + WLE_KV, 64 * kb, n0, dr, scr, lane); continue; } r -= I_KV;
        if (r < I_OUT) { const int kb = r / 64, nb = r - kb * 64; transpose_item(A.in[13] + (size_t)l * D * D, D, D, wl + WLE_OUT, 64 * kb, 32 * nb, 32 * nb, scr, lane); continue; } r -= I_OUT;
        if (r < I_GU) { const int kb = r / 352, nb = r - kb * 352; const int n0 = 32 * nb; int dr; if (n0 < FF) dr = (n0 >> 7) * 256 + (n0 & 127); else { const int n1 = n0 - FF; dr = (n1 >> 7) * 256 + 128 + (n1 & 127); }
                        transpose_item(A.in[30] + (size_t)l * D * 2 * FF, D, 2 * FF, wl + WLE_GU, 64 * kb, n0, dr, scr, lane); continue; } r -= I_GU;
        { const int kb = r / 64, nb = r - kb * 64; transpose_item(A.in[31] + (size_t)l * FF * D, FF, D, wl + WLE_DN, 64 * kb, 32 * nb, 32 * nb, scr, lane); }
    }
    { const int gt = vcu * 512 + tid, NGT = G * 512;
      for (int i = gt; i < DEPTH * 40960; i += NGT) { const int l = i / 40960, r = i - l * 40960; *(GAS v4u*)((bf16*)(A.ws + WS_W) + (size_t)l * WLE_SIZE + WLE_IN + (size_t)IN_W * D + (size_t)r * 8) = (v4u){0u, 0u, 0u, 0u}; }
      const GAS f32x4* xp = (const GAS f32x4*)A.in[0]; const GAS f32x4* xs = (const GAS f32x4*)A.in[1]; GAS v2u* o = (GAS v2u*)(A.ws + WS_X);
      { int i = gt;
        for (; i + 7 * NGT < 4194304; i += 8 * NGT) { f32x4 v[8];
#pragma unroll
            for (int j = 0; j < 8; ++j) v[j] = xp[i + j * NGT];
            MEMBAR();
#pragma unroll
            for (int j = 0; j < 8; ++j) { v2u w; w.x = pk2(v[j].x, v[j].y); w.y = pk2(v[j].z, v[j].w); o[i + j * NGT] = w; } }
        for (; i < 4194304; i += NGT) { const f32x4 v = xp[i]; v2u w; w.x = pk2(v.x, v.y); w.y = pk2(v.z, v.w); o[i] = w; } }
      { int i = gt;
        for (; i + 7 * NGT < 1048576; i += 8 * NGT) { f32x4 v[8];
#pragma unroll
            for (int j = 0; j < 8; ++j) v[j] = xs[i + j * NGT];
            MEMBAR();
#pragma unroll
            for (int j = 0; j < 8; ++j) { v2u w; w.x = pk2(v[j].x, v[j].y); w.y = pk2(v[j].z, v[j].w); o[4194304 + i + j * NGT] = w; } }
        for (; i < 1048576; i += NGT) { const f32x4 v = xs[i]; v2u w; w.x = pk2(v.x, v.y); w.y = pk2(v.z, v.w); o[4194304 + i] = w; } } }
    LAS float* scond = (LAS float*)(lds + 81920);
    LAS float* red = (LAS float*)(lds + 81920 + 24576);
    for (int i = tid; i < 3 * 2048; i += 512) { const int r = i >> 11, k = i & 2047; const float c = r == 0 ? A.in[7][k] : A.in[6][(r - 1) * 2048 + k]; scond[i] = silu(c); }
    __syncthreads();
    float* mods = (float*)(A.ws + WS_MODS);
    for (int item = vcu; item < 384; item += G) {
        const int l = item / 96, j0 = (item - l * 96) * 128;
        const float* w = A.in[10] + (size_t)l * 2048 * 12288 + j0 + 2 * lane;
        float a0x = 0, a0y = 0, a1x = 0, a1y = 0, a2x = 0, a2y = 0;
        const int kbeg = wave * 256;
#pragma unroll 8
        for (int k = kbeg; k < kbeg + 256; ++k) { const f32x2 v = *(const f32x2*)(w + (size_t)k * 12288); const float c0 = scond[k], c1 = scond[2048 + k], c2 = scond[4096 + k];
            a0x += c0 * v.x; a0y += c0 * v.y; a1x += c1 * v.x; a1y += c1 * v.y; a2x += c2 * v.x; a2y += c2 * v.y; }
        red[(wave * 3 + 0) * 128 + 2 * lane] = a0x; red[(wave * 3 + 0) * 128 + 2 * lane + 1] = a0y;
        red[(wave * 3 + 1) * 128 + 2 * lane] = a1x; red[(wave * 3 + 1) * 128 + 2 * lane + 1] = a1y;
        red[(wave * 3 + 2) * 128 + 2 * lane] = a2x; red[(wave * 3 + 2) * 128 + 2 * lane + 1] = a2y;
        __syncthreads();
        if (tid < 384) { const int r = tid >> 7, j = tid & 127; float s = 0.f;
#pragma unroll
            for (int w8 = 0; w8 < 8; ++w8) s += red[(w8 * 3 + r) * 128 + j];
            mods[(size_t)(l * 3 + r) * 12288 + j0 + j] = s + A.in[11][(size_t)l * 12288 + j0 + j]; }
        __syncthreads();
    }
}

__device__ __forceinline__ void ph_norm(bf16* X_, const float* g_, const float* mods_l_, int shift_idx, bf16* H_, const float* part_, const float* pgate_, int lane, int gw, int NGW) {
    GAS bf16* X = (GAS bf16*)X_; const GAS float* g = (const GAS float*)g_; const GAS float* mods_l = (const GAS float*)mods_l_; GAS bf16* H = (GAS bf16*)H_;
    const GAS bf16* part = (const GAS bf16*)part_; const GAS float* pgate = (const GAS float*)pgate_;
    constexpr size_t PS = (size_t)2048 * 2048;
    f32x4 ga[8], hb[8];
    { const GAS float* sh = mods_l + shift_idx * 2048; const GAS float* sc = sh + 2048;
#pragma unroll
      for (int j = 0; j < 8; ++j) { const int c = 4 * lane + 256 * j; ga[j] = *(const GAS f32x4*)(g + c) * (*(const GAS f32x4*)(sc + c) + 1.0f); hb[j] = *(const GAS f32x4*)(sh + c); } }
    for (int m0 = gw; m0 < M; m0 += 5 * NGW) {
        v2u raw[5][8];
#pragma unroll
        for (int k = 0; k < 5; ++k) { const int m = m0 + k * NGW; if (m < M) { const GAS v2u* xr = (const GAS v2u*)(X + (size_t)m * D) + lane;
#pragma unroll
            for (int j = 0; j < 8; ++j) raw[k][j] = xr[64 * j]; } }
        MEMBAR();
#pragma unroll
        for (int k = 0; k < 5; ++k) { const int m = m0 + k * NGW; if (m >= M) break;
            const int cr = m < NCTX ? 0 : 1 + ((m - NCTX) >> 10);
            f32x4 v[8]; float ss = 0.f;
#pragma unroll
            for (int j = 0; j < 8; ++j) v[j] = bf4(raw[k][j]);
            if (part_ != nullptr && m >= NCTX) {
                GAS v2u* xr = (GAS v2u*)(X + (size_t)m * D) + lane;
                const GAS v2u* pp = (const GAS v2u*)(part + (size_t)(m - NCTX) * 2048) + lane; const GAS f32x4* gp = (const GAS f32x4*)(pgate + (size_t)cr * 12288) + lane;
#pragma unroll
                for (int j = 0; j < 8; ++j) { const f32x4 p = (bf4(pp[64 * j]) + bf4(pp[PS / 4 + 64 * j])) + (bf4(pp[2 * (PS / 4) + 64 * j]) + bf4(pp[3 * (PS / 4) + 64 * j])); v[j] = v[j] + gp[64 * j] * p; v2u w; w.x = pk2(v[j].x, v[j].y); w.y = pk2(v[j].z, v[j].w); xr[64 * j] = w; } }
#pragma unroll
            for (int j = 0; j < 8; ++j) ss += (v[j].x * v[j].x + v[j].y * v[j].y) + (v[j].z * v[j].z + v[j].w * v[j].w);
            const float rstd = 1.0f / sqrtf(wave_sum(ss) * (1.0f / D) + EPS);
            if (cr == 0) {
#pragma unroll
                for (int j = 0; j < 8; ++j) { const int c = 4 * lane + 256 * j; const f32x4 o = v[j] * rstd * ga[j] + hb[j]; v2u w; w.x = pk2(o.x, o.y); w.y = pk2(o.z, o.w); *(GAS v2u*)(H + (size_t)m * D + c) = w; } }
            else { const GAS float* sh = mods_l + (size_t)cr * 12288 + shift_idx * 2048; const GAS float* sc = sh + 2048;
#pragma unroll
                for (int j = 0; j < 8; ++j) { const int c = 4 * lane + 256 * j; const f32x4 g4 = *(const GAS f32x4*)(g + c), s4 = *(const GAS f32x4*)(sc + c), h4 = *(const GAS f32x4*)(sh + c);
                    const f32x4 o = v[j] * rstd * g4 * (s4 + 1.0f) + h4; v2u w; w.x = pk2(o.x, o.y); w.y = pk2(o.z, o.w); *(GAS v2u*)(H + (size_t)m * D + c) = w; } }
        }
    }
}
__device__ __forceinline__ void ph_final(const bf16* X_, float* OUT_, const float* part_, const float* pgate_, int lane, int gw, int NGW) {
    const GAS bf16* X = (const GAS bf16*)X_; GAS float* OUT = (GAS float*)OUT_; const GAS bf16* part = (const GAS bf16*)part_; const GAS float* pgate = (const GAS float*)pgate_;
    constexpr size_t PS = (size_t)2048 * 2048;
    for (int m = NCTX + gw; m < M; m += NGW) {
        const int cr = 1 + ((m - NCTX) >> 10);
        const GAS v2u* xr = (const GAS v2u*)(X + (size_t)m * D) + lane; GAS f32x4* orow = (GAS f32x4*)(OUT + (size_t)m * D) + lane;
        const GAS v2u* pp = (const GAS v2u*)(part + (size_t)(m - NCTX) * 2048) + lane; const GAS f32x4* gp = (const GAS f32x4*)(pgate + (size_t)cr * 12288) + lane;
#pragma unroll
        for (int j = 0; j < 8; ++j) { const f32x4 p = (bf4(pp[64 * j]) + bf4(pp[PS / 4 + 64 * j])) + (bf4(pp[2 * (PS / 4) + 64 * j]) + bf4(pp[3 * (PS / 4) + 64 * j])); orow[64 * j] = bf4(xr[64 * j]) + gp[64 * j] * p; }
    }
}

__device__ __forceinline__ int seq_of(int m) { return (m < 0 || m >= M) ? -1 : (m < NCTX ? (m >> 8) : 32 + ((m - NCTX) >> 10)); }
__device__ __forceinline__ void ph_prep(const Ctx& A, int l, int lane, int gw, int NGW) {
    const GAS bf16* U = (const GAS bf16*)(A.ws + WS_U); const GAS float* USIDE = (const GAS float*)(A.ws + WS_USIDE);
    GAS bf16* CQN = (GAS bf16*)(A.ws + WS_CQN); GAS bf16* CKVN = (GAS bf16*)(A.ws + WS_CKVN);
    GAS bf16* GQ = (GAS bf16*)(A.ws + WS_GQ); GAS bf16* GK = GQ + (size_t)M * 512; GAS bf16* GV = GK + (size_t)M * 512;
    GAS float* GBETA = (GAS float*)(A.ws + WS_GBG); GAS float* GG = GBETA + (size_t)M * 8;
    GAS bf16* XBC = (GAS bf16*)(A.ws + WS_XBC); GAS float* SDT = (GAS float*)(A.ws + WS_SDT); GAS float* SDA = SDT + (size_t)M * 16;
    GAS float* OUT = (GAS float*)A.out;
    const GAS float* qn_g = (const GAS float*)(A.in[14] + l * 768); const GAS float* kvn_g = (const GAS float*)(A.in[16] + l * 512);
    const GAS float* gconv = (const GAS float*)(A.in[20] + (size_t)l * 5 * 1536); const GAS float* sconv = (const GAS float*)(A.in[24] + (size_t)l * 5 * 1024); const GAS float* sconvb = (const GAS float*)(A.in[25] + l * 1024);
    for (int run = gw; run < M / 5; run += NGW) {
        const int m0 = run * 5;
        int l4 = 4 * lane; asm volatile("" : "+v"(l4));
        { f32x4 vq[5][3], vk[5][2]; float kr[5];
#pragma unroll
          for (int r = 0; r < 5; ++r) { const GAS bf16* u = U + (size_t)(m0 + r) * IN_WP;
#pragma unroll
              for (int i = 0; i < 3; ++i) vq[r][i] = bf4(*(const GAS v2u*)(u + U_CQ + l4 + 256 * i));
#pragma unroll
              for (int i = 0; i < 2; ++i) vk[r][i] = bf4(*(const GAS v2u*)(u + U_CKV + l4 + 256 * i));
              kr[r] = bf1(u[U_KR + lane]); }
          float sq[5], sk[5];
#pragma unroll
          for (int r = 0; r < 5; ++r) { float a = 0.f, c = 0.f;
#pragma unroll
              for (int i = 0; i < 3; ++i) a += (vq[r][i].x * vq[r][i].x + vq[r][i].y * vq[r][i].y) + (vq[r][i].z * vq[r][i].z + vq[r][i].w * vq[r][i].w);
#pragma unroll
              for (int i = 0; i < 2; ++i) c += (vk[r][i].x * vk[r][i].x + vk[r][i].y * vk[r][i].y) + (vk[r][i].z * vk[r][i].z + vk[r][i].w * vk[r][i].w);
              sq[r] = a; sk[r] = c; }
#pragma unroll
          for (int o = 1; o < 64; o <<= 1) {
#pragma unroll
              for (int r = 0; r < 5; ++r) { sq[r] += __shfl_xor(sq[r], o); sk[r] += __shfl_xor(sk[r], o); } }
#pragma unroll
          for (int r = 0; r < 5; ++r) { const int m = m0 + r; const bool ctx = m < NCTX; const int b = m >> 8, t = m & 255;
              const float rq = 1.0f / sqrtf(sq[r] * (1.0f / 768.f) + EPS), rk = 1.0f / sqrtf(sk[r] * (1.0f / 512.f) + EPS);
#pragma unroll
              for (int i = 0; i < 3; ++i) { const int c = l4 + 256 * i; const f32x4 o = vq[r][i] * rq * *(const GAS f32x4*)(qn_g + c); v2u w; w.x = pk2(o.x, o.y); w.y = pk2(o.z, o.w); *(GAS v2u*)(CQN + (size_t)m * 768 + c) = w; }
#pragma unroll
              for (int i = 0; i < 2; ++i) { const int c = l4 + 256 * i; const f32x4 o = vk[r][i] * rk * *(const GAS f32x4*)(kvn_g + c); v2u w; w.x = pk2(o.x, o.y); w.y = pk2(o.z, o.w); *(GAS v2u*)(CKVN + (size_t)m * 512 + c) = w;
                  if (ctx) *(GAS f32x4*)(OUT + O_CKV + ((size_t)(b * 4 + l) * 256 + t) * 512 + c) = o; }
              if (ctx) OUT[O_KR + ((size_t)(b * 4 + l) * 256 + t) * 64 + lane] = kr[r]; } }
        MEMBAR();
        { float gb[5], ga[5], sd[5];
#pragma unroll
          for (int r = 0; r < 5; ++r) { const GAS float* us = USIDE + (size_t)(m0 + r) * 32; gb[r] = us[lane & 7]; ga[r] = us[8 + (lane & 7)]; sd[r] = us[16 + (lane & 15)]; }
          const float alog = expf(((const GAS float*)A.in[21])[l * 8 + (lane & 7)]), dtb = ((const GAS float*)A.in[22])[l * 8 + (lane & 7)];
          const float salog = expf(((const GAS float*)A.in[26])[l * 16 + (lane & 15)]), sdtb = ((const GAS float*)A.in[27])[l * 16 + (lane & 15)];
#pragma unroll
          for (int r = 0; r < 5; ++r) { const int m = m0 + r;
              if (lane < 8) { GBETA[(size_t)m * 8 + lane] = 1.0f / (1.0f + expf(-gb[r])); GG[(size_t)m * 8 + lane] = -alog * softplus(ga[r] + dtb); }
              if (lane < 16) { const float dt = softplus(sd[r] + sdtb); SDT[(size_t)m * 16 + lane] = dt; SDA[(size_t)m * 16 + lane] = -salog * dt; } } }
        MEMBAR();
        int sid[9];
#pragma unroll
        for (int jj = 0; jj < 9; ++jj) sid[jj] = seq_of(m0 - 2 + jj);
#pragma unroll
        for (int ci = 0; ci < 10; ++ci) {
            const int uoff = ci < 6 ? U_GQKV + 256 * ci : U_SXBC + 256 * (ci - 6);
            const GAS float* wp = ci < 6 ? gconv + 256 * ci : sconv + 256 * (ci - 6); const int wst = ci < 6 ? 1536 : 1024;
            f32x4 uw[9], w[5];
#pragma unroll
            for (int jj = 0; jj < 9; ++jj) { int mm = m0 - 2 + jj; mm = mm < 0 ? 0 : (mm >= M ? M - 1 : mm); uw[jj] = bf4(*(const GAS v2u*)(U + (size_t)mm * IN_WP + uoff + l4)); }
#pragma unroll
            for (int j = 0; j < 5; ++j) w[j] = *(const GAS f32x4*)(wp + j * wst + l4);
            f32x4 bias = (f32x4){0.f, 0.f, 0.f, 0.f}; if (ci >= 6) bias = *(const GAS f32x4*)(sconvb + 256 * (ci - 6) + l4);
#pragma unroll
            for (int r = 0; r < 5; ++r) { const int m = m0 + r; f32x4 acc = bias;
#pragma unroll
                for (int j = 0; j < 5; ++j) { const float mk = (sid[r + j] == sid[r + 2]) ? 1.0f : 0.0f; acc += (w[j] * mk) * uw[r + j]; }
                acc.x = silu(acc.x); acc.y = silu(acc.y); acc.z = silu(acc.z); acc.w = silu(acc.w);
                if (ci < 4) { const float ss = half_sum((acc.x * acc.x + acc.y * acc.y) + (acc.z * acc.z + acc.w * acc.w)); acc = acc * __builtin_amdgcn_rsqf(ss + EPS); }
                if (ci < 6) { GAS bf16* dst = ci < 2 ? GQ + (size_t)m * 512 + 256 * ci : (ci < 4 ? GK + (size_t)m * 512 + 256 * (ci - 2) : GV + (size_t)m * 512 + 256 * (ci - 4));
                    v2u w; w.x = pk2(acc.x, acc.y); w.y = pk2(acc.z, acc.w); *(GAS v2u*)(dst + l4) = w; }
                else { v2u w; w.x = pk2(acc.x, acc.y); w.y = pk2(acc.z, acc.w); *(GAS v2u*)(XBC + (size_t)m * 1024 + 256 * (ci - 6) + l4) = w; } }
            if (ci & 1) MEMBAR();
        }
    }
    for (int m = M + gw; m < MK; m += NGW) {
        const int j = m - M, b = j >> 8, t = j & 255; const GAS float* src = (const GAS float*)(A.in[2] + ((size_t)(b * 4 + l) * 256 + t) * 512);
#pragma unroll
        for (int i = 0; i < 2; ++i) { const int c = 4 * lane + 256 * i; const f32x4 v = *(const GAS f32x4*)(src + c); v2u w; w.x = pk2(v.x, v.y); w.y = pk2(v.z, v.w); *(GAS v2u*)(CKVN + (size_t)m * 512 + c) = w; }
    }
}

constexpr int FIN_TAB = 150000;
__device__ __forceinline__ void ph_finalize(const Ctx& A, int l, LAS unsigned char* lds, int tid, int lane, int gw, int NGW) {
    const GAS bf16* U = (const GAS bf16*)(A.ws + WS_U); const GAS bf16* QRAW = (const GAS bf16*)(A.ws + WS_QRAW); const GAS bf16* KN = (const GAS bf16*)(A.ws + WS_KN);
    GAS bf16* QB = (GAS bf16*)(A.ws + WS_QB); GAS bf16* KB = (GAS bf16*)(A.ws + WS_KB);
    const GAS float* q_g = (const GAS float*)(A.in[18] + l * 192); const GAS float* k_g = (const GAS float*)(A.in[19] + l * 192);
    const float QS = 0.07216878364870322f * 1.4426950408889634f;
    LAS float* tcos = (LAS float*)(lds + FIN_TAB); LAS float* tsin = tcos + 1024;
    for (int i = tid; i < 1024; i += NWAVES * 64) { const float ang = (float)(i >> 4) * powf(10000.f, -(float)(i & 15) * (1.0f / 16.f)); tcos[i] = cosf(ang); tsin[i] = sinf(ang); }
    __syncthreads();
    const int h = lane >> 3, sub = lane & 7;
    float qg[24], kg[24];
#pragma unroll
    for (int i = 0; i < 3; ++i)
#pragma unroll
        for (int j = 0; j < 8; ++j) { qg[i * 8 + j] = q_g[(sub + 8 * i) * 8 + j] * QS; kg[i * 8 + j] = k_g[(sub + 8 * i) * 8 + j]; }
    const bool hi = (sub >> 1) & 1;
    for (int m = gw; m < MK; m += NGW) {
        int s8 = sub * 8; asm volatile("" : "+v"(s8));
        const bool fresh = m < M, latent = fresh && m >= NCTX;
        float cs[8], sn[8];
        if (latent) { const int t = (m - NCTX) & 1023, pos = (sub >> 2) ? (t & 63) : (t >> 6); const LAS float* pc = tcos + pos * 16 + (sub & 1) * 8; const LAS float* ps = tsin + pos * 16 + (sub & 1) * 8;
            const f32x4 c0 = *(const LAS f32x4*)pc, c1 = *(const LAS f32x4*)(pc + 4), s0 = *(const LAS f32x4*)ps, s1 = *(const LAS f32x4*)(ps + 4);
            cs[0] = c0.x; cs[1] = c0.y; cs[2] = c0.z; cs[3] = c0.w; cs[4] = c1.x; cs[5] = c1.y; cs[6] = c1.z; cs[7] = c1.w; sn[0] = s0.x; sn[1] = s0.y; sn[2] = s0.z; sn[3] = s0.w; sn[4] = s1.x; sn[5] = s1.y; sn[6] = s1.z; sn[7] = s1.w; }
        else {
#pragma unroll
            for (int j = 0; j < 8; ++j) { cs[j] = 1.f; sn[j] = 0.f; } }
        const v4u kn0 = *(const GAS v4u*)(KN + (size_t)m * 1024 + h * 128 + s8), kn1 = *(const GAS v4u*)(KN + (size_t)m * 1024 + h * 128 + 64 + s8);
        float kr[8];
        if (fresh) { const v4u w = *(const GAS v4u*)(U + (size_t)m * IN_WP + U_KR + s8); const f32x4 a = bf4((v2u){w.x, w.y}), b = bf4((v2u){w.z, w.w}); kr[0] = a.x; kr[1] = a.y; kr[2] = a.z; kr[3] = a.w; kr[4] = b.x; kr[5] = b.y; kr[6] = b.z; kr[7] = b.w; }
        else { const GAS float* cp = (const GAS float*)(A.in[3] + ((size_t)(((m - M) >> 8) * 4 + l) * 256 + ((m - M) & 255)) * 64) + s8; const f32x4 a = *(const GAS f32x4*)cp, b = *(const GAS f32x4*)(cp + 4);
            kr[0] = a.x; kr[1] = a.y; kr[2] = a.z; kr[3] = a.w; kr[4] = b.x; kr[5] = b.y; kr[6] = b.z; kr[7] = b.w; }
        v4u qp[3];
        if (fresh) {
#pragma unroll
            for (int i = 0; i < 3; ++i) qp[i] = *(const GAS v4u*)(QRAW + (size_t)m * 1536 + h * 192 + 64 * i + s8); }
        { float x[24];
          { const f32x4 a = bf4((v2u){kn0.x, kn0.y}), b = bf4((v2u){kn0.z, kn0.w}), c = bf4((v2u){kn1.x, kn1.y}), d = bf4((v2u){kn1.z, kn1.w});
            x[0] = a.x; x[1] = a.y; x[2] = a.z; x[3] = a.w; x[4] = b.x; x[5] = b.y; x[6] = b.z; x[7] = b.w; x[8] = c.x; x[9] = c.y; x[10] = c.z; x[11] = c.w; x[12] = d.x; x[13] = d.y; x[14] = d.z; x[15] = d.w; }
#pragma unroll
          for (int j = 0; j < 8; ++j) x[16 + j] = kr[j];
          float ss = 0.f;
#pragma unroll
          for (int j = 0; j < 24; ++j) ss += x[j] * x[j];
          ss += __shfl_xor(ss, 1); ss += __shfl_xor(ss, 2); ss += __shfl_xor(ss, 4);
          const float rstd = 1.0f / sqrtf(ss * (1.0f / 192.f) + EPS);
#pragma unroll
          for (int j = 0; j < 24; ++j) x[j] *= rstd * kg[j];
#pragma unroll
          for (int j = 0; j < 8; ++j) { const float p = __shfl_xor(x[16 + j], 2); x[16 + j] = hi ? x[16 + j] * cs[j] + p * sn[j] : x[16 + j] * cs[j] - p * sn[j]; }
          GAS bf16* dst = KB + (size_t)m * 1536 + h * 192 + s8;
#pragma unroll
          for (int i = 0; i < 3; ++i) { v4u w; w.x = pk2(x[8 * i], x[8 * i + 1]); w.y = pk2(x[8 * i + 2], x[8 * i + 3]); w.z = pk2(x[8 * i + 4], x[8 * i + 5]); w.w = pk2(x[8 * i + 6], x[8 * i + 7]); *(GAS v4u*)(dst + 64 * i) = w; } }
        if (fresh) { float x[24];
#pragma unroll
          for (int i = 0; i < 3; ++i) { const f32x4 a = bf4((v2u){qp[i].x, qp[i].y}), b = bf4((v2u){qp[i].z, qp[i].w}); x[8 * i] = a.x; x[8 * i + 1] = a.y; x[8 * i + 2] = a.z; x[8 * i + 3] = a.w; x[8 * i + 4] = b.x; x[8 * i + 5] = b.y; x[8 * i + 6] = b.z; x[8 * i + 7] = b.w; }
          float ss = 0.f;
#pragma unroll
          for (int j = 0; j < 24; ++j) ss += x[j] * x[j];
          ss += __shfl_xor(ss, 1); ss += __shfl_xor(ss, 2); ss += __shfl_xor(ss, 4);
          const float rstd = 1.0f / sqrtf(ss * (1.0f / 192.f) + EPS);
#pragma unroll
          for (int j = 0; j < 24; ++j) x[j] *= rstd * qg[j];
#pragma unroll
          for (int j = 0; j < 8; ++j) { const float p = __shfl_xor(x[16 + j], 2); x[16 + j] = hi ? x[16 + j] * cs[j] + p * sn[j] : x[16 + j] * cs[j] - p * sn[j]; }
          GAS bf16* dst = QB + (size_t)m * 1536 + h * 192 + s8;
#pragma unroll
          for (int i = 0; i < 3; ++i) { v4u w; w.x = pk2(x[8 * i], x[8 * i + 1]); w.y = pk2(x[8 * i + 2], x[8 * i + 3]); w.z = pk2(x[8 * i + 4], x[8 * i + 5]); w.w = pk2(x[8 * i + 6], x[8 * i + 7]); *(GAS v4u*)(dst + 64 * i) = w; } }
    }
}

constexpr int AT_KROW = 400, AT_KBYTES = 64 * AT_KROW, AT_VROW = 144, AT_VBYTES = 128 * AT_VROW, AT_BUF = AT_KBYTES + AT_VBYTES;
__device__ __forceinline__ void attn_wg_item(const bf16* QB_, const bf16* KB_, const bf16* VT_, bf16* MIX_, float cmax, int qrow0, int h, int mkA, int nA, int mkB, int nB, LAS unsigned char* lds, int tid, int lane, int wave, unsigned long long* tprobe_ts = nullptr, int tprobe_l = 0) {
    const GAS bf16* QB = (const GAS bf16*)QB_; const GAS bf16* KB = (const GAS bf16*)KB_; const GAS bf16* VT = (const GAS bf16*)VT_; GAS bf16* MIX = (GAS bf16*)MIX_;
    const int fr = lane & 15, fq = lane >> 4;
    LAS unsigned char* plds = lds + 2 * AT_BUF + wave * 2304;
    const int qr = qrow0 + wave * 16;
    bf16x8 qf[6];
#pragma unroll
    for (int d = 0; d < 6; ++d) qf[d] = *(const GAS bf16x8*)(QB + ((size_t)(qr + fr) * 8 + h) * 192 + d * 32 + fq * 8);
    f32x4 o[8];
#pragma unroll
    for (int i = 0; i < 8; ++i) o[i] = (f32x4){0.f, 0.f, 0.f, 0.f};
    float lrow[4] = {0.f, 0.f, 0.f, 0.f};
    const int ntA = nA >> 6, nt = (nA + nB) >> 6;
    int kr_[3], kc_[3];
#pragma unroll
    for (int j = 0; j < 3; ++j) { const int id = tid + 512 * j; kr_[j] = id / 24; kc_[j] = id - kr_[j] * 24; }
    const int vr = tid >> 3, vc = tid & 7;
    v4u sk[3], sv[2];
#define AT_LOAD(mk_) do { _Pragma("unroll") for (int j_ = 0; j_ < 3; ++j_) sk[j_] = *(const GAS v4u*)(KB + ((size_t)((mk_) + kr_[j_]) * 8 + h) * 192 + kc_[j_] * 8); \
        _Pragma("unroll") for (int j_ = 0; j_ < 2; ++j_) sv[j_] = *(const GAS v4u*)(VT + (size_t)(h * 128 + vr + 64 * j_) * MK + (mk_) + vc * 8); } while (0)
#define AT_STORE(buf_) do { LAS unsigned char* bb_ = lds + (buf_) * AT_BUF; _Pragma("unroll") for (int j_ = 0; j_ < 3; ++j_) *(LAS v4u*)(bb_ + kr_[j_] * AT_KROW + kc_[j_] * 16) = sk[j_]; \
        _Pragma("unroll") for (int j_ = 0; j_ < 2; ++j_) *(LAS v4u*)(bb_ + AT_KBYTES + (vr + 64 * j_) * AT_VROW + vc * 16) = sv[j_]; } while (0)
    __syncthreads();
    AT_LOAD(mkA); AT_STORE(0);
    __syncthreads();
#ifdef TPROBE
    unsigned long long tp_a = 0, tp_b = 0, tp_c = 0; const unsigned long long tp_s = __builtin_amdgcn_s_memrealtime();
#endif
#pragma unroll 1
    for (int ti = 0; ti < nt; ++ti) {
#ifdef TPROBE
        const unsigned long long tp_0 = __builtin_amdgcn_s_memrealtime();
#endif
        const int cur = ti & 1;
        if (ti + 1 < nt) { const int mkn = (ti + 1 < ntA) ? mkA + (ti + 1) * 64 : mkB + (ti + 1 - ntA) * 64; AT_LOAD(mkn); }
        MEMBAR();
        const LAS unsigned char* kb_ = lds + cur * AT_BUF; const LAS unsigned char* vb_ = kb_ + AT_KBYTES;
        f32x4 s[4];
#pragma unroll
        for (int kh = 0; kh < 2; ++kh) { bf16x8 kf[12];
#pragma unroll
          for (int k2 = 0; k2 < 2; ++k2)
#pragma unroll
              for (int d = 0; d < 6; ++d) kf[k2 * 6 + d] = *(const LAS bf16x8*)(kb_ + (16 * (2 * kh + k2) + fr) * AT_KROW + d * 64 + fq * 16);
          MEMBAR();
#pragma unroll
          for (int k2 = 0; k2 < 2; ++k2) { const int kb = 2 * kh + k2; s[kb] = (f32x4){0.f, 0.f, 0.f, 0.f};
#pragma unroll
              for (int d = 0; d < 6; ++d) s[kb] = __builtin_amdgcn_mfma_f32_16x16x32_bf16(qf[d], kf[k2 * 6 + d], s[kb], 0, 0, 0); } }
        bf16x8 vf[16];
#pragma unroll
        for (int i = 0; i < 8; ++i) { vf[2 * i] = *(const LAS bf16x8*)(vb_ + (i * 16 + fr) * AT_VROW + fq * 16); vf[2 * i + 1] = *(const LAS bf16x8*)(vb_ + (i * 16 + fr) * AT_VROW + 64 + fq * 16); }
        MEMBAR();
#pragma unroll
        for (int kb = 0; kb < 4; ++kb)
#pragma unroll
            for (int r = 0; r < 4; ++r) { const float p = exp2f(s[kb][r] - cmax); lrow[r] += p; *(LAS bf16*)(plds + (4 * fq + r) * 144 + (16 * kb + fr) * 2) = (bf16)f2bf(p); }
        asm volatile("s_waitcnt lgkmcnt(0)" ::: "memory");
        const bf16x8 pf0 = *(const LAS bf16x8*)(plds + fr * 144 + fq * 16), pf1 = *(const LAS bf16x8*)(plds + fr * 144 + 64 + fq * 16);
#pragma unroll
        for (int i = 0; i < 8; ++i) { o[i] = __builtin_amdgcn_mfma_f32_16x16x32_bf16(pf0, vf[2 * i], o[i], 0, 0, 0); o[i] = __builtin_amdgcn_mfma_f32_16x16x32_bf16(pf1, vf[2 * i + 1], o[i], 0, 0, 0); }
#ifdef TPROBE
        const unsigned long long tp_1 = __builtin_amdgcn_s_memrealtime();
#endif
        if (ti + 1 < nt) AT_STORE(cur ^ 1);
#ifdef TPROBE
        const unsigned long long tp_2 = __builtin_amdgcn_s_memrealtime();
#endif
        WG_BAR();
#ifdef TPROBE
        { const unsigned long long tp_3 = __builtin_amdgcn_s_memrealtime(); tp_a += tp_1 - tp_0; tp_b += tp_2 - tp_1; tp_c += tp_3 - tp_2; }
#endif
    }
#ifdef TPROBE
    if (qrow0 == NCTX && h == 0 && wave == 0 && lane == 0 && tprobe_ts) { tprobe_ts[32 + 6 * 4 + tprobe_l] += tp_a; tprobe_ts[32 + 7 * 4 + tprobe_l] += tp_b; tprobe_ts[32 + 8 * 4 + tprobe_l] += tp_c; tprobe_ts[32 + 9 * 4 + tprobe_l] += __builtin_amdgcn_s_memrealtime() - tp_s; }
#endif
#undef AT_LOAD
#undef AT_STORE
#pragma unroll
    for (int r = 0; r < 4; ++r) { float lt = lrow[r]; lt += __shfl_xor(lt, 1); lt += __shfl_xor(lt, 2); lt += __shfl_xor(lt, 4); lt += __shfl_xor(lt, 8);
        const float inv = 1.0f / lt; GAS bf16* dst = MIX + (size_t)(qr + 4 * fq + r) * D + h * 128 + fr;
#pragma unroll
        for (int i = 0; i < 8; ++i) dst[i * 16] = (bf16)f2bf(o[i][r] * inv); }
}
__device__ __forceinline__ void ph_attn(const Ctx& A, int l, LAS unsigned char* lds, int tid, int lane, int wave, int vcu, int G) {
    const bf16* QB = (const bf16*)(A.ws + WS_QB); const bf16* KB = (const bf16*)(A.ws + WS_KB); const bf16* VT = (const bf16*)(A.ws + WS_VT); bf16* MIX = (bf16*)(A.ws + WS_MIX);
    float cmax; { const GAS float* qg = (const GAS float*)(A.in[18] + l * 192); const GAS float* kg = (const GAS float*)(A.in[19] + l * 192);
        float mq = fmaxf(fmaxf(fabsf(qg[lane]), fabsf(qg[64 + lane])), fabsf(qg[128 + lane])), mk = fmaxf(fmaxf(fabsf(kg[lane]), fabsf(kg[64 + lane])), fabsf(kg[128 + lane]));
#pragma unroll
        for (int o = 1; o < 64; o <<= 1) { mq = fmaxf(mq, __shfl_xor(mq, o)); mk = fmaxf(mk, __shfl_xor(mk, o)); }
        cmax = mq * mk * 192.0f * (0.07216878364870322f * 1.4426950408889634f); }
    for (int k = 0; k < 640; ++k) {
        int q;
        if (G == 256) { if (vcu >= 208) q = -1; else if (vcu < 128) q = k == 0 ? vcu : (k == 1 ? 128 + vcu : -1); else { q = 256 + (vcu - 128) + 80 * k; if (q >= 640) q = -1; } }
        else { q = vcu + k * G; if (q >= 640) q = -1; }
        if (q < 0) break;
        if (q < 128) { const int b = q >> 6, h = (q >> 3) & 7, qb = q & 7; attn_wg_item(QB, KB, VT, MIX, cmax, NCTX + b * 1024 + qb * 128, h, M + b * 256, 256, NCTX + b * 1024, 1024, lds, tid, lane, wave); }
        else { const int wgi = q - 128, b = wgi >> 4, h = (wgi >> 1) & 7, qb = wgi & 1; attn_wg_item(QB, KB, VT, MIX, cmax, b * 256 + qb * 128, h, b * 256, 256, 0, 0, lds, tid, lane, wave); }
    }
}

__device__ __forceinline__ void ph_post(const Ctx& A, int l, int lane, int gw, int NGW) {
    const GAS bf16* U = (const GAS bf16*)(A.ws + WS_U); const GAS float* GO = (const GAS float*)(A.ws + WS_GO); const GAS float* SY = (const GAS float*)(A.ws + WS_SY); const GAS bf16* XBC = (const GAS bf16*)(A.ws + WS_XBC);
    GAS bf16* MIX = (GAS bf16*)(A.ws + WS_MIX);
    const GAS float* gng = (const GAS float*)(A.in[23] + l * 128); const GAS float* sd = (const GAS float*)(A.in[28] + l * 8); const GAS float* sng = (const GAS float*)(A.in[29] + l * 512);
    f32x4 g4[2], s4[2]; float sdv[2];
#pragma unroll
    for (int i = 0; i < 2; ++i) { const int c = 4 * lane + 256 * i; g4[i] = *(const GAS f32x4*)(gng + (c & 127)); s4[i] = *(const GAS f32x4*)(sng + c); sdv[i] = sd[c >> 6]; }
    for (int m = gw; m < M; m += NGW) {
        int l4 = 4 * lane; asm volatile("" : "+v"(l4));
        const GAS bf16* u = U + (size_t)m * IN_WP;
        f32x4 of[2], ob[2], yf[2], yb[2]; v2u zg[2], zs[2], xx[2];
#pragma unroll
        for (int i = 0; i < 2; ++i) { const int c = l4 + 256 * i;
            of[i] = *(const GAS f32x4*)(GO + (size_t)m * 512 + c); ob[i] = *(const GAS f32x4*)(GO + ((size_t)M + m) * 512 + c);
            yf[i] = *(const GAS f32x4*)(SY + (size_t)m * 512 + c); yb[i] = *(const GAS f32x4*)(SY + ((size_t)M + m) * 512 + c);
            zg[i] = *(const GAS v2u*)(u + U_GZ + c); zs[i] = *(const GAS v2u*)(u + U_SZ + c); xx[i] = *(const GAS v2u*)(XBC + (size_t)m * 1024 + c); }
#pragma unroll
        for (int i = 0; i < 2; ++i) { const int c = l4 + 256 * i;
            f32x4 o = of[i] + ob[i];
            const float ss = half_sum((o.x * o.x + o.y * o.y) + (o.z * o.z + o.w * o.w)); const float rstd = 1.0f / sqrtf(ss * (1.0f / 128.f) + EPS);
            const f32x4 z = bf4(zg[i]);
            o = o * rstd * g4[i]; o.x *= silu(z.x); o.y *= silu(z.y); o.z *= silu(z.z); o.w *= silu(z.w);
            v2u w; w.x = pk2(o.x, o.y); w.y = pk2(o.z, o.w); *(GAS v2u*)(MIX + (size_t)m * D + 1024 + c) = w; }
#pragma unroll
        for (int i = 0; i < 2; ++i) { const int c = l4 + 256 * i;
            f32x4 y = yf[i] + yb[i] + bf4(xx[i]) * sdv[i];
            const f32x4 z = bf4(zs[i]);
            y.x *= silu(z.x); y.y *= silu(z.y); y.z *= silu(z.z); y.w *= silu(z.w);
            const float ss = wave_sum((y.x * y.x + y.y * y.y) + (y.z * y.z + y.w * y.w)); const float rstd = 1.0f / sqrtf(ss * (1.0f / 256.f) + EPS);
            y = y * rstd * s4[i];
            v2u w; w.x = pk2(y.x, y.y); w.y = pk2(y.z, y.w); *(GAS v2u*)(MIX + (size_t)m * D + 1536 + c) = w; }
    }
}

constexpr size_t GCH_W = 0, GCH_QG = 16384, GCH_KD = 32768, GCH_QK = 49152, GCH_UT = 57344, GCH_DEC = 90112, GCH_BYTES = 90368;
constexpr int NGCH = 160;
constexpr int GL_K = 0, GL_Q = 17408, GL_V = 34816, GL_KK = 52224, GL_QK = 52224 + 16640, GL_AF = 85504, GL_AB = 85504 + 16384, GL_TAB = 118272;
template <int DIR>
__device__ __forceinline__ void gdn_solve(GAS unsigned char* GCH, const LAS bf16* kb16, const LAS bf16* qb16, const LAS bf16* vb16, const LAS float* Ad, const LAS float* gcd, const LAS float* bd, int gch, int h, int wave, int lane) {
    typedef float f32x2v __attribute__((ext_vector_type(2)));
    const int c = (wave & 3) * 64 + lane, cc = c & 127; const bool isw = c < 128;
    GAS unsigned char* rec = GCH + ((size_t)(DIR * NGCH + gch) * 4 + h) * GCH_BYTES;
    { int z = 0; asm volatile("" : "+v"(z)); Ad += z; gcd += z; bd += z; }
    const LAS bf16* src = (isw ? kb16 : vb16) + cc;
    f32x2v x2[32];
    float raw[64];
#pragma unroll
    for (int i = 0; i < 64; ++i) { const int p = DIR ? 63 - i : i; raw[i] = bf1(src[p * 136]); }
#pragma unroll
    for (int i = 0; i < 64; ++i) { const int p = DIR ? 63 - i : i; const float f = isw ? bd[p] * __expf(gcd[p]) : bd[p]; x2[i >> 1][i & 1] = raw[i] * f; }
#pragma unroll
    for (int i = 1; i < 64; ++i) {
        f32x4 ac[16];
#pragma unroll
        for (int j = 0; j < (i + 3) / 4; ++j) ac[j] = *(const LAS f32x4*)(Ad + i * 64 + 4 * j);
        MEMBAR();
        f32x2v s01 = (f32x2v){0.f, 0.f}, s23 = (f32x2v){0.f, 0.f};
#pragma unroll
        for (int j = 0; j < i; j += 4) { f32x4 a4 = ac[j >> 2];
            if (j + 1 >= i) a4.y = 0.f; if (j + 2 >= i) a4.z = 0.f; if (j + 3 >= i) a4.w = 0.f;
            s01 -= (f32x2v){a4.x, a4.y} * x2[j >> 1]; s23 -= (f32x2v){a4.z, a4.w} * x2[(j >> 1) + 1]; }
        x2[i >> 1][i & 1] += (s01.x + s01.y) + (s23.x + s23.y); MEMBAR(); }
    if (isw) { GAS bf16* wdst = (GAS bf16*)(rec + GCH_W) + cc;
#pragma unroll
        for (int i = 0; i < 64; ++i) wdst[i * 128] = (bf16)f2bf(x2[i >> 1][i & 1]);
        const float gl = gcd[DIR ? 0 : 63]; GAS bf16* kd = (GAS bf16*)(rec + GCH_KD) + cc * 64;
#pragma unroll
        for (int i = 0; i < 64; i += 8) { float v[8];
#pragma unroll
            for (int u = 0; u < 8; ++u) { const int p = DIR ? 63 - (i + u) : i + u; v[u] = raw[i + u] * __expf(gl - gcd[p]); }
            v4u w; w.x = pk2(v[0], v[1]); w.y = pk2(v[2], v[3]); w.z = pk2(v[4], v[5]); w.w = pk2(v[6], v[7]); *(GAS v4u*)(kd + i) = w; }
        if (cc == 0) *(GAS float*)(rec + GCH_DEC) = __expf(gl); }
    else { GAS float* ut = (GAS float*)(rec + GCH_UT) + cc * 64;
#pragma unroll
        for (int i = 0; i < 64; i += 4) *(GAS f32x4*)(ut + i) = (f32x4){x2[i >> 1][0], x2[i >> 1][1], x2[(i >> 1) + 1][0], x2[(i >> 1) + 1][1]};
        const LAS bf16* qsrc = qb16 + cc; GAS bf16* qg = (GAS bf16*)(rec + GCH_QG) + cc;
#pragma unroll
        for (int i = 0; i < 64; ++i) { const int p = DIR ? 63 - i : i; raw[i] = bf1(qsrc[p * 136]); }
#pragma unroll
        for (int i = 0; i < 64; ++i) { const int p = DIR ? 63 - i : i; qg[i * 128] = (bf16)f2bf(raw[i] * 0.08838834764831845f * __expf(gcd[p])); } }
}
__device__ __forceinline__ void ph_gdn_local(const Ctx& A, int l, LAS unsigned char* lds, int tid, int lane, int wave, int vcu, int G) {
    const GAS bf16* GQ = (const GAS bf16*)(A.ws + WS_GQ); const GAS bf16* GK = GQ + (size_t)M * 512; const GAS bf16* GV = GK + (size_t)M * 512;
    const GAS float* GBETA = (const GAS float*)(A.ws + WS_GBG); const GAS float* GG = GBETA + (size_t)M * 8;
    GAS unsigned char* GCH = (GAS unsigned char*)(A.ws + WS_GCH);
    LAS bf16* kb16 = (LAS bf16*)(lds + GL_K); LAS bf16* qb16 = (LAS bf16*)(lds + GL_Q); LAS bf16* vb16 = (LAS bf16*)(lds + GL_V);
    LAS float* KK = (LAS float*)(lds + GL_KK); LAS float* QK = (LAS float*)(lds + GL_QK);
    LAS float* Af = (LAS float*)(lds + GL_AF); LAS float* Ab = (LAS float*)(lds + GL_AB);
    LAS float* sgcf = (LAS float*)(lds + GL_TAB); LAS float* sgcb = sgcf + 64; LAS float* sbf = sgcf + 128; LAS float* sbb = sgcf + 192;
    const int fr = lane & 15, fq = lane >> 4;
    for (int rd = 0; rd * G + vcu < 2 * NGCH * 4; ++rd) {
        if ((rd + vcu) & 1) continue;
        const int it = (rd * G + vcu) >> 1;
        const int gch = it >> 2, h = it & 3, row0 = gch * 64;
        {
#pragma unroll
          for (int j = 0; j < 2; ++j) { const int id = tid + 512 * j, r = id >> 4, c8 = (id & 15) * 8; const size_t go = (size_t)(row0 + r) * 512 + h * 128 + c8;
              *(LAS v4u*)(kb16 + r * 136 + c8) = *(const GAS v4u*)(GK + go); *(LAS v4u*)(qb16 + r * 136 + c8) = *(const GAS v4u*)(GQ + go); *(LAS v4u*)(vb16 + r * 136 + c8) = *(const GAS v4u*)(GV + go); } }
        if (wave == 0) { const float gf = GG[(size_t)(row0 + lane) * 8 + h], gb = GG[(size_t)(row0 + lane) * 8 + 4 + h];
            float pf = gf, pb = gb;
#pragma unroll
            for (int o = 1; o < 64; o <<= 1) { const float tf = __shfl_up(pf, o), tb = __shfl_up(pb, o); if (lane >= o) { pf += tf; pb += tb; } }
            const float totb = __shfl(pb, 63);
            sgcf[lane] = pf; sgcb[lane] = totb - pb + gb;
            sbf[lane] = GBETA[(size_t)(row0 + lane) * 8 + h]; sbb[lane] = GBETA[(size_t)(row0 + lane) * 8 + 4 + h]; }
        __syncthreads();
        { const int tr = wave & 3; const LAS bf16* Aimg = (wave >> 2) ? qb16 : kb16; LAS float* Out = (wave >> 2) ? QK : KK;
          bf16x8 af[4], bfr[16];
#pragma unroll
          for (int ks = 0; ks < 4; ++ks) af[ks] = *(const LAS bf16x8*)(Aimg + (16 * tr + fr) * 136 + ks * 32 + fq * 8);
#pragma unroll
          for (int tc = 0; tc < 4; ++tc)
#pragma unroll
              for (int ks = 0; ks < 4; ++ks) bfr[tc * 4 + ks] = *(const LAS bf16x8*)(kb16 + (16 * tc + fr) * 136 + ks * 32 + fq * 8);
          MEMBAR();
#pragma unroll
          for (int tc = 0; tc < 4; ++tc) { f32x4 acc = (f32x4){0.f, 0.f, 0.f, 0.f};
#pragma unroll
              for (int ks = 0; ks < 4; ++ks) acc = __builtin_amdgcn_mfma_f32_16x16x32_bf16(af[ks], bfr[tc * 4 + ks], acc, 0, 0, 0);
#pragma unroll
              for (int r = 0; r < 4; ++r) Out[(16 * tr + 4 * fq + r) * 65 + 16 * tc + fr] = acc[r]; } }
        __syncthreads();
        { GAS unsigned char* recf = GCH + ((size_t)(0 * NGCH + gch) * 4 + h) * GCH_BYTES; GAS unsigned char* recb = GCH + ((size_t)(1 * NGCH + gch) * 4 + h) * GCH_BYTES;
#pragma unroll 2
          for (int e = 0; e < 8; ++e) { const int idx = tid + 512 * e, i = idx >> 6, j = idx & 63, pi = 63 - i, pj = 63 - j;
              const float kkf = KK[i * 65 + j], qkf = QK[i * 65 + j], kkb = KK[pi * 65 + pj], qkb = QK[pi * 65 + pj];
              const float df = __expf(sgcf[i] - sgcf[j]), db = __expf(sgcb[pi] - sgcb[pj]);
              Af[idx] = (j < i) ? sbf[i] * kkf * df : 0.f; Ab[idx] = (j < i) ? sbb[pi] * kkb * db : 0.f;
              ((GAS bf16*)(recf + GCH_QK))[idx] = (bf16)f2bf((j <= i) ? qkf * 0.08838834764831845f * df : 0.f);
              ((GAS bf16*)(recb + GCH_QK))[idx] = (bf16)f2bf((j <= i) ? qkb * 0.08838834764831845f * db : 0.f); } }
        __syncthreads();
        if (wave < 4) gdn_solve<0>(GCH, kb16, qb16, vb16, Af, sgcf, sbf, gch, h, wave, lane);
        else gdn_solve<1>(GCH, kb16, qb16, vb16, Ab, sgcb, sbb, gch, h, wave, lane);
        __syncthreads();
    }
}

constexpr int GS_W = 0, GS_QG = 17408, GS_KD = 34816, GS_QK = 53248, GS_IMG = 62464;
__device__ __forceinline__ void gdn_seq_wg(const Ctx& A, int l, int b, int lat, int h, int dir, LAS unsigned char* lds, int tid, int lane, int wave) {
    const GAS unsigned char* GCH = (const GAS unsigned char*)(A.ws + WS_GCH); GAS float* GO = (GAS float*)(A.ws + WS_GO);
    const int fr = lane & 15, fq = lane >> 4, dvs = wave;
    const int nch = lat ? 16 : 4, ch0 = lat ? 128 + b * 16 : b * 4;
    LAS bf16* simg = (LAS bf16*)(lds + GS_IMG + wave * 4352);
    const LAS bf16* sW = (const LAS bf16*)(lds + GS_W); const LAS bf16* sQG = (const LAS bf16*)(lds + GS_QG); const LAS bf16* sKD = (const LAS bf16*)(lds + GS_KD); const LAS bf16* sQK = (const LAS bf16*)(lds + GS_QK);
    f32x4 S[8];
    const size_t sidx = ((size_t)(((b * 4 + l) * 2 + dir) * 4 + h) * 128) * 128 + dvs * 16 + fr;
    if (lat) {
#pragma unroll
        for (int u = 0; u < 8; ++u)
#pragma unroll
            for (int r = 0; r < 4; ++r) S[u][r] = *(const GAS float*)(A.in[4] + sidx + (size_t)(16 * u + 4 * fq + r) * 128); }
    else {
#pragma unroll
        for (int u = 0; u < 8; ++u) S[u] = (f32x4){0.f, 0.f, 0.f, 0.f}; }
#define GREC(cc_) (GCH + ((size_t)(dir * NGCH + (dir ? ch0 + nch - 1 - (cc_) : ch0 + (cc_))) * 4 + h) * GCH_BYTES)
    const int r16a = tid >> 4, c16 = tid & 15, r8a = tid >> 3, c8 = tid & 7;
    v4u pw0, pw1, pq0, pq1, pk0, pk1, pqk; f32x4 UTn[4], UTc[4]; float decn, dec;
#define GS_LOAD(cc_) do { const GAS unsigned char* rec_ = GREC(cc_); \
        pw0 = *(const GAS v4u*)(rec_ + GCH_W + (r16a * 128 + c16 * 8) * 2); pw1 = *(const GAS v4u*)(rec_ + GCH_W + ((r16a + 32) * 128 + c16 * 8) * 2); \
        pq0 = *(const GAS v4u*)(rec_ + GCH_QG + (r16a * 128 + c16 * 8) * 2); pq1 = *(const GAS v4u*)(rec_ + GCH_QG + ((r16a + 32) * 128 + c16 * 8) * 2); \
        pk0 = *(const GAS v4u*)(rec_ + GCH_KD + (r8a * 64 + c8 * 8) * 2); pk1 = *(const GAS v4u*)(rec_ + GCH_KD + ((r8a + 64) * 64 + c8 * 8) * 2); \
        pqk = *(const GAS v4u*)(rec_ + GCH_QK + (r8a * 64 + c8 * 8) * 2); decn = *(const GAS float*)(rec_ + GCH_DEC); \
        _Pragma("unroll") for (int t_ = 0; t_ < 4; ++t_) UTn[t_] = *(const GAS f32x4*)((const GAS float*)(rec_ + GCH_UT) + (dvs * 16 + fr) * 64 + 16 * t_ + 4 * fq); } while (0)
#define GS_STORE() do { *(LAS v4u*)(lds + GS_W + r16a * 272 + c16 * 16) = pw0; *(LAS v4u*)(lds + GS_W + (r16a + 32) * 272 + c16 * 16) = pw1; \
        *(LAS v4u*)(lds + GS_QG + r16a * 272 + c16 * 16) = pq0; *(LAS v4u*)(lds + GS_QG + (r16a + 32) * 272 + c16 * 16) = pq1; \
        *(LAS v4u*)(lds + GS_KD + r8a * 144 + c8 * 16) = pk0; *(LAS v4u*)(lds + GS_KD + (r8a + 64) * 144 + c8 * 16) = pk1; \
        *(LAS v4u*)(lds + GS_QK + r8a * 144 + c8 * 16) = pqk; \
        _Pragma("unroll") for (int t_ = 0; t_ < 4; ++t_) UTc[t_] = UTn[t_]; dec = decn; } while (0)
    __syncthreads();
    GS_LOAD(0); GS_STORE();
    __syncthreads();
#ifdef TPROBE
    unsigned long long tq_a = 0, tq_b = 0, tq_c = 0, tq_d = 0;
#endif
#pragma unroll 1
    for (int cc = 0; cc < nch; ++cc) {
#ifdef TPROBE
        const unsigned long long tq_0 = __builtin_amdgcn_s_memrealtime();
#endif
        const int gch = dir ? ch0 + nch - 1 - cc : ch0 + cc;
        if (cc + 1 < nch) GS_LOAD(cc + 1);
        MEMBAR();
#pragma unroll
        for (int u = 0; u < 8; ++u) { v2u w; w.x = pk2(S[u][0], S[u][1]); w.y = pk2(S[u][2], S[u][3]); *(LAS v2u*)(simg + fr * 136 + 16 * u + 4 * fq) = w; }
        asm volatile("s_waitcnt lgkmcnt(0)" ::: "memory");
        bf16x8 BS[4];
#pragma unroll
        for (int ks = 0; ks < 4; ++ks) BS[ks] = *(const LAS bf16x8*)(simg + fr * 136 + ks * 32 + fq * 8);
        asm volatile("s_waitcnt lgkmcnt(0)" ::: "memory");
        bf16x8 Wf[16];
#pragma unroll
        for (int t = 0; t < 4; ++t)
#pragma unroll
            for (int ks = 0; ks < 4; ++ks) Wf[t * 4 + ks] = *(const LAS bf16x8*)(sW + (16 * t + fr) * 136 + ks * 32 + fq * 8);
        MEMBAR();
#pragma unroll
        for (int t = 0; t < 4; ++t) { f32x4 acc = (f32x4){0.f, 0.f, 0.f, 0.f};
#pragma unroll
            for (int ks = 0; ks < 4; ++ks) acc = __builtin_amdgcn_mfma_f32_16x16x32_bf16(Wf[t * 4 + ks], BS[ks], acc, 0, 0, 0);
            const f32x4 vn = UTc[t] - acc;
            v2u w; w.x = pk2(vn[0], vn[1]); w.y = pk2(vn[2], vn[3]); *(LAS v2u*)(simg + fr * 72 + 16 * t + 4 * fq) = w; }
        asm volatile("s_waitcnt lgkmcnt(0)" ::: "memory");
        bf16x8 BV[2];
#pragma unroll
        for (int ks = 0; ks < 2; ++ks) BV[ks] = *(const LAS bf16x8*)(simg + fr * 72 + ks * 32 + fq * 8);
#ifdef TPROBE
        const unsigned long long tq_1 = __builtin_amdgcn_s_memrealtime();
#endif
        int zl = 0; asm volatile("" : "+v"(zl));
        GAS float* gob = GO + ((size_t)dir * M + gch * 64) * 512 + h * 128 + dvs * 16 + fr + zl;
        bf16x8 QGf[16], QKf[8];
#pragma unroll
        for (int t = 0; t < 4; ++t) {
#pragma unroll
            for (int ks = 0; ks < 4; ++ks) QGf[t * 4 + ks] = *(const LAS bf16x8*)(sQG + (16 * t + fr) * 136 + ks * 32 + fq * 8);
#pragma unroll
            for (int ks = 0; ks < 2; ++ks) QKf[t * 2 + ks] = *(const LAS bf16x8*)(sQK + (16 * t + fr) * 72 + ks * 32 + fq * 8); }
        MEMBAR();
#pragma unroll
        for (int t = 0; t < 4; ++t) { f32x4 acc = (f32x4){0.f, 0.f, 0.f, 0.f};
#pragma unroll
            for (int ks = 0; ks < 4; ++ks) acc = __builtin_amdgcn_mfma_f32_16x16x32_bf16(QGf[t * 4 + ks], BS[ks], acc, 0, 0, 0);
#pragma unroll
            for (int ks = 0; ks < 2; ++ks) acc = __builtin_amdgcn_mfma_f32_16x16x32_bf16(QKf[t * 2 + ks], BV[ks], acc, 0, 0, 0);
#pragma unroll
            for (int r = 0; r < 4; ++r) { const int i = 16 * t + 4 * fq + r, p = dir ? 63 - i : i; gob[(ptrdiff_t)p * 512] = acc[r]; } }
#ifdef TPROBE
        const unsigned long long tq_2 = __builtin_amdgcn_s_memrealtime();
#endif
        bf16x8 KDf[16];
#pragma unroll
        for (int u = 0; u < 8; ++u)
#pragma unroll
            for (int ks = 0; ks < 2; ++ks) KDf[u * 2 + ks] = *(const LAS bf16x8*)(sKD + (16 * u + fr) * 72 + ks * 32 + fq * 8);
        MEMBAR();
#pragma unroll
        for (int u = 0; u < 8; ++u) { f32x4 acc = S[u] * dec;
#pragma unroll
            for (int ks = 0; ks < 2; ++ks) acc = __builtin_amdgcn_mfma_f32_16x16x32_bf16(KDf[u * 2 + ks], BV[ks], acc, 0, 0, 0);
            S[u] = acc; }
#ifdef TPROBE
        const unsigned long long tq_3 = __builtin_amdgcn_s_memrealtime();
#endif
        WG_BAR();
        if (cc + 1 < nch) GS_STORE();
        WG_BAR();
#ifdef TPROBE
        { const unsigned long long tq_4 = __builtin_amdgcn_s_memrealtime(); tq_a += tq_1 - tq_0; tq_b += tq_2 - tq_1; tq_c += tq_3 - tq_2; tq_d += tq_4 - tq_3; }
#endif
    }
#ifdef TPROBE
    if (lat && b == 0 && h == 0 && dir == 0 && wave == 0 && lane == 0) { unsigned long long* ts_ = (unsigned long long*)(A.ws + WS_CTL + 65536); ts_[32 + 10 * 4 + l] += tq_a; ts_[32 + 11 * 4 + l] += tq_b; ts_[32 + 12 * 4 + l] += tq_c; ts_[32 + 13 * 4 + l] += tq_d; }
#endif
#undef GREC
#undef GS_LOAD
#undef GS_STORE
    if (!lat) { int l2 = lane; asm volatile("" : "+v"(l2)); const int fr2 = l2 & 15, fq2 = l2 >> 4;
        GAS float* so = (GAS float*)(A.out + O_SG + ((size_t)(((b * 4 + l) * 2 + dir) * 4 + h) * 128) * 128 + dvs * 16 + fr2 + (size_t)(4 * fq2) * 128);
#pragma unroll
        for (int u = 0; u < 8; ++u)
#pragma unroll
            for (int r = 0; r < 4; ++r) so[(16 * u + r) * 128] = S[u][r]; }
}
__device__ __forceinline__ void ph_gdn_seq(const Ctx& A, int l, LAS unsigned char* lds, int tid, int lane, int wave, int vcu, int G) {
    for (int k = 0; k < 272; ++k) {
        int q;
        if (G == 256) { if (vcu >= 240) q = k == 0 ? 256 + (vcu - 240) : -1; else if (vcu >= 208) q = k == 0 ? vcu - 208 : -1; else { q = 32 + vcu + 208 * k; if (q >= 256) q = -1; } }
        else { q = vcu + k * G; if (q >= 272) q = -1; }
        if (q < 0) break;
        const int lat = q >= 256, it = lat ? q - 256 : q;
        gdn_seq_wg(A, l, it >> 3, lat, (it >> 1) & 3, it & 1, lds, tid, lane, wave);
    }
}

constexpr size_t SR_P = 0, SR_X1 = 32768, SR_X2 = 49152, SR_EA = 65536, SR_DEC = 66048, SR_BYTES = 66560;
constexpr size_t SS_C = 0, SS_BT = 32768, SS_BYTES = 65536;
constexpr int NSCH = 80;
__device__ __forceinline__ void ph_ssd_local(const Ctx& A, int l, LAS unsigned char* lds, int tid, int lane, int wave, int vcu, int G) {
    const GAS bf16* XBC = (const GAS bf16*)(A.ws + WS_XBC); const GAS float* SDT = (const GAS float*)(A.ws + WS_SDT); const GAS float* SDA = SDT + (size_t)M * 16;
    GAS unsigned char* SREC = (GAS unsigned char*)(A.ws + WS_SREC); GAS unsigned char* SSH = (GAS unsigned char*)(A.ws + WS_SSH);
    LAS bf16* Cimg = (LAS bf16*)lds; LAS bf16* Bimg = (LAS bf16*)(lds + 34816);
    LAS float* sac = (LAS float*)(lds + 69632);
    LAS float* sdt = sac + 256;
    LAS bf16* ptile = (LAS bf16*)(lds + 71680 + wave * 4352);
    const int fr = lane & 15, fq = lane >> 4;
    for (int rd = 0; rd * G + vcu < 2 * NSCH * 8; ++rd) {
        if (!((rd + vcu) & 1)) continue;
        const int it = (rd * G + vcu) >> 1;
        const int ch = it >> 3, h = it & 7, g = h >> 2, row0 = ch * 128;
        GAS unsigned char* shr = SSH + (size_t)(ch * 2 + g) * SS_BYTES;
        float xv[16];
        { const GAS bf16* xp = XBC + (size_t)(row0 + wave * 16) * 1024 + h * 64 + lane;
#pragma unroll
          for (int j = 0; j < 16; ++j) xv[j] = bf1(xp[(size_t)j * 1024]); }
        { const int r = tid >> 2, c0 = (tid & 3) * 32; const GAS bf16* cp = XBC + (size_t)(row0 + r) * 1024 + 768 + g * 128 + c0; const GAS bf16* bp = XBC + (size_t)(row0 + r) * 1024 + 512 + g * 128 + c0;
#pragma unroll
          for (int i = 0; i < 4; ++i) { const v4u wc = *(const GAS v4u*)(cp + 8 * i), wb = *(const GAS v4u*)(bp + 8 * i);
              *(LAS v4u*)(Cimg + r * 136 + c0 + 8 * i) = wc; *(LAS v4u*)(Bimg + r * 136 + c0 + 8 * i) = wb;
              if ((h & 3) == 0) *(GAS v4u*)((GAS bf16*)(shr + SS_C) + r * 128 + c0 + 8 * i) = wc; } }
        if (wave < 2) { const int d = wave; const size_t mo = (size_t)(row0 + 2 * lane) * 16 + d * 8 + h;
            const float a0 = SDA[mo], a1 = SDA[mo + 16]; float ps = a0 + a1;
#pragma unroll
            for (int o = 1; o < 64; o <<= 1) { const float t = __shfl_up(ps, o); if (lane >= o) ps += t; }
            const float tot = __shfl(ps, 63);
            if (d == 0) { sac[2 * lane] = ps - a1; sac[2 * lane + 1] = ps; }
            else { sac[128 + 2 * lane] = tot - ps + a0 + a1; sac[128 + 2 * lane + 1] = tot - ps + a1; }
            sdt[d * 128 + 2 * lane] = SDT[mo]; sdt[d * 128 + 2 * lane + 1] = SDT[mo + 16]; }
        __syncthreads();
        if ((h & 3) == 0) { const int n = tid >> 2, s0 = (tid & 3) * 32; GAS bf16* dst = (GAS bf16*)(shr + SS_BT) + n * 128 + s0;
#pragma unroll
            for (int i = 0; i < 4; ++i) { unsigned w[4];
#pragma unroll
                for (int j = 0; j < 4; ++j) w[j] = (unsigned)Bimg[(s0 + 8 * i + 2 * j) * 136 + n] | ((unsigned)Bimg[(s0 + 8 * i + 2 * j + 1) * 136 + n] << 16);
                *(GAS v4u*)(dst + 8 * i) = (v4u){w[0], w[1], w[2], w[3]}; } }
        { bf16x8 af[4];
#pragma unroll
          for (int ks = 0; ks < 4; ++ks) af[ks] = *(const LAS bf16x8*)(Cimg + (16 * wave + fr) * 136 + ks * 32 + fq * 8);
          f32x4 acc[8];
#pragma unroll
          for (int tc = 0; tc < 8; ++tc) { acc[tc] = (f32x4){0.f, 0.f, 0.f, 0.f};
#pragma unroll
              for (int ks = 0; ks < 4; ++ks) { const bf16x8 bfr = *(const LAS bf16x8*)(Bimg + (16 * tc + fr) * 136 + ks * 32 + fq * 8); acc[tc] = __builtin_amdgcn_mfma_f32_16x16x32_bf16(af[ks], bfr, acc[tc], 0, 0, 0); } }
#pragma unroll
          for (int d = 0; d < 2; ++d) {
              float acr[4];
#pragma unroll
              for (int r = 0; r < 4; ++r) acr[r] = sac[d * 128 + 16 * wave + 4 * fq + r];
#pragma unroll
              for (int tc = 0; tc < 8; ++tc) { const int s = 16 * tc + fr; const float as = sac[d * 128 + s];
#pragma unroll
                  for (int r = 0; r < 4; ++r) { const int li = 16 * wave + 4 * fq + r; const bool keep = d ? (s >= li) : (s <= li);
                      ptile[(4 * fq + r) * 136 + s] = (bf16)f2bf(keep ? acc[tc][r] * __expf(acr[r] - as) : 0.f); } }
              asm volatile("s_waitcnt lgkmcnt(0)" ::: "memory");
              GAS bf16* Pd = (GAS bf16*)(SREC + ((size_t)(d * NSCH + ch) * 8 + h) * SR_BYTES + SR_P) + (size_t)(16 * wave) * 128;
#pragma unroll
              for (int j = 0; j < 4; ++j) { const int id = lane + 64 * j, rr = id >> 4, cc = id & 15; *(GAS v4u*)(Pd + rr * 128 + cc * 8) = *(const LAS v4u*)(ptile + rr * 136 + cc * 8); }
              asm volatile("s_waitcnt lgkmcnt(0)" ::: "memory"); } }
        __syncthreads();
        { const int p = lane, s0 = wave * 16;
#pragma unroll
          for (int d = 0; d < 2; ++d) { const float aend = d ? sac[128] : sac[127];
              unsigned w1[8], w2[8];
#pragma unroll
              for (int j = 0; j < 16; j += 2) { const float u0 = xv[j] * sdt[d * 128 + s0 + j], u1 = xv[j + 1] * sdt[d * 128 + s0 + j + 1];
                  w1[j >> 1] = pk2(u0, u1); w2[j >> 1] = pk2(u0 * __expf(aend - sac[d * 128 + s0 + j]), u1 * __expf(aend - sac[d * 128 + s0 + j + 1])); }
              LAS bf16* t1 = (LAS bf16*)(lds + (2 * d) * 17408) + p * 136 + s0; LAS bf16* t2 = (LAS bf16*)(lds + (2 * d + 1) * 17408) + p * 136 + s0;
              *(LAS v4u*)t1 = (v4u){w1[0], w1[1], w1[2], w1[3]}; *(LAS v4u*)(t1 + 8) = (v4u){w1[4], w1[5], w1[6], w1[7]};
              *(LAS v4u*)t2 = (v4u){w2[0], w2[1], w2[2], w2[3]}; *(LAS v4u*)(t2 + 8) = (v4u){w2[4], w2[5], w2[6], w2[7]};
              GAS unsigned char* rec = SREC + ((size_t)(d * NSCH + ch) * 8 + h) * SR_BYTES;
              if (tid < 128) ((GAS float*)(rec + SR_EA))[tid] = __expf(sac[d * 128 + tid]);
              if (tid == 0) *(GAS float*)(rec + SR_DEC) = __expf(aend); } }
        __syncthreads();
#pragma unroll
        for (int j = 0; j < 8; ++j) { const int id = tid + 512 * j, tl = id >> 10, rr = (id >> 4) & 63, cc = id & 15;
            GAS unsigned char* rec = SREC + ((size_t)((tl >> 1) * NSCH + ch) * 8 + h) * SR_BYTES + ((tl & 1) ? SR_X2 : SR_X1);
            *(GAS v4u*)((GAS bf16*)rec + rr * 128 + cc * 8) = *(const LAS v4u*)(lds + tl * 17408 + rr * 272 + cc * 16); }
        __syncthreads();
    }
}

constexpr int SQ_C = 0, SQ_P = 34816, SQ_BT = 69632, SQ_X1 = 104448, SQ_X2 = 121856, SQ_IMG = 139264;
__device__ __forceinline__ void ssd_seq_wg(const Ctx& A, int l, int b, int lat, int h, int dir, LAS unsigned char* lds, int tid, int lane, int wave) {
    const GAS unsigned char* SREC = (const GAS unsigned char*)(A.ws + WS_SREC); const GAS unsigned char* SSH = (const GAS unsigned char*)(A.ws + WS_SSH); GAS float* SY = (GAS float*)(A.ws + WS_SY);
    const int fr = lane & 15, fq = lane >> 4, g = h >> 2, ps = wave & 3, hf = wave >> 2;
    const int nch = lat ? 8 : 2, ch0 = lat ? 64 + b * 8 : b * 2;
    LAS bf16* simg = (LAS bf16*)(lds + SQ_IMG + ps * 4352);
    const LAS bf16* sC = (const LAS bf16*)(lds + SQ_C); const LAS bf16* sP = (const LAS bf16*)(lds + SQ_P); const LAS bf16* sBT = (const LAS bf16*)(lds + SQ_BT);
    const LAS bf16* sX1 = (const LAS bf16*)(lds + SQ_X1); const LAS bf16* sX2 = (const LAS bf16*)(lds + SQ_X2);
    f32x4 S[4];
    const size_t sidx = ((size_t)(((b * 4 + l) * 2 + dir) * 8 + h) * 64 + ps * 16 + fr) * 128 + 64 * hf + 4 * fq;
    if (lat) {
#pragma unroll
        for (int u = 0; u < 4; ++u) S[u] = *(const GAS f32x4*)(A.in[5] + sidx + 16 * u); }
    else {
#pragma unroll
        for (int u = 0; u < 4; ++u) S[u] = (f32x4){0.f, 0.f, 0.f, 0.f}; }
#define SCH(cc_) (dir ? ch0 + nch - 1 - (cc_) : ch0 + (cc_))
    const int r16 = tid >> 4, c16 = tid & 15;
    v4u pc[4], pp[4], pb[4], px1[2], px2[2]; float pea, decn, dec;
#define SQ_LOAD(cc_) do { const int ch_ = SCH(cc_); const GAS unsigned char* rec_ = SREC + ((size_t)(dir * NSCH + ch_) * 8 + h) * SR_BYTES; const GAS unsigned char* shr_ = SSH + (size_t)(ch_ * 2 + g) * SS_BYTES; \
        _Pragma("unroll") for (int j_ = 0; j_ < 4; ++j_) { const int off_ = ((r16 + 32 * j_) * 128 + c16 * 8) * 2; pc[j_] = *(const GAS v4u*)(shr_ + SS_C + off_); pp[j_] = *(const GAS v4u*)(rec_ + SR_P + off_); pb[j_] = *(const GAS v4u*)(shr_ + SS_BT + off_); } \
        _Pragma("unroll") for (int j_ = 0; j_ < 2; ++j_) { const int off_ = ((r16 + 32 * j_) * 128 + c16 * 8) * 2; px1[j_] = *(const GAS v4u*)(rec_ + SR_X1 + off_); px2[j_] = *(const GAS v4u*)(rec_ + SR_X2 + off_); } \
        pea = ((const GAS float*)(rec_ + SR_EA))[tid & 127]; decn = *(const GAS float*)(rec_ + SR_DEC); } while (0)
#define SQ_STORE() do { \
        _Pragma("unroll") for (int j_ = 0; j_ < 4; ++j_) { const int off_ = (r16 + 32 * j_) * 272 + c16 * 16; *(LAS v4u*)(lds + SQ_C + off_) = pc[j_]; *(LAS v4u*)(lds + SQ_P + off_) = pp[j_]; *(LAS v4u*)(lds + SQ_BT + off_) = pb[j_]; } \
        _Pragma("unroll") for (int j_ = 0; j_ < 2; ++j_) { const int off_ = (r16 + 32 * j_) * 272 + c16 * 16; *(LAS v4u*)(lds + SQ_X1 + off_) = px1[j_]; *(LAS v4u*)(lds + SQ_X2 + off_) = px2[j_]; } \
        if (tid < 128) ((LAS float*)(lds + SQ_IMG + 4 * 4352))[tid] = pea; dec = decn; } while (0)
    __syncthreads();
    SQ_LOAD(0); SQ_STORE();
    __syncthreads();
#pragma unroll 1
    for (int cc = 0; cc < nch; ++cc) {
        const int ch = SCH(cc);
        if (cc + 1 < nch) SQ_LOAD(cc + 1);
        MEMBAR();
#pragma unroll
        for (int u = 0; u < 4; ++u) { v2u w; w.x = pk2(S[u][0], S[u][1]); w.y = pk2(S[u][2], S[u][3]); *(LAS v2u*)(simg + fr * 136 + 64 * hf + 16 * u + 4 * fq) = w; }
        WG_BAR();
        bf16x8 BS[4], BX1[4];
#pragma unroll
        for (int ks = 0; ks < 4; ++ks) { BS[ks] = *(const LAS bf16x8*)(simg + fr * 136 + ks * 32 + fq * 8);
            BX1[ks] = *(const LAS bf16x8*)(sX1 + (ps * 16 + fr) * 136 + ks * 32 + fq * 8); }
        int zl = 0; asm volatile("" : "+v"(zl));
        GAS float* syb = SY + ((size_t)dir * M + ch * 128 + 64 * hf + 4 * fq) * 512 + h * 64 + ps * 16 + fr + zl;
#pragma unroll
        for (int tp = 0; tp < 2; ++tp) {
            bf16x8 Cf[8], Pf[8];
#pragma unroll
            for (int t3 = 0; t3 < 2; ++t3) { const int t = 4 * hf + 2 * tp + t3;
#pragma unroll
                for (int ks = 0; ks < 4; ++ks) { Cf[t3 * 4 + ks] = *(const LAS bf16x8*)(sC + (16 * t + fr) * 136 + ks * 32 + fq * 8); Pf[t3 * 4 + ks] = *(const LAS bf16x8*)(sP + (16 * t + fr) * 136 + ks * 32 + fq * 8); } }
            MEMBAR();
#pragma unroll
            for (int t3 = 0; t3 < 2; ++t3) { const int t2 = 2 * tp + t3; f32x4 acc = (f32x4){0.f, 0.f, 0.f, 0.f};
#pragma unroll
                for (int ks = 0; ks < 4; ++ks) acc = __builtin_amdgcn_mfma_f32_16x16x32_bf16(Cf[t3 * 4 + ks], BS[ks], acc, 0, 0, 0);
                acc = acc * *(const LAS f32x4*)((const LAS float*)(lds + SQ_IMG + 4 * 4352) + 16 * (4 * hf + t2) + 4 * fq);
#pragma unroll
                for (int ks = 0; ks < 4; ++ks) acc = __builtin_amdgcn_mfma_f32_16x16x32_bf16(Pf[t3 * 4 + ks], BX1[ks], acc, 0, 0, 0);
#pragma unroll
                for (int r = 0; r < 4; ++r) syb[(size_t)(16 * t2 + r) * 512] = acc[r]; }
        }
        { bf16x8 Bf[16], BX2[4];
#pragma unroll
          for (int ks = 0; ks < 4; ++ks) BX2[ks] = *(const LAS bf16x8*)(sX2 + (ps * 16 + fr) * 136 + ks * 32 + fq * 8);
#pragma unroll
          for (int u = 0; u < 4; ++u)
#pragma unroll
              for (int ks = 0; ks < 4; ++ks) Bf[u * 4 + ks] = *(const LAS bf16x8*)(sBT + (64 * hf + 16 * u + fr) * 136 + ks * 32 + fq * 8);
          MEMBAR();
#pragma unroll
          for (int u = 0; u < 4; ++u) { f32x4 acc = S[u] * dec;
#pragma unroll
              for (int ks = 0; ks < 4; ++ks) acc = __builtin_amdgcn_mfma_f32_16x16x32_bf16(Bf[u * 4 + ks], BX2[ks], acc, 0, 0, 0);
              S[u] = acc; } }
        WG_BAR();
        if (cc + 1 < nch) SQ_STORE();
        WG_BAR();
    }
#undef SCH
#undef SQ_LOAD
#undef SQ_STORE
    if (!lat) {
#pragma unroll
        for (int u = 0; u < 4; ++u) *(GAS f32x4*)(A.out + O_SS + sidx + 16 * u) = S[u]; }
}
__device__ __forceinline__ void ph_ssd_seq(const Ctx& A, int l, LAS unsigned char* lds, int tid, int lane, int wave, int vcu, int G) {
    for (int k = 0; k < 544; ++k) {
        int q;
        if (G == 256) { if (vcu >= 240) q = -1; else if (vcu >= 208) q = k == 0 ? 512 + (vcu - 208) : (k == 1 ? vcu - 208 : -1); else { q = 32 + (vcu + 64) % 208 + 208 * k; if (q >= 512) q = -1; } }
        else { q = vcu + k * G; if (q >= 544) q = -1; }
        if (q < 0) break;
        const int lat = q >= 512, it = lat ? q - 512 : q;
        ssd_seq_wg(A, l, it >> 4, lat, (it >> 1) & 7, it & 1, lds, tid, lane, wave);
    }
}

#ifndef REP_ATTN
#define REP_ATTN 1
#endif
#ifndef REP_LOC
#define REP_LOC 1
#endif
#ifndef REP_LAT
#define REP_LAT 1
#endif
#ifndef REP_CTX
#define REP_CTX 1
#endif
#ifndef REP_MIX
#define REP_MIX 1
#endif
#ifndef REP_PRO
#define REP_PRO 1
#endif
#ifndef REP_EW
#define REP_EW 1
#endif
#ifndef REP_GEMM
#define REP_GEMM 1
#endif
#ifndef MK_ONE_LAUNCH
#define MK_ONE_LAUNCH 0
#endif
__device__ __forceinline__ int lane_now() { unsigned m_ = ~0u; asm volatile("" : "+s"(m_)); return (int)__builtin_amdgcn_mbcnt_hi(m_, __builtin_amdgcn_mbcnt_lo(m_, 0u)); }
#define TID_NOW() (wave0 * 64 + lane_now())
#define IN(k) (lo <= (k) && (k) < hi)
#ifndef REP_BAR
#define REP_BAR 1
#endif
#ifdef TPROBE
#define TS_ACC(k) do { if (blockIdx.x == 0 && wave0 == 0 && lane_now() == 0) { unsigned long long* ts_ = (unsigned long long*)(args.ws + WS_CTL + 65536); const unsigned long long t_ = __builtin_amdgcn_s_memrealtime(); \
        const int ty_ = ((k) == 0) ? 0 : 1 + (((k) - 1) % 11); ts_[1 + ty_] += t_ - ts_[0]; ts_[0] = t_; } } while (0)
#define SEAM(k) do { if (IN((k) + 1)) { xcd_barrier(bar); TS_ACC(k); } } while (0)
#define SUB0() const unsigned long long sub_t0_ = __builtin_amdgcn_s_memrealtime()
#define SUBT(slot) do { __syncthreads(); if (wave0 == 0 && lane_now() == 0) { unsigned long long* ts_ = (unsigned long long*)(args.ws + WS_CTL + 65536); \
        atomicMax(&ts_[32 + (slot) * 4 + l], __builtin_amdgcn_s_memrealtime() - sub_t0_); } } while (0)
#else
#define SUB0() do {} while (0)
#define SUBT(slot) do {} while (0)
#define SEAM(k) do { if (IN((k) + 1)) { for (int rb_ = 0; rb_ < REP_BAR; ++rb_) xcd_barrier(bar); } } while (0)
#endif
#define PHASE_ROOTS() Ctx C; int G = (int)gridDim.x, bx = (int)blockIdx.x; int tid = TID_NOW(); asm volatile("" : "+v"(tid)); const int lane = tid & 63, wave = __builtin_amdgcn_readfirstlane(tid >> 6); (void)lane; (void)wave; \
    { unsigned long long kp_ = (unsigned long long)__builtin_amdgcn_kernarg_segment_ptr(); float* o_ = args.out; unsigned char* w_ = args.ws; \
      asm volatile("" : "+s"(kp_), "+s"(o_), "+s"(w_), "+s"(G), "+s"(bx)); C.in = (kin_t)kp_; C.out = o_; C.ws = w_; } \
    const int vcu = (G % 8 == 0) ? (bx % 8) * (G / 8) + bx / 8 : bx; const int gw = vcu * NWAVES + wave, NGW = G * NWAVES; (void)gw; (void)NGW; (void)vcu


template <int L> __device__ __forceinline__ void layer_phases(const Args& args, LAS unsigned char* lds, const int wave0, const int lo0, const int hi0, const XcdBarrier& bar) {
    constexpr int l = L;
        const int pb = 1 + l * NPH_L;
        int lo = lo0, hi = hi0; asm volatile("" : "+s"(lo), "+s"(hi));
#define MODS_L ((const float*)(C.ws + WS_MODS) + (size_t)l * 3 * 12288)
#define WL ((const bf16*)(C.ws + WS_W) + (size_t)l * WLE_SIZE)
        if (IN(pb + 0)) { PHASE_ROOTS(); for (int rep = 0; rep < REP_EW; ++rep) ph_norm((bf16*)(C.ws + WS_X), C.in[8] + l * D, MODS_L, 0, (bf16*)(C.ws + WS_H), l > 0 ? (const float*)(C.ws + WS_PART) : (const float*)nullptr, MODS_L - 3 * 12288 + 5 * 2048, lane, gw, NGW); SEAM(pb + 0); }
        if (IN(pb + 1)) { PHASE_ROOTS();
            pg8::Gemm g{(const bf16*)(C.ws + WS_H), WL + WLE_IN, M, IN_WP, D}; pg8::InOrder S; S.init(M, G, bx);
            pg8::EpiU E{(bf16*)(C.ws + WS_U), IN_WP, (float*)(C.ws + WS_USIDE)};
            pg8::gemm_phase<pg8::EpiU, pg8::InOrder, true, true>(lds, g, S, E, tid);
            SEAM(pb + 1);
        }
        if (IN(pb + 2)) { PHASE_ROOTS();
#ifndef SKIP_PREP
            for (int rep = 0; rep < REP_EW; ++rep) ph_prep(C, l, lane, gw, NGW);
#endif
            SEAM(pb + 2); }
        if (IN(pb + 3)) {
            { PHASE_ROOTS(); pg8::Gemm g{(const bf16*)(C.ws + WS_CQN), WL + WLE_UQ, M, 1536, 768}; pg8::StaticOrder S; S.init(M, 1536, G, bx);
              pg8::EpiBf16 E{(bf16*)(C.ws + WS_QRAW), 1536};
              pg8::gemm_phase<pg8::EpiBf16, pg8::StaticOrder, true, true>(lds, g, S, E, tid); }
            { PHASE_ROOTS(); pg8::Gemm g{(const bf16*)(C.ws + WS_CKVN), WL + WLE_KV, MK, 1024, 512}; pg8::StaticOrder S; S.init(MK, 1024, G, bx);
              pg8::EpiBf16 E{(bf16*)(C.ws + WS_KN), 1024};
              pg8::gemm_phase<pg8::EpiBf16, pg8::StaticOrder, true, true>(lds, g, S, E, tid); }
            { PHASE_ROOTS(); pg8::Gemm g{WL + WLE_KV + (size_t)1024 * 512, (const bf16*)(C.ws + WS_CKVN), 1024, MK, 512}; pg8::StaticOrder S; S.init(1024, MK, G, bx);
              pg8::EpiBf16 E{(bf16*)(C.ws + WS_VT), MK};
              for (int rep = 0; rep < REP_GEMM; ++rep) pg8::gemm_phase<pg8::EpiBf16, pg8::StaticOrder, true, true>(lds, g, S, E, tid); }
            { PHASE_ROOTS(); pg8::Gemm g{(const bf16*)(C.ws + WS_H), WL + WLE_IN, M, IN_WP, D}; pg8::DeferOrder S{bx};
              pg8::EpiU E{(bf16*)(C.ws + WS_U), IN_WP, (float*)(C.ws + WS_USIDE)};
              pg8::gemm_phase<pg8::EpiU, pg8::DeferOrder, true, true>(lds, g, S, E, tid); }
            SEAM(pb + 3);
        }
        if (IN(pb + 4)) { PHASE_ROOTS(); SUB0();
#ifndef SKIP_FIN
            ph_finalize(C, l, lds, tid, lane, gw, NGW);
#endif
            SUBT(3);
            for (int rep = 0; rep < REP_LOC; ++rep) { ph_gdn_local(C, l, lds, tid, lane, wave, vcu, G); SUBT(4);
            ph_ssd_local(C, l, lds, tid, lane, wave, vcu, G); SUBT(5); }
            SEAM(pb + 4); }
        if (IN(pb + 5)) { SUB0(); for (int rep = 0; rep < REP_MIX; ++rep) {
#ifndef SKIP_GDN
            { PHASE_ROOTS(); ph_gdn_seq(C, l, lds, tid, lane, wave, vcu, G); }
#endif
            SUBT(0);
            __syncthreads();
#ifndef SKIP_SSD
            { PHASE_ROOTS(); ph_ssd_seq(C, l, lds, tid, lane, wave, vcu, G); }
#endif
            SUBT(1);
            __syncthreads();
#ifndef SKIP_ATTN
            for (int rep2 = 0; rep2 < REP_ATTN; ++rep2) { PHASE_ROOTS(); ph_attn(C, l, lds, tid, lane, wave, vcu, G); }
#endif
            SUBT(2);
            __syncthreads(); }
            SEAM(pb + 5);
        }
        if (IN(pb + 6)) { PHASE_ROOTS();
#ifndef SKIP_POST
            for (int rep = 0; rep < REP_EW; ++rep) ph_post(C, l, lane, gw, NGW);
#endif
            SEAM(pb + 6); }
        if (IN(pb + 7)) { PHASE_ROOTS();
            { pg8::Gemm g{(const bf16*)(C.ws + WS_MIX), WL + WLE_OUT, M, D, D, 0}; pg8::PanelOrder S{bx};
              pg8::EpiResidT<false> E{(bf16*)(C.ws + WS_X), C.out, D, MODS_L + 2 * 2048};
              pg8::gemm_phase<pg8::EpiResidT<false>, pg8::PanelOrder, true, true>(lds, g, S, E, tid); }
            { PHASE_ROOTS(); pg8::Gemm g{(const bf16*)(C.ws + WS_MIX), WL + WLE_OUT, M, D, D / 4, D}; pg8::TailOrder S{bx, D / 4};
              pg8::EpiPart E{(bf16*)(C.ws + WS_PART), D / 4};
              pg8::gemm_phase<pg8::EpiPart, pg8::TailOrder, true, true>(lds, g, S, E, tid); }
            SEAM(pb + 7);
        }
        if (IN(pb + 8)) { PHASE_ROOTS(); for (int rep = 0; rep < REP_EW; ++rep) ph_norm((bf16*)(C.ws + WS_X), C.in[9] + l * D, MODS_L, 3, (bf16*)(C.ws + WS_H), (const float*)(C.ws + WS_PART), MODS_L + 2 * 2048, lane, gw, NGW); SEAM(pb + 8); }
        if (IN(pb + 9)) { PHASE_ROOTS();
            pg8::Gemm g{(const bf16*)(C.ws + WS_H), WL + WLE_GU, M, 2 * FF, D}; pg8::StaticOrder S; S.init(M, 2 * FF, G, bx);
            pg8::EpiSwiglu E{(bf16*)(C.ws + WS_ACT), FF};
            for (int rep = 0; rep < REP_GEMM; ++rep) pg8::gemm_phase<pg8::EpiSwiglu, pg8::StaticOrder, false, true>(lds, g, S, E, tid);
            SEAM(pb + 9);
        }
        if (IN(pb + 10)) { PHASE_ROOTS();
            { pg8::Gemm g{(const bf16*)(C.ws + WS_ACT), WL + WLE_DN, M, D, FF, 0}; pg8::PanelOrder S{bx};
              pg8::EpiResidT<(L == DEPTH - 1)> E{(bf16*)(C.ws + WS_X), C.out, D, MODS_L + 5 * 2048};
              pg8::gemm_phase<pg8::EpiResidT<(L == DEPTH - 1)>, pg8::PanelOrder, true, true>(lds, g, S, E, tid); }
            { PHASE_ROOTS(); pg8::Gemm g{(const bf16*)(C.ws + WS_ACT), WL + WLE_DN, M, D, FF / 4, FF}; pg8::TailOrder S{bx, FF / 4};
              pg8::EpiPart E{(bf16*)(C.ws + WS_PART), FF / 4};
              pg8::gemm_phase<pg8::EpiPart, pg8::TailOrder, true, true>(lds, g, S, E, tid); }
            SEAM(pb + 10);
        }
    }

__global__ void __launch_bounds__(NWAVES * 64, 2) mk_fwd(Args args) {
    extern __shared__ __attribute__((aligned(16))) unsigned char lds_raw[];
    LAS unsigned char* lds = (LAS unsigned char*)lds_raw;
    const int wave0 = __builtin_amdgcn_readfirstlane((int)threadIdx.x >> 6);
    for (int u = TID_NOW(); u < (LDS_BYTES - LDSCTL_OFF) / 4; u += NWAVES * 64) ((LAS unsigned*)(lds + LDSCTL_OFF))[u] = 0u;
    __syncthreads();
    const int lo0 = args.ph_lo, hi0 = args.ph_hi;
    XcdBarrier bar; bar.bar = (unsigned*)(args.ws + WS_CTL) + CW_BAR; bar.x = 0; bar.st = nullptr; bar.wv = wave0;
    if ((hi0 - lo0) > 1) bar = xcd_barrier_post((unsigned*)(args.ws + WS_CTL) + CW_BAR, (volatile LAS unsigned*)(lds + MISC_OFF) + 8); bar.wv = wave0;
#ifdef TPROBE
    if (blockIdx.x == 0 && wave0 == 0 && lane_now() == 0) { unsigned long long* ts_ = (unsigned long long*)(args.ws + WS_CTL + 65536); ts_[0] = __builtin_amdgcn_s_memrealtime(); ts_[20] = ts_[0]; }
#endif
    { int lo = lo0, hi = hi0;
    if (IN(0)) { for (int rep = 0; rep < REP_PRO; ++rep) { PHASE_ROOTS();
#ifndef SKIP_PRO
        ph_prologue(C, lds, tid, lane, wave, vcu, G);
#endif
        __syncthreads(); }
        SEAM(0); } }

    layer_phases<0>(args, lds, wave0, lo0, hi0, bar);
    layer_phases<1>(args, lds, wave0, lo0, hi0, bar);
    layer_phases<2>(args, lds, wave0, lo0, hi0, bar);
    layer_phases<3>(args, lds, wave0, lo0, hi0, bar);
    { int lo = lo0, hi = hi0; if (IN(NPHASES - 1)) { PHASE_ROOTS(); ph_final((const bf16*)(C.ws + WS_X), C.out, (const float*)(C.ws + WS_PART), (const float*)(C.ws + WS_MODS) + (size_t)3 * 3 * 12288 + 5 * 2048, lane, gw, NGW); } }
#ifdef TPROBE
    { xcd_barrier(bar);
      if (blockIdx.x == 0 && wave0 == 0 && lane_now() == 0) { unsigned long long* ts_ = (unsigned long long*)(args.ws + WS_CTL + 65536); const unsigned long long t_ = __builtin_amdgcn_s_memrealtime();
          ts_[1 + 12] += t_ - ts_[0]; const unsigned long long num_ = (TPROBE >= 20) ? (ts_[32 + (TPROBE - 20) * 4] + ts_[33 + (TPROBE - 20) * 4] + ts_[34 + (TPROBE - 20) * 4] + ts_[35 + (TPROBE - 20) * 4]) : ts_[1 + (TPROBE >= 20 ? 0 : TPROBE)]; const float share = (float)((double)num_ / (double)(t_ - ts_[20])); *(float*)(ts_ + 24) = share; }
      xcd_barrier(bar);
      const float sc = 1.0f + 1.0f * *(const float*)((unsigned long long*)(args.ws + WS_CTL + 65536) + 24);
      for (size_t i = (size_t)blockIdx.x * 512 + TID_NOW(); i < 2097152; i += (size_t)gridDim.x * 512) args.out[O_KR + i] *= sc; }
#endif
#undef IN
#undef SEAM
}

extern "C" void kernel_launch(void* const* d_in, const int* in_sizes, int n_in, void* d_out, int out_size, void* d_ws, size_t ws_size, hipStream_t stream) {
    static int grid = 0;
    if (grid == 0) {
        if (n_in != 32 || out_size != 73400320 || ws_size < WS_END) { fprintf(stderr, "kernel_launch: built for 32 inputs, 73400320 outputs, >= %zu bytes of workspace; got n_in %d, out %d, ws %zu; nothing launched\n", (size_t)WS_END, n_in, out_size, ws_size); grid = -1; return; }
        int dev = 0, cus = 0, per_cu = 0;
        if (hipGetDevice(&dev) != hipSuccess || hipDeviceGetAttribute(&cus, hipDeviceAttributeMultiprocessorCount, dev) != hipSuccess) { fprintf(stderr, "kernel_launch: device query failed\n"); grid = -1; return; }
        if (hipFuncSetAttribute((const void*)mk_fwd, hipFuncAttributeMaxDynamicSharedMemorySize, LDS_BYTES) != hipSuccess) { fprintf(stderr, "kernel_launch: hipFuncSetAttribute failed\n"); grid = -1; return; }
        if (hipOccupancyMaxActiveBlocksPerMultiprocessor(&per_cu, (const void*)mk_fwd, NWAVES * 64, LDS_BYTES) != hipSuccess || per_cu < 1)
            fprintf(stderr, "kernel_launch: note: occupancy query reports %d workgroups per CU\n", per_cu);
        (void)hipGetLastError();
        grid = cus;
    }
    if (grid < 0) return;
    if (hipMemsetAsync((char*)d_ws + WS_CTL, 0, CTL_ZERO_BYTES, stream) != hipSuccess) { fprintf(stderr, "kernel_launch: memset failed\n"); return; }
    Args a{};
    for (int i = 0; i < 32; ++i) a.in[i] = (const float*)d_in[i];
    a.out = (float*)d_out; a.ws = (unsigned char*)d_ws;
#if MK_ONE_LAUNCH
    a.ph_lo = 0; a.ph_hi = NPHASES;
    hipLaunchKernelGGL(mk_fwd, dim3(grid), dim3(NWAVES * 64), LDS_BYTES, stream, a);
#else
    for (int p = 0; p < NPHASES; ++p) { a.ph_lo = p; a.ph_hi = p + 1; hipLaunchKernelGGL(mk_fwd, dim3(grid), dim3(NWAVES * 64), LDS_BYTES, stream, a); }
#endif
    const hipError_t le = hipPeekAtLastError();
    if (le != hipSuccess) fprintf(stderr, "kernel_launch: launch failed: %s\n", hipGetErrorName(le));
}
```

```cpp
#include <hip/hip_runtime.h>
#include <cstdio>
#include <cstdint>
#include <cstddef>
#ifndef MK_ONE_LAUNCH
#define MK_ONE_LAUNCH 1
#endif
namespace pg8 {
#define PG8_LAS __attribute__((address_space(3)))
typedef unsigned short bf16_t;
typedef short bf16x8 __attribute__((ext_vector_type(8)));
typedef float f32x4 __attribute__((ext_vector_type(4)));
typedef unsigned u32x4 __attribute__((ext_vector_type(4)));
constexpr int BM = 256, BK = 64, HALF = 128, HTB = HALF * BK * 2  , STAGE_BYTES = 8 * HTB, NXCD = 8, WGM = 8;

__host__ __device__ __forceinline__ int lds_byte(int r, int c) { const int st = (r >> 4) * 2 + (c >> 5), rr = r & 15, cc = c & 31, ob = rr * 64 + cc * 2; return st * 1024 + (ob ^ (((ob >> 9) & 1) << 5)); }
__host__ __device__ __forceinline__ void stage_rc(int b, int& R, int& C) { const int st = b / 1024, sb = b % 1024, swz = sb ^ (((sb >> 9) & 1) << 5); R = (st >> 1) * 16 + swz / 64; C = (st & 1) * 32 + (swz % 64) / 2; }
__host__ __device__ __forceinline__ int perm32(int rho) { const int n = rho >> 4, i = rho & 15; return 8 * (i >> 2) + 4 * n + (i & 3); }

struct Unit { int pm, pn, k0; };
struct Gemm { const bf16_t* A; const bf16_t* Bt; int M, N, K, ld; };

struct StaticOrder {
    int nM, nN, nwg, G, c;
    __host__ __device__ void init(int M, int N, int G_, int c_) { nM = M / BM; nN = N / BM; nwg = nM * nN; G = G_; c = c_; }
    __host__ __device__ bool next(int i, Unit& u) const {
        const long L = (long)i * G + c; if (L >= nwg) return false;
        int wgid = (int)L; { const int q = nwg / NXCD, r = nwg % NXCD, xcd = wgid % NXCD, off = wgid / NXCD; wgid = (xcd < r ? xcd * (q + 1) : r * (q + 1) + (xcd - r) * q) + off; }
        const int nig = WGM * nN, gid = wgid / nig, fm = gid * WGM, gsz = (nM - fm) < WGM ? (nM - fm) : WGM;
        u.pm = fm + ((wgid % nig) % gsz); u.pn = (wgid % nig) / gsz; u.k0 = 0; return true;
    }
    __device__ __forceinline__ void a_ready(const Unit&) const {}
    __device__ __forceinline__ void done(const Unit&) const {}
};

__device__ __forceinline__ unsigned cvt_pk_bf16(float lo, float hi) { unsigned r; asm volatile("v_cvt_pk_bf16_f32 %0, %1, %2" : "=v"(r) : "v"(lo), "v"(hi)); return r; }
__device__ __forceinline__ float silu_f(float x) { return x * __builtin_amdgcn_rcpf(1.0f + __expf(-x)); }

struct EpiF32 {
    static constexpr bool PERM = false, AFTER_DRAIN = false;
    float* C; int ldc;
    __device__ __forceinline__ void operator()(const f32x4 (&acc)[2][2][4][2], const Unit& u, int wr, int wc, int fr, int fq) const {
        const int row0 = u.pm * BM + wr * 64 + fr, col0 = u.pn * BM + wc * 32 + 4 * fq;
#pragma unroll
        for (int ai = 0; ai < 2; ++ai)
#pragma unroll
            for (int m = 0; m < 4; ++m) { float* rowp = C + (size_t)(row0 + ai * HALF + m * 16) * ldc + col0;
#pragma unroll
                for (int bj = 0; bj < 2; ++bj)
#pragma unroll
                    for (int n = 0; n < 2; ++n) *(f32x4*)(rowp + bj * HALF + n * 16) = acc[ai][bj][m][n]; }
    }
};
struct EpiBf16 {
    static constexpr bool PERM = true, AFTER_DRAIN = false;
    bf16_t* O; int ldc;
    __device__ __forceinline__ void operator()(const f32x4 (&acc)[2][2][4][2], const Unit& u, int wr, int wc, int fr, int fq) const {
        const int row0 = u.pm * BM + wr * 64 + fr; const int col0 = u.pn * BM + wc * 32 + 8 * fq;
#pragma unroll
        for (int ai = 0; ai < 2; ++ai)
#pragma unroll
            for (int m = 0; m < 4; ++m) { bf16_t* rowp = O + (size_t)(row0 + ai * HALF + m * 16) * ldc + col0;
#pragma unroll
                for (int bj = 0; bj < 2; ++bj) { const f32x4 v0 = acc[ai][bj][m][0], v1 = acc[ai][bj][m][1];
                    u32x4 w; w.x = cvt_pk_bf16(v0[0], v0[1]); w.y = cvt_pk_bf16(v0[2], v0[3]); w.z = cvt_pk_bf16(v1[0], v1[1]); w.w = cvt_pk_bf16(v1[2], v1[3]);
                    *(u32x4*)(rowp + bj * HALF) = w; } }
    }
};
typedef unsigned u32x2 __attribute__((ext_vector_type(2)));
template <bool F32OUT> struct EpiResidT {
    static constexpr bool PERM = false, AFTER_DRAIN = false;
    bf16_t* X; float* OUT; int ldc; const float* gate;
    __device__ __forceinline__ void operator()(const f32x4 (&acc)[2][2][4][2], const Unit& u, int wr, int wc, int fr, int fq) const {
        const int row0 = u.pm * BM + wr * 64 + fr, col0 = u.pn * BM + wc * 32 + 4 * fq;
        const int cr = u.pm < 32 ? 0 : 1 + ((u.pm - 32) >> 2);
        const float* gp = gate + (size_t)cr * 12288 + col0;
        f32x4 gv[2][2];
#pragma unroll
        for (int bj = 0; bj < 2; ++bj)
#pragma unroll
            for (int n = 0; n < 2; ++n) gv[bj][n] = *(const f32x4*)(gp + bj * HALF + n * 16);
#pragma unroll
        for (int ai = 0; ai < 2; ++ai)
#pragma unroll
            for (int m = 0; m < 4; ++m) { const size_t ro = (size_t)(row0 + ai * HALF + m * 16) * ldc + col0;
#pragma unroll
                for (int bj = 0; bj < 2; ++bj)
#pragma unroll
                    for (int n = 0; n < 2; ++n) { const size_t off = ro + bj * HALF + n * 16; const u32x2 xb = *(const u32x2*)(X + off);
                        f32x4 x; x[0] = __builtin_bit_cast(float, xb.x << 16); x[1] = __builtin_bit_cast(float, xb.x & 0xffff0000u); x[2] = __builtin_bit_cast(float, xb.y << 16); x[3] = __builtin_bit_cast(float, xb.y & 0xffff0000u);
                        x = x + gv[bj][n] * acc[ai][bj][m][n];
                        if (F32OUT) *(f32x4*)(OUT + off) = x; else { u32x2 w; w.x = cvt_pk_bf16(x[0], x[1]); w.y = cvt_pk_bf16(x[2], x[3]); *(u32x2*)(X + off) = w; } } }
    }
};
struct EpiSwiglu {
    static constexpr bool PERM = true, AFTER_DRAIN = false;
    bf16_t* O; int ldc;
    __device__ __forceinline__ void operator()(const f32x4 (&acc)[2][2][4][2], const Unit& u, int wr, int wc, int fr, int fq) const {
        const int row0 = u.pm * BM + wr * 64 + fr; const int col0 = u.pn * HALF + wc * 32 + 8 * fq;
#pragma unroll
        for (int ai = 0; ai < 2; ++ai)
#pragma unroll
            for (int m = 0; m < 4; ++m) { bf16_t* rowp = O + (size_t)(row0 + ai * HALF + m * 16) * ldc + col0;
                f32x4 v0, v1;
#pragma unroll
                for (int j = 0; j < 4; ++j) { v0[j] = silu_f(acc[ai][0][m][0][j]) * acc[ai][1][m][0][j]; v1[j] = silu_f(acc[ai][0][m][1][j]) * acc[ai][1][m][1][j]; }
                u32x4 w; w.x = cvt_pk_bf16(v0[0], v0[1]); w.y = cvt_pk_bf16(v0[2], v0[3]); w.z = cvt_pk_bf16(v1[0], v1[1]); w.w = cvt_pk_bf16(v1[2], v1[3]);
                *(u32x4*)rowp = w; }
    }
};


struct PanelOrder {
    int c;
    __device__ bool next(int i, Unit& u) const { if (i != 0 || c >= 256) return false; const int x = c & 7, j = c >> 3; u.pm = 4 * x + (j >> 3); u.pn = j & 7; u.k0 = 0; return true; }
    __device__ __forceinline__ void a_ready(const Unit&) const {}
    __device__ __forceinline__ void done(const Unit&) const {}
};
struct TailOrder {
    int c, kq;
    __device__ bool next(int i, Unit& u) const { if (i != 0 || c >= 256) return false; const int x = c & 7, j = c >> 3; u.pm = 32 + x; u.pn = j & 7; u.k0 = (j >> 3) * kq; return true; }
    __device__ __forceinline__ void a_ready(const Unit&) const {}
    __device__ __forceinline__ void done(const Unit&) const {}
};
struct EpiPart {
    static constexpr bool PERM = true, AFTER_DRAIN = false;
    bf16_t* P; int kq;
    __device__ __forceinline__ void operator()(const f32x4 (&acc)[2][2][4][2], const Unit& u, int wr, int wc, int fr, int fq) const {
        const int row0 = (u.pm - 32) * BM + wr * 64 + fr, col0 = u.pn * BM + wc * 32 + 8 * fq;
        bf16_t* base = P + (size_t)(u.k0 / kq) * 2048 * 2048;
#pragma unroll
        for (int ai = 0; ai < 2; ++ai)
#pragma unroll
            for (int m = 0; m < 4; ++m) { bf16_t* rowp = base + (size_t)(row0 + ai * HALF + m * 16) * 2048 + col0;
#pragma unroll
                for (int bj = 0; bj < 2; ++bj) { const f32x4 v0 = acc[ai][bj][m][0], v1 = acc[ai][bj][m][1];
                    u32x4 w; w.x = cvt_pk_bf16(v0[0], v0[1]); w.y = cvt_pk_bf16(v0[2], v0[3]); w.z = cvt_pk_bf16(v1[0], v1[1]); w.w = cvt_pk_bf16(v1[2], v1[3]);
                    *(u32x4*)(rowp + bj * HALF) = w; } }
    }
};

struct EpiU {
    static constexpr bool PERM = true, AFTER_DRAIN = false;
    bf16_t* O; int ldc; float* side;
    __device__ __forceinline__ void operator()(const f32x4 (&acc)[2][2][4][2], const Unit& u, int wr, int wc, int fr, int fq) const {
        const int row0 = u.pm * BM + wr * 64 + fr; const int col0 = u.pn * BM + wc * 32 + 8 * fq;
        const bool sd = (wc == 2) && ((u.pn == 13 && fq < 2) || (u.pn == 19 && fq >= 2));
        const int sc0 = (u.pn == 13) ? 8 * fq : 16 + 8 * (fq - 2);
#pragma unroll
        for (int ai = 0; ai < 2; ++ai)
#pragma unroll
            for (int m = 0; m < 4; ++m) { const int row = row0 + ai * HALF + m * 16; bf16_t* rowp = O + (size_t)row * ldc + col0;
#pragma unroll
                for (int bj = 0; bj < 2; ++bj) { const f32x4 v0 = acc[ai][bj][m][0], v1 = acc[ai][bj][m][1];
                    u32x4 w; w.x = cvt_pk_bf16(v0[0], v0[1]); w.y = cvt_pk_bf16(v0[2], v0[3]); w.z = cvt_pk_bf16(v1[0], v1[1]); w.w = cvt_pk_bf16(v1[2], v1[3]);
                    *(u32x4*)(rowp + bj * HALF) = w; }
                if (sd) { float* sp = side + (size_t)row * 32 + sc0; *(f32x4*)sp = acc[ai][0][m][0]; *(f32x4*)(sp + 4) = acc[ai][0][m][1]; } }
    }
};

struct InOrder {
    StaticOrder so;
    __device__ void init(int M, int G_, int c_) { so.init(M, 18 * BM, G_, c_); }
    __device__ bool next(int i, Unit& u) const {
        if (!so.next(i, u)) { const long L = (long)i * so.G + so.c; const int d = (int)(L - 720);
            if (d < 0 || d >= 48) return false; u.pm = d >> 1; u.pn = (d & 1) ? 14 : 12; u.k0 = 0; return true; }
        u.pn = u.pn < 12 ? u.pn : (u.pn == 12 ? 13 : u.pn + 2); return true; }
    __device__ __forceinline__ void a_ready(const Unit&) const {}
    __device__ __forceinline__ void done(const Unit&) const {}
};
struct DeferOrder {
    int c;
    __device__ bool next(int i, Unit& u) const { if (i != 0 || c < 0 || c >= 32) return false; const int d = c + 48; u.pm = d >> 1; u.pn = (d & 1) ? 14 : 12; u.k0 = 0; return true; }
    __device__ __forceinline__ void a_ready(const Unit&) const {}
    __device__ __forceinline__ void done(const Unit&) const {}
};
template <class Epi, class Sched, bool ALIGN_EPI = false, bool SP2 = false>
__device__ __forceinline__ void gemm_phase(PG8_LAS unsigned char* lds, const Gemm g, const Sched& S, const Epi& E, int tid_in) {
    int tid_l = tid_in; asm volatile("" : "+v"(tid_l)); const int tid = tid_l, wid = __builtin_amdgcn_readfirstlane(tid >> 6), lane = tid & 63, wr = wid >> 2, wc = wid & 3, fr = lane & 15, fq = lane >> 4;
    const int K = g.ld ? g.ld : g.K, nt = g.K / BK;
    unsigned voffA[2], voffB[2];
#pragma unroll
    for (int i = 0; i < 2; ++i) { int R, C; stage_rc(tid * 16 + i * 8192, R, C); const int Rb = Epi::PERM ? ((R & ~31) + perm32(R & 31)) : R;
        voffA[i] = (unsigned)(R * K + C) * 2u; voffB[i] = (unsigned)(Rb * K + C) * 2u; }
    const size_t kstep = (size_t)(BK * 2);
    const size_t hstep = (size_t)HALF * K * 2;
    const size_t tstep = 2 * hstep;
    const unsigned ldsw = (unsigned)wid * 1024u;
    const int aoff = lds_byte(wr * 64 + fr, fq * 8), boff = lds_byte(wc * 32 + fr, fq * 8);
#define PG8_SA(b, h) (((b) * 2 + (h)) * HTB)
#define PG8_SB(b, h) ((4 + (b) * 2 + (h)) * HTB)
#define PG8_STAGE(bufoff, gbase, voff) do { _Pragma("unroll") for (int _i = 0; _i < 2; ++_i) \
        __builtin_amdgcn_global_load_lds((const unsigned*)((const char*)(gbase) + (voff)[_i]), (PG8_LAS unsigned*)(lds + (bufoff) + ldsw + _i * 8192), 16, 0, 0); } while (0)
#define PG8_LDA(dst, b, h) do { _Pragma("unroll") for (int m = 0; m < 4; ++m) _Pragma("unroll") for (int k = 0; k < 2; ++k) dst[m][k] = *(const PG8_LAS bf16x8*)(lds + PG8_SA(b, h) + aoff + m * 2048 + k * 1024); } while (0)
#define PG8_LDB(dst, b, h) do { _Pragma("unroll") for (int n = 0; n < 2; ++n) _Pragma("unroll") for (int k = 0; k < 2; ++k) dst[n][k] = *(const PG8_LAS bf16x8*)(lds + PG8_SB(b, h) + boff + n * 2048 + k * 1024); } while (0)
#define PG8_MMA(ai, bj, At, Bt) do { __builtin_amdgcn_s_setprio(1); _Pragma("unroll") for (int m = 0; m < 4; ++m) _Pragma("unroll") for (int n = 0; n < 2; ++n) _Pragma("unroll") for (int k = 0; k < 2; ++k) \
        acc[ai][bj][m][n] = __builtin_amdgcn_mfma_f32_16x16x32_bf16(Bt[n][k], At[m][k], acc[ai][bj][m][n], 0, 0, 0); __builtin_amdgcn_s_setprio(0); } while (0)
#define PG8_WAIT_V(n) asm volatile("s_waitcnt vmcnt(" #n ")" ::: "memory")
#define PG8_WAIT_L(n) asm volatile("s_waitcnt lgkmcnt(" #n ")" ::: "memory")
#define PG8_BAR __builtin_amdgcn_s_barrier()
#define PG8_SCHED __builtin_amdgcn_sched_barrier(0)
    Unit cur, nxt; int ui = 0;
    if (!S.next(0, cur)) return;
    f32x4 acc[2][2][4][2];
#pragma unroll
    for (int a = 0; a < 2; ++a)
#pragma unroll
        for (int b = 0; b < 2; ++b)
#pragma unroll
            for (int m = 0; m < 4; ++m)
#pragma unroll
                for (int n = 0; n < 2; ++n) acc[a][b][m][n] = (f32x4){0.f, 0.f, 0.f, 0.f};
    bf16x8 At[4][2], B0[2][2], B1[2][2];
    const char* cA = (const char*)g.A + (size_t)cur.pm * tstep + (size_t)cur.k0 * 2; const char* cB = (const char*)g.Bt + (size_t)cur.pn * tstep + (size_t)cur.k0 * 2;
    S.a_ready(cur);
    if constexpr (SP2) {
        PG8_STAGE(PG8_SB(0, 0), cB, voffB); PG8_STAGE(PG8_SB(0, 1), cB + hstep, voffB); PG8_STAGE(PG8_SA(0, 0), cA, voffA); PG8_STAGE(PG8_SA(0, 1), cA + hstep, voffA);
        if (wr == 1) PG8_BAR;
        PG8_WAIT_V(2); PG8_BAR;
        PG8_STAGE(PG8_SB(1, 0), cB + kstep, voffB); PG8_STAGE(PG8_SA(1, 0), cA + kstep, voffA); PG8_STAGE(PG8_SB(1, 1), cB + hstep + kstep, voffB);
        PG8_WAIT_V(6); PG8_BAR;
    } else {
        PG8_STAGE(PG8_SB(0, 0), cB, voffB); PG8_STAGE(PG8_SA(0, 0), cA, voffA); PG8_STAGE(PG8_SB(0, 1), cB + hstep, voffB); PG8_STAGE(PG8_SA(0, 1), cA + hstep, voffA);
        if (wr == 1) PG8_BAR;
        PG8_WAIT_V(4); PG8_BAR;
        PG8_STAGE(PG8_SB(1, 0), cB + kstep, voffB); PG8_STAGE(PG8_SA(1, 0), cA + kstep, voffA); PG8_STAGE(PG8_SB(1, 1), cB + hstep + kstep, voffB);
        PG8_WAIT_V(6); PG8_BAR;
    }
    for (;;) {
        const bool has_next = S.next(ui + 1, nxt);
        const char* nA = has_next ? (const char*)g.A + (size_t)nxt.pm * tstep + (size_t)nxt.k0 * 2 : cA; const char* nB = has_next ? (const char*)g.Bt + (size_t)nxt.pn * tstep + (size_t)nxt.k0 * 2 : cB;
        for (int t = 0; t < nt; t += 2) {
            const bool last = (t == nt - 2);
            const char* a1 = cA + (size_t)(t + 1) * kstep;
            const char* a2 = last ? nA : cA + (size_t)(t + 2) * kstep; const char* b2 = last ? nB : cB + (size_t)(t + 2) * kstep;
            const char* a3 = a2 + kstep; const char* b3 = b2 + kstep;
            if (last && has_next) S.a_ready(nxt);
            if constexpr (SP2) {
            PG8_LDB(B0, 0, 0); PG8_LDB(B1, 0, 1); PG8_SCHED; PG8_LDA(At, 0, 0); PG8_STAGE(PG8_SA(1, 1), a1 + hstep, voffA);
            PG8_WAIT_V(8); PG8_WAIT_L(0); PG8_BAR; PG8_MMA(0, 0, At, B0); PG8_MMA(0, 1, At, B1); PG8_BAR; PG8_SCHED;
            PG8_LDA(At, 0, 1); PG8_STAGE(PG8_SB(0, 0), b2, voffB); PG8_STAGE(PG8_SB(0, 1), b2 + hstep, voffB); PG8_STAGE(PG8_SA(0, 0), a2, voffA);
            PG8_WAIT_V(8); PG8_WAIT_L(0); PG8_BAR; PG8_MMA(1, 0, At, B0); PG8_MMA(1, 1, At, B1); PG8_BAR; PG8_SCHED;
            PG8_LDB(B0, 1, 0); PG8_LDB(B1, 1, 1); PG8_SCHED; PG8_LDA(At, 1, 0); PG8_STAGE(PG8_SA(0, 1), a2 + hstep, voffA);
            PG8_WAIT_V(8); PG8_WAIT_L(0); PG8_BAR; PG8_MMA(0, 0, At, B0); PG8_MMA(0, 1, At, B1); PG8_BAR; PG8_SCHED;
            PG8_LDA(At, 1, 1); PG8_STAGE(PG8_SB(1, 0), b3, voffB); PG8_STAGE(PG8_SB(1, 1), b3 + hstep, voffB); PG8_STAGE(PG8_SA(1, 0), a3, voffA);
            PG8_WAIT_V(8); PG8_WAIT_L(0); PG8_BAR; PG8_MMA(1, 0, At, B0); PG8_MMA(1, 1, At, B1); PG8_BAR; PG8_SCHED;
            } else {
            PG8_LDB(B0, 0, 0); PG8_SCHED; PG8_LDA(At, 0, 0); PG8_STAGE(PG8_SA(1, 1), a1 + hstep, voffA);
            PG8_WAIT_L(8); PG8_BAR; PG8_WAIT_L(0); PG8_MMA(0, 0, At, B0); PG8_BAR; PG8_SCHED;
            PG8_LDB(B1, 0, 1); PG8_STAGE(PG8_SB(0, 0), b2, voffB);
            PG8_BAR; PG8_WAIT_L(0); PG8_MMA(0, 1, At, B1); PG8_BAR;
            PG8_LDA(At, 0, 1); PG8_STAGE(PG8_SA(0, 0), a2, voffA);
            PG8_BAR; PG8_WAIT_L(0); PG8_MMA(1, 0, At, B0); PG8_BAR; PG8_SCHED;
            PG8_STAGE(PG8_SB(0, 1), b2 + hstep, voffB);
            PG8_WAIT_V(6); PG8_BAR; PG8_MMA(1, 1, At, B1); PG8_BAR;
            PG8_LDB(B0, 1, 0); PG8_SCHED; PG8_LDA(At, 1, 0); PG8_STAGE(PG8_SA(0, 1), a2 + hstep, voffA);
            PG8_WAIT_L(8); PG8_BAR; PG8_WAIT_L(0); PG8_MMA(0, 0, At, B0); PG8_BAR; PG8_SCHED;
            PG8_LDB(B1, 1, 1); PG8_STAGE(PG8_SB(1, 0), b3, voffB);
            PG8_BAR; PG8_WAIT_L(0); PG8_MMA(0, 1, At, B1); PG8_BAR;
            PG8_LDA(At, 1, 1); PG8_STAGE(PG8_SA(1, 0), a3, voffA);
            PG8_BAR; PG8_WAIT_L(0); PG8_MMA(1, 0, At, B0); PG8_BAR; PG8_SCHED;
            PG8_STAGE(PG8_SB(1, 1), b3 + hstep, voffB);
            PG8_WAIT_V(6); PG8_BAR; PG8_MMA(1, 1, At, B1); PG8_BAR;
            }
        }
        if constexpr (ALIGN_EPI) { if (wr == 0) PG8_BAR; }
        if constexpr (!Epi::AFTER_DRAIN) { E(acc, cur, wr, wc, fr, fq); S.done(cur); }
        if (!has_next) break;
#pragma unroll
        for (int a = 0; a < 2; ++a)
#pragma unroll
            for (int b = 0; b < 2; ++b)
#pragma unroll
                for (int m = 0; m < 4; ++m)
#pragma unroll
                    for (int n = 0; n < 2; ++n) acc[a][b][m][n] = (f32x4){0.f, 0.f, 0.f, 0.f};
        cur = nxt; cA = nA; cB = nB; ++ui;
        if constexpr (ALIGN_EPI) { if (wr == 1) PG8_BAR; }
    }
    PG8_WAIT_V(0);
    if constexpr (!ALIGN_EPI) { if (wr == 0) PG8_BAR; }
    PG8_BAR;
    if constexpr (Epi::AFTER_DRAIN) { E.fused(acc, cur, wr, wc, fr, fq, lds, wid, lane); S.done(cur); }
#undef PG8_SA
#undef PG8_SB
#undef PG8_STAGE
#undef PG8_LDA
#undef PG8_LDB
#undef PG8_MMA
#undef PG8_WAIT_V
#undef PG8_WAIT_L
#undef PG8_BAR
#undef PG8_SCHED
}
}
#ifndef REP_LAT
#define REP_LAT 1
#endif
#ifndef REP_CTX
#define REP_CTX 1
#endif
constexpr int D = 2048, NCTX = 8192, M = 10240, MK = 10752, DEPTH = 4, NWAVES = 8;
constexpr int IN_W = 4960, IN_WP = 5120, FF = 5632;
constexpr int U_CQ = 0, U_CKV = 768, U_KR = 1280, U_GQKV = 1344, U_GZ = 1344 + 1536, U_GB = 1344 + 2048, U_GA = 1344 + 2056, U_SZ = 3408, U_SXBC = 3408 + 512, U_SDT = 3408 + 1536;
constexpr float EPS = 1e-6f;
constexpr int NPH_L = 11, NPHASES = 2 + DEPTH * NPH_L;
constexpr size_t O_YP = 0, O_YS = 16777216, O_CKV = 20971520, O_KR = 37748736, O_SG = 39845888, O_SS = 56623104;
constexpr size_t MiB = 1u << 20;
constexpr size_t WS_CTL = 0, CTL_ZERO_BYTES = 1 * MiB;
constexpr size_t WL_IN = 0, WL_UQ = WL_IN + (size_t)IN_WP * D * 2, WL_UKV = WL_UQ + (size_t)1536 * 768 * 2, WL_OUT = WL_UKV + (size_t)2048 * 512 * 2,
                 WL_GU = WL_OUT + (size_t)D * D * 2, WL_DN = WL_GU + (size_t)2 * FF * D * 2, WL_SIZE = WL_DN + (size_t)D * FF * 2;
constexpr size_t WS_W = 2 * MiB;
constexpr size_t WS_MODS = WS_W + 4 * WL_SIZE;
constexpr size_t WS_H = WS_MODS + 1 * MiB;
constexpr size_t WS_U = WS_H + (size_t)M * D * 2;
constexpr size_t WS_USIDE = WS_U + (size_t)M * IN_WP * 2;
constexpr size_t WS_CQN = WS_USIDE + (size_t)M * 32 * 4;
constexpr size_t WS_CKVN = WS_CQN + (size_t)M * 768 * 2;
constexpr size_t WS_QRAW = WS_CKVN + (size_t)MK * 512 * 2;
constexpr size_t WS_KN = WS_QRAW + (size_t)M * 1536 * 4;
constexpr size_t WS_VT = WS_KN + (size_t)MK * 1024 * 4;
constexpr size_t WS_QB = WS_VT + (size_t)1024 * MK * 2;
constexpr size_t WS_KB = WS_QB + (size_t)M * 1536 * 2;
constexpr size_t WS_GQ = WS_KB + (size_t)MK * 1536 * 2;
constexpr size_t WS_GBG = WS_GQ + (size_t)3 * M * 512 * 4;
constexpr size_t WS_GO = WS_GBG + (size_t)2 * M * 8 * 4;
constexpr size_t WS_XBC = WS_GO + (size_t)2 * M * 512 * 4;
constexpr size_t WS_SDT = WS_XBC + (size_t)M * 1024 * 4;
constexpr size_t WS_SY = WS_SDT + (size_t)2 * M * 16 * 4;
constexpr size_t WS_MIX = WS_SY + (size_t)2 * M * 512 * 4;
constexpr size_t WS_ACT = WS_MIX + (size_t)M * D * 2;
constexpr size_t WS_GCH = WS_ACT + (size_t)M * FF * 2;
constexpr size_t WS_SREC = WS_GCH + (size_t)1280 * 90368;
constexpr size_t WS_SSH = WS_SREC + (size_t)1280 * 66560;
constexpr size_t WS_PART = WS_SSH + (size_t)160 * 65536;
constexpr size_t WS_X = WS_PART + (size_t)4 * 2048 * 2048 * 4;
constexpr size_t WS_END = WS_X + (size_t)M * D * 2;
constexpr int CW_BAR = 4096;
constexpr int RING_BYTES = 131072, LDS_BYTES = 163840, LDSCTL_OFF = LDS_BYTES - 512, MISC_OFF = LDSCTL_OFF + 320;

#define GAS __attribute__((address_space(1)))
#define LAS __attribute__((address_space(3)))
typedef unsigned short bf16;
typedef unsigned v4u __attribute__((ext_vector_type(4)));
typedef unsigned v2u __attribute__((ext_vector_type(2)));
typedef float f32x4 __attribute__((ext_vector_type(4)));
typedef float f32x2 __attribute__((ext_vector_type(2)));
typedef short bf16x8 __attribute__((ext_vector_type(8)));
typedef GAS unsigned gu32;
#define RLX_AGENT __ATOMIC_RELAXED, __HIP_MEMORY_SCOPE_AGENT
#define MEMBAR() asm volatile("" ::: "memory")
#define WG_BAR() do { asm volatile("s_waitcnt lgkmcnt(0)" ::: "memory"); __builtin_amdgcn_s_barrier(); asm volatile("" ::: "memory"); } while (0)
#define LDS_WAIT() asm volatile("s_waitcnt lgkmcnt(0)" ::: "memory")
#define VM_WAIT() asm volatile("s_waitcnt vmcnt(0)" ::: "memory")
__device__ __forceinline__ unsigned pk2(float lo, float hi) { unsigned r; asm("v_cvt_pk_bf16_f32 %0, %1, %2" : "=v"(r) : "v"(lo), "v"(hi)); return r; }
__device__ __forceinline__ unsigned f2bf(float f) { return pk2(f, 0.f) & 0xffffu; }
__device__ __forceinline__ float wave_sum(float v) {
#pragma unroll
    for (int o = 1; o < 64; o <<= 1) v += __shfl_xor(v, o);
    return v;
}
__device__ __forceinline__ float half_sum(float v) {
#pragma unroll
    for (int o = 1; o < 32; o <<= 1) v += __shfl_xor(v, o);
    return v;
}
__device__ __forceinline__ f32x4 bf4(v2u w) { f32x4 r; r.x = __builtin_bit_cast(float, w.x << 16); r.y = __builtin_bit_cast(float, w.x & 0xffff0000u); r.z = __builtin_bit_cast(float, w.y << 16); r.w = __builtin_bit_cast(float, w.y & 0xffff0000u); return r; }
__device__ __forceinline__ float bf1(bf16 v) { return __builtin_bit_cast(float, (unsigned)v << 16); }
__device__ __forceinline__ float silu(float x) { return x * __builtin_amdgcn_rcpf(1.0f + __expf(-x)); }
__device__ __forceinline__ float softplus(float x) { return x > 20.f ? x : log1pf(expf(x)); }

#define XB_TMO      128
#define XB_XCNT(j)  (256  + 64 * (j))
#define XB_XSUB(j)  (1280 + 64 * (j))
#define XB_XGEN(j)  (2304 + 64 * (j))
#define XB_TOP      3328
#define XB_TOPGEN   3392
#define XCD_BAR_WORDS 3456
#define XB_SPIN_CAP (1u << 18)

__device__ __forceinline__ unsigned xb_ld(unsigned* p)              { return __hip_atomic_load(p, __ATOMIC_RELAXED, __HIP_MEMORY_SCOPE_AGENT); }
__device__ __forceinline__ unsigned xb_add(unsigned* p, unsigned v) { return __hip_atomic_fetch_add(p, v, __ATOMIC_RELAXED, __HIP_MEMORY_SCOPE_AGENT); }
__device__ __forceinline__ unsigned xb_xcc_id() { return (unsigned)__builtin_amdgcn_s_getreg((3 << 11) | 20) & 0xFu; }
#define XB_SPIN(cond, bar) do { unsigned _sp = 0; while (cond) { __builtin_amdgcn_s_sleep(1); \
    if ((++_sp & 255u) == 0u) { if (xb_ld(&(bar)[XB_TMO])) break; if (_sp > XB_SPIN_CAP) { atomicAdd(&(bar)[XB_TMO], 1u); break; } } } } while (0)

struct XcdBarrier {
    unsigned* bar; unsigned x;
    volatile LAS unsigned* st;
    int wv;
};

__device__ __forceinline__ XcdBarrier xcd_barrier_post(unsigned* bar, volatile LAS unsigned* st) {
    XcdBarrier b; b.bar = bar; b.x = xb_xcc_id(); b.st = st;
    if (threadIdx.x == 0) (void)xb_add(&bar[XB_XCNT(b.x)], 1u);
    return b;
}
__device__ __forceinline__ void xcd_barrier_complete(unsigned* bar, unsigned x, unsigned& nloc, unsigned& nx) {
    const unsigned G = gridDim.x * gridDim.y * gridDim.z;
    unsigned sum, cnt, mine, sp = 0u;
    for (;;) {
        sum = 0u; cnt = 0u; mine = 0u;
#pragma unroll
        for (unsigned j = 0; j < 16; ++j) { const unsigned c = xb_ld(&bar[XB_XCNT(j)]); sum += c; cnt += (c > 0u) ? 1u : 0u; mine = (j == x) ? c : mine; }
        if (sum == G) break;
        __builtin_amdgcn_s_sleep(1);
        if ((++sp & 255u) == 0u) { if (xb_ld(&bar[XB_TMO])) break; if (sp > XB_SPIN_CAP) { atomicAdd(&bar[XB_TMO], 1u); break; } }
    }
    nloc = mine > 0u ? mine : 1u; nx = cnt > 0u ? cnt : 1u;
}

__device__ __forceinline__ void xcd_barrier(const XcdBarrier& b) {
    asm volatile("s_waitcnt vmcnt(0)" ::: "memory");
    __syncthreads();
    unsigned xm_ = ~0u; asm volatile("" : "+s"(xm_));
    if (b.wv == 0 && __builtin_amdgcn_mbcnt_hi(xm_, __builtin_amdgcn_mbcnt_lo(xm_, 0u)) == 0u) {
        unsigned* bar = b.bar;
        __builtin_amdgcn_s_waitcnt(0);
        unsigned nloc = b.st[0], nx = b.st[1];
        if (nloc == 0u) { xcd_barrier_complete(bar, b.x, nloc, nx); b.st[0] = nloc; b.st[1] = nx; }
        const unsigned old = xb_add(&bar[XB_XSUB(b.x)], 1u);
        const unsigned gen = old / nloc;
        if (old + 1u == (gen + 1u) * nloc) {
            __builtin_amdgcn_fence(__ATOMIC_RELEASE, "agent");
            asm volatile("s_waitcnt vmcnt(0)" ::: "memory");
            const unsigned og = xb_add(&bar[XB_TOP], 1u);
            const unsigned tg = og / nx;
            if (og + 1u == (tg + 1u) * nx) xb_add(&bar[XB_TOPGEN], 1u);
            else XB_SPIN(xb_ld(&bar[XB_TOPGEN]) == tg, bar);
            __builtin_amdgcn_fence(__ATOMIC_ACQUIRE, "agent");
            xb_add(&bar[XB_XGEN(b.x)], 1u);
            asm volatile("s_waitcnt vmcnt(0)" ::: "memory");
        } else {
            XB_SPIN(xb_ld(&bar[XB_XGEN(b.x)]) == gen, bar);
            __builtin_amdgcn_fence(__ATOMIC_ACQUIRE, "agent");
            asm volatile("s_waitcnt vmcnt(0)" ::: "memory");
        }
    }
    __syncthreads();
}
struct Args { const float* in[32]; float* out; unsigned char* ws; int ph_lo, ph_hi; };
#define CAS __attribute__((address_space(4)))
typedef const float* const CAS* kin_t;
struct Ctx { kin_t in; float* out; unsigned char* ws; };

__device__ __forceinline__ void transpose_item(const float* __restrict__ W, int K, int N, bf16* WT, int k0, int n0, int drow0, LAS float* scr, int lane) {
#pragma unroll 8
    for (int i = 0; i < 32; ++i) { const int kk = 2 * i + (lane >> 5); scr[kk * 33 + (lane & 31)] = W[(size_t)(k0 + kk) * N + n0 + (lane & 31)]; }
    LDS_WAIT(); asm volatile("" ::: "memory");
    const int c = lane & 7;
#pragma unroll
    for (int j = 0; j < 4; ++j) { const int n = (lane >> 3) + 8 * j; const LAS float* s = scr + (8 * c) * 33 + n;
        v4u o; o.x = pk2(s[0 * 33], s[1 * 33]); o.y = pk2(s[2 * 33], s[3 * 33]); o.z = pk2(s[4 * 33], s[5 * 33]); o.w = pk2(s[6 * 33], s[7 * 33]);
        *(GAS v4u*)(WT + (size_t)(drow0 + n) * K + k0 + 8 * c) = o; }
    LDS_WAIT(); asm volatile("" ::: "memory");
}
constexpr size_t WLE_IN = 0, WLE_UQ = WLE_IN + (size_t)IN_WP * D, WLE_KV = WLE_UQ + (size_t)1536 * 768, WLE_OUT = WLE_KV + (size_t)2048 * 512,
                 WLE_GU = WLE_OUT + (size_t)D * D, WLE_DN = WLE_GU + (size_t)2 * FF * D, WLE_SIZE = WLE_DN + (size_t)D * FF;
static_assert(WLE_SIZE * 2 == WL_SIZE, "weight map");

__device__ __forceinline__ void ph_prologue(const Ctx& A, LAS unsigned char* lds, int tid, int lane, int wave, int vcu, int G) {
    const int gw = vcu * NWAVES + wave, NGW = G * NWAVES;
    LAS float* scr = (LAS float*)(lds + wave * 8704);
    constexpr int I_IN = 32 * 155, I_UQ = 12 * 48, I_KV = 8 * 64, I_OUT = 32 * 64, I_GU = 32 * 352, I_DN = 88 * 64, I_L = I_IN + I_UQ + I_KV + I_OUT + I_GU + I_DN;
    for (int it = gw; it < DEPTH * I_L; it += NGW) {
        const int l = it / I_L; int r = it - l * I_L;
        bf16* wl = (bf16*)(A.ws + WS_W) + (size_t)l * WLE_SIZE;
        if (r < I_IN) { const int kb = r / 155, nb = r - kb * 155; transpose_item(A.in[12] + (size_t)l * D * IN_W, D, IN_W, wl + WLE_IN, 64 * kb, 32 * nb, 32 * nb, scr, lane); continue; } r -= I_IN;
        if (r < I_UQ) { const int kb = r / 48, nb = r - kb * 48; transpose_item(A.in[15] + (size_t)l * 768 * 1536, 768, 1536, wl + WLE_UQ, 64 * kb, 32 * nb, 32 * nb, scr, lane); continue; } r -= I_UQ;
        if (r < I_KV) { const int kb = r / 64, nb = r - kb * 64; const int n0 = 32 * nb, hh = n0 >> 8, c = n0 & 255; const int dr = (c < 128 ? 0 : 1024) + hh * 128 + (c & 127);
                        transpose_item(A.in[17] + (size_t)l * 512 * 2048, 512, 2048, wl + WLE_KV, 64 * kb, n0, dr, scr, lane); continue; } r -= I_KV;
        if (r < I_OUT) { const int kb = r / 64, nb = r - kb * 64; transpose_item(A.in[13] + (size_t)l * D * D, D, D, wl + WLE_OUT, 64 * kb, 32 * nb, 32 * nb, scr, lane); continue; } r -= I_OUT;
        if (r < I_GU) { const int kb = r / 352, nb = r - kb * 352; const int n0 = 32 * nb; int dr; if (n0 < FF) dr = (n0 >> 7) * 256 + (n0 & 127); else { const int n1 = n0 - FF; dr = (n1 >> 7) * 256 + 128 + (n1 & 127); }
                        transpose_item(A.in[30] + (size_t)l * D * 2 * FF, D, 2 * FF, wl + WLE_GU, 64 * kb, n0, dr, scr, lane); continue; } r -= I_GU;
        { const int kb = r / 64, nb = r - kb * 64; transpose_item(A.in[31] + (size_t)l * FF * D, FF, D, wl + WLE_DN, 64 * kb, 32 * nb, 32 * nb, scr, lane); }
    }
    { const int gt = vcu * 512 + tid, NGT = G * 512;
      for (int i = gt; i < DEPTH * 40960; i += NGT) { const int l = i / 40960, r = i - l * 40960; *(GAS v4u*)((bf16*)(A.ws + WS_W) + (size_t)l * WLE_SIZE + WLE_IN + (size_t)IN_W * D + (size_t)r * 8) = (v4u){0u, 0u, 0u, 0u}; }
      const GAS f32x4* xp = (const GAS f32x4*)A.in[0]; const GAS f32x4* xs = (const GAS f32x4*)A.in[1]; GAS v2u* o = (GAS v2u*)(A.ws + WS_X);
      for (int i = gt; i < 4194304; i += NGT) { const f32x4 v = xp[i]; v2u w; w.x = pk2(v.x, v.y); w.y = pk2(v.z, v.w); o[i] = w; }
      for (int i = gt; i < 1048576; i += NGT) { const f32x4 v = xs[i]; v2u w; w.x = pk2(v.x, v.y); w.y = pk2(v.z, v.w); o[4194304 + i] = w; } }
    LAS float* scond = (LAS float*)(lds + 81920);
    LAS float* red = (LAS float*)(lds + 81920 + 24576);
    for (int i = tid; i < 3 * 2048; i += 512) { const int r = i >> 11, k = i & 2047; const float c = r == 0 ? A.in[7][k] : A.in[6][(r - 1) * 2048 + k]; scond[i] = silu(c); }
    __syncthreads();
    float* mods = (float*)(A.ws + WS_MODS);
    for (int item = vcu; item < 384; item += G) {
        const int l = item / 96, j0 = (item - l * 96) * 128;
        const float* w = A.in[10] + (size_t)l * 2048 * 12288 + j0 + 2 * lane;
        float a0x = 0, a0y = 0, a1x = 0, a1y = 0, a2x = 0, a2y = 0;
        const int kbeg = wave * 256;
#pragma unroll 8
        for (int k = kbeg; k < kbeg + 256; ++k) { const f32x2 v = *(const f32x2*)(w + (size_t)k * 12288); const float c0 = scond[k], c1 = scond[2048 + k], c2 = scond[4096 + k];
            a0x += c0 * v.x; a0y += c0 * v.y; a1x += c1 * v.x; a1y += c1 * v.y; a2x += c2 * v.x; a2y += c2 * v.y; }
        red[(wave * 3 + 0) * 128 + 2 * lane] = a0x; red[(wave * 3 + 0) * 128 + 2 * lane + 1] = a0y;
        red[(wave * 3 + 1) * 128 + 2 * lane] = a1x; red[(wave * 3 + 1) * 128 + 2 * lane + 1] = a1y;
        red[(wave * 3 + 2) * 128 + 2 * lane] = a2x; red[(wave * 3 + 2) * 128 + 2 * lane + 1] = a2y;
        __syncthreads();
        if (tid < 384) { const int r = tid >> 7, j = tid & 127; float s = 0.f;
#pragma unroll
            for (int w8 = 0; w8 < 8; ++w8) s += red[(w8 * 3 + r) * 128 + j];
            mods[(size_t)(l * 3 + r) * 12288 + j0 + j] = s + A.in[11][(size_t)l * 12288 + j0 + j]; }
        __syncthreads();
    }
}

__device__ __forceinline__ void ph_norm(bf16* X_, const float* g_, const float* mods_l_, int shift_idx, bf16* H_, const float* part_, const float* pgate_, int lane, int gw, int NGW) {
    GAS bf16* X = (GAS bf16*)X_; const GAS float* g = (const GAS float*)g_; const GAS float* mods_l = (const GAS float*)mods_l_; GAS bf16* H = (GAS bf16*)H_;
    const GAS bf16* part = (const GAS bf16*)part_; const GAS float* pgate = (const GAS float*)pgate_;
    constexpr size_t PS = (size_t)2048 * 2048;
    f32x4 ga[8], hb[8];
    { const GAS float* sh = mods_l + shift_idx * 2048; const GAS float* sc = sh + 2048;
#pragma unroll
      for (int j = 0; j < 8; ++j) { const int c = 4 * lane + 256 * j; ga[j] = *(const GAS f32x4*)(g + c) * (*(const GAS f32x4*)(sc + c) + 1.0f); hb[j] = *(const GAS f32x4*)(sh + c); } }
    for (int m0 = gw; m0 < M; m0 += 5 * NGW) {
        v2u raw[5][8];
#pragma unroll
        for (int k = 0; k < 5; ++k) { const int m = m0 + k * NGW; if (m < M) { const GAS v2u* xr = (const GAS v2u*)(X + (size_t)m * D) + lane;
#pragma unroll
            for (int j = 0; j < 8; ++j) raw[k][j] = xr[64 * j]; } }
        MEMBAR();
#pragma unroll
        for (int k = 0; k < 5; ++k) { const int m = m0 + k * NGW; if (m >= M) break;
            const int cr = m < NCTX ? 0 : 1 + ((m - NCTX) >> 10);
            f32x4 v[8]; float ss = 0.f;
#pragma unroll
            for (int j = 0; j < 8; ++j) v[j] = bf4(raw[k][j]);
            if (part_ != nullptr && m >= NCTX) {
                GAS v2u* xr = (GAS v2u*)(X + (size_t)m * D) + lane;
                const GAS v2u* pp = (const GAS v2u*)(part + (size_t)(m - NCTX) * 2048) + lane; const GAS f32x4* gp = (const GAS f32x4*)(pgate + (size_t)cr * 12288) + lane;
#pragma unroll
                for (int j = 0; j < 8; ++j) { const f32x4 p = (bf4(pp[64 * j]) + bf4(pp[PS / 4 + 64 * j])) + (bf4(pp[2 * (PS / 4) + 64 * j]) + bf4(pp[3 * (PS / 4) + 64 * j])); v[j] = v[j] + gp[64 * j] * p; v2u w; w.x = pk2(v[j].x, v[j].y); w.y = pk2(v[j].z, v[j].w); xr[64 * j] = w; } }
#pragma unroll
            for (int j = 0; j < 8; ++j) ss += (v[j].x * v[j].x + v[j].y * v[j].y) + (v[j].z * v[j].z + v[j].w * v[j].w);
            const float rstd = 1.0f / sqrtf(wave_sum(ss) * (1.0f / D) + EPS);
            if (cr == 0) {
#pragma unroll
                for (int j = 0; j < 8; ++j) { const int c = 4 * lane + 256 * j; const f32x4 o = v[j] * rstd * ga[j] + hb[j]; v2u w; w.x = pk2(o.x, o.y); w.y = pk2(o.z, o.w); *(GAS v2u*)(H + (size_t)m * D + c) = w; } }
            else { const GAS float* sh = mods_l + (size_t)cr * 12288 + shift_idx * 2048; const GAS float* sc = sh + 2048;
#pragma unroll
                for (int j = 0; j < 8; ++j) { const int c = 4 * lane + 256 * j; const f32x4 g4 = *(const GAS f32x4*)(g + c), s4 = *(const GAS f32x4*)(sc + c), h4 = *(const GAS f32x4*)(sh + c);
                    const f32x4 o = v[j] * rstd * g4 * (s4 + 1.0f) + h4; v2u w; w.x = pk2(o.x, o.y); w.y = pk2(o.z, o.w); *(GAS v2u*)(H + (size_t)m * D + c) = w; } }
        }
    }
}
__device__ __forceinline__ void ph_final(const bf16* X_, float* OUT_, const float* part_, const float* pgate_, int lane, int gw, int NGW) {
    const GAS bf16* X = (const GAS bf16*)X_; GAS float* OUT = (GAS float*)OUT_; const GAS bf16* part = (const GAS bf16*)part_; const GAS float* pgate = (const GAS float*)pgate_;
    constexpr size_t PS = (size_t)2048 * 2048;
    for (int m = NCTX + gw; m < M; m += NGW) {
        const int cr = 1 + ((m - NCTX) >> 10);
        const GAS v2u* xr = (const GAS v2u*)(X + (size_t)m * D) + lane; GAS f32x4* orow = (GAS f32x4*)(OUT + (size_t)m * D) + lane;
        const GAS v2u* pp = (const GAS v2u*)(part + (size_t)(m - NCTX) * 2048) + lane; const GAS f32x4* gp = (const GAS f32x4*)(pgate + (size_t)cr * 12288) + lane;
#pragma unroll
        for (int j = 0; j < 8; ++j) { const f32x4 p = (bf4(pp[64 * j]) + bf4(pp[PS / 4 + 64 * j])) + (bf4(pp[2 * (PS / 4) + 64 * j]) + bf4(pp[3 * (PS / 4) + 64 * j])); orow[64 * j] = bf4(xr[64 * j]) + gp[64 * j] * p; }
    }
}

__device__ __forceinline__ int seq_of(int m) { return (m < 0 || m >= M) ? -1 : (m < NCTX ? (m >> 8) : 32 + ((m - NCTX) >> 10)); }
__device__ __forceinline__ void ph_prep(const Ctx& A, int l, int lane, int gw, int NGW) {
    const GAS bf16* U = (const GAS bf16*)(A.ws + WS_U); const GAS float* USIDE = (const GAS float*)(A.ws + WS_USIDE);
    GAS bf16* CQN = (GAS bf16*)(A.ws + WS_CQN); GAS bf16* CKVN = (GAS bf16*)(A.ws + WS_CKVN);
    GAS bf16* GQ = (GAS bf16*)(A.ws + WS_GQ); GAS bf16* GK = GQ + (size_t)M * 512; GAS bf16* GV = GK + (size_t)M * 512;
    GAS float* GBETA = (GAS float*)(A.ws + WS_GBG); GAS float* GG = GBETA + (size_t)M * 8;
    GAS bf16* XBC = (GAS bf16*)(A.ws + WS_XBC); GAS float* SDT = (GAS float*)(A.ws + WS_SDT); GAS float* SDA = SDT + (size_t)M * 16;
    GAS float* OUT = (GAS float*)A.out;
    const GAS float* qn_g = (const GAS float*)(A.in[14] + l * 768); const GAS float* kvn_g = (const GAS float*)(A.in[16] + l * 512);
    const GAS float* gconv = (const GAS float*)(A.in[20] + (size_t)l * 5 * 1536); const GAS float* sconv = (const GAS float*)(A.in[24] + (size_t)l * 5 * 1024); const GAS float* sconvb = (const GAS float*)(A.in[25] + l * 1024);
    for (int run = gw; run < M / 5; run += NGW) {
        const int m0 = run * 5;
        int l4 = 4 * lane; asm volatile("" : "+v"(l4));
        { f32x4 vq[5][3], vk[5][2]; float kr[5];
#pragma unroll
          for (int r = 0; r < 5; ++r) { const GAS bf16* u = U + (size_t)(m0 + r) * IN_WP;
#pragma unroll
              for (int i = 0; i < 3; ++i) vq[r][i] = bf4(*(const GAS v2u*)(u + U_CQ + l4 + 256 * i));
#pragma unroll
              for (int i = 0; i < 2; ++i) vk[r][i] = bf4(*(const GAS v2u*)(u + U_CKV + l4 + 256 * i));
              kr[r] = bf1(u[U_KR + lane]); }
          float sq[5], sk[5];
#pragma unroll
          for (int r = 0; r < 5; ++r) { float a = 0.f, c = 0.f;
#pragma unroll
              for (int i = 0; i < 3; ++i) a += (vq[r][i].x * vq[r][i].x + vq[r][i].y * vq[r][i].y) + (vq[r][i].z * vq[r][i].z + vq[r][i].w * vq[r][i].w);
#pragma unroll
              for (int i = 0; i < 2; ++i) c += (vk[r][i].x * vk[r][i].x + vk[r][i].y * vk[r][i].y) + (vk[r][i].z * vk[r][i].z + vk[r][i].w * vk[r][i].w);
              sq[r] = a; sk[r] = c; }
#pragma unroll
          for (int o = 1; o < 64; o <<= 1) {
#pragma unroll
              for (int r = 0; r < 5; ++r) { sq[r] += __shfl_xor(sq[r], o); sk[r] += __shfl_xor(sk[r], o); } }
#pragma unroll
          for (int r = 0; r < 5; ++r) { const int m = m0 + r; const bool ctx = m < NCTX; const int b = m >> 8, t = m & 255;
              const float rq = 1.0f / sqrtf(sq[r] * (1.0f / 768.f) + EPS), rk = 1.0f / sqrtf(sk[r] * (1.0f / 512.f) + EPS);
#pragma unroll
              for (int i = 0; i < 3; ++i) { const int c = l4 + 256 * i; const f32x4 o = vq[r][i] * rq * *(const GAS f32x4*)(qn_g + c); v2u w; w.x = pk2(o.x, o.y); w.y = pk2(o.z, o.w); *(GAS v2u*)(CQN + (size_t)m * 768 + c) = w; }
#pragma unroll
              for (int i = 0; i < 2; ++i) { const int c = l4 + 256 * i; const f32x4 o = vk[r][i] * rk * *(const GAS f32x4*)(kvn_g + c); v2u w; w.x = pk2(o.x, o.y); w.y = pk2(o.z, o.w); *(GAS v2u*)(CKVN + (size_t)m * 512 + c) = w;
                  if (ctx) *(GAS f32x4*)(OUT + O_CKV + ((size_t)(b * 4 + l) * 256 + t) * 512 + c) = o; }
              if (ctx) OUT[O_KR + ((size_t)(b * 4 + l) * 256 + t) * 64 + lane] = kr[r]; } }
        MEMBAR();
        { float gb[5], ga[5], sd[5];
#pragma unroll
          for (int r = 0; r < 5; ++r) { const GAS float* us = USIDE + (size_t)(m0 + r) * 32; gb[r] = us[lane & 7]; ga[r] = us[8 + (lane & 7)]; sd[r] = us[16 + (lane & 15)]; }
          const float alog = expf(((const GAS float*)A.in[21])[l * 8 + (lane & 7)]), dtb = ((const GAS float*)A.in[22])[l * 8 + (lane & 7)];
          const float salog = expf(((const GAS float*)A.in[26])[l * 16 + (lane & 15)]), sdtb = ((const GAS float*)A.in[27])[l * 16 + (lane & 15)];
#pragma unroll
          for (int r = 0; r < 5; ++r) { const int m = m0 + r;
              if (lane < 8) { GBETA[(size_t)m * 8 + lane] = 1.0f / (1.0f + expf(-gb[r])); GG[(size_t)m * 8 + lane] = -alog * softplus(ga[r] + dtb); }
              if (lane < 16) { const float dt = softplus(sd[r] + sdtb); SDT[(size_t)m * 16 + lane] = dt; SDA[(size_t)m * 16 + lane] = -salog * dt; } } }
        MEMBAR();
        int sid[9];
#pragma unroll
        for (int jj = 0; jj < 9; ++jj) sid[jj] = seq_of(m0 - 2 + jj);
#pragma unroll
        for (int ci = 0; ci < 10; ++ci) {
            const int uoff = ci < 6 ? U_GQKV + 256 * ci : U_SXBC + 256 * (ci - 6);
            const GAS float* wp = ci < 6 ? gconv + 256 * ci : sconv + 256 * (ci - 6); const int wst = ci < 6 ? 1536 : 1024;
            f32x4 uw[9], w[5];
#pragma unroll
            for (int jj = 0; jj < 9; ++jj) { int mm = m0 - 2 + jj; mm = mm < 0 ? 0 : (mm >= M ? M - 1 : mm); uw[jj] = bf4(*(const GAS v2u*)(U + (size_t)mm * IN_WP + uoff + l4)); }
#pragma unroll
            for (int j = 0; j < 5; ++j) w[j] = *(const GAS f32x4*)(wp + j * wst + l4);
            f32x4 bias = (f32x4){0.f, 0.f, 0.f, 0.f}; if (ci >= 6) bias = *(const GAS f32x4*)(sconvb + 256 * (ci - 6) + l4);
#pragma unroll
            for (int r = 0; r < 5; ++r) { const int m = m0 + r; f32x4 acc = bias;
#pragma unroll
                for (int j = 0; j < 5; ++j) { const float mk = (sid[r + j] == sid[r + 2]) ? 1.0f : 0.0f; acc += (w[j] * mk) * uw[r + j]; }
                acc.x = silu(acc.x); acc.y = silu(acc.y); acc.z = silu(acc.z); acc.w = silu(acc.w);
                if (ci < 4) { const float ss = half_sum((acc.x * acc.x + acc.y * acc.y) + (acc.z * acc.z + acc.w * acc.w)); acc = acc * __builtin_amdgcn_rsqf(ss + EPS); }
                if (ci < 6) { GAS bf16* dst = ci < 2 ? GQ + (size_t)m * 512 + 256 * ci : (ci < 4 ? GK + (size_t)m * 512 + 256 * (ci - 2) : GV + (size_t)m * 512 + 256 * (ci - 4));
                    v2u w; w.x = pk2(acc.x, acc.y); w.y = pk2(acc.z, acc.w); *(GAS v2u*)(dst + l4) = w; }
                else { v2u w; w.x = pk2(acc.x, acc.y); w.y = pk2(acc.z, acc.w); *(GAS v2u*)(XBC + (size_t)m * 1024 + 256 * (ci - 6) + l4) = w; } }
            if (ci & 1) MEMBAR();
        }
    }
    for (int m = M + gw; m < MK; m += NGW) {
        const int j = m - M, b = j >> 8, t = j & 255; const GAS float* src = (const GAS float*)(A.in[2] + ((size_t)(b * 4 + l) * 256 + t) * 512);
#pragma unroll
        for (int i = 0; i < 2; ++i) { const int c = 4 * lane + 256 * i; const f32x4 v = *(const GAS f32x4*)(src + c); v2u w; w.x = pk2(v.x, v.y); w.y = pk2(v.z, v.w); *(GAS v2u*)(CKVN + (size_t)m * 512 + c) = w; }
    }
}

constexpr int FIN_TAB = 150000;
__device__ __forceinline__ void ph_finalize(const Ctx& A, int l, LAS unsigned char* lds, int tid, int lane, int gw, int NGW) {
    const GAS bf16* U = (const GAS bf16*)(A.ws + WS_U); const GAS bf16* QRAW = (const GAS bf16*)(A.ws + WS_QRAW); const GAS bf16* KN = (const GAS bf16*)(A.ws + WS_KN);
    GAS bf16* QB = (GAS bf16*)(A.ws + WS_QB); GAS bf16* KB = (GAS bf16*)(A.ws + WS_KB);
    const GAS float* q_g = (const GAS float*)(A.in[18] + l * 192); const GAS float* k_g = (const GAS float*)(A.in[19] + l * 192);
    const float QS = 0.07216878364870322f * 1.4426950408889634f;
    LAS float* tcos = (LAS float*)(lds + FIN_TAB); LAS float* tsin = tcos + 1024;
    for (int i = tid; i < 1024; i += NWAVES * 64) { const float ang = (float)(i >> 4) * powf(10000.f, -(float)(i & 15) * (1.0f / 16.f)); tcos[i] = cosf(ang); tsin[i] = sinf(ang); }
    __syncthreads();
    const int h = lane >> 3, sub = lane & 7;
    float qg[24], kg[24];
#pragma unroll
    for (int i = 0; i < 3; ++i)
#pragma unroll
        for (int j = 0; j < 8; ++j) { qg[i * 8 + j] = q_g[(sub + 8 * i) * 8 + j] * QS; kg[i * 8 + j] = k_g[(sub + 8 * i) * 8 + j]; }
    const bool hi = (sub >> 1) & 1;
    for (int m = gw; m < MK; m += NGW) {
        int s8 = sub * 8; asm volatile("" : "+v"(s8));
        const bool fresh = m < M, latent = fresh && m >= NCTX;
        float cs[8], sn[8];
        if (latent) { const int t = (m - NCTX) & 1023, pos = (sub >> 2) ? (t & 63) : (t >> 6); const LAS float* pc = tcos + pos * 16 + (sub & 1) * 8; const LAS float* ps = tsin + pos * 16 + (sub & 1) * 8;
            const f32x4 c0 = *(const LAS f32x4*)pc, c1 = *(const LAS f32x4*)(pc + 4), s0 = *(const LAS f32x4*)ps, s1 = *(const LAS f32x4*)(ps + 4);
            cs[0] = c0.x; cs[1] = c0.y; cs[2] = c0.z; cs[3] = c0.w; cs[4] = c1.x; cs[5] = c1.y; cs[6] = c1.z; cs[7] = c1.w; sn[0] = s0.x; sn[1] = s0.y; sn[2] = s0.z; sn[3] = s0.w; sn[4] = s1.x; sn[5] = s1.y; sn[6] = s1.z; sn[7] = s1.w; }
        else {
#pragma unroll
            for (int j = 0; j < 8; ++j) { cs[j] = 1.f; sn[j] = 0.f; } }
        const v4u kn0 = *(const GAS v4u*)(KN + (size_t)m * 1024 + h * 128 + s8), kn1 = *(const GAS v4u*)(KN + (size_t)m * 1024 + h * 128 + 64 + s8);
        float kr[8];
        if (fresh) { const v4u w = *(const GAS v4u*)(U + (size_t)m * IN_WP + U_KR + s8); const f32x4 a = bf4((v2u){w.x, w.y}), b = bf4((v2u){w.z, w.w}); kr[0] = a.x; kr[1] = a.y; kr[2] = a.z; kr[3] = a.w; kr[4] = b.x; kr[5] = b.y; kr[6] = b.z; kr[7] = b.w; }
        else { const GAS float* cp = (const GAS float*)(A.in[3] + ((size_t)(((m - M) >> 8) * 4 + l) * 256 + ((m - M) & 255)) * 64) + s8; const f32x4 a = *(const GAS f32x4*)cp, b = *(const GAS f32x4*)(cp + 4);
            kr[0] = a.x; kr[1] = a.y; kr[2] = a.z; kr[3] = a.w; kr[4] = b.x; kr[5] = b.y; kr[6] = b.z; kr[7] = b.w; }
        v4u qp[3];
        if (fresh) {
#pragma unroll
            for (int i = 0; i < 3; ++i) qp[i] = *(const GAS v4u*)(QRAW + (size_t)m * 1536 + h * 192 + 64 * i + s8); }
        { float x[24];
          { const f32x4 a = bf4((v2u){kn0.x, kn0.y}), b = bf4((v2u){kn0.z, kn0.w}), c = bf4((v2u){kn1.x, kn1.y}), d = bf4((v2u){kn1.z, kn1.w});
            x[0] = a.x; x[1] = a.y; x[2] = a.z; x[3] = a.w; x[4] = b.x; x[5] = b.y; x[6] = b.z; x[7] = b.w; x[8] = c.x; x[9] = c.y; x[10] = c.z; x[11] = c.w; x[12] = d.x; x[13] = d.y; x[14] = d.z; x[15] = d.w; }
#pragma unroll
          for (int j = 0; j < 8; ++j) x[16 + j] = kr[j];
          float ss = 0.f;
#pragma unroll
          for (int j = 0; j < 24; ++j) ss += x[j] * x[j];
          ss += __shfl_xor(ss, 1); ss += __shfl_xor(ss, 2); ss += __shfl_xor(ss, 4);
          const float rstd = 1.0f / sqrtf(ss * (1.0f / 192.f) + EPS);
#pragma unroll
          for (int j = 0; j < 24; ++j) x[j] *= rstd * kg[j];
#pragma unroll
          for (int j = 0; j < 8; ++j) { const float p = __shfl_xor(x[16 + j], 2); x[16 + j] = hi ? x[16 + j] * cs[j] + p * sn[j] : x[16 + j] * cs[j] - p * sn[j]; }
          GAS bf16* dst = KB + (size_t)m * 1536 + h * 192 + s8;
#pragma unroll
          for (int i = 0; i < 3; ++i) { v4u w; w.x = pk2(x[8 * i], x[8 * i + 1]); w.y = pk2(x[8 * i + 2], x[8 * i + 3]); w.z = pk2(x[8 * i + 4], x[8 * i + 5]); w.w = pk2(x[8 * i + 6], x[8 * i + 7]); *(GAS v4u*)(dst + 64 * i) = w; } }
        if (fresh) { float x[24];
#pragma unroll
          for (int i = 0; i < 3; ++i) { const f32x4 a = bf4((v2u){qp[i].x, qp[i].y}), b = bf4((v2u){qp[i].z, qp[i].w}); x[8 * i] = a.x; x[8 * i + 1] = a.y; x[8 * i + 2] = a.z; x[8 * i + 3] = a.w; x[8 * i + 4] = b.x; x[8 * i + 5] = b.y; x[8 * i + 6] = b.z; x[8 * i + 7] = b.w; }
          float ss = 0.f;
#pragma unroll
          for (int j = 0; j < 24; ++j) ss += x[j] * x[j];
          ss += __shfl_xor(ss, 1); ss += __shfl_xor(ss, 2); ss += __shfl_xor(ss, 4);
          const float rstd = 1.0f / sqrtf(ss * (1.0f / 192.f) + EPS);
#pragma unroll
          for (int j = 0; j < 24; ++j) x[j] *= rstd * qg[j];
#pragma unroll
          for (int j = 0; j < 8; ++j) { const float p = __shfl_xor(x[16 + j], 2); x[16 + j] = hi ? x[16 + j] * cs[j] + p * sn[j] : x[16 + j] * cs[j] - p * sn[j]; }
          GAS bf16* dst = QB + (size_t)m * 1536 + h * 192 + s8;
#pragma unroll
          for (int i = 0; i < 3; ++i) { v4u w; w.x = pk2(x[8 * i], x[8 * i + 1]); w.y = pk2(x[8 * i + 2], x[8 * i + 3]); w.z = pk2(x[8 * i + 4], x[8 * i + 5]); w.w = pk2(x[8 * i + 6], x[8 * i + 7]); *(GAS v4u*)(dst + 64 * i) = w; } }
    }
}

constexpr int AT_KROW = 400, AT_KBYTES = 64 * AT_KROW, AT_VROW = 144, AT_VBYTES = 128 * AT_VROW, AT_BUF = AT_KBYTES + AT_VBYTES;
__device__ __forceinline__ void attn_wg_item(const bf16* QB_, const bf16* KB_, const bf16* VT_, bf16* MIX_, float cmax, int qrow0, int h, int mkA, int nA, int mkB, int nB, LAS unsigned char* lds, int tid, int lane, int wave, unsigned long long* tprobe_ts = nullptr, int tprobe_l = 0) {
    const GAS bf16* QB = (const GAS bf16*)QB_; const GAS bf16* KB = (const GAS bf16*)KB_; const GAS bf16* VT = (const GAS bf16*)VT_; GAS bf16* MIX = (GAS bf16*)MIX_;
    const int fr = lane & 15, fq = lane >> 4;
    LAS unsigned char* plds = lds + 2 * AT_BUF + wave * 2304;
    const int qr = qrow0 + wave * 16;
    bf16x8 qf[6];
#pragma unroll
    for (int d = 0; d < 6; ++d) qf[d] = *(const GAS bf16x8*)(QB + ((size_t)(qr + fr) * 8 + h) * 192 + d * 32 + fq * 8);
    f32x4 o[8];
#pragma unroll
    for (int i = 0; i < 8; ++i) o[i] = (f32x4){0.f, 0.f, 0.f, 0.f};
    float lrow[4] = {0.f, 0.f, 0.f, 0.f};
    const int ntA = nA >> 6, nt = (nA + nB) >> 6;
    int kr_[3], kc_[3];
#pragma unroll
    for (int j = 0; j < 3; ++j) { const int id = tid + 512 * j; kr_[j] = id / 24; kc_[j] = id - kr_[j] * 24; }
    const int vr = tid >> 3, vc = tid & 7;
    v4u sk[3], sv[2];
#define AT_LOAD(mk_) do { _Pragma("unroll") for (int j_ = 0; j_ < 3; ++j_) sk[j_] = *(const GAS v4u*)(KB + ((size_t)((mk_) + kr_[j_]) * 8 + h) * 192 + kc_[j_] * 8); \
        _Pragma("unroll") for (int j_ = 0; j_ < 2; ++j_) sv[j_] = *(const GAS v4u*)(VT + (size_t)(h * 128 + vr + 64 * j_) * MK + (mk_) + vc * 8); } while (0)
#define AT_STORE(buf_) do { LAS unsigned char* bb_ = lds + (buf_) * AT_BUF; _Pragma("unroll") for (int j_ = 0; j_ < 3; ++j_) *(LAS v4u*)(bb_ + kr_[j_] * AT_KROW + kc_[j_] * 16) = sk[j_]; \
        _Pragma("unroll") for (int j_ = 0; j_ < 2; ++j_) *(LAS v4u*)(bb_ + AT_KBYTES + (vr + 64 * j_) * AT_VROW + vc * 16) = sv[j_]; } while (0)
    __syncthreads();
    AT_LOAD(mkA); AT_STORE(0);
    __syncthreads();
#ifdef TPROBE
    unsigned long long tp_a = 0, tp_b = 0, tp_c = 0; const unsigned long long tp_s = __builtin_amdgcn_s_memrealtime();
#endif
#pragma unroll 1
    for (int ti = 0; ti < nt; ++ti) {
#ifdef TPROBE
        const unsigned long long tp_0 = __builtin_amdgcn_s_memrealtime();
#endif
        const int cur = ti & 1;
        if (ti + 1 < nt) { const int mkn = (ti + 1 < ntA) ? mkA + (ti + 1) * 64 : mkB + (ti + 1 - ntA) * 64; AT_LOAD(mkn); }
        MEMBAR();
        const LAS unsigned char* kb_ = lds + cur * AT_BUF; const LAS unsigned char* vb_ = kb_ + AT_KBYTES;
        f32x4 s[4];
#pragma unroll
        for (int kh = 0; kh < 2; ++kh) { bf16x8 kf[12];
#pragma unroll
          for (int k2 = 0; k2 < 2; ++k2)
#pragma unroll
              for (int d = 0; d < 6; ++d) kf[k2 * 6 + d] = *(const LAS bf16x8*)(kb_ + (16 * (2 * kh + k2) + fr) * AT_KROW + d * 64 + fq * 16);
          MEMBAR();
#pragma unroll
          for (int k2 = 0; k2 < 2; ++k2) { const int kb = 2 * kh + k2; s[kb] = (f32x4){0.f, 0.f, 0.f, 0.f};
#pragma unroll
              for (int d = 0; d < 6; ++d) s[kb] = __builtin_amdgcn_mfma_f32_16x16x32_bf16(qf[d], kf[k2 * 6 + d], s[kb], 0, 0, 0); } }
        bf16x8 vf[16];
#pragma unroll
        for (int i = 0; i < 8; ++i) { vf[2 * i] = *(const LAS bf16x8*)(vb_ + (i * 16 + fr) * AT_VROW + fq * 16); vf[2 * i + 1] = *(const LAS bf16x8*)(vb_ + (i * 16 + fr) * AT_VROW + 64 + fq * 16); }
        MEMBAR();
#pragma unroll
        for (int kb = 0; kb < 4; ++kb)
#pragma unroll
            for (int r = 0; r < 4; ++r) { const float p = exp2f(s[kb][r] - cmax); lrow[r] += p; *(LAS bf16*)(plds + (4 * fq + r) * 144 + (16 * kb + fr) * 2) = (bf16)f2bf(p); }
        asm volatile("s_waitcnt lgkmcnt(0)" ::: "memory");
        const bf16x8 pf0 = *(const LAS bf16x8*)(plds + fr * 144 + fq * 16), pf1 = *(const LAS bf16x8*)(plds + fr * 144 + 64 + fq * 16);
#pragma unroll
        for (int i = 0; i < 8; ++i) { o[i] = __builtin_amdgcn_mfma_f32_16x16x32_bf16(pf0, vf[2 * i], o[i], 0, 0, 0); o[i] = __builtin_amdgcn_mfma_f32_16x16x32_bf16(pf1, vf[2 * i + 1], o[i], 0, 0, 0); }
#ifdef TPROBE
        const unsigned long long tp_1 = __builtin_amdgcn_s_memrealtime();
#endif
        if (ti + 1 < nt) AT_STORE(cur ^ 1);
#ifdef TPROBE
        const unsigned long long tp_2 = __builtin_amdgcn_s_memrealtime();
#endif
        WG_BAR();
#ifdef TPROBE
        { const unsigned long long tp_3 = __builtin_amdgcn_s_memrealtime(); tp_a += tp_1 - tp_0; tp_b += tp_2 - tp_1; tp_c += tp_3 - tp_2; }
#endif
    }
#ifdef TPROBE
    if (qrow0 == NCTX && h == 0 && wave == 0 && lane == 0 && tprobe_ts) { tprobe_ts[32 + 6 * 4 + tprobe_l] += tp_a; tprobe_ts[32 + 7 * 4 + tprobe_l] += tp_b; tprobe_ts[32 + 8 * 4 + tprobe_l] += tp_c; tprobe_ts[32 + 9 * 4 + tprobe_l] += __builtin_amdgcn_s_memrealtime() - tp_s; }
#endif
#undef AT_LOAD
#undef AT_STORE
#pragma unroll
    for (int r = 0; r < 4; ++r) { float lt = lrow[r]; lt += __shfl_xor(lt, 1); lt += __shfl_xor(lt, 2); lt += __shfl_xor(lt, 4); lt += __shfl_xor(lt, 8);
        const float inv = 1.0f / lt; GAS bf16* dst = MIX + (size_t)(qr + 4 * fq + r) * D + h * 128 + fr;
#pragma unroll
        for (int i = 0; i < 8; ++i) dst[i * 16] = (bf16)f2bf(o[i][r] * inv); }
}
__device__ __forceinline__ void ph_attn(const Ctx& A, int l, LAS unsigned char* lds, int tid, int lane, int wave, int vcu, int G) {
    const bf16* QB = (const bf16*)(A.ws + WS_QB); const bf16* KB = (const bf16*)(A.ws + WS_KB); const bf16* VT = (const bf16*)(A.ws + WS_VT); bf16* MIX = (bf16*)(A.ws + WS_MIX);
    float cmax; { const GAS float* qg = (const GAS float*)(A.in[18] + l * 192); const GAS float* kg = (const GAS float*)(A.in[19] + l * 192);
        float mq = fmaxf(fmaxf(fabsf(qg[lane]), fabsf(qg[64 + lane])), fabsf(qg[128 + lane])), mk = fmaxf(fmaxf(fabsf(kg[lane]), fabsf(kg[64 + lane])), fabsf(kg[128 + lane]));
#pragma unroll
        for (int o = 1; o < 64; o <<= 1) { mq = fmaxf(mq, __shfl_xor(mq, o)); mk = fmaxf(mk, __shfl_xor(mk, o)); }
        cmax = mq * mk * 192.0f * (0.07216878364870322f * 1.4426950408889634f); }
    for (int k = 0; k < 640; ++k) {
        int q;
        if (G == 256) { if (vcu >= 208) q = -1; else if (vcu < 128) q = k == 0 ? vcu : (k == 1 ? 128 + vcu : -1); else { q = 256 + (vcu - 128) + 80 * k; if (q >= 640) q = -1; } }
        else { q = vcu + k * G; if (q >= 640) q = -1; }
        if (q < 0) break;
        if (q < 128) { const int b = q >> 6, h = (q >> 3) & 7, qb = q & 7; attn_wg_item(QB, KB, VT, MIX, cmax, NCTX + b * 1024 + qb * 128, h, M + b * 256, 256, NCTX + b * 1024, 1024, lds, tid, lane, wave); }
        else { const int wgi = q - 128, b = wgi >> 4, h = (wgi >> 1) & 7, qb = wgi & 1; attn_wg_item(QB, KB, VT, MIX, cmax, b * 256 + qb * 128, h, b * 256, 256, 0, 0, lds, tid, lane, wave); }
    }
}

__device__ __forceinline__ void ph_post(const Ctx& A, int l, int lane, int gw, int NGW) {
    const GAS bf16* U = (const GAS bf16*)(A.ws + WS_U); const GAS float* GO = (const GAS float*)(A.ws + WS_GO); const GAS float* SY = (const GAS float*)(A.ws + WS_SY); const GAS bf16* XBC = (const GAS bf16*)(A.ws + WS_XBC);
    GAS bf16* MIX = (GAS bf16*)(A.ws + WS_MIX);
    const GAS float* gng = (const GAS float*)(A.in[23] + l * 128); const GAS float* sd = (const GAS float*)(A.in[28] + l * 8); const GAS float* sng = (const GAS float*)(A.in[29] + l * 512);
    f32x4 g4[2], s4[2]; float sdv[2];
#pragma unroll
    for (int i = 0; i < 2; ++i) { const int c = 4 * lane + 256 * i; g4[i] = *(const GAS f32x4*)(gng + (c & 127)); s4[i] = *(const GAS f32x4*)(sng + c); sdv[i] = sd[c >> 6]; }
    for (int m = gw; m < M; m += NGW) {
        int l4 = 4 * lane; asm volatile("" : "+v"(l4));
        const GAS bf16* u = U + (size_t)m * IN_WP;
        f32x4 of[2], ob[2], yf[2], yb[2]; v2u zg[2], zs[2], xx[2];
#pragma unroll
        for (int i = 0; i < 2; ++i) { const int c = l4 + 256 * i;
            of[i] = *(const GAS f32x4*)(GO + (size_t)m * 512 + c); ob[i] = *(const GAS f32x4*)(GO + ((size_t)M + m) * 512 + c);
            yf[i] = *(const GAS f32x4*)(SY + (size_t)m * 512 + c); yb[i] = *(const GAS f32x4*)(SY + ((size_t)M + m) * 512 + c);
            zg[i] = *(const GAS v2u*)(u + U_GZ + c); zs[i] = *(const GAS v2u*)(u + U_SZ + c); xx[i] = *(const GAS v2u*)(XBC + (size_t)m * 1024 + c); }
#pragma unroll
        for (int i = 0; i < 2; ++i) { const int c = l4 + 256 * i;
            f32x4 o = of[i] + ob[i];
            const float ss = half_sum((o.x * o.x + o.y * o.y) + (o.z * o.z + o.w * o.w)); const float rstd = 1.0f / sqrtf(ss * (1.0f / 128.f) + EPS);
            const f32x4 z = bf4(zg[i]);
            o = o * rstd * g4[i]; o.x *= silu(z.x); o.y *= silu(z.y); o.z *= silu(z.z); o.w *= silu(z.w);
            v2u w; w.x = pk2(o.x, o.y); w.y = pk2(o.z, o.w); *(GAS v2u*)(MIX + (size_t)m * D + 1024 + c) = w; }
#pragma unroll
        for (int i = 0; i < 2; ++i) { const int c = l4 + 256 * i;
            f32x4 y = yf[i] + yb[i] + bf4(xx[i]) * sdv[i];
            const f32x4 z = bf4(zs[i]);
            y.x *= silu(z.x); y.y *= silu(z.y); y.z *= silu(z.z); y.w *= silu(z.w);
            const float ss = wave_sum((y.x * y.x + y.y * y.y) + (y.z * y.z + y.w * y.w)); const float rstd = 1.0f / sqrtf(ss * (1.0f / 256.f) + EPS);
            y = y * rstd * s4[i];
            v2u w; w.x = pk2(y.x, y.y); w.y = pk2(y.z, y.w); *(GAS v2u*)(MIX + (size_t)m * D + 1536 + c) = w; }
    }
}

constexpr size_t GCH_W = 0, GCH_QG = 16384, GCH_KD = 32768, GCH_QK = 49152, GCH_UT = 57344, GCH_DEC = 90112, GCH_BYTES = 90368;
constexpr int NGCH = 160;
constexpr int GL_K = 0, GL_Q = 17408, GL_V = 34816, GL_KK = 52224, GL_QK = 52224 + 16640, GL_AF = 85504, GL_AB = 85504 + 16384, GL_TAB = 118272;
template <int DIR>
__device__ __forceinline__ void gdn_solve(GAS unsigned char* GCH, const LAS bf16* kb16, const LAS bf16* qb16, const LAS bf16* vb16, const LAS float* Ad, const LAS float* gcd, const LAS float* bd, int gch, int h, int wave, int lane) {
    typedef float f32x2v __attribute__((ext_vector_type(2)));
    const int c = (wave & 3) * 64 + lane, cc = c & 127; const bool isw = c < 128;
    GAS unsigned char* rec = GCH + ((size_t)(DIR * NGCH + gch) * 4 + h) * GCH_BYTES;
    { int z = 0; asm volatile("" : "+v"(z)); Ad += z; gcd += z; bd += z; }
    const LAS bf16* src = (isw ? kb16 : vb16) + cc;
    f32x2v x2[32];
    float raw[64];
#pragma unroll
    for (int i = 0; i < 64; ++i) { const int p = DIR ? 63 - i : i; raw[i] = bf1(src[p * 136]); }
#pragma unroll
    for (int i = 0; i < 64; ++i) { const int p = DIR ? 63 - i : i; const float f = isw ? bd[p] * __expf(gcd[p]) : bd[p]; x2[i >> 1][i & 1] = raw[i] * f; }
#pragma unroll
    for (int i = 1; i < 64; ++i) {
        f32x4 ac[16];
#pragma unroll
        for (int j = 0; j < (i + 3) / 4; ++j) ac[j] = *(const LAS f32x4*)(Ad + i * 64 + 4 * j);
        MEMBAR();
        f32x2v s01 = (f32x2v){0.f, 0.f}, s23 = (f32x2v){0.f, 0.f};
#pragma unroll
        for (int j = 0; j < i; j += 4) { f32x4 a4 = ac[j >> 2];
            if (j + 1 >= i) a4.y = 0.f; if (j + 2 >= i) a4.z = 0.f; if (j + 3 >= i) a4.w = 0.f;
            s01 -= (f32x2v){a4.x, a4.y} * x2[j >> 1]; s23 -= (f32x2v){a4.z, a4.w} * x2[(j >> 1) + 1]; }
        x2[i >> 1][i & 1] += (s01.x + s01.y) + (s23.x + s23.y); MEMBAR(); }
    if (isw) { GAS bf16* wdst = (GAS bf16*)(rec + GCH_W) + cc;
#pragma unroll
        for (int i = 0; i < 64; ++i) wdst[i * 128] = (bf16)f2bf(x2[i >> 1][i & 1]);
        const float gl = gcd[DIR ? 0 : 63]; GAS bf16* kd = (GAS bf16*)(rec + GCH_KD) + cc * 64;
#pragma unroll
        for (int i = 0; i < 64; i += 8) { float v[8];
#pragma unroll
            for (int u = 0; u < 8; ++u) { const int p = DIR ? 63 - (i + u) : i + u; v[u] = raw[i + u] * __expf(gl - gcd[p]); }
            v4u w; w.x = pk2(v[0], v[1]); w.y = pk2(v[2], v[3]); w.z = pk2(v[4], v[5]); w.w = pk2(v[6], v[7]); *(GAS v4u*)(kd + i) = w; }
        if (cc == 0) *(GAS float*)(rec + GCH_DEC) = __expf(gl); }
    else { GAS float* ut = (GAS float*)(rec + GCH_UT) + cc * 64;
#pragma unroll
        for (int i = 0; i < 64; i += 4) *(GAS f32x4*)(ut + i) = (f32x4){x2[i >> 1][0], x2[i >> 1][1], x2[(i >> 1) + 1][0], x2[(i >> 1) + 1][1]};
        const LAS bf16* qsrc = qb16 + cc; GAS bf16* qg = (GAS bf16*)(rec + GCH_QG) + cc;
#pragma unroll
        for (int i = 0; i < 64; ++i) { const int p = DIR ? 63 - i : i; raw[i] = bf1(qsrc[p * 136]); }
#pragma unroll
        for (int i = 0; i < 64; ++i) { const int p = DIR ? 63 - i : i; qg[i * 128] = (bf16)f2bf(raw[i] * 0.08838834764831845f * __expf(gcd[p])); } }
}
__device__ __forceinline__ void ph_gdn_local(const Ctx& A, int l, LAS unsigned char* lds, int tid, int lane, int wave, int vcu, int G) {
    const GAS bf16* GQ = (const GAS bf16*)(A.ws + WS_GQ); const GAS bf16* GK = GQ + (size_t)M * 512; const GAS bf16* GV = GK + (size_t)M * 512;
    const GAS float* GBETA = (const GAS float*)(A.ws + WS_GBG); const GAS float* GG = GBETA + (size_t)M * 8;
    GAS unsigned char* GCH = (GAS unsigned char*)(A.ws + WS_GCH);
    LAS bf16* kb16 = (LAS bf16*)(lds + GL_K); LAS bf16* qb16 = (LAS bf16*)(lds + GL_Q); LAS bf16* vb16 = (LAS bf16*)(lds + GL_V);
    LAS float* KK = (LAS float*)(lds + GL_KK); LAS float* QK = (LAS float*)(lds + GL_QK);
    LAS float* Af = (LAS float*)(lds + GL_AF); LAS float* Ab = (LAS float*)(lds + GL_AB);
    LAS float* sgcf = (LAS float*)(lds + GL_TAB); LAS float* sgcb = sgcf + 64; LAS float* sbf = sgcf + 128; LAS float* sbb = sgcf + 192;
    const int fr = lane & 15, fq = lane >> 4;
    for (int rd = 0; rd * G + vcu < 2 * NGCH * 4; ++rd) {
        if ((rd + vcu) & 1) continue;
        const int it = (rd * G + vcu) >> 1;
        const int gch = it >> 2, h = it & 3, row0 = gch * 64;
        {
#pragma unroll
          for (int j = 0; j < 2; ++j) { const int id = tid + 512 * j, r = id >> 4, c8 = (id & 15) * 8; const size_t go = (size_t)(row0 + r) * 512 + h * 128 + c8;
              *(LAS v4u*)(kb16 + r * 136 + c8) = *(const GAS v4u*)(GK + go); *(LAS v4u*)(qb16 + r * 136 + c8) = *(const GAS v4u*)(GQ + go); *(LAS v4u*)(vb16 + r * 136 + c8) = *(const GAS v4u*)(GV + go); } }
        if (wave == 0) { const float gf = GG[(size_t)(row0 + lane) * 8 + h], gb = GG[(size_t)(row0 + lane) * 8 + 4 + h];
            float pf = gf, pb = gb;
#pragma unroll
            for (int o = 1; o < 64; o <<= 1) { const float tf = __shfl_up(pf, o), tb = __shfl_up(pb, o); if (lane >= o) { pf += tf; pb += tb; } }
            const float totb = __shfl(pb, 63);
            sgcf[lane] = pf; sgcb[lane] = totb - pb + gb;
            sbf[lane] = GBETA[(size_t)(row0 + lane) * 8 + h]; sbb[lane] = GBETA[(size_t)(row0 + lane) * 8 + 4 + h]; }
        __syncthreads();
        { const int tr = wave & 3; const LAS bf16* Aimg = (wave >> 2) ? qb16 : kb16; LAS float* Out = (wave >> 2) ? QK : KK;
          bf16x8 af[4], bfr[16];
#pragma unroll
          for (int ks = 0; ks < 4; ++ks) af[ks] = *(const LAS bf16x8*)(Aimg + (16 * tr + fr) * 136 + ks * 32 + fq * 8);
#pragma unroll
          for (int tc = 0; tc < 4; ++tc)
#pragma unroll
              for (int ks = 0; ks < 4; ++ks) bfr[tc * 4 + ks] = *(const LAS bf16x8*)(kb16 + (16 * tc + fr) * 136 + ks * 32 + fq * 8);
          MEMBAR();
#pragma unroll
          for (int tc = 0; tc < 4; ++tc) { f32x4 acc = (f32x4){0.f, 0.f, 0.f, 0.f};
#pragma unroll
              for (int ks = 0; ks < 4; ++ks) acc = __builtin_amdgcn_mfma_f32_16x16x32_bf16(af[ks], bfr[tc * 4 + ks], acc, 0, 0, 0);
#pragma unroll
              for (int r = 0; r < 4; ++r) Out[(16 * tr + 4 * fq + r) * 65 + 16 * tc + fr] = acc[r]; } }
        __syncthreads();
        { GAS unsigned char* recf = GCH + ((size_t)(0 * NGCH + gch) * 4 + h) * GCH_BYTES; GAS unsigned char* recb = GCH + ((size_t)(1 * NGCH + gch) * 4 + h) * GCH_BYTES;
#pragma unroll 2
          for (int e = 0; e < 8; ++e) { const int idx = tid + 512 * e, i = idx >> 6, j = idx & 63, pi = 63 - i, pj = 63 - j;
              const float kkf = KK[i * 65 + j], qkf = QK[i * 65 + j], kkb = KK[pi * 65 + pj], qkb = QK[pi * 65 + pj];
              const float df = __expf(sgcf[i] - sgcf[j]), db = __expf(sgcb[pi] - sgcb[pj]);
              Af[idx] = (j < i) ? sbf[i] * kkf * df : 0.f; Ab[idx] = (j < i) ? sbb[pi] * kkb * db : 0.f;
              ((GAS bf16*)(recf + GCH_QK))[idx] = (bf16)f2bf((j <= i) ? qkf * 0.08838834764831845f * df : 0.f);
              ((GAS bf16*)(recb + GCH_QK))[idx] = (bf16)f2bf((j <= i) ? qkb * 0.08838834764831845f * db : 0.f); } }
        __syncthreads();
        if (wave < 4) gdn_solve<0>(GCH, kb16, qb16, vb16, Af, sgcf, sbf, gch, h, wave, lane);
        else gdn_solve<1>(GCH, kb16, qb16, vb16, Ab, sgcb, sbb, gch, h, wave, lane);
        __syncthreads();
    }
}

constexpr int GS_W = 0, GS_QG = 17408, GS_KD = 34816, GS_QK = 53248, GS_IMG = 62464;
__device__ __forceinline__ void gdn_seq_wg(const Ctx& A, int l, int b, int lat, int h, int dir, LAS unsigned char* lds, int tid, int lane, int wave) {
    const GAS unsigned char* GCH = (const GAS unsigned char*)(A.ws + WS_GCH); GAS float* GO = (GAS float*)(A.ws + WS_GO);
    const int fr = lane & 15, fq = lane >> 4, dvs = wave;
    const int nch = lat ? 16 : 4, ch0 = lat ? 128 + b * 16 : b * 4;
    LAS bf16* simg = (LAS bf16*)(lds + GS_IMG + wave * 4352);
    const LAS bf16* sW = (const LAS bf16*)(lds + GS_W); const LAS bf16* sQG = (const LAS bf16*)(lds + GS_QG); const LAS bf16* sKD = (const LAS bf16*)(lds + GS_KD); const LAS bf16* sQK = (const LAS bf16*)(lds + GS_QK);
    f32x4 S[8];
    const size_t sidx = ((size_t)(((b * 4 + l) * 2 + dir) * 4 + h) * 128) * 128 + dvs * 16 + fr;
    if (lat) {
#pragma unroll
        for (int u = 0; u < 8; ++u)
#pragma unroll
            for (int r = 0; r < 4; ++r) S[u][r] = *(const GAS float*)(A.in[4] + sidx + (size_t)(16 * u + 4 * fq + r) * 128); }
    else {
#pragma unroll
        for (int u = 0; u < 8; ++u) S[u] = (f32x4){0.f, 0.f, 0.f, 0.f}; }
#define GREC(cc_) (GCH + ((size_t)(dir * NGCH + (dir ? ch0 + nch - 1 - (cc_) : ch0 + (cc_))) * 4 + h) * GCH_BYTES)
    const int r16a = tid >> 4, c16 = tid & 15, r8a = tid >> 3, c8 = tid & 7;
    v4u pw0, pw1, pq0, pq1, pk0, pk1, pqk; f32x4 UTn[4], UTc[4]; float decn, dec;
#define GS_LOAD(cc_) do { const GAS unsigned char* rec_ = GREC(cc_); \
        pw0 = *(const GAS v4u*)(rec_ + GCH_W + (r16a * 128 + c16 * 8) * 2); pw1 = *(const GAS v4u*)(rec_ + GCH_W + ((r16a + 32) * 128 + c16 * 8) * 2); \
        pq0 = *(const GAS v4u*)(rec_ + GCH_QG + (r16a * 128 + c16 * 8) * 2); pq1 = *(const GAS v4u*)(rec_ + GCH_QG + ((r16a + 32) * 128 + c16 * 8) * 2); \
        pk0 = *(const GAS v4u*)(rec_ + GCH_KD + (r8a * 64 + c8 * 8) * 2); pk1 = *(const GAS v4u*)(rec_ + GCH_KD + ((r8a + 64) * 64 + c8 * 8) * 2); \
        pqk = *(const GAS v4u*)(rec_ + GCH_QK + (r8a * 64 + c8 * 8) * 2); decn = *(const GAS float*)(rec_ + GCH_DEC); \
        _Pragma("unroll") for (int t_ = 0; t_ < 4; ++t_) UTn[t_] = *(const GAS f32x4*)((const GAS float*)(rec_ + GCH_UT) + (dvs * 16 + fr) * 64 + 16 * t_ + 4 * fq); } while (0)
#define GS_STORE() do { *(LAS v4u*)(lds + GS_W + r16a * 272 + c16 * 16) = pw0; *(LAS v4u*)(lds + GS_W + (r16a + 32) * 272 + c16 * 16) = pw1; \
        *(LAS v4u*)(lds + GS_QG + r16a * 272 + c16 * 16) = pq0; *(LAS v4u*)(lds + GS_QG + (r16a + 32) * 272 + c16 * 16) = pq1; \
        *(LAS v4u*)(lds + GS_KD + r8a * 144 + c8 * 16) = pk0; *(LAS v4u*)(lds + GS_KD + (r8a + 64) * 144 + c8 * 16) = pk1; \
        *(LAS v4u*)(lds + GS_QK + r8a * 144 + c8 * 16) = pqk; \
        _Pragma("unroll") for (int t_ = 0; t_ < 4; ++t_) UTc[t_] = UTn[t_]; dec = decn; } while (0)
    __syncthreads();
    GS_LOAD(0); GS_STORE();
    __syncthreads();
#ifdef TPROBE
    unsigned long long tq_a = 0, tq_b = 0, tq_c = 0, tq_d = 0;
#endif
#pragma unroll 1
    for (int cc = 0; cc < nch; ++cc) {
#ifdef TPROBE
        const unsigned long long tq_0 = __builtin_amdgcn_s_memrealtime();
#endif
        const int gch = dir ? ch0 + nch - 1 - cc : ch0 + cc;
        if (cc + 1 < nch) GS_LOAD(cc + 1);
        MEMBAR();
#pragma unroll
        for (int u = 0; u < 8; ++u) { v2u w; w.x = pk2(S[u][0], S[u][1]); w.y = pk2(S[u][2], S[u][3]); *(LAS v2u*)(simg + fr * 136 + 16 * u + 4 * fq) = w; }
        asm volatile("s_waitcnt lgkmcnt(0)" ::: "memory");
        bf16x8 BS[4];
#pragma unroll
        for (int ks = 0; ks < 4; ++ks) BS[ks] = *(const LAS bf16x8*)(simg + fr * 136 + ks * 32 + fq * 8);
        asm volatile("s_waitcnt lgkmcnt(0)" ::: "memory");
        bf16x8 Wf[16];
#pragma unroll
        for (int t = 0; t < 4; ++t)
#pragma unroll
            for (int ks = 0; ks < 4; ++ks) Wf[t * 4 + ks] = *(const LAS bf16x8*)(sW + (16 * t + fr) * 136 + ks * 32 + fq * 8);
        MEMBAR();
#pragma unroll
        for (int t = 0; t < 4; ++t) { f32x4 acc = (f32x4){0.f, 0.f, 0.f, 0.f};
#pragma unroll
            for (int ks = 0; ks < 4; ++ks) acc = __builtin_amdgcn_mfma_f32_16x16x32_bf16(Wf[t * 4 + ks], BS[ks], acc, 0, 0, 0);
            const f32x4 vn = UTc[t] - acc;
            v2u w; w.x = pk2(vn[0], vn[1]); w.y = pk2(vn[2], vn[3]); *(LAS v2u*)(simg + fr * 72 + 16 * t + 4 * fq) = w; }
        asm volatile("s_waitcnt lgkmcnt(0)" ::: "memory");
        bf16x8 BV[2];
#pragma unroll
        for (int ks = 0; ks < 2; ++ks) BV[ks] = *(const LAS bf16x8*)(simg + fr * 72 + ks * 32 + fq * 8);
#ifdef TPROBE
        const unsigned long long tq_1 = __builtin_amdgcn_s_memrealtime();
#endif
        int zl = 0; asm volatile("" : "+v"(zl));
        GAS float* gob = GO + ((size_t)dir * M + gch * 64) * 512 + h * 128 + dvs * 16 + fr + zl;
        bf16x8 QGf[16], QKf[8];
#pragma unroll
        for (int t = 0; t < 4; ++t) {
#pragma unroll
            for (int ks = 0; ks < 4; ++ks) QGf[t * 4 + ks] = *(const LAS bf16x8*)(sQG + (16 * t + fr) * 136 + ks * 32 + fq * 8);
#pragma unroll
            for (int ks = 0; ks < 2; ++ks) QKf[t * 2 + ks] = *(const LAS bf16x8*)(sQK + (16 * t + fr) * 72 + ks * 32 + fq * 8); }
        MEMBAR();
#pragma unroll
        for (int t = 0; t < 4; ++t) { f32x4 acc = (f32x4){0.f, 0.f, 0.f, 0.f};
#pragma unroll
            for (int ks = 0; ks < 4; ++ks) acc = __builtin_amdgcn_mfma_f32_16x16x32_bf16(QGf[t * 4 + ks], BS[ks], acc, 0, 0, 0);
#pragma unroll
            for (int ks = 0; ks < 2; ++ks) acc = __builtin_amdgcn_mfma_f32_16x16x32_bf16(QKf[t * 2 + ks], BV[ks], acc, 0, 0, 0);
#pragma unroll
            for (int r = 0; r < 4; ++r) { const int i = 16 * t + 4 * fq + r, p = dir ? 63 - i : i; gob[(ptrdiff_t)p * 512] = acc[r]; } }
#ifdef TPROBE
        const unsigned long long tq_2 = __builtin_amdgcn_s_memrealtime();
#endif
        bf16x8 KDf[16];
#pragma unroll
        for (int u = 0; u < 8; ++u)
#pragma unroll
            for (int ks = 0; ks < 2; ++ks) KDf[u * 2 + ks] = *(const LAS bf16x8*)(sKD + (16 * u + fr) * 72 + ks * 32 + fq * 8);
        MEMBAR();
#pragma unroll
        for (int u = 0; u < 8; ++u) { f32x4 acc = S[u] * dec;
#pragma unroll
            for (int ks = 0; ks < 2; ++ks) acc = __builtin_amdgcn_mfma_f32_16x16x32_bf16(KDf[u * 2 + ks], BV[ks], acc, 0, 0, 0);
            S[u] = acc; }
#ifdef TPROBE
        const unsigned long long tq_3 = __builtin_amdgcn_s_memrealtime();
#endif
        WG_BAR();
        if (cc + 1 < nch) GS_STORE();
        WG_BAR();
#ifdef TPROBE
        { const unsigned long long tq_4 = __builtin_amdgcn_s_memrealtime(); tq_a += tq_1 - tq_0; tq_b += tq_2 - tq_1; tq_c += tq_3 - tq_2; tq_d += tq_4 - tq_3; }
#endif
    }
#ifdef TPROBE
    if (lat && b == 0 && h == 0 && dir == 0 && wave == 0 && lane == 0) { unsigned long long* ts_ = (unsigned long long*)(A.ws + WS_CTL + 65536); ts_[32 + 10 * 4 + l] += tq_a; ts_[32 + 11 * 4 + l] += tq_b; ts_[32 + 12 * 4 + l] += tq_c; ts_[32 + 13 * 4 + l] += tq_d; }
#endif
#undef GREC
#undef GS_LOAD
#undef GS_STORE
    if (!lat) { int l2 = lane; asm volatile("" : "+v"(l2)); const int fr2 = l2 & 15, fq2 = l2 >> 4;
        GAS float* so = (GAS float*)(A.out + O_SG + ((size_t)(((b * 4 + l) * 2 + dir) * 4 + h) * 128) * 128 + dvs * 16 + fr2 + (size_t)(4 * fq2) * 128);
#pragma unroll
        for (int u = 0; u < 8; ++u)
#pragma unroll
            for (int r = 0; r < 4; ++r) so[(16 * u + r) * 128] = S[u][r]; }
}
__device__ __forceinline__ void ph_gdn_seq(const Ctx& A, int l, LAS unsigned char* lds, int tid, int lane, int wave, int vcu, int G) {
    for (int k = 0; k < 272; ++k) {
        int q;
        if (G == 256) { if (vcu >= 240) q = k == 0 ? 256 + (vcu - 240) : -1; else if (vcu >= 208) q = k == 0 ? vcu - 208 : -1; else { q = 32 + vcu + 208 * k; if (q >= 256) q = -1; } }
        else { q = vcu + k * G; if (q >= 272) q = -1; }
        if (q < 0) break;
        const int lat = q >= 256, it = lat ? q - 256 : q;
        gdn_seq_wg(A, l, it >> 3, lat, (it >> 1) & 3, it & 1, lds, tid, lane, wave);
    }
}

constexpr size_t SR_P = 0, SR_X1 = 32768, SR_X2 = 49152, SR_EA = 65536, SR_DEC = 66048, SR_BYTES = 66560;
constexpr size_t SS_C = 0, SS_BT = 32768, SS_BYTES = 65536;
constexpr int NSCH = 80;
__device__ __forceinline__ void ph_ssd_local(const Ctx& A, int l, LAS unsigned char* lds, int tid, int lane, int wave, int vcu, int G) {
    const GAS bf16* XBC = (const GAS bf16*)(A.ws + WS_XBC); const GAS float* SDT = (const GAS float*)(A.ws + WS_SDT); const GAS float* SDA = SDT + (size_t)M * 16;
    GAS unsigned char* SREC = (GAS unsigned char*)(A.ws + WS_SREC); GAS unsigned char* SSH = (GAS unsigned char*)(A.ws + WS_SSH);
    LAS bf16* Cimg = (LAS bf16*)lds; LAS bf16* Bimg = (LAS bf16*)(lds + 34816);
    LAS float* sac = (LAS float*)(lds + 69632);
    LAS float* sdt = sac + 256;
    LAS bf16* ptile = (LAS bf16*)(lds + 71680 + wave * 4352);
    const int fr = lane & 15, fq = lane >> 4;
    for (int rd = 0; rd * G + vcu < 2 * NSCH * 8; ++rd) {
        if (!((rd + vcu) & 1)) continue;
        const int it = (rd * G + vcu) >> 1;
        const int ch = it >> 3, h = it & 7, g = h >> 2, row0 = ch * 128;
        GAS unsigned char* shr = SSH + (size_t)(ch * 2 + g) * SS_BYTES;
        float xv[16];
        { const GAS bf16* xp = XBC + (size_t)(row0 + wave * 16) * 1024 + h * 64 + lane;
#pragma unroll
          for (int j = 0; j < 16; ++j) xv[j] = bf1(xp[(size_t)j * 1024]); }
        { const int r = tid >> 2, c0 = (tid & 3) * 32; const GAS bf16* cp = XBC + (size_t)(row0 + r) * 1024 + 768 + g * 128 + c0; const GAS bf16* bp = XBC + (size_t)(row0 + r) * 1024 + 512 + g * 128 + c0;
#pragma unroll
          for (int i = 0; i < 4; ++i) { const v4u wc = *(const GAS v4u*)(cp + 8 * i), wb = *(const GAS v4u*)(bp + 8 * i);
              *(LAS v4u*)(Cimg + r * 136 + c0 + 8 * i) = wc; *(LAS v4u*)(Bimg + r * 136 + c0 + 8 * i) = wb;
              if ((h & 3) == 0) *(GAS v4u*)((GAS bf16*)(shr + SS_C) + r * 128 + c0 + 8 * i) = wc; } }
        if (wave < 2) { const int d = wave; const size_t mo = (size_t)(row0 + 2 * lane) * 16 + d * 8 + h;
            const float a0 = SDA[mo], a1 = SDA[mo + 16]; float ps = a0 + a1;
#pragma unroll
            for (int o = 1; o < 64; o <<= 1) { const float t = __shfl_up(ps, o); if (lane >= o) ps += t; }
            const float tot = __shfl(ps, 63);
            if (d == 0) { sac[2 * lane] = ps - a1; sac[2 * lane + 1] = ps; }
            else { sac[128 + 2 * lane] = tot - ps + a0 + a1; sac[128 + 2 * lane + 1] = tot - ps + a1; }
            sdt[d * 128 + 2 * lane] = SDT[mo]; sdt[d * 128 + 2 * lane + 1] = SDT[mo + 16]; }
        __syncthreads();
        if ((h & 3) == 0) { const int n = tid >> 2, s0 = (tid & 3) * 32; GAS bf16* dst = (GAS bf16*)(shr + SS_BT) + n * 128 + s0;
#pragma unroll
            for (int i = 0; i < 4; ++i) { unsigned w[4];
#pragma unroll
                for (int j = 0; j < 4; ++j) w[j] = (unsigned)Bimg[(s0 + 8 * i + 2 * j) * 136 + n] | ((unsigned)Bimg[(s0 + 8 * i + 2 * j + 1) * 136 + n] << 16);
                *(GAS v4u*)(dst + 8 * i) = (v4u){w[0], w[1], w[2], w[3]}; } }
        { bf16x8 af[4];
#pragma unroll
          for (int ks = 0; ks < 4; ++ks) af[ks] = *(const LAS bf16x8*)(Cimg + (16 * wave + fr) * 136 + ks * 32 + fq * 8);
          f32x4 acc[8];
#pragma unroll
          for (int tc = 0; tc < 8; ++tc) { acc[tc] = (f32x4){0.f, 0.f, 0.f, 0.f};
#pragma unroll
              for (int ks = 0; ks < 4; ++ks) { const bf16x8 bfr = *(const LAS bf16x8*)(Bimg + (16 * tc + fr) * 136 + ks * 32 + fq * 8); acc[tc] = __builtin_amdgcn_mfma_f32_16x16x32_bf16(af[ks], bfr, acc[tc], 0, 0, 0); } }
#pragma unroll
          for (int d = 0; d < 2; ++d) {
              float acr[4];
#pragma unroll
              for (int r = 0; r < 4; ++r) acr[r] = sac[d * 128 + 16 * wave + 4 * fq + r];
#pragma unroll
              for (int tc = 0; tc < 8; ++tc) { const int s = 16 * tc + fr; const float as = sac[d * 128 + s];
#pragma unroll
                  for (int r = 0; r < 4; ++r) { const int li = 16 * wave + 4 * fq + r; const bool keep = d ? (s >= li) : (s <= li);
                      ptile[(4 * fq + r) * 136 + s] = (bf16)f2bf(keep ? acc[tc][r] * __expf(acr[r] - as) : 0.f); } }
              asm volatile("s_waitcnt lgkmcnt(0)" ::: "memory");
              GAS bf16* Pd = (GAS bf16*)(SREC + ((size_t)(d * NSCH + ch) * 8 + h) * SR_BYTES + SR_P) + (size_t)(16 * wave) * 128;
#pragma unroll
              for (int j = 0; j < 4; ++j) { const int id = lane + 64 * j, rr = id >> 4, cc = id & 15; *(GAS v4u*)(Pd + rr * 128 + cc * 8) = *(const LAS v4u*)(ptile + rr * 136 + cc * 8); }
              asm volatile("s_waitcnt lgkmcnt(0)" ::: "memory"); } }
        __syncthreads();
        { const int p = lane, s0 = wave * 16;
#pragma unroll
          for (int d = 0; d < 2; ++d) { const float aend = d ? sac[128] : sac[127];
              unsigned w1[8], w2[8];
#pragma unroll
              for (int j = 0; j < 16; j += 2) { const float u0 = xv[j] * sdt[d * 128 + s0 + j], u1 = xv[j + 1] * sdt[d * 128 + s0 + j + 1];
                  w1[j >> 1] = pk2(u0, u1); w2[j >> 1] = pk2(u0 * __expf(aend - sac[d * 128 + s0 + j]), u1 * __expf(aend - sac[d * 128 + s0 + j + 1])); }
              LAS bf16* t1 = (LAS bf16*)(lds + (2 * d) * 17408) + p * 136 + s0; LAS bf16* t2 = (LAS bf16*)(lds + (2 * d + 1) * 17408) + p * 136 + s0;
              *(LAS v4u*)t1 = (v4u){w1[0], w1[1], w1[2], w1[3]}; *(LAS v4u*)(t1 + 8) = (v4u){w1[4], w1[5], w1[6], w1[7]};
              *(LAS v4u*)t2 = (v4u){w2[0], w2[1], w2[2], w2[3]}; *(LAS v4u*)(t2 + 8) = (v4u){w2[4], w2[5], w2[6], w2[7]};
              GAS unsigned char* rec = SREC + ((size_t)(d * NSCH + ch) * 8 + h) * SR_BYTES;
              if (tid < 128) ((GAS float*)(rec + SR_EA))[tid] = __expf(sac[d * 128 + tid]);
              if (tid == 0) *(GAS float*)(rec + SR_DEC) = __expf(aend); } }
        __syncthreads();
#pragma unroll
        for (int j = 0; j < 8; ++j) { const int id = tid + 512 * j, tl = id >> 10, rr = (id >> 4) & 63, cc = id & 15;
            GAS unsigned char* rec = SREC + ((size_t)((tl >> 1) * NSCH + ch) * 8 + h) * SR_BYTES + ((tl & 1) ? SR_X2 : SR_X1);
            *(GAS v4u*)((GAS bf16*)rec + rr * 128 + cc * 8) = *(const LAS v4u*)(lds + tl * 17408 + rr * 272 + cc * 16); }
        __syncthreads();
    }
}

constexpr int SQ_C = 0, SQ_P = 34816, SQ_BT = 69632, SQ_X1 = 104448, SQ_X2 = 121856, SQ_IMG = 139264;
__device__ __forceinline__ void ssd_seq_wg(const Ctx& A, int l, int b, int lat, int h, int dir, LAS unsigned char* lds, int tid, int lane, int wave) {
    const GAS unsigned char* SREC = (const GAS unsigned char*)(A.ws + WS_SREC); const GAS unsigned char* SSH = (const GAS unsigned char*)(A.ws + WS_SSH); GAS float* SY = (GAS float*)(A.ws + WS_SY);
    const int fr = lane & 15, fq = lane >> 4, g = h >> 2, ps = wave & 3, hf = wave >> 2;
    const int nch = lat ? 8 : 2, ch0 = lat ? 64 + b * 8 : b * 2;
    LAS bf16* simg = (LAS bf16*)(lds + SQ_IMG + ps * 4352);
    const LAS bf16* sC = (const LAS bf16*)(lds + SQ_C); const LAS bf16* sP = (const LAS bf16*)(lds + SQ_P); const LAS bf16* sBT = (const LAS bf16*)(lds + SQ_BT);
    const LAS bf16* sX1 = (const LAS bf16*)(lds + SQ_X1); const LAS bf16* sX2 = (const LAS bf16*)(lds + SQ_X2);
    f32x4 S[4];
    const size_t sidx = ((size_t)(((b * 4 + l) * 2 + dir) * 8 + h) * 64 + ps * 16 + fr) * 128 + 64 * hf + 4 * fq;
    if (lat) {
#pragma unroll
        for (int u = 0; u < 4; ++u) S[u] = *(const GAS f32x4*)(A.in[5] + sidx + 16 * u); }
    else {
#pragma unroll
        for (int u = 0; u < 4; ++u) S[u] = (f32x4){0.f, 0.f, 0.f, 0.f}; }
#define SCH(cc_) (dir ? ch0 + nch - 1 - (cc_) : ch0 + (cc_))
    const int r16 = tid >> 4, c16 = tid & 15;
    v4u pc[4], pp[4], pb[4], px1[2], px2[2]; float pea, decn, dec;
#define SQ_LOAD(cc_) do { const int ch_ = SCH(cc_); const GAS unsigned char* rec_ = SREC + ((size_t)(dir * NSCH + ch_) * 8 + h) * SR_BYTES; const GAS unsigned char* shr_ = SSH + (size_t)(ch_ * 2 + g) * SS_BYTES; \
        _Pragma("unroll") for (int j_ = 0; j_ < 4; ++j_) { const int off_ = ((r16 + 32 * j_) * 128 + c16 * 8) * 2; pc[j_] = *(const GAS v4u*)(shr_ + SS_C + off_); pp[j_] = *(const GAS v4u*)(rec_ + SR_P + off_); pb[j_] = *(const GAS v4u*)(shr_ + SS_BT + off_); } \
        _Pragma("unroll") for (int j_ = 0; j_ < 2; ++j_) { const int off_ = ((r16 + 32 * j_) * 128 + c16 * 8) * 2; px1[j_] = *(const GAS v4u*)(rec_ + SR_X1 + off_); px2[j_] = *(const GAS v4u*)(rec_ + SR_X2 + off_); } \
        pea = ((const GAS float*)(rec_ + SR_EA))[tid & 127]; decn = *(const GAS float*)(rec_ + SR_DEC); } while (0)
#define SQ_STORE() do { \
        _Pragma("unroll") for (int j_ = 0; j_ < 4; ++j_) { const int off_ = (r16 + 32 * j_) * 272 + c16 * 16; *(LAS v4u*)(lds + SQ_C + off_) = pc[j_]; *(LAS v4u*)(lds + SQ_P + off_) = pp[j_]; *(LAS v4u*)(lds + SQ_BT + off_) = pb[j_]; } \
        _Pragma("unroll") for (int j_ = 0; j_ < 2; ++j_) { const int off_ = (r16 + 32 * j_) * 272 + c16 * 16; *(LAS v4u*)(lds + SQ_X1 + off_) = px1[j_]; *(LAS v4u*)(lds + SQ_X2 + off_) = px2[j_]; } \
        if (tid < 128) ((LAS float*)(lds + SQ_IMG + 4 * 4352))[tid] = pea; dec = decn; } while (0)
    __syncthreads();
    SQ_LOAD(0); SQ_STORE();
    __syncthreads();
#pragma unroll 1
    for (int cc = 0; cc < nch; ++cc) {
        const int ch = SCH(cc);
        if (cc + 1 < nch) SQ_LOAD(cc + 1);
        MEMBAR();
#pragma unroll
        for (int u = 0; u < 4; ++u) { v2u w; w.x = pk2(S[u][0], S[u][1]); w.y = pk2(S[u][2], S[u][3]); *(LAS v2u*)(simg + fr * 136 + 64 * hf + 16 * u + 4 * fq) = w; }
        WG_BAR();
        bf16x8 BS[4], BX1[4];
#pragma unroll
        for (int ks = 0; ks < 4; ++ks) { BS[ks] = *(const LAS bf16x8*)(simg + fr * 136 + ks * 32 + fq * 8);
            BX1[ks] = *(const LAS bf16x8*)(sX1 + (ps * 16 + fr) * 136 + ks * 32 + fq * 8); }
        int zl = 0; asm volatile("" : "+v"(zl));
        GAS float* syb = SY + ((size_t)dir * M + ch * 128 + 64 * hf + 4 * fq) * 512 + h * 64 + ps * 16 + fr + zl;
#pragma unroll
        for (int tp = 0; tp < 2; ++tp) {
            bf16x8 Cf[8], Pf[8];
#pragma unroll
            for (int t3 = 0; t3 < 2; ++t3) { const int t = 4 * hf + 2 * tp + t3;
#pragma unroll
                for (int ks = 0; ks < 4; ++ks) { Cf[t3 * 4 + ks] = *(const LAS bf16x8*)(sC + (16 * t + fr) * 136 + ks * 32 + fq * 8); Pf[t3 * 4 + ks] = *(const LAS bf16x8*)(sP + (16 * t + fr) * 136 + ks * 32 + fq * 8); } }
            MEMBAR();
#pragma unroll
            for (int t3 = 0; t3 < 2; ++t3) { const int t2 = 2 * tp + t3; f32x4 acc = (f32x4){0.f, 0.f, 0.f, 0.f};
#pragma unroll
                for (int ks = 0; ks < 4; ++ks) acc = __builtin_amdgcn_mfma_f32_16x16x32_bf16(Cf[t3 * 4 + ks], BS[ks], acc, 0, 0, 0);
                acc = acc * *(const LAS f32x4*)((const LAS float*)(lds + SQ_IMG + 4 * 4352) + 16 * (4 * hf + t2) + 4 * fq);
#pragma unroll
                for (int ks = 0; ks < 4; ++ks) acc = __builtin_amdgcn_mfma_f32_16x16x32_bf16(Pf[t3 * 4 + ks], BX1[ks], acc, 0, 0, 0);
#pragma unroll
                for (int r = 0; r < 4; ++r) syb[(size_t)(16 * t2 + r) * 512] = acc[r]; }
        }
        { bf16x8 Bf[16], BX2[4];
#pragma unroll
          for (int ks = 0; ks < 4; ++ks) BX2[ks] = *(const LAS bf16x8*)(sX2 + (ps * 16 + fr) * 136 + ks * 32 + fq * 8);
#pragma unroll
          for (int u = 0; u < 4; ++u)
#pragma unroll
              for (int ks = 0; ks < 4; ++ks) Bf[u * 4 + ks] = *(const LAS bf16x8*)(sBT + (64 * hf + 16 * u + fr) * 136 + ks * 32 + fq * 8);
          MEMBAR();
#pragma unroll
          for (int u = 0; u < 4; ++u) { f32x4 acc = S[u] * dec;
#pragma unroll
              for (int ks = 0; ks < 4; ++ks) acc = __builtin_amdgcn_mfma_f32_16x16x32_bf16(Bf[u * 4 + ks], BX2[ks], acc, 0, 0, 0);
              S[u] = acc; } }
        WG_BAR();
        if (cc + 1 < nch) SQ_STORE();
        WG_BAR();
    }
#undef SCH
#undef SQ_LOAD
#undef SQ_STORE
    if (!lat) {
#pragma unroll
        for (int u = 0; u < 4; ++u) *(GAS f32x4*)(A.out + O_SS + sidx + 16 * u) = S[u]; }
}
__device__ __forceinline__ void ph_ssd_seq(const Ctx& A, int l, LAS unsigned char* lds, int tid, int lane, int wave, int vcu, int G) {
    for (int k = 0; k < 544; ++k) {
        int q;
        if (G == 256) { if (vcu >= 240) q = -1; else if (vcu >= 208) q = k == 0 ? 512 + (vcu - 208) : (k == 1 ? vcu - 208 : -1); else { q = 32 + (vcu + 64) % 208 + 208 * k; if (q >= 512) q = -1; } }
        else { q = vcu + k * G; if (q >= 544) q = -1; }
        if (q < 0) break;
        const int lat = q >= 512, it = lat ? q - 512 : q;
        ssd_seq_wg(A, l, it >> 4, lat, (it >> 1) & 7, it & 1, lds, tid, lane, wave);
    }
}

#ifndef REP_ATTN
#define REP_ATTN 1
#endif
#ifndef REP_LOC
#define REP_LOC 1
#endif
#ifndef REP_LAT
#define REP_LAT 1
#endif
#ifndef REP_CTX
#define REP_CTX 1
#endif
#ifndef REP_MIX
#define REP_MIX 1
#endif
#ifndef REP_PRO
#define REP_PRO 1
#endif
#ifndef REP_EW
#define REP_EW 1
#endif
#ifndef REP_GEMM
#define REP_GEMM 1
#endif
#ifndef MK_ONE_LAUNCH
#define MK_ONE_LAUNCH 0
#endif
__device__ __forceinline__ int lane_now() { unsigned m_ = ~0u; asm volatile("" : "+s"(m_)); return (int)__builtin_amdgcn_mbcnt_hi(m_, __builtin_amdgcn_mbcnt_lo(m_, 0u)); }
#define TID_NOW() (wave0 * 64 + lane_now())
#define IN(k) (lo <= (k) && (k) < hi)
#ifndef REP_BAR
#define REP_BAR 1
#endif
#ifdef TPROBE
#define TS_ACC(k) do { if (blockIdx.x == 0 && wave0 == 0 && lane_now() == 0) { unsigned long long* ts_ = (unsigned long long*)(args.ws + WS_CTL + 65536); const unsigned long long t_ = __builtin_amdgcn_s_memrealtime(); \
        const int ty_ = ((k) == 0) ? 0 : 1 + (((k) - 1) % 11); ts_[1 + ty_] += t_ - ts_[0]; ts_[0] = t_; } } while (0)
#define SEAM(k) do { if (IN((k) + 1)) { xcd_barrier(bar); TS_ACC(k); } } while (0)
#define SUB0() const unsigned long long sub_t0_ = __builtin_amdgcn_s_memrealtime()
#define SUBT(slot) do { __syncthreads(); if (wave0 == 0 && lane_now() == 0) { unsigned long long* ts_ = (unsigned long long*)(args.ws + WS_CTL + 65536); \
        atomicMax(&ts_[32 + (slot) * 4 + l], __builtin_amdgcn_s_memrealtime() - sub_t0_); } } while (0)
#else
#define SUB0() do {} while (0)
#define SUBT(slot) do {} while (0)
#define SEAM(k) do { if (IN((k) + 1)) { for (int rb_ = 0; rb_ < REP_BAR; ++rb_) xcd_barrier(bar); } } while (0)
#endif
#define PHASE_ROOTS() Ctx C; int G = (int)gridDim.x, bx = (int)blockIdx.x; int tid = TID_NOW(); asm volatile("" : "+v"(tid)); const int lane = tid & 63, wave = __builtin_amdgcn_readfirstlane(tid >> 6); (void)lane; (void)wave; \
    { unsigned long long kp_ = (unsigned long long)__builtin_amdgcn_kernarg_segment_ptr(); float* o_ = args.out; unsigned char* w_ = args.ws; \
      asm volatile("" : "+s"(kp_), "+s"(o_), "+s"(w_), "+s"(G), "+s"(bx)); C.in = (kin_t)kp_; C.out = o_; C.ws = w_; } \
    const int vcu = (G % 8 == 0) ? (bx % 8) * (G / 8) + bx / 8 : bx; const int gw = vcu * NWAVES + wave, NGW = G * NWAVES; (void)gw; (void)NGW; (void)vcu


template <int L> __device__ __forceinline__ void layer_phases(const Args& args, LAS unsigned char* lds, const int wave0, const int lo0, const int hi0, const XcdBarrier& bar) {
    constexpr int l = L;
        const int pb = 1 + l * NPH_L;
        int lo = lo0, hi = hi0; asm volatile("" : "+s"(lo), "+s"(hi));
#define MODS_L ((const float*)(C.ws + WS_MODS) + (size_t)l * 3 * 12288)
#define WL ((const bf16*)(C.ws + WS_W) + (size_t)l * WLE_SIZE)
        if (IN(pb + 0)) { PHASE_ROOTS(); for (int rep = 0; rep < REP_EW; ++rep) ph_norm((bf16*)(C.ws + WS_X), C.in[8] + l * D, MODS_L, 0, (bf16*)(C.ws + WS_H), l > 0 ? (const float*)(C.ws + WS_PART) : (const float*)nullptr, MODS_L - 3 * 12288 + 5 * 2048, lane, gw, NGW); SEAM(pb + 0); }
        if (IN(pb + 1)) { PHASE_ROOTS();
            pg8::Gemm g{(const bf16*)(C.ws + WS_H), WL + WLE_IN, M, IN_WP, D}; pg8::InOrder S; S.init(M, G, bx);
            pg8::EpiU E{(bf16*)(C.ws + WS_U), IN_WP, (float*)(C.ws + WS_USIDE)};
            pg8::gemm_phase<pg8::EpiU, pg8::InOrder, true, true>(lds, g, S, E, tid);
            SEAM(pb + 1);
        }
        if (IN(pb + 2)) { PHASE_ROOTS();
#ifndef SKIP_PREP
            for (int rep = 0; rep < REP_EW; ++rep) ph_prep(C, l, lane, gw, NGW);
#endif
            SEAM(pb + 2); }
        if (IN(pb + 3)) {
            { PHASE_ROOTS(); pg8::Gemm g{(const bf16*)(C.ws + WS_CQN), WL + WLE_UQ, M, 1536, 768}; pg8::StaticOrder S; S.init(M, 1536, G - 32, bx < G - 32 ? bx : (1 << 20));
              pg8::EpiBf16 E{(bf16*)(C.ws + WS_QRAW), 1536};
              pg8::gemm_phase<pg8::EpiBf16, pg8::StaticOrder, true, true>(lds, g, S, E, tid); }
            { PHASE_ROOTS(); pg8::Gemm g{(const bf16*)(C.ws + WS_CKVN), WL + WLE_KV, MK, 1024, 512}; pg8::StaticOrder S; S.init(MK, 1024, G - 32, bx < G - 32 ? G - 33 - bx : (1 << 20));
              pg8::EpiBf16 E{(bf16*)(C.ws + WS_KN), 1024};
              pg8::gemm_phase<pg8::EpiBf16, pg8::StaticOrder, true, true>(lds, g, S, E, tid); }
            { PHASE_ROOTS(); pg8::Gemm g{WL + WLE_KV + (size_t)1024 * 512, (const bf16*)(C.ws + WS_CKVN), 1024, MK, 512}; pg8::StaticOrder S; S.init(1024, MK, G - 32, bx < G - 32 ? G - 33 - bx : (1 << 20));
              pg8::EpiBf16 E{(bf16*)(C.ws + WS_VT), MK};
              for (int rep = 0; rep < REP_GEMM; ++rep) pg8::gemm_phase<pg8::EpiBf16, pg8::StaticOrder, true, true>(lds, g, S, E, tid); }
            { PHASE_ROOTS(); pg8::Gemm g{(const bf16*)(C.ws + WS_H), WL + WLE_IN, M, IN_WP, D}; pg8::DeferOrder S{bx - (G - 32)};
              pg8::EpiU E{(bf16*)(C.ws + WS_U), IN_WP, (float*)(C.ws + WS_USIDE)};
              pg8::gemm_phase<pg8::EpiU, pg8::DeferOrder, true, true>(lds, g, S, E, tid); }
            SEAM(pb + 3);
        }
        if (IN(pb + 4)) { PHASE_ROOTS(); SUB0();
#ifndef SKIP_FIN
            ph_finalize(C, l, lds, tid, lane, gw, NGW);
#endif
            SUBT(3);
            for (int rep = 0; rep < REP_LOC; ++rep) { ph_gdn_local(C, l, lds, tid, lane, wave, vcu, G); SUBT(4);
            ph_ssd_local(C, l, lds, tid, lane, wave, vcu, G); SUBT(5); }
            SEAM(pb + 4); }
        if (IN(pb + 5)) { SUB0(); for (int rep = 0; rep < REP_MIX; ++rep) {
#ifndef SKIP_GDN
            { PHASE_ROOTS(); ph_gdn_seq(C, l, lds, tid, lane, wave, vcu, G); }
#endif
            SUBT(0);
            __syncthreads();
#ifndef SKIP_SSD
            { PHASE_ROOTS(); ph_ssd_seq(C, l, lds, tid, lane, wave, vcu, G); }
#endif
            SUBT(1);
            __syncthreads();
#ifndef SKIP_ATTN
            for (int rep2 = 0; rep2 < REP_ATTN; ++rep2) { PHASE_ROOTS(); ph_attn(C, l, lds, tid, lane, wave, vcu, G); }
#endif
            SUBT(2);
            __syncthreads(); }
            SEAM(pb + 5);
        }
        if (IN(pb + 6)) { PHASE_ROOTS();
#ifndef SKIP_POST
            for (int rep = 0; rep < REP_EW; ++rep) ph_post(C, l, lane, gw, NGW);
#endif
            SEAM(pb + 6); }
        if (IN(pb + 7)) { PHASE_ROOTS();
            { pg8::Gemm g{(const bf16*)(C.ws + WS_MIX), WL + WLE_OUT, M, D, D, 0}; pg8::PanelOrder S{bx};
              pg8::EpiResidT<false> E{(bf16*)(C.ws + WS_X), C.out, D, MODS_L + 2 * 2048};
              pg8::gemm_phase<pg8::EpiResidT<false>, pg8::PanelOrder, true, true>(lds, g, S, E, tid); }
            { PHASE_ROOTS(); pg8::Gemm g{(const bf16*)(C.ws + WS_MIX), WL + WLE_OUT, M, D, D / 4, D}; pg8::TailOrder S{bx, D / 4};
              pg8::EpiPart E{(bf16*)(C.ws + WS_PART), D / 4};
              pg8::gemm_phase<pg8::EpiPart, pg8::TailOrder, true, true>(lds, g, S, E, tid); }
            SEAM(pb + 7);
        }
        if (IN(pb + 8)) { PHASE_ROOTS(); for (int rep = 0; rep < REP_EW; ++rep) ph_norm((bf16*)(C.ws + WS_X), C.in[9] + l * D, MODS_L, 3, (bf16*)(C.ws + WS_H), (const float*)(C.ws + WS_PART), MODS_L + 2 * 2048, lane, gw, NGW); SEAM(pb + 8); }
        if (IN(pb + 9)) { PHASE_ROOTS();
            pg8::Gemm g{(const bf16*)(C.ws + WS_H), WL + WLE_GU, M, 2 * FF, D}; pg8::StaticOrder S; S.init(M, 2 * FF, G, bx);
            pg8::EpiSwiglu E{(bf16*)(C.ws + WS_ACT), FF};
            for (int rep = 0; rep < REP_GEMM; ++rep) pg8::gemm_phase<pg8::EpiSwiglu, pg8::StaticOrder, false, true>(lds, g, S, E, tid);
            SEAM(pb + 9);
        }
        if (IN(pb + 10)) { PHASE_ROOTS();
            { pg8::Gemm g{(const bf16*)(C.ws + WS_ACT), WL + WLE_DN, M, D, FF, 0}; pg8::PanelOrder S{bx};
              pg8::EpiResidT<(L == DEPTH - 1)> E{(bf16*)(C.ws + WS_X), C.out, D, MODS_L + 5 * 2048};
              pg8::gemm_phase<pg8::EpiResidT<(L == DEPTH - 1)>, pg8::PanelOrder, true, true>(lds, g, S, E, tid); }
            { PHASE_ROOTS(); pg8::Gemm g{(const bf16*)(C.ws + WS_ACT), WL + WLE_DN, M, D, FF / 4, FF}; pg8::TailOrder S{bx, FF / 4};
              pg8::EpiPart E{(bf16*)(C.ws + WS_PART), FF / 4};
              pg8::gemm_phase<pg8::EpiPart, pg8::TailOrder, true, true>(lds, g, S, E, tid); }
            SEAM(pb + 10);
        }
    }

__global__ void __launch_bounds__(NWAVES * 64, 2) mk_fwd(Args args) {
    extern __shared__ __attribute__((aligned(16))) unsigned char lds_raw[];
    LAS unsigned char* lds = (LAS unsigned char*)lds_raw;
    const int wave0 = __builtin_amdgcn_readfirstlane((int)threadIdx.x >> 6);
    for (int u = TID_NOW(); u < (LDS_BYTES - LDSCTL_OFF) / 4; u += NWAVES * 64) ((LAS unsigned*)(lds + LDSCTL_OFF))[u] = 0u;
    __syncthreads();
    const int lo0 = args.ph_lo, hi0 = args.ph_hi;
    XcdBarrier bar; bar.bar = (unsigned*)(args.ws + WS_CTL) + CW_BAR; bar.x = 0; bar.st = nullptr; bar.wv = wave0;
    if ((hi0 - lo0) > 1) bar = xcd_barrier_post((unsigned*)(args.ws + WS_CTL) + CW_BAR, (volatile LAS unsigned*)(lds + MISC_OFF) + 8); bar.wv = wave0;
#ifdef TPROBE
    if (blockIdx.x == 0 && wave0 == 0 && lane_now() == 0) { unsigned long long* ts_ = (unsigned long long*)(args.ws + WS_CTL + 65536); ts_[0] = __builtin_amdgcn_s_memrealtime(); ts_[20] = ts_[0]; }
#endif
    { int lo = lo0, hi = hi0;
    if (IN(0)) { for (int rep = 0; rep < REP_PRO; ++rep) { PHASE_ROOTS();
#ifndef SKIP_PRO
        ph_prologue(C, lds, tid, lane, wave, vcu, G);
#endif
        __syncthreads(); }
        SEAM(0); } }

    layer_phases<0>(args, lds, wave0, lo0, hi0, bar);
    layer_phases<1>(args, lds, wave0, lo0, hi0, bar);
    layer_phases<2>(args, lds, wave0, lo0, hi0, bar);
    layer_phases<3>(args, lds, wave0, lo0, hi0, bar);
    { int lo = lo0, hi = hi0; if (IN(NPHASES - 1)) { PHASE_ROOTS(); ph_final((const bf16*)(C.ws + WS_X), C.out, (const float*)(C.ws + WS_PART), (const float*)(C.ws + WS_MODS) + (size_t)3 * 3 * 12288 + 5 * 2048, lane, gw, NGW); } }
#ifdef TPROBE
    { xcd_barrier(bar);
      if (blockIdx.x == 0 && wave0 == 0 && lane_now() == 0) { unsigned long long* ts_ = (unsigned long long*)(args.ws + WS_CTL + 65536); const unsigned long long t_ = __builtin_amdgcn_s_memrealtime();
          ts_[1 + 12] += t_ - ts_[0]; const unsigned long long num_ = (TPROBE >= 20) ? (ts_[32 + (TPROBE - 20) * 4] + ts_[33 + (TPROBE - 20) * 4] + ts_[34 + (TPROBE - 20) * 4] + ts_[35 + (TPROBE - 20) * 4]) : ts_[1 + (TPROBE >= 20 ? 0 : TPROBE)]; const float share = (float)((double)num_ / (double)(t_ - ts_[20])); *(float*)(ts_ + 24) = share; }
      xcd_barrier(bar);
      const float sc = 1.0f + 1.0f * *(const float*)((unsigned long long*)(args.ws + WS_CTL + 65536) + 24);
      for (size_t i = (size_t)blockIdx.x * 512 + TID_NOW(); i < 2097152; i += (size_t)gridDim.x * 512) args.out[O_KR + i] *= sc; }
#endif
#undef IN
#undef SEAM
}

extern "C" void kernel_launch(void* const* d_in, const int* in_sizes, int n_in, void* d_out, int out_size, void* d_ws, size_t ws_size, hipStream_t stream) {
    static int grid = 0;
    if (grid == 0) {
        if (n_in != 32 || out_size != 73400320 || ws_size < WS_END) { fprintf(stderr, "kernel_launch: built for 32 inputs, 73400320 outputs, >= %zu bytes of workspace; got n_in %d, out %d, ws %zu; nothing launched\n", (size_t)WS_END, n_in, out_size, ws_size); grid = -1; return; }
        int dev = 0, cus = 0, per_cu = 0;
        if (hipGetDevice(&dev) != hipSuccess || hipDeviceGetAttribute(&cus, hipDeviceAttributeMultiprocessorCount, dev) != hipSuccess) { fprintf(stderr, "kernel_launch: device query failed\n"); grid = -1; return; }
        if (hipFuncSetAttribute((const void*)mk_fwd, hipFuncAttributeMaxDynamicSharedMemorySize, LDS_BYTES) != hipSuccess) { fprintf(stderr, "kernel_launch: hipFuncSetAttribute failed\n"); grid = -1; return; }
        if (hipOccupancyMaxActiveBlocksPerMultiprocessor(&per_cu, (const void*)mk_fwd, NWAVES * 64, LDS_BYTES) != hipSuccess || per_cu < 1)
            fprintf(stderr, "kernel_launch: note: occupancy query reports %d workgroups per CU\n", per_cu);
        (void)hipGetLastError();
        grid = cus;
    }
    if (grid < 0) return;
    if (hipMemsetAsync((char*)d_ws + WS_CTL, 0, CTL_ZERO_BYTES, stream) != hipSuccess) { fprintf(stderr, "kernel_launch: memset failed\n"); return; }
    Args a{};
    for (int i = 0; i < 32; ++i) a.in[i] = (const float*)d_in[i];
    a.out = (float*)d_out; a.ws = (unsigned char*)d_ws;
#if MK_ONE_LAUNCH
    a.ph_lo = 0; a.ph_hi = NPHASES;
    hipLaunchKernelGGL(mk_fwd, dim3(grid), dim3(NWAVES * 64), LDS_BYTES, stream, a);
#else
    for (int p = 0; p < NPHASES; ++p) { a.ph_lo = p; a.ph_hi = p + 1; hipLaunchKernelGGL(mk_fwd, dim3(grid), dim3(NWAVES * 64), LDS_BYTES, stream, a); }
#endif
    const hipError_t le = hipPeekAtLastError();
    if (le != hipSuccess) fprintf(stderr, "kernel_launch: launch failed: %s\n", hipGetErrorName(le));
}
```

```cpp
#include <hip/hip_runtime.h>
#include <cstdio>
#include <cstdint>
#include <cstddef>
#ifndef MK_ONE_LAUNCH
#define MK_ONE_LAUNCH 1
#endif
namespace pg8 {
#define PG8_LAS __attribute__((address_space(3)))
typedef unsigned short bf16_t;
typedef short bf16x8 __attribute__((ext_vector_type(8)));
typedef float f32x4 __attribute__((ext_vector_type(4)));
typedef unsigned u32x4 __attribute__((ext_vector_type(4)));
constexpr int BM = 256, BK = 64, HALF = 128, HTB = HALF * BK * 2  , STAGE_BYTES = 8 * HTB, NXCD = 8, WGM = 8;

__host__ __device__ __forceinline__ int lds_byte(int r, int c) { const int st = (r >> 4) * 2 + (c >> 5), rr = r & 15, cc = c & 31, ob = rr * 64 + cc * 2; return st * 1024 + (ob ^ (((ob >> 9) & 1) << 5)); }
__host__ __device__ __forceinline__ void stage_rc(int b, int& R, int& C) { const int st = b / 1024, sb = b % 1024, swz = sb ^ (((sb >> 9) & 1) << 5); R = (st >> 1) * 16 + swz / 64; C = (st & 1) * 32 + (swz % 64) / 2; }
__host__ __device__ __forceinline__ int perm32(int rho) { const int n = rho >> 4, i = rho & 15; return 8 * (i >> 2) + 4 * n + (i & 3); }

struct Unit { int pm, pn, k0; };
struct Gemm { const bf16_t* A; const bf16_t* Bt; int M, N, K, ld; };

struct StaticOrder {
    int nM, nN, nwg, G, c;
    __host__ __device__ void init(int M, int N, int G_, int c_) { nM = M / BM; nN = N / BM; nwg = nM * nN; G = G_; c = c_; }
    __host__ __device__ bool next(int i, Unit& u) const {
        const long L = (long)i * G + c; if (L >= nwg) return false;
        int wgid = (int)L; { const int q = nwg / NXCD, r = nwg % NXCD, xcd = wgid % NXCD, off = wgid / NXCD; wgid = (xcd < r ? xcd * (q + 1) : r * (q + 1) + (xcd - r) * q) + off; }
        const int nig = WGM * nN, gid = wgid / nig, fm = gid * WGM, gsz = (nM - fm) < WGM ? (nM - fm) : WGM;
        u.pm = fm + ((wgid % nig) % gsz); u.pn = (wgid % nig) / gsz; u.k0 = 0; return true;
    }
    __device__ __forceinline__ void a_ready(const Unit&) const {}
    __device__ __forceinline__ void done(const Unit&) const {}
};

__device__ __forceinline__ unsigned cvt_pk_bf16(float lo, float hi) { unsigned r; asm volatile("v_cvt_pk_bf16_f32 %0, %1, %2" : "=v"(r) : "v"(lo), "v"(hi)); return r; }
__device__ __forceinline__ float silu_f(float x) { return x * __builtin_amdgcn_rcpf(1.0f + __expf(-x)); }

struct EpiF32 {
    static constexpr bool PERM = false, AFTER_DRAIN = false;
    float* C; int ldc;
    __device__ __forceinline__ void operator()(const f32x4 (&acc)[2][2][4][2], const Unit& u, int wr, int wc, int fr, int fq) const {
        const int row0 = u.pm * BM + wr * 64 + fr, col0 = u.pn * BM + wc * 32 + 4 * fq;
#pragma unroll
        for (int ai = 0; ai < 2; ++ai)
#pragma unroll
            for (int m = 0; m < 4; ++m) { float* rowp = C + (size_t)(row0 + ai * HALF + m * 16) * ldc + col0;
#pragma unroll
                for (int bj = 0; bj < 2; ++bj)
#pragma unroll
                    for (int n = 0; n < 2; ++n) *(f32x4*)(rowp + bj * HALF + n * 16) = acc[ai][bj][m][n]; }
    }
};
struct EpiBf16 {
    static constexpr bool PERM = true, AFTER_DRAIN = false;
    bf16_t* O; int ldc;
    __device__ __forceinline__ void operator()(const f32x4 (&acc)[2][2][4][2], const Unit& u, int wr, int wc, int fr, int fq) const {
        const int row0 = u.pm * BM + wr * 64 + fr; const int col0 = u.pn * BM + wc * 32 + 8 * fq;
#pragma unroll
        for (int ai = 0; ai < 2; ++ai)
#pragma unroll
            for (int m = 0; m < 4; ++m) { bf16_t* rowp = O + (size_t)(row0 + ai * HALF + m * 16) * ldc + col0;
#pragma unroll
                for (int bj = 0; bj < 2; ++bj) { const f32x4 v0 = acc[ai][bj][m][0], v1 = acc[ai][bj][m][1];
                    u32x4 w; w.x = cvt_pk_bf16(v0[0], v0[1]); w.y = cvt_pk_bf16(v0[2], v0[3]); w.z = cvt_pk_bf16(v1[0], v1[1]); w.w = cvt_pk_bf16(v1[2], v1[3]);
                    *(u32x4*)(rowp + bj * HALF) = w; } }
    }
};
typedef unsigned u32x2 __attribute__((ext_vector_type(2)));
template <bool F32OUT> struct EpiResidT {
    static constexpr bool PERM = false, AFTER_DRAIN = false;
    bf16_t* X; float* OUT; int ldc; const float* gate;
    __device__ __forceinline__ void operator()(const f32x4 (&acc)[2][2][4][2], const Unit& u, int wr, int wc, int fr, int fq) const {
        const int row0 = u.pm * BM + wr * 64 + fr, col0 = u.pn * BM + wc * 32 + 4 * fq;
        const int cr = u.pm < 32 ? 0 : 1 + ((u.pm - 32) >> 2);
        const float* gp = gate + (size_t)cr * 12288 + col0;
        f32x4 gv[2][2];
#pragma unroll
        for (int bj = 0; bj < 2; ++bj)
#pragma unroll
            for (int n = 0; n < 2; ++n) gv[bj][n] = *(const f32x4*)(gp + bj * HALF + n * 16);
#pragma unroll
        for (int ai = 0; ai < 2; ++ai)
#pragma unroll
            for (int m = 0; m < 4; ++m) { const size_t ro = (size_t)(row0 + ai * HALF + m * 16) * ldc + col0;
#pragma unroll
                for (int bj = 0; bj < 2; ++bj)
#pragma unroll
                    for (int n = 0; n < 2; ++n) { const size_t off = ro + bj * HALF + n * 16; const u32x2 xb = *(const u32x2*)(X + off);
                        f32x4 x; x[0] = __builtin_bit_cast(float, xb.x << 16); x[1] = __builtin_bit_cast(float, xb.x & 0xffff0000u); x[2] = __builtin_bit_cast(float, xb.y << 16); x[3] = __builtin_bit_cast(float, xb.y & 0xffff0000u);
                        x = x + gv[bj][n] * acc[ai][bj][m][n];
                        if (F32OUT) *(f32x4*)(OUT + off) = x; else { u32x2 w; w.x = cvt_pk_bf16(x[0], x[1]); w.y = cvt_pk_bf16(x[2], x[3]); *(u32x2*)(X + off) = w; } } }
    }
};
struct EpiSwiglu {
    static constexpr bool PERM = true, AFTER_DRAIN = false;
    bf16_t* O; int ldc;
    __device__ __forceinline__ void operator()(const f32x4 (&acc)[2][2][4][2], const Unit& u, int wr, int wc, int fr, int fq) const {
        const int row0 = u.pm * BM + wr * 64 + fr; const int col0 = u.pn * HALF + wc * 32 + 8 * fq;
#pragma unroll
        for (int ai = 0; ai < 2; ++ai)
#pragma unroll
            for (int m = 0; m < 4; ++m) { bf16_t* rowp = O + (size_t)(row0 + ai * HALF + m * 16) * ldc + col0;
                f32x4 v0, v1;
#pragma unroll
                for (int j = 0; j < 4; ++j) { v0[j] = silu_f(acc[ai][0][m][0][j]) * acc[ai][1][m][0][j]; v1[j] = silu_f(acc[ai][0][m][1][j]) * acc[ai][1][m][1][j]; }
                u32x4 w; w.x = cvt_pk_bf16(v0[0], v0[1]); w.y = cvt_pk_bf16(v0[2], v0[3]); w.z = cvt_pk_bf16(v1[0], v1[1]); w.w = cvt_pk_bf16(v1[2], v1[3]);
                *(u32x4*)rowp = w; }
    }
};


struct PanelOrder {
    int c;
    __device__ bool next(int i, Unit& u) const { if (i != 0 || c >= 256) return false; const int x = c & 7, j = c >> 3; u.pm = 4 * x + (j >> 3); u.pn = j & 7; u.k0 = 0; return true; }
    __device__ __forceinline__ void a_ready(const Unit&) const {}
    __device__ __forceinline__ void done(const Unit&) const {}
};
struct TailOrder {
    int c, kq;
    __device__ bool next(int i, Unit& u) const { if (i != 0 || c >= 256) return false; const int x = c & 7, j = c >> 3; u.pm = 32 + x; u.pn = j & 7; u.k0 = (j >> 3) * kq; return true; }
    __device__ __forceinline__ void a_ready(const Unit&) const {}
    __device__ __forceinline__ void done(const Unit&) const {}
};
struct EpiPart {
    static constexpr bool PERM = true, AFTER_DRAIN = false;
    bf16_t* P; int kq;
    __device__ __forceinline__ void operator()(const f32x4 (&acc)[2][2][4][2], const Unit& u, int wr, int wc, int fr, int fq) const {
        const int row0 = (u.pm - 32) * BM + wr * 64 + fr, col0 = u.pn * BM + wc * 32 + 8 * fq;
        bf16_t* base = P + (size_t)(u.k0 / kq) * 2048 * 2048;
#pragma unroll
        for (int ai = 0; ai < 2; ++ai)
#pragma unroll
            for (int m = 0; m < 4; ++m) { bf16_t* rowp = base + (size_t)(row0 + ai * HALF + m * 16) * 2048 + col0;
#pragma unroll
                for (int bj = 0; bj < 2; ++bj) { const f32x4 v0 = acc[ai][bj][m][0], v1 = acc[ai][bj][m][1];
                    u32x4 w; w.x = cvt_pk_bf16(v0[0], v0[1]); w.y = cvt_pk_bf16(v0[2], v0[3]); w.z = cvt_pk_bf16(v1[0], v1[1]); w.w = cvt_pk_bf16(v1[2], v1[3]);
                    *(u32x4*)(rowp + bj * HALF) = w; } }
    }
};

struct EpiU {
    static constexpr bool PERM = true, AFTER_DRAIN = false;
    bf16_t* O; int ldc; float* side;
    __device__ __forceinline__ void operator()(const f32x4 (&acc)[2][2][4][2], const Unit& u, int wr, int wc, int fr, int fq) const {
        const int row0 = u.pm * BM + wr * 64 + fr; const int col0 = u.pn * BM + wc * 32 + 8 * fq;
        const bool sd = (wc == 2) && ((u.pn == 13 && fq < 2) || (u.pn == 19 && fq >= 2));
        const int sc0 = (u.pn == 13) ? 8 * fq : 16 + 8 * (fq - 2);
#pragma unroll
        for (int ai = 0; ai < 2; ++ai)
#pragma unroll
            for (int m = 0; m < 4; ++m) { const int row = row0 + ai * HALF + m * 16; bf16_t* rowp = O + (size_t)row * ldc + col0;
#pragma unroll
                for (int bj = 0; bj < 2; ++bj) { const f32x4 v0 = acc[ai][bj][m][0], v1 = acc[ai][bj][m][1];
                    u32x4 w; w.x = cvt_pk_bf16(v0[0], v0[1]); w.y = cvt_pk_bf16(v0[2], v0[3]); w.z = cvt_pk_bf16(v1[0], v1[1]); w.w = cvt_pk_bf16(v1[2], v1[3]);
                    *(u32x4*)(rowp + bj * HALF) = w; }
                if (sd) { float* sp = side + (size_t)row * 32 + sc0; *(f32x4*)sp = acc[ai][0][m][0]; *(f32x4*)(sp + 4) = acc[ai][0][m][1]; } }
    }
};

struct InOrder {
    StaticOrder so;
    __device__ void init(int M, int G_, int c_) { so.init(M, 18 * BM, G_, c_); }
    __device__ bool next(int i, Unit& u) const {
        if (!so.next(i, u)) { const long L = (long)i * so.G + so.c; const int d = (int)(L - 720);
            if (d < 0 || d >= 48) return false; u.pm = d >> 1; u.pn = (d & 1) ? 14 : 12; u.k0 = 0; return true; }
        u.pn = u.pn < 12 ? u.pn : (u.pn == 12 ? 13 : u.pn + 2); return true; }
    __device__ __forceinline__ void a_ready(const Unit&) const {}
    __device__ __forceinline__ void done(const Unit&) const {}
};
struct DeferOrder {
    int c;
    __device__ bool next(int i, Unit& u) const { if (i != 0 || c < 0 || c >= 32) return false; const int d = c + 48; u.pm = d >> 1; u.pn = (d & 1) ? 14 : 12; u.k0 = 0; return true; }
    __device__ __forceinline__ void a_ready(const Unit&) const {}
    __device__ __forceinline__ void done(const Unit&) const {}
};
template <class Epi, class Sched, bool ALIGN_EPI = false, bool SP2 = false>
__device__ __forceinline__ void gemm_phase(PG8_LAS unsigned char* lds, const Gemm g, const Sched& S, const Epi& E, int tid_in) {
    int tid_l = tid_in; asm volatile("" : "+v"(tid_l)); const int tid = tid_l, wid = __builtin_amdgcn_readfirstlane(tid >> 6), lane = tid & 63, wr = wid >> 2, wc = wid & 3, fr = lane & 15, fq = lane >> 4;
    const int K = g.ld ? g.ld : g.K, nt = g.K / BK;
    unsigned voffA[2], voffB[2];
#pragma unroll
    for (int i = 0; i < 2; ++i) { int R, C; stage_rc(tid * 16 + i * 8192, R, C); const int Rb = Epi::PERM ? ((R & ~31) + perm32(R & 31)) : R;
        voffA[i] = (unsigned)(R * K + C) * 2u; voffB[i] = (unsigned)(Rb * K + C) * 2u; }
    const size_t kstep = (size_t)(BK * 2);
    const size_t hstep = (size_t)HALF * K * 2;
    const size_t tstep = 2 * hstep;
    const unsigned ldsw = (unsigned)wid * 1024u;
    const int aoff = lds_byte(wr * 64 + fr, fq * 8), boff = lds_byte(wc * 32 + fr, fq * 8);
#define PG8_SA(b, h) (((b) * 2 + (h)) * HTB)
#define PG8_SB(b, h) ((4 + (b) * 2 + (h)) * HTB)
#define PG8_STAGE(bufoff, gbase, voff) do { _Pragma("unroll") for (int _i = 0; _i < 2; ++_i) \
        __builtin_amdgcn_global_load_lds((const unsigned*)((const char*)(gbase) + (voff)[_i]), (PG8_LAS unsigned*)(lds + (bufoff) + ldsw + _i * 8192), 16, 0, 0); } while (0)
#define PG8_LDA(dst, b, h) do { _Pragma("unroll") for (int m = 0; m < 4; ++m) _Pragma("unroll") for (int k = 0; k < 2; ++k) dst[m][k] = *(const PG8_LAS bf16x8*)(lds + PG8_SA(b, h) + aoff + m * 2048 + k * 1024); } while (0)
#define PG8_LDB(dst, b, h) do { _Pragma("unroll") for (int n = 0; n < 2; ++n) _Pragma("unroll") for (int k = 0; k < 2; ++k) dst[n][k] = *(const PG8_LAS bf16x8*)(lds + PG8_SB(b, h) + boff + n * 2048 + k * 1024); } while (0)
#define PG8_MMA(ai, bj, At, Bt) do { __builtin_amdgcn_s_setprio(1); _Pragma("unroll") for (int m = 0; m < 4; ++m) _Pragma("unroll") for (int n = 0; n < 2; ++n) _Pragma("unroll") for (int k = 0; k < 2; ++k) \
        acc[ai][bj][m][n] = __builtin_amdgcn_mfma_f32_16x16x32_bf16(Bt[n][k], At[m][k], acc[ai][bj][m][n], 0, 0, 0); __builtin_amdgcn_s_setprio(0); } while (0)
#define PG8_WAIT_V(n) asm volatile("s_waitcnt vmcnt(" #n ")" ::: "memory")
#define PG8_WAIT_L(n) asm volatile("s_waitcnt lgkmcnt(" #n ")" ::: "memory")
#define PG8_BAR __builtin_amdgcn_s_barrier()
#define PG8_SCHED __builtin_amdgcn_sched_barrier(0)
    Unit cur, nxt; int ui = 0;
    if (!S.next(0, cur)) return;
    f32x4 acc[2][2][4][2];
#pragma unroll
    for (int a = 0; a < 2; ++a)
#pragma unroll
        for (int b = 0; b < 2; ++b)
#pragma unroll
            for (int m = 0; m < 4; ++m)
#pragma unroll
                for (int n = 0; n < 2; ++n) acc[a][b][m][n] = (f32x4){0.f, 0.f, 0.f, 0.f};
    bf16x8 At[4][2], B0[2][2], B1[2][2];
    const char* cA = (const char*)g.A + (size_t)cur.pm * tstep + (size_t)cur.k0 * 2; const char* cB = (const char*)g.Bt + (size_t)cur.pn * tstep + (size_t)cur.k0 * 2;
    S.a_ready(cur);
    if constexpr (SP2) {
        PG8_STAGE(PG8_SB(0, 0), cB, voffB); PG8_STAGE(PG8_SB(0, 1), cB + hstep, voffB); PG8_STAGE(PG8_SA(0, 0), cA, voffA); PG8_STAGE(PG8_SA(0, 1), cA + hstep, voffA);
        if (wr == 1) PG8_BAR;
        PG8_WAIT_V(2); PG8_BAR;
        PG8_STAGE(PG8_SB(1, 0), cB + kstep, voffB); PG8_STAGE(PG8_SA(1, 0), cA + kstep, voffA); PG8_STAGE(PG8_SB(1, 1), cB + hstep + kstep, voffB);
        PG8_WAIT_V(6); PG8_BAR;
    } else {
        PG8_STAGE(PG8_SB(0, 0), cB, voffB); PG8_STAGE(PG8_SA(0, 0), cA, voffA); PG8_STAGE(PG8_SB(0, 1), cB + hstep, voffB); PG8_STAGE(PG8_SA(0, 1), cA + hstep, voffA);
        if (wr == 1) PG8_BAR;
        PG8_WAIT_V(4); PG8_BAR;
        PG8_STAGE(PG8_SB(1, 0), cB + kstep, voffB); PG8_STAGE(PG8_SA(1, 0), cA + kstep, voffA); PG8_STAGE(PG8_SB(1, 1), cB + hstep + kstep, voffB);
        PG8_WAIT_V(6); PG8_BAR;
    }
    for (;;) {
        const bool has_next = S.next(ui + 1, nxt);
        const char* nA = has_next ? (const char*)g.A + (size_t)nxt.pm * tstep + (size_t)nxt.k0 * 2 : cA; const char* nB = has_next ? (const char*)g.Bt + (size_t)nxt.pn * tstep + (size_t)nxt.k0 * 2 : cB;
        for (int t = 0; t < nt; t += 2) {
            const bool last = (t == nt - 2);
            const char* a1 = cA + (size_t)(t + 1) * kstep;
            const char* a2 = last ? nA : cA + (size_t)(t + 2) * kstep; const char* b2 = last ? nB : cB + (size_t)(t + 2) * kstep;
            const char* a3 = a2 + kstep; const char* b3 = b2 + kstep;
            if (last && has_next) S.a_ready(nxt);
            if constexpr (SP2) {
            PG8_LDB(B0, 0, 0); PG8_LDB(B1, 0, 1); PG8_SCHED; PG8_LDA(At, 0, 0); PG8_STAGE(PG8_SA(1, 1), a1 + hstep, voffA);
            PG8_WAIT_V(8); PG8_WAIT_L(0); PG8_BAR; PG8_MMA(0, 0, At, B0); PG8_MMA(0, 1, At, B1); PG8_BAR; PG8_SCHED;
            PG8_LDA(At, 0, 1); PG8_STAGE(PG8_SB(0, 0), b2, voffB); PG8_STAGE(PG8_SB(0, 1), b2 + hstep, voffB); PG8_STAGE(PG8_SA(0, 0), a2, voffA);
            PG8_WAIT_V(8); PG8_WAIT_L(0); PG8_BAR; PG8_MMA(1, 0, At, B0); PG8_MMA(1, 1, At, B1); PG8_BAR; PG8_SCHED;
            PG8_LDB(B0, 1, 0); PG8_LDB(B1, 1, 1); PG8_SCHED; PG8_LDA(At, 1, 0); PG8_STAGE(PG8_SA(0, 1), a2 + hstep, voffA);
            PG8_WAIT_V(8); PG8_WAIT_L(0); PG8_BAR; PG8_MMA(0, 0, At, B0); PG8_MMA(0, 1, At, B1); PG8_BAR; PG8_SCHED;
            PG8_LDA(At, 1, 1); PG8_STAGE(PG8_SB(1, 0), b3, voffB); PG8_STAGE(PG8_SB(1, 1), b3 + hstep, voffB); PG8_STAGE(PG8_SA(1, 0), a3, voffA);
            PG8_WAIT_V(8); PG8_WAIT_L(0); PG8_BAR; PG8_MMA(1, 0, At, B0); PG8_MMA(1, 1, At, B1); PG8_BAR; PG8_SCHED;
            } else {
            PG8_LDB(B0, 0, 0); PG8_SCHED; PG8_LDA(At, 0, 0); PG8_STAGE(PG8_SA(1, 1), a1 + hstep, voffA);
            PG8_WAIT_L(8); PG8_BAR; PG8_WAIT_L(0); PG8_MMA(0, 0, At, B0); PG8_BAR; PG8_SCHED;
            PG8_LDB(B1, 0, 1); PG8_STAGE(PG8_SB(0, 0), b2, voffB);
            PG8_BAR; PG8_WAIT_L(0); PG8_MMA(0, 1, At, B1); PG8_BAR;
            PG8_LDA(At, 0, 1); PG8_STAGE(PG8_SA(0, 0), a2, voffA);
            PG8_BAR; PG8_WAIT_L(0); PG8_MMA(1, 0, At, B0); PG8_BAR; PG8_SCHED;
            PG8_STAGE(PG8_SB(0, 1), b2 + hstep, voffB);
            PG8_WAIT_V(6); PG8_BAR; PG8_MMA(1, 1, At, B1); PG8_BAR;
            PG8_LDB(B0, 1, 0); PG8_SCHED; PG8_LDA(At, 1, 0); PG8_STAGE(PG8_SA(0, 1), a2 + hstep, voffA);
            PG8_WAIT_L(8); PG8_BAR; PG8_WAIT_L(0); PG8_MMA(0, 0, At, B0); PG8_BAR; PG8_SCHED;
            PG8_LDB(B1, 1, 1); PG8_STAGE(PG8_SB(1, 0), b3, voffB);
            PG8_BAR; PG8_WAIT_L(0); PG8_MMA(0, 1, At, B1); PG8_BAR;
            PG8_LDA(At, 1, 1); PG8_STAGE(PG8_SA(1, 0), a3, voffA);
            PG8_BAR; PG8_WAIT_L(0); PG8_MMA(1, 0, At, B0); PG8_BAR; PG8_SCHED;
            PG8_STAGE(PG8_SB(1, 1), b3 + hstep, voffB);
            PG8_WAIT_V(6); PG8_BAR; PG8_MMA(1, 1, At, B1); PG8_BAR;
            }
        }
        if constexpr (ALIGN_EPI) { if (wr == 0) PG8_BAR; }
        if constexpr (!Epi::AFTER_DRAIN) { E(acc, cur, wr, wc, fr, fq); S.done(cur); }
        if (!has_next) break;
#pragma unroll
        for (int a = 0; a < 2; ++a)
#pragma unroll
            for (int b = 0; b < 2; ++b)
#pragma unroll
                for (int m = 0; m < 4; ++m)
#pragma unroll
                    for (int n = 0; n < 2; ++n) acc[a][b][m][n] = (f32x4){0.f, 0.f, 0.f, 0.f};
        cur = nxt; cA = nA; cB = nB; ++ui;
        if constexpr (ALIGN_EPI) { if (wr == 1) PG8_BAR; }
    }
    PG8_WAIT_V(0);
    if constexpr (!ALIGN_EPI) { if (wr == 0) PG8_BAR; }
    PG8_BAR;
    if constexpr (Epi::AFTER_DRAIN) { E.fused(acc, cur, wr, wc, fr, fq, lds, wid, lane); S.done(cur); }
#undef PG8_SA
#undef PG8_SB
#undef PG8_STAGE
#undef PG8_LDA
#undef PG8_LDB
#undef PG8_MMA
#undef PG8_WAIT_V
#undef PG8_WAIT_L
#undef PG8_BAR
#undef PG8_SCHED
}
}
#ifndef REP_LAT
#define REP_LAT 1
#endif
#ifndef REP_CTX
#define REP_CTX 1
#endif
constexpr int D = 2048, NCTX = 8192, M = 10240, MK = 10752, DEPTH = 4, NWAVES = 8;
constexpr int IN_W = 4960, IN_WP = 5120, FF = 5632;
constexpr int U_CQ = 0, U_CKV = 768, U_KR = 1280, U_GQKV = 1344, U_GZ = 1344 + 1536, U_GB = 1344 + 2048, U_GA = 1344 + 2056, U_SZ = 3408, U_SXBC = 3408 + 512, U_SDT = 3408 + 1536;
constexpr float EPS = 1e-6f;
constexpr int NPH_L = 11, NPHASES = 2 + DEPTH * NPH_L;
constexpr size_t O_YP = 0, O_YS = 16777216, O_CKV = 20971520, O_KR = 37748736, O_SG = 39845888, O_SS = 56623104;
constexpr size_t MiB = 1u << 20;
constexpr size_t WS_CTL = 0, CTL_ZERO_BYTES = 1 * MiB;
constexpr size_t WL_IN = 0, WL_UQ = WL_IN + (size_t)IN_WP * D * 2, WL_UKV = WL_UQ + (size_t)1536 * 768 * 2, WL_OUT = WL_UKV + (size_t)2048 * 512 * 2,
                 WL_GU = WL_OUT + (size_t)D * D * 2, WL_DN = WL_GU + (size_t)2 * FF * D * 2, WL_SIZE = WL_DN + (size_t)D * FF * 2;
constexpr size_t WS_W = 2 * MiB;
constexpr size_t WS_MODS = WS_W + 4 * WL_SIZE;
constexpr size_t WS_H = WS_MODS + 1 * MiB;
constexpr size_t WS_U = WS_H + (size_t)M * D * 2;
constexpr size_t WS_USIDE = WS_U + (size_t)M * IN_WP * 2;
constexpr size_t WS_CQN = WS_USIDE + (size_t)M * 32 * 4;
constexpr size_t WS_CKVN = WS_CQN + (size_t)M * 768 * 2;
constexpr size_t WS_QRAW = WS_CKVN + (size_t)MK * 512 * 2;
constexpr size_t WS_KN = WS_QRAW + (size_t)M * 1536 * 4;
constexpr size_t WS_VT = WS_KN + (size_t)MK * 1024 * 4;
constexpr size_t WS_QB = WS_VT + (size_t)1024 * MK * 2;
constexpr size_t WS_KB = WS_QB + (size_t)M * 1536 * 2;
constexpr size_t WS_GQ = WS_KB + (size_t)MK * 1536 * 2;
constexpr size_t WS_GBG = WS_GQ + (size_t)3 * M * 512 * 4;
constexpr size_t WS_GO = WS_GBG + (size_t)2 * M * 8 * 4;
constexpr size_t WS_XBC = WS_GO + (size_t)2 * M * 512 * 4;
constexpr size_t WS_SDT = WS_XBC + (size_t)M * 1024 * 4;
constexpr size_t WS_SY = WS_SDT + (size_t)2 * M * 16 * 4;
constexpr size_t WS_MIX = WS_SY + (size_t)2 * M * 512 * 4;
constexpr size_t WS_ACT = WS_MIX + (size_t)M * D * 2;
constexpr size_t WS_GCH = WS_ACT + (size_t)M * FF * 2;
constexpr size_t WS_SREC = WS_GCH + (size_t)1280 * 90368;
constexpr size_t WS_SSH = WS_SREC + (size_t)1280 * 66560;
constexpr size_t WS_PART = WS_SSH + (size_t)160 * 65536;
constexpr size_t WS_X = WS_PART + (size_t)4 * 2048 * 2048 * 4;
constexpr size_t WS_END = WS_X + (size_t)M * D * 2;
constexpr int CW_BAR = 4096;
constexpr int RING_BYTES = 131072, LDS_BYTES = 163840, LDSCTL_OFF = LDS_BYTES - 512, MISC_OFF = LDSCTL_OFF + 320;

#define GAS __attribute__((address_space(1)))
#define LAS __attribute__((address_space(3)))
typedef unsigned short bf16;
typedef unsigned v4u __attribute__((ext_vector_type(4)));
typedef unsigned v2u __attribute__((ext_vector_type(2)));
typedef float f32x4 __attribute__((ext_vector_type(4)));
typedef float f32x2 __attribute__((ext_vector_type(2)));
typedef short bf16x8 __attribute__((ext_vector_type(8)));
typedef GAS unsigned gu32;
#define RLX_AGENT __ATOMIC_RELAXED, __HIP_MEMORY_SCOPE_AGENT
#define MEMBAR() asm volatile("" ::: "memory")
#define WG_BAR() do { asm volatile("s_waitcnt lgkmcnt(0)" ::: "memory"); __builtin_amdgcn_s_barrier(); asm volatile("" ::: "memory"); } while (0)
#define LDS_WAIT() asm volatile("s_waitcnt lgkmcnt(0)" ::: "memory")
#define VM_WAIT() asm volatile("s_waitcnt vmcnt(0)" ::: "memory")
__device__ __forceinline__ unsigned pk2(float lo, float hi) { unsigned r; asm("v_cvt_pk_bf16_f32 %0, %1, %2" : "=v"(r) : "v"(lo), "v"(hi)); return r; }
__device__ __forceinline__ unsigned f2bf(float f) { return pk2(f, 0.f) & 0xffffu; }
__device__ __forceinline__ float wave_sum(float v) {
#pragma unroll
    for (int o = 1; o < 64; o <<= 1) v += __shfl_xor(v, o);
    return v;
}
__device__ __forceinline__ float half_sum(float v) {
#pragma unroll
    for (int o = 1; o < 32; o <<= 1) v += __shfl_xor(v, o);
    return v;
}
__device__ __forceinline__ f32x4 bf4(v2u w) { f32x4 r; r.x = __builtin_bit_cast(float, w.x << 16); r.y = __builtin_bit_cast(float, w.x & 0xffff0000u); r.z = __builtin_bit_cast(float, w.y << 16); r.w = __builtin_bit_cast(float, w.y & 0xffff0000u); return r; }
__device__ __forceinline__ float bf1(bf16 v) { return __builtin_bit_cast(float, (unsigned)v << 16); }
__device__ __forceinline__ float silu(float x) { return x * __builtin_amdgcn_rcpf(1.0f + __expf(-x)); }
__device__ __forceinline__ float softplus(float x) { return x > 20.f ? x : log1pf(expf(x)); }

#define XB_TMO      128
#define XB_XCNT(j)  (256  + 64 * (j))
#define XB_XSUB(j)  (1280 + 64 * (j))
#define XB_XGEN(j)  (2304 + 64 * (j))
#define XB_TOP      3328
#define XB_TOPGEN   3392
#define XCD_BAR_WORDS 3456
#define XB_SPIN_CAP (1u << 18)

__device__ __forceinline__ unsigned xb_ld(unsigned* p)              { return __hip_atomic_load(p, __ATOMIC_RELAXED, __HIP_MEMORY_SCOPE_AGENT); }
__device__ __forceinline__ unsigned xb_add(unsigned* p, unsigned v) { return __hip_atomic_fetch_add(p, v, __ATOMIC_RELAXED, __HIP_MEMORY_SCOPE_AGENT); }
__device__ __forceinline__ unsigned xb_xcc_id() { return (unsigned)__builtin_amdgcn_s_getreg((3 << 11) | 20) & 0xFu; }
#define XB_SPIN(cond, bar) do { unsigned _sp = 0; while (cond) { __builtin_amdgcn_s_sleep(1); \
    if ((++_sp & 255u) == 0u) { if (xb_ld(&(bar)[XB_TMO])) break; if (_sp > XB_SPIN_CAP) { atomicAdd(&(bar)[XB_TMO], 1u); break; } } } } while (0)

struct XcdBarrier {
    unsigned* bar; unsigned x;
    volatile LAS unsigned* st;
    int wv;
};

__device__ __forceinline__ XcdBarrier xcd_barrier_post(unsigned* bar, volatile LAS unsigned* st) {
    XcdBarrier b; b.bar = bar; b.x = xb_xcc_id(); b.st = st;
    if (threadIdx.x == 0) (void)xb_add(&bar[XB_XCNT(b.x)], 1u);
    return b;
}
__device__ __forceinline__ void xcd_barrier_complete(unsigned* bar, unsigned x, unsigned& nloc, unsigned& nx) {
    const unsigned G = gridDim.x * gridDim.y * gridDim.z;
    unsigned sum, cnt, mine, sp = 0u;
    for (;;) {
        sum = 0u; cnt = 0u; mine = 0u;
#pragma unroll
        for (unsigned j = 0; j < 16; ++j) { const unsigned c = xb_ld(&bar[XB_XCNT(j)]); sum += c; cnt += (c > 0u) ? 1u : 0u; mine = (j == x) ? c : mine; }
        if (sum == G) break;
        __builtin_amdgcn_s_sleep(1);
        if ((++sp & 255u) == 0u) { if (xb_ld(&bar[XB_TMO])) break; if (sp > XB_SPIN_CAP) { atomicAdd(&bar[XB_TMO], 1u); break; } }
    }
    nloc = mine > 0u ? mine : 1u; nx = cnt > 0u ? cnt : 1u;
}

__device__ __forceinline__ void xcd_barrier(const XcdBarrier& b) {
    asm volatile("s_waitcnt vmcnt(0)" ::: "memory");
    __syncthreads();
    unsigned xm_ = ~0u; asm volatile("" : "+s"(xm_));
    if (b.wv == 0 && __builtin_amdgcn_mbcnt_hi(xm_, __builtin_amdgcn_mbcnt_lo(xm_, 0u)) == 0u) {
        unsigned* bar = b.bar;
        __builtin_amdgcn_s_waitcnt(0);
        unsigned nloc = b.st[0], nx = b.st[1];
        if (nloc == 0u) { xcd_barrier_complete(bar, b.x, nloc, nx); b.st[0] = nloc; b.st[1] = nx; }
        const unsigned old = xb_add(&bar[XB_XSUB(b.x)], 1u);
        const unsigned gen = old / nloc;
        if (old + 1u == (gen + 1u) * nloc) {
            __builtin_amdgcn_fence(__ATOMIC_RELEASE, "agent");
            asm volatile("s_waitcnt vmcnt(0)" ::: "memory");
            const unsigned og = xb_add(&bar[XB_TOP], 1u);
            const unsigned tg = og / nx;
            if (og + 1u == (tg + 1u) * nx) xb_add(&bar[XB_TOPGEN], 1u);
            else XB_SPIN(xb_ld(&bar[XB_TOPGEN]) == tg, bar);
            __builtin_amdgcn_fence(__ATOMIC_ACQUIRE, "agent");
            xb_add(&bar[XB_XGEN(b.x)], 1u);
            asm volatile("s_waitcnt vmcnt(0)" ::: "memory");
        } else {
            XB_SPIN(xb_ld(&bar[XB_XGEN(b.x)]) == gen, bar);
            __builtin_amdgcn_fence(__ATOMIC_ACQUIRE, "agent");
            asm volatile("s_waitcnt vmcnt(0)" ::: "memory");
        }
    }
    __syncthreads();
}
struct Args { const float* in[32]; float* out; unsigned char* ws; int ph_lo, ph_hi; };
#define CAS __attribute__((address_space(4)))
typedef const float* const CAS* kin_t;
struct Ctx { kin_t in; float* out; unsigned char* ws; };

__device__ __forceinline__ void transpose_item(const float* __restrict__ W, int K, int N, bf16* WT, int k0, int n0, int drow0, LAS float* scr, int lane) {
#pragma unroll 8
    for (int i = 0; i < 32; ++i) { const int kk = 2 * i + (lane >> 5); scr[kk * 33 + (lane & 31)] = W[(size_t)(k0 + kk) * N + n0 + (lane & 31)]; }
    LDS_WAIT(); asm volatile("" ::: "memory");
    const int c = lane & 7;
#pragma unroll
    for (int j = 0; j < 4; ++j) { const int n = (lane >> 3) + 8 * j; const LAS float* s = scr + (8 * c) * 33 + n;
        v4u o; o.x = pk2(s[0 * 33], s[1 * 33]); o.y = pk2(s[2 * 33], s[3 * 33]); o.z = pk2(s[4 * 33], s[5 * 33]); o.w = pk2(s[6 * 33], s[7 * 33]);
        *(GAS v4u*)(WT + (size_t)(drow0 + n) * K + k0 + 8 * c) = o; }
    LDS_WAIT(); asm volatile("" ::: "memory");
}
constexpr size_t WLE_IN = 0, WLE_UQ = WLE_IN + (size_t)IN_WP * D, WLE_KV = WLE_UQ + (size_t)1536 * 768, WLE_OUT = WLE_KV + (size_t)2048 * 512,
                 WLE_GU = WLE_OUT + (size_t)D * D, WLE_DN = WLE_GU + (size_t)2 * FF * D, WLE_SIZE = WLE_DN + (size_t)D * FF;
static_assert(WLE_SIZE * 2 == WL_SIZE, "weight map");

__device__ __forceinline__ void ph_prologue(const Ctx& A, LAS unsigned char* lds, int tid, int lane, int wave, int vcu, int G) {
    const int gw = vcu * NWAVES + wave, NGW = G * NWAVES;
    LAS float* scr = (LAS float*)(lds + wave * 8704);
    constexpr int I_IN = 32 * 155, I_UQ = 12 * 48, I_KV = 8 * 64, I_OUT = 32 * 64, I_GU = 32 * 352, I_DN = 88 * 64, I_L = I_IN + I_UQ + I_KV + I_OUT + I_GU + I_DN;
    for (int it = gw; it < DEPTH * I_L; it += NGW) {
        const int l = it / I_L; int r = it - l * I_L;
        bf16* wl = (bf16*)(A.ws + WS_W) + (size_t)l * WLE_SIZE;
        if (r < I_IN) { const int kb = r / 155, nb = r - kb * 155; transpose_item(A.in[12] + (size_t)l * D * IN_W, D, IN_W, wl + WLE_IN, 64 * kb, 32 * nb, 32 * nb, scr, lane); continue; } r -= I_IN;
        if (r < I_UQ) { const int kb = r / 48, nb = r - kb * 48; transpose_item(A.in[15] + (size_t)l * 768 * 1536, 768, 1536, wl + WLE_UQ, 64 * kb, 32 * nb, 32 * nb, scr, lane); continue; } r -= I_UQ;
        if (r < I_KV) { const int kb = r / 64, nb = r - kb * 64; const int n0 = 32 * nb, hh = n0 >> 8, c = n0 & 255; const int dr = (c < 128 ? 0 : 1024) + hh * 128 + (c & 127);
                        transpose_item(A.in[17] + (size_t)l * 512 * 2048, 512, 2048, wl + WLE_KV, 64 * kb, n0, dr, scr, lane); continue; } r -= I_KV;
        if (r < I_OUT) { const int kb = r / 64, nb = r - kb * 64; transpose_item(A.in[13] + (size_t)l * D * D, D, D, wl + WLE_OUT, 64 * kb, 32 * nb, 32 * nb, scr, lane); continue; } r -= I_OUT;
        if (r < I_GU) { const int kb = r / 352, nb = r - kb * 352; const int n0 = 32 * nb; int dr; if (n0 < FF) dr = (n0 >> 7) * 256 + (n0 & 127); else { const int n1 = n0 - FF; dr = (n1 >> 7) * 256 + 128 + (n1 & 127); }
                        transpose_item(A.in[30] + (size_t)l * D * 2 * FF, D, 2 * FF, wl + WLE_GU, 64 * kb, n0, dr, scr, lane); continue; } r -= I_GU;
        { const int kb = r / 64, nb = r - kb * 64; transpose_item(A.in[31] + (size_t)l * FF * D, FF, D, wl + WLE_DN, 64 * kb, 32 * nb, 32 * nb, scr, lane); }
    }
    { const int gt = vcu * 512 + tid, NGT = G * 512;
      for (int i = gt; i < DEPTH * 40960; i += NGT) { const int l = i / 40960, r = i - l * 40960; *(GAS v4u*)((bf16*)(A.ws + WS_W) + (size_t)l * WLE_SIZE + WLE_IN + (size_t)IN_W * D + (size_t)r * 8) = (v4u){0u, 0u, 0u, 0u}; }
      const GAS f32x4* xp = (const GAS f32x4*)A.in[0]; const GAS f32x4* xs = (const GAS f32x4*)A.in[1]; GAS v2u* o = (GAS v2u*)(A.ws + WS_X);
      for (int i = gt; i < 4194304; i += NGT) { const f32x4 v = xp[i]; v2u w; w.x = pk2(v.x, v.y); w.y = pk2(v.z, v.w); o[i] = w; }
      for (int i = gt; i < 1048576; i += NGT) { const f32x4 v = xs[i]; v2u w; w.x = pk2(v.x, v.y); w.y = pk2(v.z, v.w); o[4194304 + i] = w; } }
    LAS float* scond = (LAS float*)(lds + 81920);
    LAS float* red = (LAS float*)(lds + 81920 + 24576);
    for (int i = tid; i < 3 * 2048; i += 512) { const int r = i >> 11, k = i & 2047; const float c = r == 0 ? A.in[7][k] : A.in[6][(r - 1) * 2048 + k]; scond[i] = silu(c); }
    __syncthreads();
    float* mods = (float*)(A.ws + WS_MODS);
    for (int item = vcu; item < 768; item += G) {
        const int l = item / 192, j0 = (item - l * 192) * 64;
        const float* w = A.in[10] + (size_t)l * 2048 * 12288 + j0 + lane;
        float a0 = 0, a1 = 0, a2 = 0;
        const int kbeg = wave * 256;
#pragma unroll 16
        for (int k = kbeg; k < kbeg + 256; ++k) { const float v = w[(size_t)k * 12288]; a0 += scond[k] * v; a1 += scond[2048 + k] * v; a2 += scond[4096 + k] * v; }
        red[(wave * 3 + 0) * 64 + lane] = a0; red[(wave * 3 + 1) * 64 + lane] = a1; red[(wave * 3 + 2) * 64 + lane] = a2;
        __syncthreads();
        if (tid < 192) { const int r = tid >> 6, j = tid & 63; float s = 0.f;
#pragma unroll
            for (int w8 = 0; w8 < 8; ++w8) s += red[(w8 * 3 + r) * 64 + j];
            mods[(size_t)(l * 3 + r) * 12288 + j0 + j] = s + A.in[11][(size_t)l * 12288 + j0 + j]; }
        __syncthreads();
    }
}

__device__ __forceinline__ void ph_norm(bf16* X_, const float* g_, const float* mods_l_, int shift_idx, bf16* H_, const float* part_, const float* pgate_, int lane, int gw, int NGW) {
    GAS bf16* X = (GAS bf16*)X_; const GAS float* g = (const GAS float*)g_; const GAS float* mods_l = (const GAS float*)mods_l_; GAS bf16* H = (GAS bf16*)H_;
    const GAS bf16* part = (const GAS bf16*)part_; const GAS float* pgate = (const GAS float*)pgate_;
    constexpr size_t PS = (size_t)2048 * 2048;
    f32x4 ga[8], hb[8];
    { const GAS float* sh = mods_l + shift_idx * 2048; const GAS float* sc = sh + 2048;
#pragma unroll
      for (int j = 0; j < 8; ++j) { const int c = 4 * lane + 256 * j; ga[j] = *(const GAS f32x4*)(g + c) * (*(const GAS f32x4*)(sc + c) + 1.0f); hb[j] = *(const GAS f32x4*)(sh + c); } }
    for (int m0 = gw; m0 < M; m0 += 5 * NGW) {
        v2u raw[5][8];
#pragma unroll
        for (int k = 0; k < 5; ++k) { const int m = m0 + k * NGW; if (m < M) { const GAS v2u* xr = (const GAS v2u*)(X + (size_t)m * D) + lane;
#pragma unroll
            for (int j = 0; j < 8; ++j) raw[k][j] = xr[64 * j]; } }
        MEMBAR();
#pragma unroll
        for (int k = 0; k < 5; ++k) { const int m = m0 + k * NGW; if (m >= M) break;
            const int cr = m < NCTX ? 0 : 1 + ((m - NCTX) >> 10);
            f32x4 v[8]; float ss = 0.f;
#pragma unroll
            for (int j = 0; j < 8; ++j) v[j] = bf4(raw[k][j]);
            if (part_ != nullptr && m >= NCTX) {
                GAS v2u* xr = (GAS v2u*)(X + (size_t)m * D) + lane;
                const GAS v2u* pp = (const GAS v2u*)(part + (size_t)(m - NCTX) * 2048) + lane; const GAS f32x4* gp = (const GAS f32x4*)(pgate + (size_t)cr * 12288) + lane;
#pragma unroll
                for (int j = 0; j < 8; ++j) { const f32x4 p = (bf4(pp[64 * j]) + bf4(pp[PS / 4 + 64 * j])) + (bf4(pp[2 * (PS / 4) + 64 * j]) + bf4(pp[3 * (PS / 4) + 64 * j])); v[j] = v[j] + gp[64 * j] * p; v2u w; w.x = pk2(v[j].x, v[j].y); w.y = pk2(v[j].z, v[j].w); xr[64 * j] = w; } }
#pragma unroll
            for (int j = 0; j < 8; ++j) ss += (v[j].x * v[j].x + v[j].y * v[j].y) + (v[j].z * v[j].z + v[j].w * v[j].w);
            const float rstd = 1.0f / sqrtf(wave_sum(ss) * (1.0f / D) + EPS);
            if (cr == 0) {
#pragma unroll
                for (int j = 0; j < 8; ++j) { const int c = 4 * lane + 256 * j; const f32x4 o = v[j] * rstd * ga[j] + hb[j]; v2u w; w.x = pk2(o.x, o.y); w.y = pk2(o.z, o.w); *(GAS v2u*)(H + (size_t)m * D + c) = w; } }
            else { const GAS float* sh = mods_l + (size_t)cr * 12288 + shift_idx * 2048; const GAS float* sc = sh + 2048;
#pragma unroll
                for (int j = 0; j < 8; ++j) { const int c = 4 * lane + 256 * j; const f32x4 g4 = *(const GAS f32x4*)(g + c), s4 = *(const GAS f32x4*)(sc + c), h4 = *(const GAS f32x4*)(sh + c);
                    const f32x4 o = v[j] * rstd * g4 * (s4 + 1.0f) + h4; v2u w; w.x = pk2(o.x, o.y); w.y = pk2(o.z, o.w); *(GAS v2u*)(H + (size_t)m * D + c) = w; } }
        }
    }
}
__device__ __forceinline__ void ph_final(const bf16* X_, float* OUT_, const float* part_, const float* pgate_, int lane, int gw, int NGW) {
    const GAS bf16* X = (const GAS bf16*)X_; GAS float* OUT = (GAS float*)OUT_; const GAS bf16* part = (const GAS bf16*)part_; const GAS float* pgate = (const GAS float*)pgate_;
    constexpr size_t PS = (size_t)2048 * 2048;
    for (int m = NCTX + gw; m < M; m += NGW) {
        const int cr = 1 + ((m - NCTX) >> 10);
        const GAS v2u* xr = (const GAS v2u*)(X + (size_t)m * D) + lane; GAS f32x4* orow = (GAS f32x4*)(OUT + (size_t)m * D) + lane;
        const GAS v2u* pp = (const GAS v2u*)(part + (size_t)(m - NCTX) * 2048) + lane; const GAS f32x4* gp = (const GAS f32x4*)(pgate + (size_t)cr * 12288) + lane;
#pragma unroll
        for (int j = 0; j < 8; ++j) { const f32x4 p = (bf4(pp[64 * j]) + bf4(pp[PS / 4 + 64 * j])) + (bf4(pp[2 * (PS / 4) + 64 * j]) + bf4(pp[3 * (PS / 4) + 64 * j])); orow[64 * j] = bf4(xr[64 * j]) + gp[64 * j] * p; }
    }
}

__device__ __forceinline__ int seq_of(int m) { return (m < 0 || m >= M) ? -1 : (m < NCTX ? (m >> 8) : 32 + ((m - NCTX) >> 10)); }
__device__ __forceinline__ void ph_prep(const Ctx& A, int l, int lane, int gw, int NGW) {
    const GAS bf16* U = (const GAS bf16*)(A.ws + WS_U); const GAS float* USIDE = (const GAS float*)(A.ws + WS_USIDE);
    GAS bf16* CQN = (GAS bf16*)(A.ws + WS_CQN); GAS bf16* CKVN = (GAS bf16*)(A.ws + WS_CKVN);
    GAS bf16* GQ = (GAS bf16*)(A.ws + WS_GQ); GAS bf16* GK = GQ + (size_t)M * 512; GAS bf16* GV = GK + (size_t)M * 512;
    GAS float* GBETA = (GAS float*)(A.ws + WS_GBG); GAS float* GG = GBETA + (size_t)M * 8;
    GAS bf16* XBC = (GAS bf16*)(A.ws + WS_XBC); GAS float* SDT = (GAS float*)(A.ws + WS_SDT); GAS float* SDA = SDT + (size_t)M * 16;
    GAS float* OUT = (GAS float*)A.out;
    const GAS float* qn_g = (const GAS float*)(A.in[14] + l * 768); const GAS float* kvn_g = (const GAS float*)(A.in[16] + l * 512);
    const GAS float* gconv = (const GAS float*)(A.in[20] + (size_t)l * 5 * 1536); const GAS float* sconv = (const GAS float*)(A.in[24] + (size_t)l * 5 * 1024); const GAS float* sconvb = (const GAS float*)(A.in[25] + l * 1024);
    for (int run = gw; run < M / 5; run += NGW) {
        const int m0 = run * 5;
        int l4 = 4 * lane; asm volatile("" : "+v"(l4));
        { f32x4 vq[5][3], vk[5][2]; float kr[5];
#pragma unroll
          for (int r = 0; r < 5; ++r) { const GAS bf16* u = U + (size_t)(m0 + r) * IN_WP;
#pragma unroll
              for (int i = 0; i < 3; ++i) vq[r][i] = bf4(*(const GAS v2u*)(u + U_CQ + l4 + 256 * i));
#pragma unroll
              for (int i = 0; i < 2; ++i) vk[r][i] = bf4(*(const GAS v2u*)(u + U_CKV + l4 + 256 * i));
              kr[r] = bf1(u[U_KR + lane]); }
          float sq[5], sk[5];
#pragma unroll
          for (int r = 0; r < 5; ++r) { float a = 0.f, c = 0.f;
#pragma unroll
              for (int i = 0; i < 3; ++i) a += (vq[r][i].x * vq[r][i].x + vq[r][i].y * vq[r][i].y) + (vq[r][i].z * vq[r][i].z + vq[r][i].w * vq[r][i].w);
#pragma unroll
              for (int i = 0; i < 2; ++i) c += (vk[r][i].x * vk[r][i].x + vk[r][i].y * vk[r][i].y) + (vk[r][i].z * vk[r][i].z + vk[r][i].w * vk[r][i].w);
              sq[r] = a; sk[r] = c; }
#pragma unroll
          for (int o = 1; o < 64; o <<= 1) {
#pragma unroll
              for (int r = 0; r < 5; ++r) { sq[r] += __shfl_xor(sq[r], o); sk[r] += __shfl_xor(sk[r], o); } }
#pragma unroll
          for (int r = 0; r < 5; ++r) { const int m = m0 + r; const bool ctx = m < NCTX; const int b = m >> 8, t = m & 255;
              const float rq = 1.0f / sqrtf(sq[r] * (1.0f / 768.f) + EPS), rk = 1.0f / sqrtf(sk[r] * (1.0f / 512.f) + EPS);
#pragma unroll
              for (int i = 0; i < 3; ++i) { const int c = l4 + 256 * i; const f32x4 o = vq[r][i] * rq * *(const GAS f32x4*)(qn_g + c); v2u w; w.x = pk2(o.x, o.y); w.y = pk2(o.z, o.w); *(GAS v2u*)(CQN + (size_t)m * 768 + c) = w; }
#pragma unroll
              for (int i = 0; i < 2; ++i) { const int c = l4 + 256 * i; const f32x4 o = vk[r][i] * rk * *(const GAS f32x4*)(kvn_g + c); v2u w; w.x = pk2(o.x, o.y); w.y = pk2(o.z, o.w); *(GAS v2u*)(CKVN + (size_t)m * 512 + c) = w;
                  if (ctx) *(GAS f32x4*)(OUT + O_CKV + ((size_t)(b * 4 + l) * 256 + t) * 512 + c) = o; }
              if (ctx) OUT[O_KR + ((size_t)(b * 4 + l) * 256 + t) * 64 + lane] = kr[r]; } }
        MEMBAR();
        { float gb[5], ga[5], sd[5];
#pragma unroll
          for (int r = 0; r < 5; ++r) { const GAS float* us = USIDE + (size_t)(m0 + r) * 32; gb[r] = us[lane & 7]; ga[r] = us[8 + (lane & 7)]; sd[r] = us[16 + (lane & 15)]; }
          const float alog = expf(((const GAS float*)A.in[21])[l * 8 + (lane & 7)]), dtb = ((const GAS float*)A.in[22])[l * 8 + (lane & 7)];
          const float salog = expf(((const GAS float*)A.in[26])[l * 16 + (lane & 15)]), sdtb = ((const GAS float*)A.in[27])[l * 16 + (lane & 15)];
#pragma unroll
          for (int r = 0; r < 5; ++r) { const int m = m0 + r;
              if (lane < 8) { GBETA[(size_t)m * 8 + lane] = 1.0f / (1.0f + expf(-gb[r])); GG[(size_t)m * 8 + lane] = -alog * softplus(ga[r] + dtb); }
              if (lane < 16) { const float dt = softplus(sd[r] + sdtb); SDT[(size_t)m * 16 + lane] = dt; SDA[(size_t)m * 16 + lane] = -salog * dt; } } }
        MEMBAR();
        int sid[9];
#pragma unroll
        for (int jj = 0; jj < 9; ++jj) sid[jj] = seq_of(m0 - 2 + jj);
#pragma unroll
        for (int ci = 0; ci < 10; ++ci) {
            const int uoff = ci < 6 ? U_GQKV + 256 * ci : U_SXBC + 256 * (ci - 6);
            const GAS float* wp = ci < 6 ? gconv + 256 * ci : sconv + 256 * (ci - 6); const int wst = ci < 6 ? 1536 : 1024;
            f32x4 uw[9], w[5];
#pragma unroll
            for (int jj = 0; jj < 9; ++jj) { int mm = m0 - 2 + jj; mm = mm < 0 ? 0 : (mm >= M ? M - 1 : mm); uw[jj] = bf4(*(const GAS v2u*)(U + (size_t)mm * IN_WP + uoff + l4)); }
#pragma unroll
            for (int j = 0; j < 5; ++j) w[j] = *(const GAS f32x4*)(wp + j * wst + l4);
            f32x4 bias = (f32x4){0.f, 0.f, 0.f, 0.f}; if (ci >= 6) bias = *(const GAS f32x4*)(sconvb + 256 * (ci - 6) + l4);
#pragma unroll
            for (int r = 0; r < 5; ++r) { const int m = m0 + r; f32x4 acc = bias;
#pragma unroll
                for (int j = 0; j < 5; ++j) { const float mk = (sid[r + j] == sid[r + 2]) ? 1.0f : 0.0f; acc += (w[j] * mk) * uw[r + j]; }
                acc.x = silu(acc.x); acc.y = silu(acc.y); acc.z = silu(acc.z); acc.w = silu(acc.w);
                if (ci < 4) { const float ss = half_sum((acc.x * acc.x + acc.y * acc.y) + (acc.z * acc.z + acc.w * acc.w)); acc = acc * __builtin_amdgcn_rsqf(ss + EPS); }
                if (ci < 6) { GAS bf16* dst = ci < 2 ? GQ + (size_t)m * 512 + 256 * ci : (ci < 4 ? GK + (size_t)m * 512 + 256 * (ci - 2) : GV + (size_t)m * 512 + 256 * (ci - 4));
                    v2u w; w.x = pk2(acc.x, acc.y); w.y = pk2(acc.z, acc.w); *(GAS v2u*)(dst + l4) = w; }
                else { v2u w; w.x = pk2(acc.x, acc.y); w.y = pk2(acc.z, acc.w); *(GAS v2u*)(XBC + (size_t)m * 1024 + 256 * (ci - 6) + l4) = w; } }
            if (ci & 1) MEMBAR();
        }
    }
    for (int m = M + gw; m < MK; m += NGW) {
        const int j = m - M, b = j >> 8, t = j & 255; const GAS float* src = (const GAS float*)(A.in[2] + ((size_t)(b * 4 + l) * 256 + t) * 512);
#pragma unroll
        for (int i = 0; i < 2; ++i) { const int c = 4 * lane + 256 * i; const f32x4 v = *(const GAS f32x4*)(src + c); v2u w; w.x = pk2(v.x, v.y); w.y = pk2(v.z, v.w); *(GAS v2u*)(CKVN + (size_t)m * 512 + c) = w; }
    }
}

constexpr int FIN_TAB = 150000;
__device__ __forceinline__ void ph_finalize(const Ctx& A, int l, LAS unsigned char* lds, int tid, int lane, int gw, int NGW) {
    const GAS bf16* U = (const GAS bf16*)(A.ws + WS_U); const GAS bf16* QRAW = (const GAS bf16*)(A.ws + WS_QRAW); const GAS bf16* KN = (const GAS bf16*)(A.ws + WS_KN);
    GAS bf16* QB = (GAS bf16*)(A.ws + WS_QB); GAS bf16* KB = (GAS bf16*)(A.ws + WS_KB);
    const GAS float* q_g = (const GAS float*)(A.in[18] + l * 192); const GAS float* k_g = (const GAS float*)(A.in[19] + l * 192);
    const float QS = 0.07216878364870322f * 1.4426950408889634f;
    LAS float* tcos = (LAS float*)(lds + FIN_TAB); LAS float* tsin = tcos + 1024;
    for (int i = tid; i < 1024; i += NWAVES * 64) { const float ang = (float)(i >> 4) * powf(10000.f, -(float)(i & 15) * (1.0f / 16.f)); tcos[i] = cosf(ang); tsin[i] = sinf(ang); }
    __syncthreads();
    const int h = lane >> 3, sub = lane & 7;
    float qg[24], kg[24];
#pragma unroll
    for (int i = 0; i < 3; ++i)
#pragma unroll
        for (int j = 0; j < 8; ++j) { qg[i * 8 + j] = q_g[(sub + 8 * i) * 8 + j] * QS; kg[i * 8 + j] = k_g[(sub + 8 * i) * 8 + j]; }
    const bool hi = (sub >> 1) & 1;
    for (int m = gw; m < MK; m += NGW) {
        int s8 = sub * 8; asm volatile("" : "+v"(s8));
        const bool fresh = m < M, latent = fresh && m >= NCTX;
        float cs[8], sn[8];
        if (latent) { const int t = (m - NCTX) & 1023, pos = (sub >> 2) ? (t & 63) : (t >> 6); const LAS float* pc = tcos + pos * 16 + (sub & 1) * 8; const LAS float* ps = tsin + pos * 16 + (sub & 1) * 8;
            const f32x4 c0 = *(const LAS f32x4*)pc, c1 = *(const LAS f32x4*)(pc + 4), s0 = *(const LAS f32x4*)ps, s1 = *(const LAS f32x4*)(ps + 4);
            cs[0] = c0.x; cs[1] = c0.y; cs[2] = c0.z; cs[3] = c0.w; cs[4] = c1.x; cs[5] = c1.y; cs[6] = c1.z; cs[7] = c1.w; sn[0] = s0.x; sn[1] = s0.y; sn[2] = s0.z; sn[3] = s0.w; sn[4] = s1.x; sn[5] = s1.y; sn[6] = s1.z; sn[7] = s1.w; }
        else {
#pragma unroll
            for (int j = 0; j < 8; ++j) { cs[j] = 1.f; sn[j] = 0.f; } }
        const v4u kn0 = *(const GAS v4u*)(KN + (size_t)m * 1024 + h * 128 + s8), kn1 = *(const GAS v4u*)(KN + (size_t)m * 1024 + h * 128 + 64 + s8);
        float kr[8];
        if (fresh) { const v4u w = *(const GAS v4u*)(U + (size_t)m * IN_WP + U_KR + s8); const f32x4 a = bf4((v2u){w.x, w.y}), b = bf4((v2u){w.z, w.w}); kr[0] = a.x; kr[1] = a.y; kr[2] = a.z; kr[3] = a.w; kr[4] = b.x; kr[5] = b.y; kr[6] = b.z; kr[7] = b.w; }
        else { const GAS float* cp = (const GAS float*)(A.in[3] + ((size_t)(((m - M) >> 8) * 4 + l) * 256 + ((m - M) & 255)) * 64) + s8; const f32x4 a = *(const GAS f32x4*)cp, b = *(const GAS f32x4*)(cp + 4);
            kr[0] = a.x; kr[1] = a.y; kr[2] = a.z; kr[3] = a.w; kr[4] = b.x; kr[5] = b.y; kr[6] = b.z; kr[7] = b.w; }
        v4u qp[3];
        if (fresh) {
#pragma unroll
            for (int i = 0; i < 3; ++i) qp[i] = *(const GAS v4u*)(QRAW + (size_t)m * 1536 + h * 192 + 64 * i + s8); }
        { float x[24];
          { const f32x4 a = bf4((v2u){kn0.x, kn0.y}), b = bf4((v2u){kn0.z, kn0.w}), c = bf4((v2u){kn1.x, kn1.y}), d = bf4((v2u){kn1.z, kn1.w});
            x[0] = a.x; x[1] = a.y; x[2] = a.z; x[3] = a.w; x[4] = b.x; x[5] = b.y; x[6] = b.z; x[7] = b.w; x[8] = c.x; x[9] = c.y; x[10] = c.z; x[11] = c.w; x[12] = d.x; x[13] = d.y; x[14] = d.z; x[15] = d.w; }
#pragma unroll
          for (int j = 0; j < 8; ++j) x[16 + j] = kr[j];
          float ss = 0.f;
#pragma unroll
          for (int j = 0; j < 24; ++j) ss += x[j] * x[j];
          ss += __shfl_xor(ss, 1); ss += __shfl_xor(ss, 2); ss += __shfl_xor(ss, 4);
          const float rstd = 1.0f / sqrtf(ss * (1.0f / 192.f) + EPS);
#pragma unroll
          for (int j = 0; j < 24; ++j) x[j] *= rstd * kg[j];
#pragma unroll
          for (int j = 0; j < 8; ++j) { const float p = __shfl_xor(x[16 + j], 2); x[16 + j] = hi ? x[16 + j] * cs[j] + p * sn[j] : x[16 + j] * cs[j] - p * sn[j]; }
          GAS bf16* dst = KB + (size_t)m * 1536 + h * 192 + s8;
#pragma unroll
          for (int i = 0; i < 3; ++i) { v4u w; w.x = pk2(x[8 * i], x[8 * i + 1]); w.y = pk2(x[8 * i + 2], x[8 * i + 3]); w.z = pk2(x[8 * i + 4], x[8 * i + 5]); w.w = pk2(x[8 * i + 6], x[8 * i + 7]); *(GAS v4u*)(dst + 64 * i) = w; } }
        if (fresh) { float x[24];
#pragma unroll
          for (int i = 0; i < 3; ++i) { const f32x4 a = bf4((v2u){qp[i].x, qp[i].y}), b = bf4((v2u){qp[i].z, qp[i].w}); x[8 * i] = a.x; x[8 * i + 1] = a.y; x[8 * i + 2] = a.z; x[8 * i + 3] = a.w; x[8 * i + 4] = b.x; x[8 * i + 5] = b.y; x[8 * i + 6] = b.z; x[8 * i + 7] = b.w; }
          float ss = 0.f;
#pragma unroll
          for (int j = 0; j < 24; ++j) ss += x[j] * x[j];
          ss += __shfl_xor(ss, 1); ss += __shfl_xor(ss, 2); ss += __shfl_xor(ss, 4);
          const float rstd = 1.0f / sqrtf(ss * (1.0f / 192.f) + EPS);
#pragma unroll
          for (int j = 0; j < 24; ++j) x[j] *= rstd * qg[j];
#pragma unroll
          for (int j = 0; j < 8; ++j) { const float p = __shfl_xor(x[16 + j], 2); x[16 + j] = hi ? x[16 + j] * cs[j] + p * sn[j] : x[16 + j] * cs[j] - p * sn[j]; }
          GAS bf16* dst = QB + (size_t)m * 1536 + h * 192 + s8;
#pragma unroll
          for (int i = 0; i < 3; ++i) { v4u w; w.x = pk2(x[8 * i], x[8 * i + 1]); w.y = pk2(x[8 * i + 2], x[8 * i + 3]); w.z = pk2(x[8 * i + 4], x[8 * i + 5]); w.w = pk2(x[8 * i + 6], x[8 * i + 7]); *(GAS v4u*)(dst + 64 * i) = w; } }
    }
}

constexpr int AT_KROW = 400, AT_KBYTES = 64 * AT_KROW, AT_VROW = 144, AT_VBYTES = 128 * AT_VROW, AT_BUF = AT_KBYTES + AT_VBYTES;
__device__ __forceinline__ void attn_wg_item(const bf16* QB_, const bf16* KB_, const bf16* VT_, bf16* MIX_, float cmax, int qrow0, int h, int mkA, int nA, int mkB, int nB, LAS unsigned char* lds, int tid, int lane, int wave, unsigned long long* tprobe_ts = nullptr, int tprobe_l = 0) {
    const GAS bf16* QB = (const GAS bf16*)QB_; const GAS bf16* KB = (const GAS bf16*)KB_; const GAS bf16* VT = (const GAS bf16*)VT_; GAS bf16* MIX = (GAS bf16*)MIX_;
    const int fr = lane & 15, fq = lane >> 4;
    LAS unsigned char* plds = lds + 2 * AT_BUF + wave * 2304;
    const int qr = qrow0 + wave * 16;
    bf16x8 qf[6];
#pragma unroll
    for (int d = 0; d < 6; ++d) qf[d] = *(const GAS bf16x8*)(QB + ((size_t)(qr + fr) * 8 + h) * 192 + d * 32 + fq * 8);
    f32x4 o[8];
#pragma unroll
    for (int i = 0; i < 8; ++i) o[i] = (f32x4){0.f, 0.f, 0.f, 0.f};
    float lrow[4] = {0.f, 0.f, 0.f, 0.f};
    const int ntA = nA >> 6, nt = (nA + nB) >> 6;
    int kr_[3], kc_[3];
#pragma unroll
    for (int j = 0; j < 3; ++j) { const int id = tid + 512 * j; kr_[j] = id / 24; kc_[j] = id - kr_[j] * 24; }
    const int vr = tid >> 3, vc = tid & 7;
    v4u sk[3], sv[2];
#define AT_LOAD(mk_) do { _Pragma("unroll") for (int j_ = 0; j_ < 3; ++j_) sk[j_] = *(const GAS v4u*)(KB + ((size_t)((mk_) + kr_[j_]) * 8 + h) * 192 + kc_[j_] * 8); \
        _Pragma("unroll") for (int j_ = 0; j_ < 2; ++j_) sv[j_] = *(const GAS v4u*)(VT + (size_t)(h * 128 + vr + 64 * j_) * MK + (mk_) + vc * 8); } while (0)
#define AT_STORE(buf_) do { LAS unsigned char* bb_ = lds + (buf_) * AT_BUF; _Pragma("unroll") for (int j_ = 0; j_ < 3; ++j_) *(LAS v4u*)(bb_ + kr_[j_] * AT_KROW + kc_[j_] * 16) = sk[j_]; \
        _Pragma("unroll") for (int j_ = 0; j_ < 2; ++j_) *(LAS v4u*)(bb_ + AT_KBYTES + (vr + 64 * j_) * AT_VROW + vc * 16) = sv[j_]; } while (0)
    __syncthreads();
    AT_LOAD(mkA); AT_STORE(0);
    __syncthreads();
#ifdef TPROBE
    unsigned long long tp_a = 0, tp_b = 0, tp_c = 0; const unsigned long long tp_s = __builtin_amdgcn_s_memrealtime();
#endif
#pragma unroll 1
    for (int ti = 0; ti < nt; ++ti) {
#ifdef TPROBE
        const unsigned long long tp_0 = __builtin_amdgcn_s_memrealtime();
#endif
        const int cur = ti & 1;
        if (ti + 1 < nt) { const int mkn = (ti + 1 < ntA) ? mkA + (ti + 1) * 64 : mkB + (ti + 1 - ntA) * 64; AT_LOAD(mkn); }
        MEMBAR();
        const LAS unsigned char* kb_ = lds + cur * AT_BUF; const LAS unsigned char* vb_ = kb_ + AT_KBYTES;
        f32x4 s[4];
#pragma unroll
        for (int kh = 0; kh < 2; ++kh) { bf16x8 kf[12];
#pragma unroll
          for (int k2 = 0; k2 < 2; ++k2)
#pragma unroll
              for (int d = 0; d < 6; ++d) kf[k2 * 6 + d] = *(const LAS bf16x8*)(kb_ + (16 * (2 * kh + k2) + fr) * AT_KROW + d * 64 + fq * 16);
          MEMBAR();
#pragma unroll
          for (int k2 = 0; k2 < 2; ++k2) { const int kb = 2 * kh + k2; s[kb] = (f32x4){0.f, 0.f, 0.f, 0.f};
#pragma unroll
              for (int d = 0; d < 6; ++d) s[kb] = __builtin_amdgcn_mfma_f32_16x16x32_bf16(qf[d], kf[k2 * 6 + d], s[kb], 0, 0, 0); } }
        bf16x8 vf[16];
#pragma unroll
        for (int i = 0; i < 8; ++i) { vf[2 * i] = *(const LAS bf16x8*)(vb_ + (i * 16 + fr) * AT_VROW + fq * 16); vf[2 * i + 1] = *(const LAS bf16x8*)(vb_ + (i * 16 + fr) * AT_VROW + 64 + fq * 16); }
        MEMBAR();
#pragma unroll
        for (int kb = 0; kb < 4; ++kb)
#pragma unroll
            for (int r = 0; r < 4; ++r) { const float p = exp2f(s[kb][r] - cmax); lrow[r] += p; *(LAS bf16*)(plds + (4 * fq + r) * 144 + (16 * kb + fr) * 2) = (bf16)f2bf(p); }
        asm volatile("s_waitcnt lgkmcnt(0)" ::: "memory");
        const bf16x8 pf0 = *(const LAS bf16x8*)(plds + fr * 144 + fq * 16), pf1 = *(const LAS bf16x8*)(plds + fr * 144 + 64 + fq * 16);
#pragma unroll
        for (int i = 0; i < 8; ++i) { o[i] = __builtin_amdgcn_mfma_f32_16x16x32_bf16(pf0, vf[2 * i], o[i], 0, 0, 0); o[i] = __builtin_amdgcn_mfma_f32_16x16x32_bf16(pf1, vf[2 * i + 1], o[i], 0, 0, 0); }
#ifdef TPROBE
        const unsigned long long tp_1 = __builtin_amdgcn_s_memrealtime();
#endif
        if (ti + 1 < nt) AT_STORE(cur ^ 1);
#ifdef TPROBE
        const unsigned long long tp_2 = __builtin_amdgcn_s_memrealtime();
#endif
        WG_BAR();
#ifdef TPROBE
        { const unsigned long long tp_3 = __builtin_amdgcn_s_memrealtime(); tp_a += tp_1 - tp_0; tp_b += tp_2 - tp_1; tp_c += tp_3 - tp_2; }
#endif
    }
#ifdef TPROBE
    if (qrow0 == NCTX && h == 0 && wave == 0 && lane == 0 && tprobe_ts) { tprobe_ts[32 + 6 * 4 + tprobe_l] += tp_a; tprobe_ts[32 + 7 * 4 + tprobe_l] += tp_b; tprobe_ts[32 + 8 * 4 + tprobe_l] += tp_c; tprobe_ts[32 + 9 * 4 + tprobe_l] += __builtin_amdgcn_s_memrealtime() - tp_s; }
#endif
#undef AT_LOAD
#undef AT_STORE
#pragma unroll
    for (int r = 0; r < 4; ++r) { float lt = lrow[r]; lt += __shfl_xor(lt, 1); lt += __shfl_xor(lt, 2); lt += __shfl_xor(lt, 4); lt += __shfl_xor(lt, 8);
        const float inv = 1.0f / lt; GAS bf16* dst = MIX + (size_t)(qr + 4 * fq + r) * D + h * 128 + fr;
#pragma unroll
        for (int i = 0; i < 8; ++i) dst[i * 16] = (bf16)f2bf(o[i][r] * inv); }
}
__device__ __forceinline__ void ph_attn(const Ctx& A, int l, LAS unsigned char* lds, int tid, int lane, int wave, int vcu, int G) {
    const bf16* QB = (const bf16*)(A.ws + WS_QB); const bf16* KB = (const bf16*)(A.ws + WS_KB); const bf16* VT = (const bf16*)(A.ws + WS_VT); bf16* MIX = (bf16*)(A.ws + WS_MIX);
    float cmax; { const GAS float* qg = (const GAS float*)(A.in[18] + l * 192); const GAS float* kg = (const GAS float*)(A.in[19] + l * 192);
        float mq = fmaxf(fmaxf(fabsf(qg[lane]), fabsf(qg[64 + lane])), fabsf(qg[128 + lane])), mk = fmaxf(fmaxf(fabsf(kg[lane]), fabsf(kg[64 + lane])), fabsf(kg[128 + lane]));
#pragma unroll
        for (int o = 1; o < 64; o <<= 1) { mq = fmaxf(mq, __shfl_xor(mq, o)); mk = fmaxf(mk, __shfl_xor(mk, o)); }
        cmax = mq * mk * 192.0f * (0.07216878364870322f * 1.4426950408889634f); }
    for (int k = 0; k < 640; ++k) {
        int q;
        if (G == 256) { if (vcu >= 208) q = -1; else if (vcu < 128) q = k == 0 ? vcu : (k == 1 ? 128 + vcu : -1); else { q = 256 + (vcu - 128) + 80 * k; if (q >= 640) q = -1; } }
        else { q = vcu + k * G; if (q >= 640) q = -1; }
        if (q < 0) break;
        if (q < 128) { const int b = q >> 6, h = (q >> 3) & 7, qb = q & 7; attn_wg_item(QB, KB, VT, MIX, cmax, NCTX + b * 1024 + qb * 128, h, M + b * 256, 256, NCTX + b * 1024, 1024, lds, tid, lane, wave); }
        else { const int wgi = q - 128, b = wgi >> 4, h = (wgi >> 1) & 7, qb = wgi & 1; attn_wg_item(QB, KB, VT, MIX, cmax, b * 256 + qb * 128, h, b * 256, 256, 0, 0, lds, tid, lane, wave); }
    }
}

__device__ __forceinline__ void ph_post(const Ctx& A, int l, int lane, int gw, int NGW) {
    const GAS bf16* U = (const GAS bf16*)(A.ws + WS_U); const GAS float* GO = (const GAS float*)(A.ws + WS_GO); const GAS float* SY = (const GAS float*)(A.ws + WS_SY); const GAS bf16* XBC = (const GAS bf16*)(A.ws + WS_XBC);
    GAS bf16* MIX = (GAS bf16*)(A.ws + WS_MIX);
    const GAS float* gng = (const GAS float*)(A.in[23] + l * 128); const GAS float* sd = (const GAS float*)(A.in[28] + l * 8); const GAS float* sng = (const GAS float*)(A.in[29] + l * 512);
    f32x4 g4[2], s4[2]; float sdv[2];
#pragma unroll
    for (int i = 0; i < 2; ++i) { const int c = 4 * lane + 256 * i; g4[i] = *(const GAS f32x4*)(gng + (c & 127)); s4[i] = *(const GAS f32x4*)(sng + c); sdv[i] = sd[c >> 6]; }
    for (int m = gw; m < M; m += NGW) {
        int l4 = 4 * lane; asm volatile("" : "+v"(l4));
        const GAS bf16* u = U + (size_t)m * IN_WP;
        f32x4 of[2], ob[2], yf[2], yb[2]; v2u zg[2], zs[2], xx[2];
#pragma unroll
        for (int i = 0; i < 2; ++i) { const int c = l4 + 256 * i;
            of[i] = *(const GAS f32x4*)(GO + (size_t)m * 512 + c); ob[i] = *(const GAS f32x4*)(GO + ((size_t)M + m) * 512 + c);
            yf[i] = *(const GAS f32x4*)(SY + (size_t)m * 512 + c); yb[i] = *(const GAS f32x4*)(SY + ((size_t)M + m) * 512 + c);
            zg[i] = *(const GAS v2u*)(u + U_GZ + c); zs[i] = *(const GAS v2u*)(u + U_SZ + c); xx[i] = *(const GAS v2u*)(XBC + (size_t)m * 1024 + c); }
#pragma unroll
        for (int i = 0; i < 2; ++i) { const int c = l4 + 256 * i;
            f32x4 o = of[i] + ob[i];
            const float ss = half_sum((o.x * o.x + o.y * o.y) + (o.z * o.z + o.w * o.w)); const float rstd = 1.0f / sqrtf(ss * (1.0f / 128.f) + EPS);
            const f32x4 z = bf4(zg[i]);
            o = o * rstd * g4[i]; o.x *= silu(z.x); o.y *= silu(z.y); o.z *= silu(z.z); o.w *= silu(z.w);
            v2u w; w.x = pk2(o.x, o.y); w.y = pk2(o.z, o.w); *(GAS v2u*)(MIX + (size_t)m * D + 1024 + c) = w; }
#pragma unroll
        for (int i = 0; i < 2; ++i) { const int c = l4 + 256 * i;
            f32x4 y = yf[i] + yb[i] + bf4(xx[i]) * sdv[i];
            const f32x4 z = bf4(zs[i]);
            y.x *= silu(z.x); y.y *= silu(z.y); y.z *= silu(z.z); y.w *= silu(z.w);
            const float ss = wave_sum((y.x * y.x + y.y * y.y) + (y.z * y.z + y.w * y.w)); const float rstd = 1.0f / sqrtf(ss * (1.0f / 256.f) + EPS);
            y = y * rstd * s4[i];
            v2u w; w.x = pk2(y.x, y.y); w.y = pk2(y.z, y.w); *(GAS v2u*)(MIX + (size_t)m * D + 1536 + c) = w; }
    }
}

constexpr size_t GCH_W = 0, GCH_QG = 16384, GCH_KD = 32768, GCH_QK = 49152, GCH_UT = 57344, GCH_DEC = 90112, GCH_BYTES = 90368;
constexpr int NGCH = 160;
constexpr int GL_K = 0, GL_Q = 17408, GL_V = 34816, GL_KK = 52224, GL_QK = 52224 + 16640, GL_AF = 85504, GL_AB = 85504 + 16384, GL_TAB = 118272;
template <int DIR>
__device__ __forceinline__ void gdn_solve(GAS unsigned char* GCH, const LAS bf16* kb16, const LAS bf16* qb16, const LAS bf16* vb16, const LAS float* Ad, const LAS float* gcd, const LAS float* bd, int gch, int h, int wave, int lane) {
    typedef float f32x2v __attribute__((ext_vector_type(2)));
    const int c = (wave & 3) * 64 + lane, cc = c & 127; const bool isw = c < 128;
    GAS unsigned char* rec = GCH + ((size_t)(DIR * NGCH + gch) * 4 + h) * GCH_BYTES;
    { int z = 0; asm volatile("" : "+v"(z)); Ad += z; gcd += z; bd += z; }
    const LAS bf16* src = (isw ? kb16 : vb16) + cc;
    f32x2v x2[32];
    float raw[64];
#pragma unroll
    for (int i = 0; i < 64; ++i) { const int p = DIR ? 63 - i : i; raw[i] = bf1(src[p * 136]); }
#pragma unroll
    for (int i = 0; i < 64; ++i) { const int p = DIR ? 63 - i : i; const float f = isw ? bd[p] * __expf(gcd[p]) : bd[p]; x2[i >> 1][i & 1] = raw[i] * f; }
#pragma unroll
    for (int i = 1; i < 64; ++i) {
        f32x4 ac[16];
#pragma unroll
        for (int j = 0; j < (i + 3) / 4; ++j) ac[j] = *(const LAS f32x4*)(Ad + i * 64 + 4 * j);
        MEMBAR();
        f32x2v s01 = (f32x2v){0.f, 0.f}, s23 = (f32x2v){0.f, 0.f};
#pragma unroll
        for (int j = 0; j < i; j += 4) { f32x4 a4 = ac[j >> 2];
            if (j + 1 >= i) a4.y = 0.f; if (j + 2 >= i) a4.z = 0.f; if (j + 3 >= i) a4.w = 0.f;
            s01 -= (f32x2v){a4.x, a4.y} * x2[j >> 1]; s23 -= (f32x2v){a4.z, a4.w} * x2[(j >> 1) + 1]; }
        x2[i >> 1][i & 1] += (s01.x + s01.y) + (s23.x + s23.y); MEMBAR(); }
    if (isw) { GAS bf16* wdst = (GAS bf16*)(rec + GCH_W) + cc;
#pragma unroll
        for (int i = 0; i < 64; ++i) wdst[i * 128] = (bf16)f2bf(x2[i >> 1][i & 1]);
        const float gl = gcd[DIR ? 0 : 63]; GAS bf16* kd = (GAS bf16*)(rec + GCH_KD) + cc * 64;
#pragma unroll
        for (int i = 0; i < 64; i += 8) { float v[8];
#pragma unroll
            for (int u = 0; u < 8; ++u) { const int p = DIR ? 63 - (i + u) : i + u; v[u] = raw[i + u] * __expf(gl - gcd[p]); }
            v4u w; w.x = pk2(v[0], v[1]); w.y = pk2(v[2], v[3]); w.z = pk2(v[4], v[5]); w.w = pk2(v[6], v[7]); *(GAS v4u*)(kd + i) = w; }
        if (cc == 0) *(GAS float*)(rec + GCH_DEC) = __expf(gl); }
    else { GAS float* ut = (GAS float*)(rec + GCH_UT) + cc * 64;
#pragma unroll
        for (int i = 0; i < 64; i += 4) *(GAS f32x4*)(ut + i) = (f32x4){x2[i >> 1][0], x2[i >> 1][1], x2[(i >> 1) + 1][0], x2[(i >> 1) + 1][1]};
        const LAS bf16* qsrc = qb16 + cc; GAS bf16* qg = (GAS bf16*)(rec + GCH_QG) + cc;
#pragma unroll
        for (int i = 0; i < 64; ++i) { const int p = DIR ? 63 - i : i; raw[i] = bf1(qsrc[p * 136]); }
#pragma unroll
        for (int i = 0; i < 64; ++i) { const int p = DIR ? 63 - i : i; qg[i * 128] = (bf16)f2bf(raw[i] * 0.08838834764831845f * __expf(gcd[p])); } }
}
__device__ __forceinline__ void ph_gdn_local(const Ctx& A, int l, LAS unsigned char* lds, int tid, int lane, int wave, int vcu, int G) {
    const GAS bf16* GQ = (const GAS bf16*)(A.ws + WS_GQ); const GAS bf16* GK = GQ + (size_t)M * 512; const GAS bf16* GV = GK + (size_t)M * 512;
    const GAS float* GBETA = (const GAS float*)(A.ws + WS_GBG); const GAS float* GG = GBETA + (size_t)M * 8;
    GAS unsigned char* GCH = (GAS unsigned char*)(A.ws + WS_GCH);
    LAS bf16* kb16 = (LAS bf16*)(lds + GL_K); LAS bf16* qb16 = (LAS bf16*)(lds + GL_Q); LAS bf16* vb16 = (LAS bf16*)(lds + GL_V);
    LAS float* KK = (LAS float*)(lds + GL_KK); LAS float* QK = (LAS float*)(lds + GL_QK);
    LAS float* Af = (LAS float*)(lds + GL_AF); LAS float* Ab = (LAS float*)(lds + GL_AB);
    LAS float* sgcf = (LAS float*)(lds + GL_TAB); LAS float* sgcb = sgcf + 64; LAS float* sbf = sgcf + 128; LAS float* sbb = sgcf + 192;
    const int fr = lane & 15, fq = lane >> 4;
    for (int rd = 0; rd * G + vcu < 2 * NGCH * 4; ++rd) {
        if ((rd + vcu) & 1) continue;
        const int it = (rd * G + vcu) >> 1;
        const int gch = it >> 2, h = it & 3, row0 = gch * 64;
        {
#pragma unroll
          for (int j = 0; j < 2; ++j) { const int id = tid + 512 * j, r = id >> 4, c8 = (id & 15) * 8; const size_t go = (size_t)(row0 + r) * 512 + h * 128 + c8;
              *(LAS v4u*)(kb16 + r * 136 + c8) = *(const GAS v4u*)(GK + go); *(LAS v4u*)(qb16 + r * 136 + c8) = *(const GAS v4u*)(GQ + go); *(LAS v4u*)(vb16 + r * 136 + c8) = *(const GAS v4u*)(GV + go); } }
        if (wave == 0) { const float gf = GG[(size_t)(row0 + lane) * 8 + h], gb = GG[(size_t)(row0 + lane) * 8 + 4 + h];
            float pf = gf, pb = gb;
#pragma unroll
            for (int o = 1; o < 64; o <<= 1) { const float tf = __shfl_up(pf, o), tb = __shfl_up(pb, o); if (lane >= o) { pf += tf; pb += tb; } }
            const float totb = __shfl(pb, 63);
            sgcf[lane] = pf; sgcb[lane] = totb - pb + gb;
            sbf[lane] = GBETA[(size_t)(row0 + lane) * 8 + h]; sbb[lane] = GBETA[(size_t)(row0 + lane) * 8 + 4 + h]; }
        __syncthreads();
        { const int tr = wave & 3; const LAS bf16* Aimg = (wave >> 2) ? qb16 : kb16; LAS float* Out = (wave >> 2) ? QK : KK;
          bf16x8 af[4], bfr[16];
#pragma unroll
          for (int ks = 0; ks < 4; ++ks) af[ks] = *(const LAS bf16x8*)(Aimg + (16 * tr + fr) * 136 + ks * 32 + fq * 8);
#pragma unroll
          for (int tc = 0; tc < 4; ++tc)
#pragma unroll
              for (int ks = 0; ks < 4; ++ks) bfr[tc * 4 + ks] = *(const LAS bf16x8*)(kb16 + (16 * tc + fr) * 136 + ks * 32 + fq * 8);
          MEMBAR();
#pragma unroll
          for (int tc = 0; tc < 4; ++tc) { f32x4 acc = (f32x4){0.f, 0.f, 0.f, 0.f};
#pragma unroll
              for (int ks = 0; ks < 4; ++ks) acc = __builtin_amdgcn_mfma_f32_16x16x32_bf16(af[ks], bfr[tc * 4 + ks], acc, 0, 0, 0);
#pragma unroll
              for (int r = 0; r < 4; ++r) Out[(16 * tr + 4 * fq + r) * 65 + 16 * tc + fr] = acc[r]; } }
        __syncthreads();
        { GAS unsigned char* recf = GCH + ((size_t)(0 * NGCH + gch) * 4 + h) * GCH_BYTES; GAS unsigned char* recb = GCH + ((size_t)(1 * NGCH + gch) * 4 + h) * GCH_BYTES;
#pragma unroll 2
          for (int e = 0; e < 8; ++e) { const int idx = tid + 512 * e, i = idx >> 6, j = idx & 63, pi = 63 - i, pj = 63 - j;
              const float kkf = KK[i * 65 + j], qkf = QK[i * 65 + j], kkb = KK[pi * 65 + pj], qkb = QK[pi * 65 + pj];
              const float df = __expf(sgcf[i] - sgcf[j]), db = __expf(sgcb[pi] - sgcb[pj]);
              Af[idx] = (j < i) ? sbf[i] * kkf * df : 0.f; Ab[idx] = (j < i) ? sbb[pi] * kkb * db : 0.f;
              ((GAS bf16*)(recf + GCH_QK))[idx] = (bf16)f2bf((j <= i) ? qkf * 0.08838834764831845f * df : 0.f);
              ((GAS bf16*)(recb + GCH_QK))[idx] = (bf16)f2bf((j <= i) ? qkb * 0.08838834764831845f * db : 0.f); } }
        __syncthreads();
        if (wave < 4) gdn_solve<0>(GCH, kb16, qb16, vb16, Af, sgcf, sbf, gch, h, wave, lane);
        else gdn_solve<1>(GCH, kb16, qb16, vb16, Ab, sgcb, sbb, gch, h, wave, lane);
        __syncthreads();
    }
}

constexpr int GS_W = 0, GS_QG = 17408, GS_KD = 34816, GS_QK = 53248, GS_IMG = 62464;
__device__ __forceinline__ void gdn_seq_wg(const Ctx& A, int l, int b, int lat, int h, int dir, LAS unsigned char* lds, int tid, int lane, int wave) {
    const GAS unsigned char* GCH = (const GAS unsigned char*)(A.ws + WS_GCH); GAS float* GO = (GAS float*)(A.ws + WS_GO);
    const int fr = lane & 15, fq = lane >> 4, dvs = wave;
    const int nch = lat ? 16 : 4, ch0 = lat ? 128 + b * 16 : b * 4;
    LAS bf16* simg = (LAS bf16*)(lds + GS_IMG + wave * 4352);
    const LAS bf16* sW = (const LAS bf16*)(lds + GS_W); const LAS bf16* sQG = (const LAS bf16*)(lds + GS_QG); const LAS bf16* sKD = (const LAS bf16*)(lds + GS_KD); const LAS bf16* sQK = (const LAS bf16*)(lds + GS_QK);
    f32x4 S[8];
    const size_t sidx = ((size_t)(((b * 4 + l) * 2 + dir) * 4 + h) * 128) * 128 + dvs * 16 + fr;
    if (lat) {
#pragma unroll
        for (int u = 0; u < 8; ++u)
#pragma unroll
            for (int r = 0; r < 4; ++r) S[u][r] = *(const GAS float*)(A.in[4] + sidx + (size_t)(16 * u + 4 * fq + r) * 128); }
    else {
#pragma unroll
        for (int u = 0; u < 8; ++u) S[u] = (f32x4){0.f, 0.f, 0.f, 0.f}; }
#define GREC(cc_) (GCH + ((size_t)(dir * NGCH + (dir ? ch0 + nch - 1 - (cc_) : ch0 + (cc_))) * 4 + h) * GCH_BYTES)
    const int r16a = tid >> 4, c16 = tid & 15, r8a = tid >> 3, c8 = tid & 7;
    v4u pw0, pw1, pq0, pq1, pk0, pk1, pqk; f32x4 UTn[4], UTc[4]; float decn, dec;
#define GS_LOAD(cc_) do { const GAS unsigned char* rec_ = GREC(cc_); \
        pw0 = *(const GAS v4u*)(rec_ + GCH_W + (r16a * 128 + c16 * 8) * 2); pw1 = *(const GAS v4u*)(rec_ + GCH_W + ((r16a + 32) * 128 + c16 * 8) * 2); \
        pq0 = *(const GAS v4u*)(rec_ + GCH_QG + (r16a * 128 + c16 * 8) * 2); pq1 = *(const GAS v4u*)(rec_ + GCH_QG + ((r16a + 32) * 128 + c16 * 8) * 2); \
        pk0 = *(const GAS v4u*)(rec_ + GCH_KD + (r8a * 64 + c8 * 8) * 2); pk1 = *(const GAS v4u*)(rec_ + GCH_KD + ((r8a + 64) * 64 + c8 * 8) * 2); \
        pqk = *(const GAS v4u*)(rec_ + GCH_QK + (r8a * 64 + c8 * 8) * 2); decn = *(const GAS float*)(rec_ + GCH_DEC); \
        _Pragma("unroll") for (int t_ = 0; t_ < 4; ++t_) UTn[t_] = *(const GAS f32x4*)((const GAS float*)(rec_ + GCH_UT) + (dvs * 16 + fr) * 64 + 16 * t_ + 4 * fq); } while (0)
#define GS_STORE() do { *(LAS v4u*)(lds + GS_W + r16a * 272 + c16 * 16) = pw0; *(LAS v4u*)(lds + GS_W + (r16a + 32) * 272 + c16 * 16) = pw1; \
        *(LAS v4u*)(lds + GS_QG + r16a * 272 + c16 * 16) = pq0; *(LAS v4u*)(lds + GS_QG + (r16a + 32) * 272 + c16 * 16) = pq1; \
        *(LAS v4u*)(lds + GS_KD + r8a * 144 + c8 * 16) = pk0; *(LAS v4u*)(lds + GS_KD + (r8a + 64) * 144 + c8 * 16) = pk1; \
        *(LAS v4u*)(lds + GS_QK + r8a * 144 + c8 * 16) = pqk; \
        _Pragma("unroll") for (int t_ = 0; t_ < 4; ++t_) UTc[t_] = UTn[t_]; dec = decn; } while (0)
    __syncthreads();
    GS_LOAD(0); GS_STORE();
    __syncthreads();
#ifdef TPROBE
    unsigned long long tq_a = 0, tq_b = 0, tq_c = 0, tq_d = 0;
#endif
#pragma unroll 1
    for (int cc = 0; cc < nch; ++cc) {
#ifdef TPROBE
        const unsigned long long tq_0 = __builtin_amdgcn_s_memrealtime();
#endif
        const int gch = dir ? ch0 + nch - 1 - cc : ch0 + cc;
        if (cc + 1 < nch) GS_LOAD(cc + 1);
        MEMBAR();
#pragma unroll
        for (int u = 0; u < 8; ++u) { v2u w; w.x = pk2(S[u][0], S[u][1]); w.y = pk2(S[u][2], S[u][3]); *(LAS v2u*)(simg + fr * 136 + 16 * u + 4 * fq) = w; }
        asm volatile("s_waitcnt lgkmcnt(0)" ::: "memory");
        bf16x8 BS[4];
#pragma unroll
        for (int ks = 0; ks < 4; ++ks) BS[ks] = *(const LAS bf16x8*)(simg + fr * 136 + ks * 32 + fq * 8);
        asm volatile("s_waitcnt lgkmcnt(0)" ::: "memory");
        bf16x8 Wf[16];
#pragma unroll
        for (int t = 0; t < 4; ++t)
#pragma unroll
            for (int ks = 0; ks < 4; ++ks) Wf[t * 4 + ks] = *(const LAS bf16x8*)(sW + (16 * t + fr) * 136 + ks * 32 + fq * 8);
        MEMBAR();
#pragma unroll
        for (int t = 0; t < 4; ++t) { f32x4 acc = (f32x4){0.f, 0.f, 0.f, 0.f};
#pragma unroll
            for (int ks = 0; ks < 4; ++ks) acc = __builtin_amdgcn_mfma_f32_16x16x32_bf16(Wf[t * 4 + ks], BS[ks], acc, 0, 0, 0);
            const f32x4 vn = UTc[t] - acc;
            v2u w; w.x = pk2(vn[0], vn[1]); w.y = pk2(vn[2], vn[3]); *(LAS v2u*)(simg + fr * 72 + 16 * t + 4 * fq) = w; }
        asm volatile("s_waitcnt lgkmcnt(0)" ::: "memory");
        bf16x8 BV[2];
#pragma unroll
        for (int ks = 0; ks < 2; ++ks) BV[ks] = *(const LAS bf16x8*)(simg + fr * 72 + ks * 32 + fq * 8);
#ifdef TPROBE
        const unsigned long long tq_1 = __builtin_amdgcn_s_memrealtime();
#endif
        int zl = 0; asm volatile("" : "+v"(zl));
        GAS float* gob = GO + ((size_t)dir * M + gch * 64) * 512 + h * 128 + dvs * 16 + fr + zl;
        bf16x8 QGf[16], QKf[8];
#pragma unroll
        for (int t = 0; t < 4; ++t) {
#pragma unroll
            for (int ks = 0; ks < 4; ++ks) QGf[t * 4 + ks] = *(const LAS bf16x8*)(sQG + (16 * t + fr) * 136 + ks * 32 + fq * 8);
#pragma unroll
            for (int ks = 0; ks < 2; ++ks) QKf[t * 2 + ks] = *(const LAS bf16x8*)(sQK + (16 * t + fr) * 72 + ks * 32 + fq * 8); }
        MEMBAR();
#pragma unroll
        for (int t = 0; t < 4; ++t) { f32x4 acc = (f32x4){0.f, 0.f, 0.f, 0.f};
#pragma unroll
            for (int ks = 0; ks < 4; ++ks) acc = __builtin_amdgcn_mfma_f32_16x16x32_bf16(QGf[t * 4 + ks], BS[ks], acc, 0, 0, 0);
#pragma unroll
            for (int ks = 0; ks < 2; ++ks) acc = __builtin_amdgcn_mfma_f32_16x16x32_bf16(QKf[t * 2 + ks], BV[ks], acc, 0, 0, 0);
#pragma unroll
            for (int r = 0; r < 4; ++r) { const int i = 16 * t + 4 * fq + r, p = dir ? 63 - i : i; gob[(ptrdiff_t)p * 512] = acc[r]; } }
#ifdef TPROBE
        const unsigned long long tq_2 = __builtin_amdgcn_s_memrealtime();
#endif
        bf16x8 KDf[16];
#pragma unroll
        for (int u = 0; u < 8; ++u)
#pragma unroll
            for (int ks = 0; ks < 2; ++ks) KDf[u * 2 + ks] = *(const LAS bf16x8*)(sKD + (16 * u + fr) * 72 + ks * 32 + fq * 8);
        MEMBAR();
#pragma unroll
        for (int u = 0; u < 8; ++u) { f32x4 acc = S[u] * dec;
#pragma unroll
            for (int ks = 0; ks < 2; ++ks) acc = __builtin_amdgcn_mfma_f32_16x16x32_bf16(KDf[u * 2 + ks], BV[ks], acc, 0, 0, 0);
            S[u] = acc; }
#ifdef TPROBE
        const unsigned long long tq_3 = __builtin_amdgcn_s_memrealtime();
#endif
        WG_BAR();
        if (cc + 1 < nch) GS_STORE();
        WG_BAR();
#ifdef TPROBE
        { const unsigned long long tq_4 = __builtin_amdgcn_s_memrealtime(); tq_a += tq_1 - tq_0; tq_b += tq_2 - tq_1; tq_c += tq_3 - tq_2; tq_d += tq_4 - tq_3; }
#endif
    }
#ifdef TPROBE
    if (lat && b == 0 && h == 0 && dir == 0 && wave == 0 && lane == 0) { unsigned long long* ts_ = (unsigned long long*)(A.ws + WS_CTL + 65536); ts_[32 + 10 * 4 + l] += tq_a; ts_[32 + 11 * 4 + l] += tq_b; ts_[32 + 12 * 4 + l] += tq_c; ts_[32 + 13 * 4 + l] += tq_d; }
#endif
#undef GREC
#undef GS_LOAD
#undef GS_STORE
    if (!lat) { int l2 = lane; asm volatile("" : "+v"(l2)); const int fr2 = l2 & 15, fq2 = l2 >> 4;
        GAS float* so = (GAS float*)(A.out + O_SG + ((size_t)(((b * 4 + l) * 2 + dir) * 4 + h) * 128) * 128 + dvs * 16 + fr2 + (size_t)(4 * fq2) * 128);
#pragma unroll
        for (int u = 0; u < 8; ++u)
#pragma unroll
            for (int r = 0; r < 4; ++r) so[(16 * u + r) * 128] = S[u][r]; }
}
__device__ __forceinline__ void ph_gdn_seq(const Ctx& A, int l, LAS unsigned char* lds, int tid, int lane, int wave, int vcu, int G) {
    for (int k = 0; k < 272; ++k) {
        int q;
        if (G == 256) { if (vcu >= 240) q = k == 0 ? 256 + (vcu - 240) : -1; else if (vcu >= 208) q = k == 0 ? vcu - 208 : -1; else { q = 32 + vcu + 208 * k; if (q >= 256) q = -1; } }
        else { q = vcu + k * G; if (q >= 272) q = -1; }
        if (q < 0) break;
        const int lat = q >= 256, it = lat ? q - 256 : q;
        gdn_seq_wg(A, l, it >> 3, lat, (it >> 1) & 3, it & 1, lds, tid, lane, wave);
    }
}

constexpr size_t SR_P = 0, SR_X1 = 32768, SR_X2 = 49152, SR_EA = 65536, SR_DEC = 66048, SR_BYTES = 66560;
constexpr size_t SS_C = 0, SS_BT = 32768, SS_BYTES = 65536;
constexpr int NSCH = 80;
__device__ __forceinline__ void ph_ssd_local(const Ctx& A, int l, LAS unsigned char* lds, int tid, int lane, int wave, int vcu, int G) {
    const GAS bf16* XBC = (const GAS bf16*)(A.ws + WS_XBC); const GAS float* SDT = (const GAS float*)(A.ws + WS_SDT); const GAS float* SDA = SDT + (size_t)M * 16;
    GAS unsigned char* SREC = (GAS unsigned char*)(A.ws + WS_SREC); GAS unsigned char* SSH = (GAS unsigned char*)(A.ws + WS_SSH);
    LAS bf16* Cimg = (LAS bf16*)lds; LAS bf16* Bimg = (LAS bf16*)(lds + 34816);
    LAS float* sac = (LAS float*)(lds + 69632);
    LAS float* sdt = sac + 256;
    LAS bf16* ptile = (LAS bf16*)(lds + 71680 + wave * 4352);
    const int fr = lane & 15, fq = lane >> 4;
    for (int rd = 0; rd * G + vcu < 2 * NSCH * 8; ++rd) {
        if (!((rd + vcu) & 1)) continue;
        const int it = (rd * G + vcu) >> 1;
        const int ch = it >> 3, h = it & 7, g = h >> 2, row0 = ch * 128;
        GAS unsigned char* shr = SSH + (size_t)(ch * 2 + g) * SS_BYTES;
        float xv[16];
        { const GAS bf16* xp = XBC + (size_t)(row0 + wave * 16) * 1024 + h * 64 + lane;
#pragma unroll
          for (int j = 0; j < 16; ++j) xv[j] = bf1(xp[(size_t)j * 1024]); }
        { const int r = tid >> 2, c0 = (tid & 3) * 32; const GAS bf16* cp = XBC + (size_t)(row0 + r) * 1024 + 768 + g * 128 + c0; const GAS bf16* bp = XBC + (size_t)(row0 + r) * 1024 + 512 + g * 128 + c0;
#pragma unroll
          for (int i = 0; i < 4; ++i) { const v4u wc = *(const GAS v4u*)(cp + 8 * i), wb = *(const GAS v4u*)(bp + 8 * i);
              *(LAS v4u*)(Cimg + r * 136 + c0 + 8 * i) = wc; *(LAS v4u*)(Bimg + r * 136 + c0 + 8 * i) = wb;
              if ((h & 3) == 0) *(GAS v4u*)((GAS bf16*)(shr + SS_C) + r * 128 + c0 + 8 * i) = wc; } }
        if (wave < 2) { const int d = wave; const size_t mo = (size_t)(row0 + 2 * lane) * 16 + d * 8 + h;
            const float a0 = SDA[mo], a1 = SDA[mo + 16]; float ps = a0 + a1;
#pragma unroll
            for (int o = 1; o < 64; o <<= 1) { const float t = __shfl_up(ps, o); if (lane >= o) ps += t; }
            const float tot = __shfl(ps, 63);
            if (d == 0) { sac[2 * lane] = ps - a1; sac[2 * lane + 1] = ps; }
            else { sac[128 + 2 * lane] = tot - ps + a0 + a1; sac[128 + 2 * lane + 1] = tot - ps + a1; }
            sdt[d * 128 + 2 * lane] = SDT[mo]; sdt[d * 128 + 2 * lane + 1] = SDT[mo + 16]; }
        __syncthreads();
        if ((h & 3) == 0) { const int n = tid >> 2, s0 = (tid & 3) * 32; GAS bf16* dst = (GAS bf16*)(shr + SS_BT) + n * 128 + s0;
#pragma unroll
            for (int i = 0; i < 4; ++i) { unsigned w[4];
#pragma unroll
                for (int j = 0; j < 4; ++j) w[j] = (unsigned)Bimg[(s0 + 8 * i + 2 * j) * 136 + n] | ((unsigned)Bimg[(s0 + 8 * i + 2 * j + 1) * 136 + n] << 16);
                *(GAS v4u*)(dst + 8 * i) = (v4u){w[0], w[1], w[2], w[3]}; } }
        { bf16x8 af[4];
#pragma unroll
          for (int ks = 0; ks < 4; ++ks) af[ks] = *(const LAS bf16x8*)(Cimg + (16 * wave + fr) * 136 + ks * 32 + fq * 8);
          f32x4 acc[8];
#pragma unroll
          for (int tc = 0; tc < 8; ++tc) { acc[tc] = (f32x4){0.f, 0.f, 0.f, 0.f};
#pragma unroll
              for (int ks = 0; ks < 4; ++ks) { const bf16x8 bfr = *(const LAS bf16x8*)(Bimg + (16 * tc + fr) * 136 + ks * 32 + fq * 8); acc[tc] = __builtin_amdgcn_mfma_f32_16x16x32_bf16(af[ks], bfr, acc[tc], 0, 0, 0); } }
#pragma unroll
          for (int d = 0; d < 2; ++d) {
              float acr[4];
#pragma unroll
              for (int r = 0; r < 4; ++r) acr[r] = sac[d * 128 + 16 * wave + 4 * fq + r];
#pragma unroll
              for (int tc = 0; tc < 8; ++tc) { const int s = 16 * tc + fr; const float as = sac[d * 128 + s];
#pragma unroll
                  for (int r = 0; r < 4; ++r) { const int li = 16 * wave + 4 * fq + r; const bool keep = d ? (s >= li) : (s <= li);
                      ptile[(4 * fq + r) * 136 + s] = (bf16)f2bf(keep ? acc[tc][r] * __expf(acr[r] - as) : 0.f); } }
              asm volatile("s_waitcnt lgkmcnt(0)" ::: "memory");
              GAS bf16* Pd = (GAS bf16*)(SREC + ((size_t)(d * NSCH + ch) * 8 + h) * SR_BYTES + SR_P) + (size_t)(16 * wave) * 128;
#pragma unroll
              for (int j = 0; j < 4; ++j) { const int id = lane + 64 * j, rr = id >> 4, cc = id & 15; *(GAS v4u*)(Pd + rr * 128 + cc * 8) = *(const LAS v4u*)(ptile + rr * 136 + cc * 8); }
              asm volatile("s_waitcnt lgkmcnt(0)" ::: "memory"); } }
        __syncthreads();
        { const int p = lane, s0 = wave * 16;
#pragma unroll
          for (int d = 0; d < 2; ++d) { const float aend = d ? sac[128] : sac[127];
              unsigned w1[8], w2[8];
#pragma unroll
              for (int j = 0; j < 16; j += 2) { const float u0 = xv[j] * sdt[d * 128 + s0 + j], u1 = xv[j + 1] * sdt[d * 128 + s0 + j + 1];
                  w1[j >> 1] = pk2(u0, u1); w2[j >> 1] = pk2(u0 * __expf(aend - sac[d * 128 + s0 + j]), u1 * __expf(aend - sac[d * 128 + s0 + j + 1])); }
              LAS bf16* t1 = (LAS bf16*)(lds + (2 * d) * 17408) + p * 136 + s0; LAS bf16* t2 = (LAS bf16*)(lds + (2 * d + 1) * 17408) + p * 136 + s0;
              *(LAS v4u*)t1 = (v4u){w1[0], w1[1], w1[2], w1[3]}; *(LAS v4u*)(t1 + 8) = (v4u){w1[4], w1[5], w1[6], w1[7]};
              *(LAS v4u*)t2 = (v4u){w2[0], w2[1], w2[2], w2[3]}; *(LAS v4u*)(t2 + 8) = (v4u){w2[4], w2[5], w2[6], w2[7]};
              GAS unsigned char* rec = SREC + ((size_t)(d * NSCH + ch) * 8 + h) * SR_BYTES;
              if (tid < 128) ((GAS float*)(rec + SR_EA))[tid] = __expf(sac[d * 128 + tid]);
              if (tid == 0) *(GAS float*)(rec + SR_DEC) = __expf(aend); } }
        __syncthreads();
#pragma unroll
        for (int j = 0; j < 8; ++j) { const int id = tid + 512 * j, tl = id >> 10, rr = (id >> 4) & 63, cc = id & 15;
            GAS unsigned char* rec = SREC + ((size_t)((tl >> 1) * NSCH + ch) * 8 + h) * SR_BYTES + ((tl & 1) ? SR_X2 : SR_X1);
            *(GAS v4u*)((GAS bf16*)rec + rr * 128 + cc * 8) = *(const LAS v4u*)(lds + tl * 17408 + rr * 272 + cc * 16); }
        __syncthreads();
    }
}

constexpr int SQ_C = 0, SQ_P = 34816, SQ_BT = 69632, SQ_X1 = 104448, SQ_X2 = 121856, SQ_IMG = 139264;
__device__ __forceinline__ void ssd_seq_wg(const Ctx& A, int l, int b, int lat, int h, int dir, LAS unsigned char* lds, int tid, int lane, int wave) {
    const GAS unsigned char* SREC = (const GAS unsigned char*)(A.ws + WS_SREC); const GAS unsigned char* SSH = (const GAS unsigned char*)(A.ws + WS_SSH); GAS float* SY = (GAS float*)(A.ws + WS_SY);
    const int fr = lane & 15, fq = lane >> 4, g = h >> 2, ps = wave & 3, hf = wave >> 2;
    const int nch = lat ? 8 : 2, ch0 = lat ? 64 + b * 8 : b * 2;
    LAS bf16* simg = (LAS bf16*)(lds + SQ_IMG + ps * 4352);
    const LAS bf16* sC = (const LAS bf16*)(lds + SQ_C); const LAS bf16* sP = (const LAS bf16*)(lds + SQ_P); const LAS bf16* sBT = (const LAS bf16*)(lds + SQ_BT);
    const LAS bf16* sX1 = (const LAS bf16*)(lds + SQ_X1); const LAS bf16* sX2 = (const LAS bf16*)(lds + SQ_X2);
    f32x4 S[4];
    const size_t sidx = ((size_t)(((b * 4 + l) * 2 + dir) * 8 + h) * 64 + ps * 16 + fr) * 128 + 64 * hf + 4 * fq;
    if (lat) {
#pragma unroll
        for (int u = 0; u < 4; ++u) S[u] = *(const GAS f32x4*)(A.in[5] + sidx + 16 * u); }
    else {
#pragma unroll
        for (int u = 0; u < 4; ++u) S[u] = (f32x4){0.f, 0.f, 0.f, 0.f}; }
#define SCH(cc_) (dir ? ch0 + nch - 1 - (cc_) : ch0 + (cc_))
    const int r16 = tid >> 4, c16 = tid & 15;
    v4u pc[4], pp[4], pb[4], px1[2], px2[2]; float pea, decn, dec;
#define SQ_LOAD(cc_) do { const int ch_ = SCH(cc_); const GAS unsigned char* rec_ = SREC + ((size_t)(dir * NSCH + ch_) * 8 + h) * SR_BYTES; const GAS unsigned char* shr_ = SSH + (size_t)(ch_ * 2 + g) * SS_BYTES; \
        _Pragma("unroll") for (int j_ = 0; j_ < 4; ++j_) { const int off_ = ((r16 + 32 * j_) * 128 + c16 * 8) * 2; pc[j_] = *(const GAS v4u*)(shr_ + SS_C + off_); pp[j_] = *(const GAS v4u*)(rec_ + SR_P + off_); pb[j_] = *(const GAS v4u*)(shr_ + SS_BT + off_); } \
        _Pragma("unroll") for (int j_ = 0; j_ < 2; ++j_) { const int off_ = ((r16 + 32 * j_) * 128 + c16 * 8) * 2; px1[j_] = *(const GAS v4u*)(rec_ + SR_X1 + off_); px2[j_] = *(const GAS v4u*)(rec_ + SR_X2 + off_); } \
        pea = ((const GAS float*)(rec_ + SR_EA))[tid & 127]; decn = *(const GAS float*)(rec_ + SR_DEC); } while (0)
#define SQ_STORE() do { \
        _Pragma("unroll") for (int j_ = 0; j_ < 4; ++j_) { const int off_ = (r16 + 32 * j_) * 272 + c16 * 16; *(LAS v4u*)(lds + SQ_C + off_) = pc[j_]; *(LAS v4u*)(lds + SQ_P + off_) = pp[j_]; *(LAS v4u*)(lds + SQ_BT + off_) = pb[j_]; } \
        _Pragma("unroll") for (int j_ = 0; j_ < 2; ++j_) { const int off_ = (r16 + 32 * j_) * 272 + c16 * 16; *(LAS v4u*)(lds + SQ_X1 + off_) = px1[j_]; *(LAS v4u*)(lds + SQ_X2 + off_) = px2[j_]; } \
        if (tid < 128) ((LAS float*)(lds + SQ_IMG + 4 * 4352))[tid] = pea; dec = decn; } while (0)
    __syncthreads();
    SQ_LOAD(0); SQ_STORE();
    __syncthreads();
#pragma unroll 1
    for (int cc = 0; cc < nch; ++cc) {
        const int ch = SCH(cc);
        if (cc + 1 < nch) SQ_LOAD(cc + 1);
        MEMBAR();
#pragma unroll
        for (int u = 0; u < 4; ++u) { v2u w; w.x = pk2(S[u][0], S[u][1]); w.y = pk2(S[u][2], S[u][3]); *(LAS v2u*)(simg + fr * 136 + 64 * hf + 16 * u + 4 * fq) = w; }
        WG_BAR();
        bf16x8 BS[4], BX1[4];
#pragma unroll
        for (int ks = 0; ks < 4; ++ks) { BS[ks] = *(const LAS bf16x8*)(simg + fr * 136 + ks * 32 + fq * 8);
            BX1[ks] = *(const LAS bf16x8*)(sX1 + (ps * 16 + fr) * 136 + ks * 32 + fq * 8); }
        int zl = 0; asm volatile("" : "+v"(zl));
        GAS float* syb = SY + ((size_t)dir * M + ch * 128 + 64 * hf + 4 * fq) * 512 + h * 64 + ps * 16 + fr + zl;
#pragma unroll
        for (int tp = 0; tp < 2; ++tp) {
            bf16x8 Cf[8], Pf[8];
#pragma unroll
            for (int t3 = 0; t3 < 2; ++t3) { const int t = 4 * hf + 2 * tp + t3;
#pragma unroll
                for (int ks = 0; ks < 4; ++ks) { Cf[t3 * 4 + ks] = *(const LAS bf16x8*)(sC + (16 * t + fr) * 136 + ks * 32 + fq * 8); Pf[t3 * 4 + ks] = *(const LAS bf16x8*)(sP + (16 * t + fr) * 136 + ks * 32 + fq * 8); } }
            MEMBAR();
#pragma unroll
            for (int t3 = 0; t3 < 2; ++t3) { const int t2 = 2 * tp + t3; f32x4 acc = (f32x4){0.f, 0.f, 0.f, 0.f};
#pragma unroll
                for (int ks = 0; ks < 4; ++ks) acc = __builtin_amdgcn_mfma_f32_16x16x32_bf16(Cf[t3 * 4 + ks], BS[ks], acc, 0, 0, 0);
                acc = acc * *(const LAS f32x4*)((const LAS float*)(lds + SQ_IMG + 4 * 4352) + 16 * (4 * hf + t2) + 4 * fq);
#pragma unroll
                for (int ks = 0; ks < 4; ++ks) acc = __builtin_amdgcn_mfma_f32_16x16x32_bf16(Pf[t3 * 4 + ks], BX1[ks], acc, 0, 0, 0);
#pragma unroll
                for (int r = 0; r < 4; ++r) syb[(size_t)(16 * t2 + r) * 512] = acc[r]; }
        }
        { bf16x8 Bf[16], BX2[4];
#pragma unroll
          for (int ks = 0; ks < 4; ++ks) BX2[ks] = *(const LAS bf16x8*)(sX2 + (ps * 16 + fr) * 136 + ks * 32 + fq * 8);
#pragma unroll
          for (int u = 0; u < 4; ++u)
#pragma unroll
              for (int ks = 0; ks < 4; ++ks) Bf[u * 4 + ks] = *(const LAS bf16x8*)(sBT + (64 * hf + 16 * u + fr) * 136 + ks * 32 + fq * 8);
          MEMBAR();
#pragma unroll
          for (int u = 0; u < 4; ++u) { f32x4 acc = S[u] * dec;
#pragma unroll
              for (int ks = 0; ks < 4; ++ks) acc = __builtin_amdgcn_mfma_f32_16x16x32_bf16(Bf[u * 4 + ks], BX2[ks], acc, 0, 0, 0);
              S[u] = acc; } }
        WG_BAR();
        if (cc + 1 < nch) SQ_STORE();
        WG_BAR();
    }
#undef SCH
#undef SQ_LOAD
#undef SQ_STORE
    if (!lat) {
#pragma unroll
        for (int u = 0; u < 4; ++u) *(GAS f32x4*)(A.out + O_SS + sidx + 16 * u) = S[u]; }
}
__device__ __forceinline__ void ph_ssd_seq(const Ctx& A, int l, LAS unsigned char* lds, int tid, int lane, int wave, int vcu, int G) {
    for (int k = 0; k < 544; ++k) {
        int q;
        if (G == 256) { if (vcu >= 240) q = -1; else if (vcu >= 208) q = k == 0 ? 512 + (vcu - 208) : (k == 1 ? vcu - 208 : -1); else { q = 32 + (vcu + 64) % 208 + 208 * k; if (q >= 512) q = -1; } }
        else { q = vcu + k * G; if (q >= 544) q = -1; }
        if (q < 0) break;
        const int lat = q >= 512, it = lat ? q - 512 : q;
        ssd_seq_wg(A, l, it >> 4, lat, (it >> 1) & 7, it & 1, lds, tid, lane, wave);
    }
}

#ifndef REP_ATTN
#define REP_ATTN 1
#endif
#ifndef REP_LOC
#define REP_LOC 1
#endif
#ifndef REP_LAT
#define REP_LAT 1
#endif
#ifndef REP_CTX
#define REP_CTX 1
#endif
#ifndef REP_MIX
#define REP_MIX 1
#endif
#ifndef REP_PRO
#define REP_PRO 1
#endif
#ifndef REP_EW
#define REP_EW 1
#endif
#ifndef REP_GEMM
#define REP_GEMM 1
#endif
#ifndef MK_ONE_LAUNCH
#define MK_ONE_LAUNCH 0
#endif
__device__ __forceinline__ int lane_now() { unsigned m_ = ~0u; asm volatile("" : "+s"(m_)); return (int)__builtin_amdgcn_mbcnt_hi(m_, __builtin_amdgcn_mbcnt_lo(m_, 0u)); }
#define TID_NOW() (wave0 * 64 + lane_now())
#define IN(k) (lo <= (k) && (k) < hi)
#ifndef REP_BAR
#define REP_BAR 1
#endif
#ifdef TPROBE
#define TS_ACC(k) do { if (blockIdx.x == 0 && wave0 == 0 && lane_now() == 0) { unsigned long long* ts_ = (unsigned long long*)(args.ws + WS_CTL + 65536); const unsigned long long t_ = __builtin_amdgcn_s_memrealtime(); \
        const int ty_ = ((k) == 0) ? 0 : 1 + (((k) - 1) % 11); ts_[1 + ty_] += t_ - ts_[0]; ts_[0] = t_; } } while (0)
#define SEAM(k) do { if (IN((k) + 1)) { xcd_barrier(bar); TS_ACC(k); } } while (0)
#define SUB0() const unsigned long long sub_t0_ = __builtin_amdgcn_s_memrealtime()
#define SUBT(slot) do { __syncthreads(); if (wave0 == 0 && lane_now() == 0) { unsigned long long* ts_ = (unsigned long long*)(args.ws + WS_CTL + 65536); \
        atomicMax(&ts_[32 + (slot) * 4 + l], __builtin_amdgcn_s_memrealtime() - sub_t0_); } } while (0)
#else
#define SUB0() do {} while (0)
#define SUBT(slot) do {} while (0)
#define SEAM(k) do { if (IN((k) + 1)) { for (int rb_ = 0; rb_ < REP_BAR; ++rb_) xcd_barrier(bar); } } while (0)
#endif
#define PHASE_ROOTS() Ctx C; int G = (int)gridDim.x, bx = (int)blockIdx.x; int tid = TID_NOW(); asm volatile("" : "+v"(tid)); const int lane = tid & 63, wave = __builtin_amdgcn_readfirstlane(tid >> 6); (void)lane; (void)wave; \
    { unsigned long long kp_ = (unsigned long long)__builtin_amdgcn_kernarg_segment_ptr(); float* o_ = args.out; unsigned char* w_ = args.ws; \
      asm volatile("" : "+s"(kp_), "+s"(o_), "+s"(w_), "+s"(G), "+s"(bx)); C.in = (kin_t)kp_; C.out = o_; C.ws = w_; } \
    const int vcu = (G % 8 == 0) ? (bx % 8) * (G / 8) + bx / 8 : bx; const int gw = vcu * NWAVES + wave, NGW = G * NWAVES; (void)gw; (void)NGW; (void)vcu


template <int L> __device__ __forceinline__ void layer_phases(const Args& args, LAS unsigned char* lds, const int wave0, const int lo0, const int hi0, const XcdBarrier& bar) {
    constexpr int l = L;
        const int pb = 1 + l * NPH_L;
        int lo = lo0, hi = hi0; asm volatile("" : "+s"(lo), "+s"(hi));
#define MODS_L ((const float*)(C.ws + WS_MODS) + (size_t)l * 3 * 12288)
#define WL ((const bf16*)(C.ws + WS_W) + (size_t)l * WLE_SIZE)
        if (IN(pb + 0)) { PHASE_ROOTS(); for (int rep = 0; rep < REP_EW; ++rep) ph_norm((bf16*)(C.ws + WS_X), C.in[8] + l * D, MODS_L, 0, (bf16*)(C.ws + WS_H), l > 0 ? (const float*)(C.ws + WS_PART) : (const float*)nullptr, MODS_L - 3 * 12288 + 5 * 2048, lane, gw, NGW); SEAM(pb + 0); }
        if (IN(pb + 1)) { PHASE_ROOTS();
            pg8::Gemm g{(const bf16*)(C.ws + WS_H), WL + WLE_IN, M, IN_WP, D}; pg8::InOrder S; S.init(M, G, bx);
            pg8::EpiU E{(bf16*)(C.ws + WS_U), IN_WP, (float*)(C.ws + WS_USIDE)};
            pg8::gemm_phase<pg8::EpiU, pg8::InOrder, true, true>(lds, g, S, E, tid);
            SEAM(pb + 1);
        }
        if (IN(pb + 2)) { PHASE_ROOTS();
#ifndef SKIP_PREP
            for (int rep = 0; rep < REP_EW; ++rep) ph_prep(C, l, lane, gw, NGW);
#endif
            SEAM(pb + 2); }
        if (IN(pb + 3)) {
            { PHASE_ROOTS(); pg8::Gemm g{(const bf16*)(C.ws + WS_CQN), WL + WLE_UQ, M, 1536, 768}; pg8::StaticOrder S; S.init(M, 1536, G - 32, bx < G - 32 ? bx : (1 << 20));
              pg8::EpiBf16 E{(bf16*)(C.ws + WS_QRAW), 1536};
              pg8::gemm_phase<pg8::EpiBf16, pg8::StaticOrder, true, true>(lds, g, S, E, tid); }
            { PHASE_ROOTS(); pg8::Gemm g{(const bf16*)(C.ws + WS_CKVN), WL + WLE_KV, MK, 1024, 512}; pg8::StaticOrder S; S.init(MK, 1024, G - 32, bx < G - 32 ? G - 33 - bx : (1 << 20));
              pg8::EpiBf16 E{(bf16*)(C.ws + WS_KN), 1024};
              pg8::gemm_phase<pg8::EpiBf16, pg8::StaticOrder, true, true>(lds, g, S, E, tid); }
            { PHASE_ROOTS(); pg8::Gemm g{WL + WLE_KV + (size_t)1024 * 512, (const bf16*)(C.ws + WS_CKVN), 1024, MK, 512}; pg8::StaticOrder S; S.init(1024, MK, G - 32, bx < G - 32 ? G - 33 - bx : (1 << 20));
              pg8::EpiBf16 E{(bf16*)(C.ws + WS_VT), MK};
              for (int rep = 0; rep < REP_GEMM; ++rep) pg8::gemm_phase<pg8::EpiBf16, pg8::StaticOrder, true, true>(lds, g, S, E, tid); }
            { PHASE_ROOTS(); pg8::Gemm g{(const bf16*)(C.ws + WS_H), WL + WLE_IN, M, IN_WP, D}; pg8::DeferOrder S{bx - (G - 32)};
              pg8::EpiU E{(bf16*)(C.ws + WS_U), IN_WP, (float*)(C.ws + WS_USIDE)};
              pg8::gemm_phase<pg8::EpiU, pg8::DeferOrder, true, true>(lds, g, S, E, tid); }
            SEAM(pb + 3);
        }
        if (IN(pb + 4)) { PHASE_ROOTS(); SUB0();
#ifndef SKIP_FIN
            ph_finalize(C, l, lds, tid, lane, gw, NGW);
#endif
            SUBT(3);
            for (int rep = 0; rep < REP_LOC; ++rep) { ph_gdn_local(C, l, lds, tid, lane, wave, vcu, G); SUBT(4);
            ph_ssd_local(C, l, lds, tid, lane, wave, vcu, G); SUBT(5); }
            SEAM(pb + 4); }
        if (IN(pb + 5)) { SUB0(); for (int rep = 0; rep < REP_MIX; ++rep) {
#ifndef SKIP_GDN
            { PHASE_ROOTS(); ph_gdn_seq(C, l, lds, tid, lane, wave, vcu, G); }
#endif
            SUBT(0);
            __syncthreads();
#ifndef SKIP_SSD
            { PHASE_ROOTS(); ph_ssd_seq(C, l, lds, tid, lane, wave, vcu, G); }
#endif
            SUBT(1);
            __syncthreads();
#ifndef SKIP_ATTN
            for (int rep2 = 0; rep2 < REP_ATTN; ++rep2) { PHASE_ROOTS(); ph_attn(C, l, lds, tid, lane, wave, vcu, G); }
#endif
            SUBT(2);
            __syncthreads(); }
            SEAM(pb + 5);
        }
        if (IN(pb + 6)) { PHASE_ROOTS();
#ifndef SKIP_POST
            for (int rep = 0; rep < REP_EW; ++rep) ph_post(C, l, lane, gw, NGW);
#endif
            SEAM(pb + 6); }
        if (IN(pb + 7)) { PHASE_ROOTS();
            { pg8::Gemm g{(const bf16*)(C.ws + WS_MIX), WL + WLE_OUT, M, D, D, 0}; pg8::PanelOrder S{bx};
              pg8::EpiResidT<false> E{(bf16*)(C.ws + WS_X), C.out, D, MODS_L + 2 * 2048};
              pg8::gemm_phase<pg8::EpiResidT<false>, pg8::PanelOrder, true, true>(lds, g, S, E, tid); }
            { PHASE_ROOTS(); pg8::Gemm g{(const bf16*)(C.ws + WS_MIX), WL + WLE_OUT, M, D, D / 4, D}; pg8::TailOrder S{bx, D / 4};
              pg8::EpiPart E{(bf16*)(C.ws + WS_PART), D / 4};
              pg8::gemm_phase<pg8::EpiPart, pg8::TailOrder, true, true>(lds, g, S, E, tid); }
            SEAM(pb + 7);
        }
        if (IN(pb + 8)) { PHASE_ROOTS(); for (int rep = 0; rep < REP_EW; ++rep) ph_norm((bf16*)(C.ws + WS_X), C.in[9] + l * D, MODS_L, 3, (bf16*)(C.ws + WS_H), (const float*)(C.ws + WS_PART), MODS_L + 2 * 2048, lane, gw, NGW); SEAM(pb + 8); }
        if (IN(pb + 9)) { PHASE_ROOTS();
            pg8::Gemm g{(const bf16*)(C.ws + WS_H), WL + WLE_GU, M, 2 * FF, D}; pg8::StaticOrder S; S.init(M, 2 * FF, G, bx);
            pg8::EpiSwiglu E{(bf16*)(C.ws + WS_ACT), FF};
            for (int rep = 0; rep < REP_GEMM; ++rep) pg8::gemm_phase<pg8::EpiSwiglu, pg8::StaticOrder, false, true>(lds, g, S, E, tid);
            SEAM(pb + 9);
        }
        if (IN(pb + 10)) { PHASE_ROOTS();
            { pg8::Gemm g{(const bf16*)(C.ws + WS_ACT), WL + WLE_DN, M, D, FF, 0}; pg8::PanelOrder S{bx};
              pg8::EpiResidT<(L == DEPTH - 1)> E{(bf16*)(C.ws + WS_X), C.out, D, MODS_L + 5 * 2048};
              pg8::gemm_phase<pg8::EpiResidT<(L == DEPTH - 1)>, pg8::PanelOrder, true, true>(lds, g, S, E, tid); }
            { PHASE_ROOTS(); pg8::Gemm g{(const bf16*)(C.ws + WS_ACT), WL + WLE_DN, M, D, FF / 4, FF}; pg8::TailOrder S{bx, FF / 4};
              pg8::EpiPart E{(bf16*)(C.ws + WS_PART), FF / 4};
              pg8::gemm_phase<pg8::EpiPart, pg8::TailOrder, true, true>(lds, g, S, E, tid); }
            SEAM(pb + 10);
        }
    }

__global__ void __launch_bounds__(NWAVES * 64, 2) mk_fwd(Args args) {
    extern __shared__ __attribute__((aligned(16))) unsigned char lds_raw[];
    LAS unsigned char* lds = (LAS unsigned char*)lds_raw;
    const int wave0 = __builtin_amdgcn_readfirstlane((int)threadIdx.x >> 6);
    for (int u = TID_NOW(); u < (LDS_BYTES - LDSCTL_OFF) / 4; u += NWAVES * 64) ((LAS unsigned*)(lds + LDSCTL_OFF))[u] = 0u;
    __syncthreads();
    const int lo0 = args.ph_lo, hi0 = args.ph_hi;
    XcdBarrier bar; bar.bar = (unsigned*)(args.ws + WS_CTL) + CW_BAR; bar.x = 0; bar.st = nullptr; bar.wv = wave0;
    if ((hi0 - lo0) > 1) bar = xcd_barrier_post((unsigned*)(args.ws + WS_CTL) + CW_BAR, (volatile LAS unsigned*)(lds + MISC_OFF) + 8); bar.wv = wave0;
#ifdef TPROBE
    if (blockIdx.x == 0 && wave0 == 0 && lane_now() == 0) { unsigned long long* ts_ = (unsigned long long*)(args.ws + WS_CTL + 65536); ts_[0] = __builtin_amdgcn_s_memrealtime(); ts_[20] = ts_[0]; }
#endif
    { int lo = lo0, hi = hi0;
    if (IN(0)) { for (int rep = 0; rep < REP_PRO; ++rep) { PHASE_ROOTS();
#ifndef SKIP_PRO
        ph_prologue(C, lds, tid, lane, wave, vcu, G);
#endif
        __syncthreads(); }
        SEAM(0); } }

    layer_phases<0>(args, lds, wave0, lo0, hi0, bar);
    layer_phases<1>(args, lds, wave0, lo0, hi0, bar);
    layer_phases<2>(args, lds, wave0, lo0, hi0, bar);
    layer_phases<3>(args, lds, wave0, lo0, hi0, bar);
    { int lo = lo0, hi = hi0; if (IN(NPHASES - 1)) { PHASE_ROOTS(); ph_final((const bf16*)(C.ws + WS_X), C.out, (const float*)(C.ws + WS_PART), (const float*)(C.ws + WS_MODS) + (size_t)3 * 3 * 12288 + 5 * 2048, lane, gw, NGW); } }
#ifdef TPROBE
    { xcd_barrier(bar);
      if (blockIdx.x == 0 && wave0 == 0 && lane_now() == 0) { unsigned long long* ts_ = (unsigned long long*)(args.ws + WS_CTL + 65536); const unsigned long long t_ = __builtin_amdgcn_s_memrealtime();
          ts_[1 + 12] += t_ - ts_[0]; const unsigned long long num_ = (TPROBE >= 20) ? (ts_[32 + (TPROBE - 20) * 4] + ts_[33 + (TPROBE - 20) * 4] + ts_[34 + (TPROBE - 20) * 4] + ts_[35 + (TPROBE - 20) * 4]) : ts_[1 + (TPROBE >= 20 ? 0 : TPROBE)]; const float share = (float)((double)num_ / (double)(t_ - ts_[20])); *(float*)(ts_ + 24) = share; }
      xcd_barrier(bar);
      const float sc = 1.0f + 1.0f * *(const float*)((unsigned long long*)(args.ws + WS_CTL + 65536) + 24);
      for (size_t i = (size_t)blockIdx.x * 512 + TID_NOW(); i < 2097152; i += (size_t)gridDim.x * 512) args.out[O_KR + i] *= sc; }
#endif
#undef IN
#undef SEAM
}

extern "C" void kernel_launch(void* const* d_in, const int* in_sizes, int n_in, void* d_out, int out_size, void* d_ws, size_t ws_size, hipStream_t stream) {
    static int grid = 0;
    if (grid == 0) {
        if (n_in != 32 || out_size != 73400320 || ws_size < WS_END) { fprintf(stderr, "kernel_launch: built for 32 inputs, 73400320 outputs, >= %zu bytes of workspace; got n_in %d, out %d, ws %zu; nothing launched\n", (size_t)WS_END, n_in, out_size, ws_size); grid = -1; return; }
        int dev = 0, cus = 0, per_cu = 0;
        if (hipGetDevice(&dev) != hipSuccess || hipDeviceGetAttribute(&cus, hipDeviceAttributeMultiprocessorCount, dev) != hipSuccess) { fprintf(stderr, "kernel_launch: device query failed\n"); grid = -1; return; }
        if (hipFuncSetAttribute((const void*)mk_fwd, hipFuncAttributeMaxDynamicSharedMemorySize, LDS_BYTES) != hipSuccess) { fprintf(stderr, "kernel_launch: hipFuncSetAttribute failed\n"); grid = -1; return; }
        if (hipOccupancyMaxActiveBlocksPerMultiprocessor(&per_cu, (const void*)mk_fwd, NWAVES * 64, LDS_BYTES) != hipSuccess || per_cu < 1)
            fprintf(stderr, "kernel_launch: note: occupancy query reports %d workgroups per CU\n", per_cu);
        (void)hipGetLastError();
        grid = cus;
    }
    if (grid < 0) return;
    if (hipMemsetAsync((char*)d_ws + WS_CTL, 0, CTL_ZERO_BYTES, stream) != hipSuccess) { fprintf(stderr, "kernel_launch: memset failed\n"); return; }
    Args a{};
    for (int i = 0; i < 32; ++i) a.in[i] = (const float*)d_in[i];
    a.out = (float*)d_out; a.ws = (unsigned char*)d_ws;
#if MK_ONE_LAUNCH
    a.ph_lo = 0; a.ph_hi = NPHASES;
    hipLaunchKernelGGL(mk_fwd, dim3(grid), dim3(NWAVES * 64), LDS_BYTES, stream, a);
#else
    for (int p = 0; p < NPHASES; ++p) { a.ph_lo = p; a.ph_hi = p + 1; hipLaunchKernelGGL(mk_fwd, dim3(grid), dim3(NWAVES * 64), LDS_BYTES, stream, a); }
#endif
    const hipError_t le = hipPeekAtLastError();
    if (le != hipSuccess) fprintf(stderr, "kernel_launch: launch failed: %s\n", hipGetErrorName(le));
}
```
